# Optimizing an MI355X kernel written in HIP

```python
import jax, jax.numpy as jnp
from jax import lax
import numpy as np

D_MODEL = 1024
BATCH = 4
SEQ = 8192
DEPTH = 2

RW_HEADS = 8
RW_HEAD_DIM = 64
RW_WIDTH = RW_HEADS * RW_HEAD_DIM
RW_DECAY_RANK = 64
RW_ICLR_RANK = 64
RW_GATE_RANK = 128
RW_COLS = 3 * RW_WIDTH + RW_DECAY_RANK + RW_ICLR_RANK + RW_GATE_RANK
RW_GN_EPS = 64e-5
RET_HEADS = 4
RET_QK_DIM = 64
RET_V_DIM = 128
RET_QK_WIDTH = RET_HEADS * RET_QK_DIM
RET_V_WIDTH = RET_HEADS * RET_V_DIM
RET_COLS = 2 * RET_QK_WIDTH + 2 * RET_V_WIDTH
RET_CHUNK = 128
ROPE_BASE = 10000.0
SG_GROUPS = 4
SG_CHUNK = 128
SG_WIDTH = 512
SG_GROUP_DIM = SG_WIDTH // SG_GROUPS
SG_COLS = 2 * SG_WIDTH
N_BRANCH = 3
BRANCH_WIDTH = 512
GATE_COLS = N_BRANCH * D_MODEL
IN_COLS = RW_COLS + RET_COLS + SG_COLS + GATE_COLS
D_FF = 2816
CONV_WIDTH = 3
EPS = 1e-6

kernel_name = "hybrid_rwkv7_retention_sgu_gated_merge"


def rmsnorm(x, g):
    xf = x.astype(jnp.float32)
    y = xf * lax.rsqrt(jnp.mean(xf * xf, axis=-1, keepdims=True) + EPS) * g.astype(jnp.float32)
    return y.astype(x.dtype)


def rwkv7_scan(r, w, k, v, kk, a):
    B, S, H, N = r.shape

    def step(state, inp):
        r_t, w_t, k_t, v_t, kk_t, a_t = inp
        sa = jnp.einsum('bhvk,bhk->bhv', state, -kk_t)
        state = (state * w_t[:, :, None, :]
                 + sa[..., None] * (kk_t * a_t)[:, :, None, :]
                 + v_t[..., None] * k_t[:, :, None, :])
        y = jnp.einsum('bhvk,bhk->bhv', state, r_t)
        return state, y

    xs = tuple(jnp.moveaxis(t.astype(jnp.float32), 1, 0) for t in (r, w, k, v, kk, a))
    s0 = jnp.zeros((B, H, N, N), jnp.float32)
    _, ys = lax.scan(step, s0, xs)
    return jnp.moveaxis(ys, 0, 1)


def rwkv7_branch(p, mu, w0, w_up, a0, a_up, g_up, k_k, k_a, r_k, lnx_g, lnx_b):
    B, S, _ = p.shape
    p_prev = jnp.pad(p, ((0, 0), (1, 0), (0, 0)))[:, :S]
    p = p + mu * (p_prev - p)
    cuts = [RW_WIDTH, 2 * RW_WIDTH, 3 * RW_WIDTH, 3 * RW_WIDTH + RW_DECAY_RANK,
            3 * RW_WIDTH + RW_DECAY_RANK + RW_ICLR_RANK]
    r, k, v, wd, ad, gd = jnp.split(p, cuts, axis=-1)
    w = -jax.nn.softplus(-(w0 + jnp.tanh(wd) @ w_up)) - 0.5
    decay = jnp.exp(-jnp.exp(w.astype(jnp.float32)))
    a = jax.nn.sigmoid(a0 + ad @ a_up)
    g = jax.nn.sigmoid(gd) @ g_up
    kk = (k * k_k).astype(jnp.float32)
    k = k * (1.0 + (a - 1.0) * k_a)

    def heads(t):
        return t.reshape(B, S, RW_HEADS, RW_HEAD_DIM)

    r, k, v, decay, a, kk = map(heads, (r, k, v, decay, a, kk))
    kk = kk / jnp.maximum(jnp.sqrt(jnp.sum(kk * kk, axis=-1, keepdims=True)), 1e-12)
    y = rwkv7_scan(r, decay, k, v, kk, a)
    mean = jnp.mean(y, axis=-1, keepdims=True)
    var = jnp.mean(jnp.square(y - mean), axis=-1, keepdims=True)
    y = (y - mean) * lax.rsqrt(var + RW_GN_EPS) * lnx_g + lnx_b
    y = y + jnp.sum(r * k * r_k, axis=-1, keepdims=True) * v
    return (y.reshape(B, S, RW_WIDTH) * g).astype(p.dtype)


def rotary(t, cos, sin):
    t1, t2 = jnp.split(t, 2, axis=-1)
    c = cos[None, :, None, :]
    s = sin[None, :, None, :]
    return jnp.concatenate([t1 * c - t2 * s, t2 * c + t1 * s], axis=-1)


def retention_branch(p, cos, sin):
    B, S, _ = p.shape
    nC = S // RET_CHUNK
    q, k, v, g = jnp.split(p, [RET_QK_WIDTH, 2 * RET_QK_WIDTH, 2 * RET_QK_WIDTH + RET_V_WIDTH], axis=-1)
    q = rotary(q.reshape(B, S, RET_HEADS, RET_QK_DIM), cos, sin)
    k = rotary(k.reshape(B, S, RET_HEADS, RET_QK_DIM), cos, sin) * (RET_QK_DIM ** -0.5)
    v = v.reshape(B, S, RET_HEADS, RET_V_DIM)

    def chunks(t):
        return t.reshape(B, nC, RET_CHUNK, RET_HEADS, t.shape[-1]).transpose(0, 3, 1, 2, 4)

    qc, kc, vc = chunks(q), chunks(k), chunks(v)
    log_gamma = jnp.log(1.0 - 2.0 ** (-5.0 - jnp.arange(RET_HEADS, dtype=jnp.float32)))
    pos = jnp.arange(RET_CHUNK, dtype=jnp.float32)
    diff = pos[:, None] - pos[None, :]
    decay_in = jnp.where(diff[None] >= 0,
                         jnp.exp(jnp.maximum(diff, 0.0)[None] * log_gamma[:, None, None]), 0.0)
    scores = jnp.einsum('bhnid,bhnjd->bhnij', qc, kc) * decay_in[:, None]
    inner = jnp.einsum('bhnij,bhnje->bhnie', scores, vc)
    k_dec = jnp.exp((RET_CHUNK - 1.0 - pos)[None] * log_gamma[:, None])
    kv = jnp.einsum('bhnjd,bhnje,hj->nbhde', kc, vc, k_dec).astype(jnp.float32)
    chunk_decay = jnp.exp(RET_CHUNK * log_gamma)[None, :, None, None]

    def step(R, kv_n):
        return R * chunk_decay + kv_n, R

    _, R_prev = lax.scan(step, jnp.zeros((B, RET_HEADS, RET_QK_DIM, RET_V_DIM), jnp.float32), kv)
    q_dec = jnp.exp((pos + 1.0)[None] * log_gamma[:, None])
    cross = jnp.einsum('bhnid,nbhde,hi->bhnie', qc, R_prev, q_dec)
    y = (inner + cross).transpose(0, 2, 3, 1, 4).reshape(B, S, RET_HEADS, RET_V_DIM)
    y = y * lax.rsqrt(jnp.mean(y * y, axis=-1, keepdims=True) + EPS)
    return (y.reshape(B, S, RET_V_WIDTH) * jax.nn.silu(g)).astype(p.dtype)


def sgu_branch(p, ln_g, ln_b, w_s, b_s):
    B, S, _ = p.shape
    nC = S // SG_CHUNK
    z = jax.nn.gelu(p, approximate=False)
    u, v = jnp.split(z, 2, axis=-1)
    vf = v.astype(jnp.float32)
    mean = jnp.mean(vf, axis=-1, keepdims=True)
    var = jnp.mean(jnp.square(vf - mean), axis=-1, keepdims=True)
    v = ((vf - mean) * lax.rsqrt(var + EPS) * ln_g + ln_b).astype(p.dtype)
    vc = v.reshape(B, nC, SG_CHUNK, SG_GROUPS, SG_GROUP_DIM)
    causal = jnp.tril(jnp.ones((SG_CHUNK, SG_CHUNK), dtype=bool))
    w = jnp.where(causal[None], w_s, 0.0)
    mixed = jnp.einsum('gij,bnjgd->bnigd', w, vc) + b_s.T[:, :, None]
    return u * mixed.reshape(B, S, SG_WIDTH)


def conv_ffn(h, w_up, conv_w, conv_b, w_down):
    S = h.shape[1]
    u = h @ w_up
    up = jnp.pad(u, ((0, 0), (CONV_WIDTH - 1, 0), (0, 0)))
    c = conv_b
    for j in range(CONV_WIDTH):
        c = c + conv_w[j] * up[:, j:j + S]
    gate, val = jnp.split(c, 2, axis=-1)
    return (jax.nn.silu(gate) * val) @ w_down


def _normal(k, shape, scale):
    return scale * jax.random.normal(k, shape, jnp.float32)


def setup_inputs(seed: int = 0) -> dict:
    key = jax.random.key(seed)
    ks = jax.random.split(key, 32)
    L = DEPTH
    f32 = jnp.float32
    return {
        "x": jax.random.normal(ks[0], (BATCH, SEQ, D_MODEL), f32),
        "norm1_g": 1.0 + _normal(ks[1], (L, D_MODEL), 0.05),
        "w_in": _normal(ks[2], (L, D_MODEL, IN_COLS), D_MODEL ** -0.5),
        "rw_mu": jax.random.uniform(ks[3], (L, RW_COLS), f32),
        "rw_w0": jax.random.uniform(ks[4], (L, RW_WIDTH), f32, -6.0, 1.0),
        "rw_w_up": _normal(ks[5], (L, RW_DECAY_RANK, RW_WIDTH), 0.1 * RW_DECAY_RANK ** -0.5),
        "rw_a0": _normal(ks[6], (L, RW_WIDTH), 0.1),
        "rw_a_up": _normal(ks[7], (L, RW_ICLR_RANK, RW_WIDTH), 0.3 * RW_ICLR_RANK ** -0.5),
        "rw_g_up": _normal(ks[8], (L, RW_GATE_RANK, RW_WIDTH), RW_GATE_RANK ** -0.5),
        "rw_k_k": 0.85 + _normal(ks[9], (L, RW_WIDTH), 0.05),
        "rw_k_a": 1.0 + _normal(ks[10], (L, RW_WIDTH), 0.05),
        "rw_r_k": _normal(ks[11], (L, RW_HEADS, RW_HEAD_DIM), 0.1),
        "rw_lnx_g": 1.0 + _normal(ks[12], (L, RW_HEADS, RW_HEAD_DIM), 0.05),
        "rw_lnx_b": _normal(ks[13], (L, RW_HEADS, RW_HEAD_DIM), 0.02),
        "sg_ln_g": 1.0 + _normal(ks[14], (L, SG_WIDTH), 0.05),
        "sg_ln_b": _normal(ks[15], (L, SG_WIDTH), 0.02),
        "sg_w_s": _normal(ks[16], (L, SG_GROUPS, SG_CHUNK, SG_CHUNK), SG_CHUNK ** -0.5),
        "sg_b": 1.0 + _normal(ks[17], (L, SG_GROUPS, SG_CHUNK), 0.1),
        "w_branch": _normal(ks[18], (L, N_BRANCH, BRANCH_WIDTH, D_MODEL), BRANCH_WIDTH ** -0.5),
        "w_out": _normal(ks[19], (L, D_MODEL, D_MODEL), 0.5 * D_MODEL ** -0.5),
        "norm2_g": 1.0 + _normal(ks[20], (L, D_MODEL), 0.05),
        "ffn_w_up": _normal(ks[21], (L, D_MODEL, 2 * D_FF), D_MODEL ** -0.5),
        "ffn_conv_w": _normal(ks[22], (L, CONV_WIDTH, 2 * D_FF), CONV_WIDTH ** -0.5),
        "ffn_conv_b": _normal(ks[23], (L, 2 * D_FF), 0.02),
        "ffn_w_down": _normal(ks[24], (L, D_FF, D_MODEL), 0.5 * D_FF ** -0.5),
        "final_g": 1.0 + _normal(ks[25], (D_MODEL,), 0.05),
    }


def reference(x, norm1_g, w_in, rw_mu, rw_w0, rw_w_up, rw_a0, rw_a_up, rw_g_up, rw_k_k, rw_k_a,
              rw_r_k, rw_lnx_g, rw_lnx_b, sg_ln_g, sg_ln_b, sg_w_s, sg_b, w_branch, w_out,
              norm2_g, ffn_w_up, ffn_conv_w, ffn_conv_b, ffn_w_down, final_g):
    B, S, _ = x.shape
    inv_freq = 1.0 / (ROPE_BASE ** jnp.linspace(0.0, 1.0, RET_QK_DIM // 2, dtype=jnp.float32))
    ang = jnp.arange(S, dtype=jnp.float32)[:, None] * inv_freq[None, :]
    cos, sin = jnp.cos(ang), jnp.sin(ang)
    in_cuts = [RW_COLS, RW_COLS + RET_COLS, RW_COLS + RET_COLS + SG_COLS]
    for l in range(DEPTH):
        h = rmsnorm(x, norm1_g[l])
        p = h @ w_in[l]
        p_rw, p_ret, p_sg, gate_logits = jnp.split(p, in_cuts, axis=-1)
        y_rw = rwkv7_branch(p_rw, rw_mu[l], rw_w0[l], rw_w_up[l], rw_a0[l], rw_a_up[l], rw_g_up[l],
                            rw_k_k[l], rw_k_a[l], rw_r_k[l], rw_lnx_g[l], rw_lnx_b[l])
        y_ret = retention_branch(p_ret, cos, sin)
        y_sg = sgu_branch(p_sg, sg_ln_g[l], sg_ln_b[l], sg_w_s[l], sg_b[l])
        branches = jnp.stack([y_rw, y_ret, y_sg], axis=2)
        proj = jnp.einsum('bsgc,gcd->bsgd', branches, w_branch[l])
        gates = jax.nn.sigmoid(gate_logits.reshape(B, S, N_BRANCH, D_MODEL))
        x = x + jnp.sum(gates * proj, axis=2) @ w_out[l]
        x = x + conv_ffn(rmsnorm(x, norm2_g[l]), ffn_w_up[l], ffn_conv_w[l], ffn_conv_b[l], ffn_w_down[l])
    return rmsnorm(x, final_g)
```

```cpp
#include <hip/hip_runtime.h>
#include <hip/hip_cooperative_groups.h>
#include <cstdio>
#include <cstdint>
namespace cg = cooperative_groups;

#ifndef COOP
#define COOP 1
#endif

#define DEV __device__ __forceinline__
typedef unsigned short u16;
typedef short bf16x8 __attribute__((ext_vector_type(8)));
typedef float f32x16 __attribute__((ext_vector_type(16)));

#define NTHR 512
#define NTOK 32768
#define SEQ 8192
#define DM 1024
#define INC 7424
#define DFF 2816
#define MiB (1048576ull)

#define OFF_ROPE (64ull * 1024)
#define OFF_RSTD (OFF_ROPE + 2 * MiB)
#define OFF_PF (OFF_RSTD + 640ull * 1024)
#define OFF_W (3 * MiB)
#define LW_BYTES (37 * MiB)
#define W_IN 0ull
#define W_BR 15204352ull
#define W_OUT 18350080ull
#define W_UP 20447232ull
#define W_DN 31981568ull
#define W_RWUP 37748736ull
#define W_RAUP 37814272ull
#define W_RGUP 37879808ull
#define W_SGW 38010880ull
#define OFF_XB (77 * MiB)
#define OFF_BIG (141 * MiB)
#define B_PRW 0ull
#define B_YRW 0ull
#define B_YRET (32 * MiB)
#define B_YSG (64 * MiB)
#define B_OPS (112 * MiB)
#define B_PRS (112 * MiB)
#define B_KV (272 * MiB)
#define B_M (112 * MiB)
#define B_PL (304 * MiB)
#define B_SINIT (320 * MiB)
#define B_ACT 0ull
#define WS_NEED (OFF_BIG + 328 * MiB)

struct Params {
  const float* in[26];
  float* out;
  unsigned char* ws;
};

DEV int my_tid() {
  int t = __builtin_amdgcn_workitem_id_x();
  asm volatile("" : "+v"(t));
  return t;
}
DEV u16 f2bf(float f) {
  unsigned u = __float_as_uint(f);
  u += 0x7fffu + ((u >> 16) & 1u);
  return (u16)(u >> 16);
}
DEV float bf2f(u16 h) { return __uint_as_float(((unsigned)h) << 16); }
DEV unsigned pack2(float a, float b) { return (unsigned)f2bf(a) | ((unsigned)f2bf(b) << 16); }
DEV void unpack8(uint4 v, float* f) {
  f[0] = __uint_as_float(v.x << 16); f[1] = __uint_as_float(v.x & 0xffff0000u);
  f[2] = __uint_as_float(v.y << 16); f[3] = __uint_as_float(v.y & 0xffff0000u);
  f[4] = __uint_as_float(v.z << 16); f[5] = __uint_as_float(v.z & 0xffff0000u);
  f[6] = __uint_as_float(v.w << 16); f[7] = __uint_as_float(v.w & 0xffff0000u);
}
DEV uint4 pack8(const float* f) {
  return make_uint4(pack2(f[0], f[1]), pack2(f[2], f[3]), pack2(f[4], f[5]), pack2(f[6], f[7]));
}
template <int CTRL>
DEV float dppmov(float x) {
  return __builtin_bit_cast(float, __builtin_amdgcn_update_dpp(0, __builtin_bit_cast(int, x), CTRL, 0xF, 0xF, true));
}
DEV float red4(float x) { x += dppmov<0xB1>(x); x += dppmov<0x4E>(x); return x; }
DEV float red8(float x) { x = red4(x); x += dppmov<0x141>(x); return x; }
DEV float wave_sum(float x) {
  x = red8(x);
  x += dppmov<0x140>(x);
  const int xi = __builtin_bit_cast(int, x);
  return __builtin_bit_cast(float, __builtin_amdgcn_readlane(xi, 0)) + __builtin_bit_cast(float, __builtin_amdgcn_readlane(xi, 16)) +
         __builtin_bit_cast(float, __builtin_amdgcn_readlane(xi, 32)) + __builtin_bit_cast(float, __builtin_amdgcn_readlane(xi, 48));
}
DEV float sigmoidf_(float x) { return 1.f / (1.f + __expf(-x)); }
DEV float siluf_(float x) { return x / (1.f + __expf(-x)); }
DEV float geluf_(float x) { return 0.5f * x * (1.f + erff(x * 0.70710678118654752f)); }

DEV float rstd_of(const float* ssq, int row) { return rsqrtf(ssq[row] * (1.0f / DM) + 1e-6f); }
DEV int vbid(int bid, int nb) { return ((nb & 7) == 0) ? (bid & 7) * (nb >> 3) + (bid >> 3) : bid; }
DEV void tile_map(int t, int MTL, int NTL, int& m, int& n) {
  int per = 8 * NTL;
  int g = t / per;
  int r = t - g * per;
  int gm = MTL - g * 8; gm = gm > 8 ? 8 : gm;
  m = g * 8 + r % gm;
  n = r / gm;
}

typedef unsigned u32x4 __attribute__((ext_vector_type(4)));
template <int NA>
struct GStage { u32x4 a0, a1, a2, a3, b0, b1; };
DEV u32x4 g_ld_a(const u16* A, long lda, int g, int azero_below, int arow_max, int ko) {
  const bool z = g < azero_below;
  g = g < 0 ? 0 : g;
  g = g > arow_max ? arow_max : g;
  u32x4 v = *(const u32x4*)(A + (long)g * lda + ko);
  const u32x4 zero = {0u, 0u, 0u, 0u};
  return z ? zero : v;
}
template <int NA>
DEV void g_load(GStage<NA>& S, const u16* A, long lda, int arow, int azero_below, int arow_max,
                const u16* bp0, const u16* bp1, int ko) {
  S.a0 = g_ld_a(A, lda, arow, azero_below, arow_max, ko);
  S.a1 = g_ld_a(A, lda, arow + 64, azero_below, arow_max, ko);
  if constexpr (NA == 4) {
    S.a2 = g_ld_a(A, lda, arow + 128, azero_below, arow_max, ko);
    S.a3 = g_ld_a(A, lda, arow + 192, azero_below, arow_max, ko);
  }
  S.b0 = *(const u32x4*)(bp0 + ko);
  S.b1 = *(const u32x4*)(bp1 + ko);
}
template <int NA>
DEV void g_store(const GStage<NA>& S, u16* An, u16* Bn, int st_off) {
  *(u32x4*)(An + st_off) = S.a0;
  *(u32x4*)(An + st_off + 64 * 72) = S.a1;
  if constexpr (NA == 4) {
    *(u32x4*)(An + st_off + 128 * 72) = S.a2;
    *(u32x4*)(An + st_off + 192 * 72) = S.a3;
  }
  *(u32x4*)(Bn + st_off) = S.b0;
  *(u32x4*)(Bn + st_off + 64 * 72) = S.b1;
}
template <int MT>
DEV void g_compute(f32x16 (&acc)[MT][2], const u16* Ab, const u16* Bb) {
#pragma unroll
  for (int ks = 0; ks < 4; ++ks) {
    bf16x8 a[MT], b[2];
#pragma unroll
    for (int i = 0; i < MT; ++i) a[i] = *(const bf16x8*)(Ab + i * 32 * 72 + ks * 16);
#pragma unroll
    for (int j = 0; j < 2; ++j) b[j] = *(const bf16x8*)(Bb + j * 32 * 72 + ks * 16);
#pragma unroll
    for (int i = 0; i < MT; ++i)
#pragma unroll
      for (int j = 0; j < 2; ++j) acc[i][j] = __builtin_amdgcn_mfma_f32_32x32x16_bf16(a[i], b[j], acc[i][j], 0, 0, 0);
  }
}
template <int MT>
DEV void gemm_tile(f32x16 (&acc)[MT][2], const u16* A, long lda, int arow0, int azero_below, int arow_max,
                   const u16* B, long ldb, int K, u16* smem) {
  constexpr int TM = 128 * MT;
  constexpr int ASZ = TM * 72, BSZ = 128 * 72;
  constexpr int NA = TM / 64;
  const int tid = my_tid(), lane = tid & 63, wave = tid >> 6, wm = wave >> 1, wn = wave & 1;
  const int crow = tid >> 3, ckc = tid & 7;
  GStage<NA> s0, s1;
  const u16* Ak = A + ckc * 8;
  const int arow = arow0 + crow;
  const u16* bp0 = B + (long)crow * ldb + ckc * 8;
  const u16* bp1 = B + (long)(crow + 64) * ldb + ckc * 8;
  const int nk = K >> 6;
  const int arow_l = (wm * 32 * MT + (lane & 31)) * 72 + (lane >> 5) * 8;
  const int brow_l = (wn * 64 + (lane & 31)) * 72 + (lane >> 5) * 8;
  const int st_off = crow * 72 + ckc * 8;
  g_load<NA>(s0, Ak, lda, arow, azero_below, arow_max, bp0, bp1, 0);
  g_store<NA>(s0, smem, smem + ASZ, st_off);
  g_load<NA>(s1, Ak, lda, arow, azero_below, arow_max, bp0, bp1, 64);
  __syncthreads();
  for (int kt = 0; kt < nk; kt += 2) {
    if (kt + 2 < nk) g_load<NA>(s0, Ak, lda, arow, azero_below, arow_max, bp0, bp1, (kt + 2) * 64);
    g_compute<MT>(acc, smem + arow_l, smem + ASZ + brow_l);
    g_store<NA>(s1, smem + (ASZ + BSZ), smem + (ASZ + BSZ) + ASZ, st_off);
    __syncthreads();
    if (kt + 3 < nk) g_load<NA>(s1, Ak, lda, arow, azero_below, arow_max, bp0, bp1, (kt + 3) * 64);
    g_compute<MT>(acc, smem + (ASZ + BSZ) + arow_l, smem + (ASZ + BSZ) + ASZ + brow_l);
    if (kt + 2 < nk) g_store<NA>(s0, smem, smem + ASZ, st_off);
    __syncthreads();
  }
}
struct GStageB { u32x4 a0, a1, a2, a3, b0, b1, b2, b3; };
DEV const u16* g_rowptr(const u16* A, long lda, int g, int arow_max) {
  g = g < 0 ? 0 : g;
  g = g > arow_max ? arow_max : g;
  return A + (long)g * lda;
}
DEV void gb_load(GStageB& S, const u16* A, long lda, int arow, int arow_max, const u16* Bk, long ldb, int ko) {
  S.a0 = *(const u32x4*)(g_rowptr(A, lda, arow, arow_max) + ko);
  S.a1 = *(const u32x4*)(g_rowptr(A, lda, arow + 64, arow_max) + ko);
  S.a2 = *(const u32x4*)(g_rowptr(A, lda, arow + 128, arow_max) + ko);
  S.a3 = *(const u32x4*)(g_rowptr(A, lda, arow + 192, arow_max) + ko);
  S.b0 = *(const u32x4*)(Bk + ko);
  S.b1 = *(const u32x4*)(Bk + 64 * ldb + ko);
  S.b2 = *(const u32x4*)(Bk + 128 * ldb + ko);
  S.b3 = *(const u32x4*)(Bk + 192 * ldb + ko);
}
DEV void gb_store(const GStageB& S, u16* An, u16* Bn, int st_off, int arow, int azero_below) {
  const u32x4 zero = {0u, 0u, 0u, 0u};
  *(u32x4*)(An + st_off) = (arow < azero_below) ? zero : S.a0;
  *(u32x4*)(An + st_off + 64 * 72) = (arow + 64 < azero_below) ? zero : S.a1;
  *(u32x4*)(An + st_off + 128 * 72) = (arow + 128 < azero_below) ? zero : S.a2;
  *(u32x4*)(An + st_off + 192 * 72) = (arow + 192 < azero_below) ? zero : S.a3;
  *(u32x4*)(Bn + st_off) = S.b0;
  *(u32x4*)(Bn + st_off + 64 * 72) = S.b1;
  *(u32x4*)(Bn + st_off + 128 * 72) = S.b2;
  *(u32x4*)(Bn + st_off + 192 * 72) = S.b3;
}
DEV void gb_compute(f32x16 (&acc)[2][4], const u16* Ab, const u16* Bb) {
#pragma unroll
  for (int ks = 0; ks < 4; ++ks) {
    bf16x8 a[2], b[4];
#pragma unroll
    for (int i = 0; i < 2; ++i) a[i] = *(const bf16x8*)(Ab + i * 32 * 72 + ks * 16);
#pragma unroll
    for (int j = 0; j < 4; ++j) b[j] = *(const bf16x8*)(Bb + j * 32 * 72 + ks * 16);
#pragma unroll
    for (int i = 0; i < 2; ++i)
#pragma unroll
      for (int j = 0; j < 4; ++j) acc[i][j] = __builtin_amdgcn_mfma_f32_32x32x16_bf16(a[i], b[j], acc[i][j], 0, 0, 0);
  }
}
DEV void gemm_big(f32x16 (&acc)[2][4], const u16* A, long lda, int arow0, int azero_below, int arow_max,
                  const u16* B, long ldb, int K, u16* smem) {
  constexpr int ASZ = 256 * 72, BSZ = 256 * 72;
  const int tid = my_tid(), lane = tid & 63, wave = tid >> 6, wm = wave >> 1, wn = wave & 1;
  const int crow = tid >> 3, ckc = tid & 7;
  const u16* Ak = A + ckc * 8;
  const int arow = arow0 + crow;
  const u16* Bk = B + (long)crow * ldb + ckc * 8;
  const int nk = K >> 6;
  const int arow_l = (wm * 64 + (lane & 31)) * 72 + (lane >> 5) * 8;
  const int brow_l = (wn * 128 + (lane & 31)) * 72 + (lane >> 5) * 8;
  const int st_off = crow * 72 + ckc * 8;
  GStageB s;
  gb_load(s, Ak, lda, arow, arow_max, Bk, ldb, 0);
  gb_store(s, smem, smem + ASZ, st_off, arow, azero_below);
  __syncthreads();
  for (int kt = 0; kt < nk; ++kt) {
    const bool more = kt + 1 < nk;
    if (more) gb_load(s, Ak, lda, arow, arow_max, Bk, ldb, (kt + 1) * 64);
    __builtin_amdgcn_sched_barrier(0);
    const u16* cb = smem + (kt & 1) * (ASZ + BSZ);
    gb_compute(acc, cb + arow_l, cb + ASZ + brow_l);
    __builtin_amdgcn_sched_barrier(0);
    if (more) {
      u16* nb_ = smem + ((kt + 1) & 1) * (ASZ + BSZ);
      gb_store(s, nb_, nb_ + ASZ, st_off, arow, azero_below);
    }
    __syncthreads();
  }
}
#define BIG_ROW(i, e) (wm * 64 + (i) * 32 + ((e) & 3) + 8 * ((e) >> 2) + 4 * (lane >> 5))
#define BIG_COL(j) (wn * 128 + (j) * 32 + (lane & 31))
#define ZERO_BIG(acc)                                   \
  _Pragma("unroll") for (int i_ = 0; i_ < 2; ++i_)      \
  _Pragma("unroll") for (int j_ = 0; j_ < 4; ++j_)      \
  _Pragma("unroll") for (int e_ = 0; e_ < 16; ++e_) acc[i_][j_][e_] = 0.f;

#define ACC_ROW(MT_, i, e) (wm * 32 * (MT_) + (i) * 32 + ((e) & 3) + 8 * ((e) >> 2) + 4 * (lane >> 5))
#define ACC_COL(j) (wn * 64 + (j) * 32 + (lane & 31))

DEV void tconv(const float* src, int K, int N, u16* dst, const float* scale, int mode, float* t, int bid, int nb) {
  const int tid = my_tid();
  const int KT = K >> 6, NT = N >> 6;
  for (int tt = bid; tt < KT * NT; tt += nb) {
    const int kt = tt % KT, nt = tt / KT;
    const int k0 = kt * 64, n0 = nt * 64;
    int sn0 = n0;
    if (mode == 1) { int j = n0 >> 8, c = n0 & 255; sn0 = (c < 128) ? (j * 128 + c) : (DFF + j * 128 + c - 128); }
    {
      const int kk = tid >> 6, n = tid & 63;
#pragma unroll
      for (int i = 0; i < 8; ++i) {
        int k = kk + 8 * i;
        float v = src[(long)(k0 + k) * N + sn0 + n];
        if (scale) v *= scale[k0 + k];
        t[k * 65 + n] = v;
      }
    }
    __syncthreads();
    {
      const int n = tid >> 3, k8 = tid & 7;
      float f[8];
#pragma unroll
      for (int j = 0; j < 8; ++j) f[j] = t[(k8 * 8 + j) * 65 + n];
      *(uint4*)(dst + (long)(n0 + n) * K + k0 + k8 * 8) = pack8(f);
    }
    __syncthreads();
  }
}

DEV void phase_prep(const Params& p, float* smf, int bid, int nb) {
  for (int l = 0; l < 2; ++l) {
    unsigned char* W = p.ws + OFF_W + (size_t)l * LW_BYTES;
    tconv(p.in[2] + (size_t)l * DM * INC, DM, INC, (u16*)(W + W_IN), p.in[1] + l * DM, 0, smf, bid, nb);
    for (int g = 0; g < 3; ++g)
      tconv(p.in[18] + (size_t)(l * 3 + g) * 512 * DM, 512, DM, (u16*)(W + W_BR) + (size_t)g * DM * 512, nullptr, 0, smf, bid, nb);
    tconv(p.in[19] + (size_t)l * DM * DM, DM, DM, (u16*)(W + W_OUT), nullptr, 0, smf, bid, nb);
    tconv(p.in[21] + (size_t)l * DM * 2 * DFF, DM, 2 * DFF, (u16*)(W + W_UP), p.in[20] + l * DM, 1, smf, bid, nb);
    tconv(p.in[24] + (size_t)l * DFF * DM, DFF, DM, (u16*)(W + W_DN), nullptr, 0, smf, bid, nb);
    tconv(p.in[5] + (size_t)l * 64 * 512, 64, 512, (u16*)(W + W_RWUP), nullptr, 0, smf, bid, nb);
    tconv(p.in[7] + (size_t)l * 64 * 512, 64, 512, (u16*)(W + W_RAUP), nullptr, 0, smf, bid, nb);
    tconv(p.in[8] + (size_t)l * 128 * 512, 128, 512, (u16*)(W + W_RGUP), nullptr, 0, smf, bid, nb);
    const float* sw = p.in[16] + (size_t)l * 4 * 128 * 128;
    u16* sd = (u16*)(W + W_SGW);
    for (int idx = bid * NTHR + my_tid(); idx < 4 * 128 * 128; idx += nb * NTHR) {
      int i = (idx >> 7) & 127, j = idx & 127;
      sd[idx] = f2bf(j <= i ? sw[idx] : 0.f);
    }
  }
  {
    float* sq = (float*)(p.ws + OFF_RSTD) + NTOK;
    for (int idx = bid * NTHR + my_tid(); idx < 3 * NTOK; idx += nb * NTHR) sq[idx] = 0.f;
  }
  float* rc = (float*)(p.ws + OFF_ROPE);
  float* rs = rc + SEQ * 32;
  for (int idx = bid * NTHR + my_tid(); idx < SEQ * 32; idx += nb * NTHR) {
    int pos = idx >> 5, d = idx & 31;
    float lin = (d == 31) ? 1.0f : (float)d * (1.0f / 31.0f);
    float invf = 1.0f / powf(10000.0f, lin);
    float ang = (float)pos * invf;
    double rev = (double)ang * 0.15915494309189533577;
    float fr = (float)(rev - floor(rev));
    rc[idx] = __builtin_amdgcn_cosf(fr);
    rs[idx] = __builtin_amdgcn_sinf(fr);
  }
}

DEV void phase_norm(const float* x, u16* xb, float* rstd, int bid, int nb) {
  const int lane = my_tid() & 63, wave = my_tid() >> 6;
  for (int row = bid * 8 + wave; row < NTOK; row += nb * 8) {
    const float4* xr = (const float4*)(x + (size_t)row * DM);
    float4 v[4];
    float ss = 0.f;
#pragma unroll
    for (int i = 0; i < 4; ++i) {
      v[i] = xr[lane + 64 * i];
      ss += v[i].x * v[i].x + v[i].y * v[i].y + v[i].z * v[i].z + v[i].w * v[i].w;
    }
    ss = wave_sum(ss);
    if (lane == 0) rstd[row] = ss;
    uint2* o = (uint2*)(xb + (size_t)row * DM);
#pragma unroll
    for (int i = 0; i < 4; ++i) o[lane + 64 * i] = make_uint2(pack2(v[i].x, v[i].y), pack2(v[i].z, v[i].w));
  }
}
DEV void phase_final(float* x, const float* g, int bid, int nb) {
  const int lane = my_tid() & 63, wave = my_tid() >> 6;
  for (int row = bid * 8 + wave; row < NTOK; row += nb * 8) {
    float4* xr = (float4*)(x + (size_t)row * DM);
    const float4* gr = (const float4*)g;
    float4 v[4];
    float ss = 0.f;
#pragma unroll
    for (int i = 0; i < 4; ++i) {
      v[i] = xr[lane + 64 * i];
      ss += v[i].x * v[i].x + v[i].y * v[i].y + v[i].z * v[i].z + v[i].w * v[i].w;
    }
    ss = wave_sum(ss);
    float r = rsqrtf(ss * (1.0f / DM) + 1e-6f);
#pragma unroll
    for (int i = 0; i < 4; ++i) {
      float4 gg = gr[lane + 64 * i];
      xr[lane + 64 * i] = make_float4(v[i].x * r * gg.x, v[i].y * r * gg.y, v[i].z * r * gg.z, v[i].w * r * gg.w);
    }
  }
}

DEV void phase_inproj(const u16* xb, const float* rstd, const u16* wt, int N, u16* out, u16* smem, int bid, int nb) {
  const int tid = my_tid(), lane = tid & 63, wave = tid >> 6, wm = wave >> 1, wn = wave & 1;
  const int MTL = NTOK / 256, NTL = N / 256;
  for (int t = vbid(bid, nb); t < MTL * NTL; t += nb) {
    int m, n;
    tile_map(t, MTL, NTL, m, n);
    f32x16 acc[2][4];
    ZERO_BIG(acc);
    gemm_big(acc, xb, DM, m * 256, -(1 << 30), NTOK - 1, wt + (size_t)n * 256 * DM, DM, DM, smem);
#pragma unroll
    for (int i = 0; i < 2; ++i)
#pragma unroll
      for (int e = 0; e < 16; ++e) {
        const int r = BIG_ROW(i, e);
        const float rs = rstd_of(rstd, m * 256 + r);
#pragma unroll
        for (int j = 0; j < 4; ++j) smem[r * 264 + BIG_COL(j)] = f2bf(acc[i][j][e] * rs);
      }
    __syncthreads();
#pragma unroll 4
    for (int k = 0; k < 16; ++k) {
      const int c = tid + NTHR * k;
      const int r = c >> 5, cc = c & 31;
      *(uint4*)(out + (size_t)(m * 256 + r) * N + n * 256 + cc * 8) = *(const uint4*)(smem + r * 264 + cc * 8);
    }
    __syncthreads();
  }
}

#define OPS_STRIDE ((size_t)NTOK * 512)
DEV void phase_rwprep(const Params& p, int l, u16* smem, int bid, int nb) {
  const int tid = my_tid(), lane = tid & 63, wave = tid >> 6, wm = wave >> 1, wn = wave & 1;
  const u16* prw = (const u16*)(p.ws + OFF_BIG + B_PRW);
  u16* ops = (u16*)(p.ws + OFF_BIG + B_OPS);
  unsigned char* W = p.ws + OFF_W + (size_t)l * LW_BYTES;
  const u16* wup = (const u16*)(W + W_RWUP);
  const u16* aup = (const u16*)(W + W_RAUP);
  const u16* gup = (const u16*)(W + W_RGUP);
  const float* mu = p.in[3] + l * 1792;
  const float* w0 = p.in[4] + l * 512;
  const float* a0 = p.in[6] + l * 512;
  u16* T = smem;
  for (int tile = bid; tile < NTOK / 128; tile += nb) {
    const int t0 = tile * 128;
    for (int c = tid; c < 128 * 224; c += NTHR) {
      int tok = c / 224, ch = (c % 224) * 8;
      int t = t0 + tok;
      float cur[8], prv[8], o[8];
      unpack8(*(const uint4*)(prw + (size_t)t * 1792 + ch), cur);
      if ((t & (SEQ - 1)) != 0) unpack8(*(const uint4*)(prw + (size_t)(t - 1) * 1792 + ch), prv);
      else {
#pragma unroll
        for (int j = 0; j < 8; ++j) prv[j] = 0.f;
      }
      float4 m0 = *(const float4*)(mu + ch), m1 = *(const float4*)(mu + ch + 4);
      float mm[8] = {m0.x, m0.y, m0.z, m0.w, m1.x, m1.y, m1.z, m1.w};
#pragma unroll
      for (int j = 0; j < 8; ++j) o[j] = cur[j] + mm[j] * (prv[j] - cur[j]);
      if (ch < 1536) {
        int arr = ch >> 9;
        *(uint4*)(ops + arr * OPS_STRIDE + (size_t)t * 512 + (ch & 511)) = pack8(o);
      } else {
        int cc = ch - 1536;
        if (cc < 64) {
#pragma unroll
          for (int j = 0; j < 8; ++j) o[j] = tanhf(o[j]);
        } else if (cc >= 128) {
#pragma unroll
          for (int j = 0; j < 8; ++j) o[j] = sigmoidf_(o[j]);
        }
        *(uint4*)(T + tok * 264 + cc) = pack8(o);
      }
    }
    __syncthreads();
    for (int nbk = 0; nbk < 4; ++nbk) {
      const int arow = (wm * 32 + (lane & 31)) * 264 + (lane >> 5) * 8;
      const int bn = nbk * 128 + wn * 64 + (lane & 31);
#pragma unroll 1
      for (int which = 0; which < 3; ++which) {
        f32x16 ac[2];
#pragma unroll
        for (int j = 0; j < 2; ++j)
#pragma unroll
          for (int e = 0; e < 16; ++e) ac[j][e] = 0.f;
        const int kd = (which == 2) ? 128 : 64;
        const int aoff = (which == 0) ? 0 : (which == 1 ? 64 : 128);
        const u16* wsrc = (which == 0) ? wup : (which == 1 ? aup : gup);
        for (int ks = 0; ks < kd / 16; ++ks) {
          bf16x8 a1 = *(const bf16x8*)(T + arow + aoff + ks * 16);
#pragma unroll
          for (int j = 0; j < 2; ++j) {
            bf16x8 b1 = *(const bf16x8*)(wsrc + (size_t)(bn + j * 32) * kd + ks * 16 + (lane >> 5) * 8);
            ac[j] = __builtin_amdgcn_mfma_f32_32x32x16_bf16(a1, b1, ac[j], 0, 0, 0);
          }
        }
#pragma unroll
        for (int j = 0; j < 2; ++j) {
          const int ch = nbk * 128 + ACC_COL(j);
          const float w0c = w0[ch], a0c = a0[ch];
#pragma unroll
          for (int e = 0; e < 16; ++e) {
            const int t = t0 + ACC_ROW(1, 0, e);
            const size_t o = (size_t)t * 512 + ch;
            float val;
            if (which == 0) {
              float z = -(w0c + ac[j][e]);
              float sp = fmaxf(z, 0.f) + log1pf(__expf(-fabsf(z)));
              val = __expf(-sp - 0.5f);
            } else if (which == 1) {
              val = sigmoidf_(a0c + ac[j][e]);
            } else {
              val = ac[j][e];
            }
            const int arr = (which == 0) ? 4 : (which == 1 ? 3 : 5);
            ops[(size_t)arr * OPS_STRIDE + o] = f2bf(val);
          }
        }
      }
    }
    __syncthreads();
  }
}

#define TS 32
struct ScanStage {
  float* W; float* KK; float* BB; float* KP; float* RR; float* VV; float* YY;
};
template <int PASS>
DEV void phase_scan(const Params& p, int l, float* smf, int bid, int nb) {
  const int tid = my_tid();
  const int half = tid >> 8, tu = tid & 255;
  const u16* ops = (const u16*)(p.ws + OFF_BIG + B_OPS);
  float* PL = (float*)(p.ws + OFF_BIG + B_PL);
  const float* SIN = (const float*)(p.ws + OFF_BIG + B_SINIT);
  u16* yrw = (u16*)(p.ws + OFF_BIG + B_YRW);
  const float* k_k = p.in[9] + l * 512;
  const float* k_a = p.in[10] + l * 512;
  const float* r_k = p.in[11] + l * 512;
  const float* lng = p.in[12] + l * 512;
  const float* lnb = p.in[13] + l * 512;
  float* base = smf + half * (7 * TS * 64);
  float* sW = base; float* sKK = base + TS * 64; float* sB = base + 2 * TS * 64; float* sKP = base + 3 * TS * 64;
  float* sR = base + 4 * TS * 64; float* sV = base + 5 * TS * 64; float* sY = base + 6 * TS * 64;
  const int ss = tu >> 3, c8 = tu & 7;
  const int ks = tu & 7, rp = tu >> 3;
  for (int u2 = bid; u2 < 256; u2 += nb) {
    const int u = u2 * 2 + half;
    const int bh = u >> 4, c = u & 15;
    const int b = bh >> 3, h = bh & 7;
    const int tok0 = b * SEQ + c * 512;
    const int chb = h * 64 + c8 * 8;
    float S0[8], S1[8], Q0[8], Q1[8];
    if (PASS == 1) {
#pragma unroll
      for (int j = 0; j < 8; ++j) {
        S0[j] = 0.f; S1[j] = 0.f;
        Q0[j] = (ks * 8 + j == 2 * rp) ? 1.f : 0.f;
        Q1[j] = (ks * 8 + j == 2 * rp + 1) ? 1.f : 0.f;
      }
    } else {
      const float* si = SIN + (size_t)u * 4096;
      float4 x0 = *(const float4*)(si + (2 * rp) * 64 + ks * 8), x1 = *(const float4*)(si + (2 * rp) * 64 + ks * 8 + 4);
      float4 y0 = *(const float4*)(si + (2 * rp + 1) * 64 + ks * 8), y1 = *(const float4*)(si + (2 * rp + 1) * 64 + ks * 8 + 4);
      S0[0] = x0.x; S0[1] = x0.y; S0[2] = x0.z; S0[3] = x0.w; S0[4] = x1.x; S0[5] = x1.y; S0[6] = x1.z; S0[7] = x1.w;
      S1[0] = y0.x; S1[1] = y0.y; S1[2] = y0.z; S1[3] = y0.w; S1[4] = y1.x; S1[5] = y1.y; S1[6] = y1.z; S1[7] = y1.w;
#pragma unroll
      for (int j = 0; j < 8; ++j) { Q0[j] = 0.f; Q1[j] = 0.f; }
    }
    float kkc[8], kac[8], rkc[8];
    {
      float4 q0 = *(const float4*)(k_k + chb), q1 = *(const float4*)(k_k + chb + 4);
      kkc[0] = q0.x; kkc[1] = q0.y; kkc[2] = q0.z; kkc[3] = q0.w; kkc[4] = q1.x; kkc[5] = q1.y; kkc[6] = q1.z; kkc[7] = q1.w;
      q0 = *(const float4*)(k_a + chb); q1 = *(const float4*)(k_a + chb + 4);
      kac[0] = q0.x; kac[1] = q0.y; kac[2] = q0.z; kac[3] = q0.w; kac[4] = q1.x; kac[5] = q1.y; kac[6] = q1.z; kac[7] = q1.w;
      q0 = *(const float4*)(r_k + chb); q1 = *(const float4*)(r_k + chb + 4);
      rkc[0] = q0.x; rkc[1] = q0.y; rkc[2] = q0.z; rkc[3] = q0.w; rkc[4] = q1.x; rkc[5] = q1.y; rkc[6] = q1.z; rkc[7] = q1.w;
    }
    uint4 pr_r, pr_k, pr_v, pr_a, pr_e, pr_g = make_uint4(0, 0, 0, 0);
    {
      const size_t o0 = (size_t)(tok0 + ss) * 512 + chb;
      pr_r = *(const uint4*)(ops + 0 * OPS_STRIDE + o0);
      pr_k = *(const uint4*)(ops + 1 * OPS_STRIDE + o0);
      pr_v = *(const uint4*)(ops + 2 * OPS_STRIDE + o0);
      pr_a = *(const uint4*)(ops + 3 * OPS_STRIDE + o0);
      pr_e = *(const uint4*)(ops + 4 * OPS_STRIDE + o0);
      if (PASS == 3) pr_g = *(const uint4*)(ops + 5 * OPS_STRIDE + o0);
    }
    for (int sc = 0; sc < 512 / TS; ++sc) {
      const size_t o = (size_t)(tok0 + sc * TS + ss) * 512 + chb;
      float fr[8], fk[8], fv[8], fa[8], fe[8];
      unpack8(pr_r, fr);
      unpack8(pr_k, fk);
      unpack8(pr_v, fv);
      unpack8(pr_a, fa);
      unpack8(pr_e, fe);
      const uint4 graw = pr_g;
      if (sc + 1 < 512 / TS) {
        const size_t o1 = o + (size_t)TS * 512;
        pr_r = *(const uint4*)(ops + 0 * OPS_STRIDE + o1);
        pr_k = *(const uint4*)(ops + 1 * OPS_STRIDE + o1);
        pr_v = *(const uint4*)(ops + 2 * OPS_STRIDE + o1);
        pr_a = *(const uint4*)(ops + 3 * OPS_STRIDE + o1);
        pr_e = *(const uint4*)(ops + 4 * OPS_STRIDE + o1);
        if (PASS == 3) pr_g = *(const uint4*)(ops + 5 * OPS_STRIDE + o1);
      }
      float kk[8], kp[8], ssq = 0.f, bon = 0.f;
#pragma unroll
      for (int j = 0; j < 8; ++j) {
        kk[j] = fk[j] * kkc[j];
        ssq += kk[j] * kk[j];
        kp[j] = fk[j] * (1.f + (fa[j] - 1.f) * kac[j]);
        bon += fr[j] * kp[j] * rkc[j];
      }
      ssq = red8(ssq);
      bon = red8(bon);
      const float inv = 1.f / fmaxf(sqrtf(ssq), 1e-12f);
      float fw[8], fb[8];
#pragma unroll
      for (int j = 0; j < 8; ++j) {
        kk[j] *= inv;
        fb[j] = fa[j] * kk[j];
        fw[j] = __expf(-fe[j]);
      }
      {
        const int so = ss * 64 + c8 * 8;
        *(float4*)(sW + so) = make_float4(fw[0], fw[1], fw[2], fw[3]); *(float4*)(sW + so + 4) = make_float4(fw[4], fw[5], fw[6], fw[7]);
        *(float4*)(sKK + so) = make_float4(kk[0], kk[1], kk[2], kk[3]); *(float4*)(sKK + so + 4) = make_float4(kk[4], kk[5], kk[6], kk[7]);
        *(float4*)(sB + so) = make_float4(fb[0], fb[1], fb[2], fb[3]); *(float4*)(sB + so + 4) = make_float4(fb[4], fb[5], fb[6], fb[7]);
        *(float4*)(sKP + so) = make_float4(kp[0], kp[1], kp[2], kp[3]); *(float4*)(sKP + so + 4) = make_float4(kp[4], kp[5], kp[6], kp[7]);
        *(float4*)(sV + so) = make_float4(fv[0], fv[1], fv[2], fv[3]); *(float4*)(sV + so + 4) = make_float4(fv[4], fv[5], fv[6], fv[7]);
        if (PASS == 3) {
          *(float4*)(sR + so) = make_float4(fr[0], fr[1], fr[2], fr[3]); *(float4*)(sR + so + 4) = make_float4(fr[4], fr[5], fr[6], fr[7]);
        }
      }
      __syncthreads();
#pragma unroll 2
      for (int s = 0; s < TS; ++s) {
        const int so = s * 64 + ks * 8;
        float4 t0 = *(const float4*)(sW + so), t1 = *(const float4*)(sW + so + 4);
        float w[8] = {t0.x, t0.y, t0.z, t0.w, t1.x, t1.y, t1.z, t1.w};
        t0 = *(const float4*)(sKK + so); t1 = *(const float4*)(sKK + so + 4);
        float kq[8] = {t0.x, t0.y, t0.z, t0.w, t1.x, t1.y, t1.z, t1.w};
        t0 = *(const float4*)(sB + so); t1 = *(const float4*)(sB + so + 4);
        float bq[8] = {t0.x, t0.y, t0.z, t0.w, t1.x, t1.y, t1.z, t1.w};
        t0 = *(const float4*)(sKP + so); t1 = *(const float4*)(sKP + so + 4);
        float kpq[8] = {t0.x, t0.y, t0.z, t0.w, t1.x, t1.y, t1.z, t1.w};
        const float2 vv = *(const float2*)(sV + s * 64 + 2 * rp);
        float sa0 = 0.f, sa1 = 0.f;
#pragma unroll
        for (int j = 0; j < 8; ++j) { sa0 += S0[j] * kq[j]; sa1 += S1[j] * kq[j]; }
        sa0 = red8(sa0); sa1 = red8(sa1);
#pragma unroll
        for (int j = 0; j < 8; ++j) {
          S0[j] = S0[j] * w[j] - sa0 * bq[j] + vv.x * kpq[j];
          S1[j] = S1[j] * w[j] - sa1 * bq[j] + vv.y * kpq[j];
        }
        if (PASS == 1) {
          float pa0 = 0.f, pa1 = 0.f;
#pragma unroll
          for (int j = 0; j < 8; ++j) { pa0 += Q0[j] * kq[j]; pa1 += Q1[j] * kq[j]; }
          pa0 = red8(pa0); pa1 = red8(pa1);
#pragma unroll
          for (int j = 0; j < 8; ++j) {
            Q0[j] = Q0[j] * w[j] - pa0 * bq[j];
            Q1[j] = Q1[j] * w[j] - pa1 * bq[j];
          }
        } else {
          t0 = *(const float4*)(sR + so); t1 = *(const float4*)(sR + so + 4);
          float rq[8] = {t0.x, t0.y, t0.z, t0.w, t1.x, t1.y, t1.z, t1.w};
          float y0 = 0.f, y1 = 0.f;
#pragma unroll
          for (int j = 0; j < 8; ++j) { y0 += S0[j] * rq[j]; y1 += S1[j] * rq[j]; }
          y0 = red8(y0); y1 = red8(y1);
          if (ks == 0) *(float2*)(sY + s * 64 + 2 * rp) = make_float2(y0, y1);
        }
      }
      __syncthreads();
      if (PASS == 3) {
        const int so = ss * 64 + c8 * 8;
        float4 y0 = *(const float4*)(sY + so), y1 = *(const float4*)(sY + so + 4);
        float y[8] = {y0.x, y0.y, y0.z, y0.w, y1.x, y1.y, y1.z, y1.w};
        float sm = 0.f;
#pragma unroll
        for (int j = 0; j < 8; ++j) sm += y[j];
        const float mean = red8(sm) * (1.f / 64.f);
        float sv = 0.f;
#pragma unroll
        for (int j = 0; j < 8; ++j) { y[j] -= mean; sv += y[j] * y[j]; }
        const float var = red8(sv) * (1.f / 64.f);
        const float rs = rsqrtf(var + 64e-5f);
        float g[8], outv[8];
        unpack8(graw, g);
        float4 l0 = *(const float4*)(lng + chb), l1 = *(const float4*)(lng + chb + 4);
        float4 b0 = *(const float4*)(lnb + chb), b1 = *(const float4*)(lnb + chb + 4);
        float lg[8] = {l0.x, l0.y, l0.z, l0.w, l1.x, l1.y, l1.z, l1.w};
        float lb[8] = {b0.x, b0.y, b0.z, b0.w, b1.x, b1.y, b1.z, b1.w};
#pragma unroll
        for (int j = 0; j < 8; ++j) outv[j] = (y[j] * rs * lg[j] + lb[j] + bon * fv[j]) * g[j];
        if (!(c == 0 && sc == 0 && ss == 0)) *(uint4*)(yrw + o) = pack8(outv);
      }
    }
    if (PASS == 1) {
      float* pl = PL + (size_t)u * 8192;
      float* Pm = pl;
      float* Lm = pl + 4096;
      *(float4*)(Pm + (2 * rp) * 64 + ks * 8) = make_float4(Q0[0], Q0[1], Q0[2], Q0[3]);
      *(float4*)(Pm + (2 * rp) * 64 + ks * 8 + 4) = make_float4(Q0[4], Q0[5], Q0[6], Q0[7]);
      *(float4*)(Pm + (2 * rp + 1) * 64 + ks * 8) = make_float4(Q1[0], Q1[1], Q1[2], Q1[3]);
      *(float4*)(Pm + (2 * rp + 1) * 64 + ks * 8 + 4) = make_float4(Q1[4], Q1[5], Q1[6], Q1[7]);
      *(float4*)(Lm + (2 * rp) * 64 + ks * 8) = make_float4(S0[0], S0[1], S0[2], S0[3]);
      *(float4*)(Lm + (2 * rp) * 64 + ks * 8 + 4) = make_float4(S0[4], S0[5], S0[6], S0[7]);
      *(float4*)(Lm + (2 * rp + 1) * 64 + ks * 8) = make_float4(S1[0], S1[1], S1[2], S1[3]);
      *(float4*)(Lm + (2 * rp + 1) * 64 + ks * 8 + 4) = make_float4(S1[4], S1[5], S1[6], S1[7]);
    }
  }
}

DEV void phase_scanprop(const Params& p, float* smf, int bid, int nb) {
  const int tid = my_tid();
  const float* PL = (const float*)(p.ws + OFF_BIG + B_PL);
  float* SIN = (float*)(p.ws + OFF_BIG + B_SINIT);
  float* sS = smf;
  float* sP = smf + 4096;
  const int i = tid >> 3, k8 = tid & 7;
  for (int bh = bid; bh < 32; bh += nb) {
    float cur[8];
#pragma unroll
    for (int j = 0; j < 8; ++j) cur[j] = 0.f;
    for (int c = 0; c < 16; ++c) {
      const int u = bh * 16 + c;
      float* so = SIN + (size_t)u * 4096 + i * 64 + k8 * 8;
      *(float4*)so = make_float4(cur[0], cur[1], cur[2], cur[3]);
      *(float4*)(so + 4) = make_float4(cur[4], cur[5], cur[6], cur[7]);
      if (c == 15) break;
      const float* pl = PL + (size_t)u * 8192;
      *(float4*)(sS + i * 64 + k8 * 8) = make_float4(cur[0], cur[1], cur[2], cur[3]);
      *(float4*)(sS + i * 64 + k8 * 8 + 4) = make_float4(cur[4], cur[5], cur[6], cur[7]);
      *(float4*)(sP + tid * 8) = *(const float4*)(pl + tid * 8);
      *(float4*)(sP + tid * 8 + 4) = *(const float4*)(pl + tid * 8 + 4);
      float4 l0 = *(const float4*)(pl + 4096 + i * 64 + k8 * 8), l1 = *(const float4*)(pl + 4096 + i * 64 + k8 * 8 + 4);
      __syncthreads();
      float nw[8] = {l0.x, l0.y, l0.z, l0.w, l1.x, l1.y, l1.z, l1.w};
#pragma unroll 8
      for (int j = 0; j < 64; ++j) {
        const float sij = sS[i * 64 + j];
        float4 p0 = *(const float4*)(sP + j * 64 + k8 * 8), p1 = *(const float4*)(sP + j * 64 + k8 * 8 + 4);
        nw[0] += sij * p0.x; nw[1] += sij * p0.y; nw[2] += sij * p0.z; nw[3] += sij * p0.w;
        nw[4] += sij * p1.x; nw[5] += sij * p1.y; nw[6] += sij * p1.z; nw[7] += sij * p1.w;
      }
#pragma unroll
      for (int j = 0; j < 8; ++j) cur[j] = nw[j];
      __syncthreads();
    }
  }
}

DEV float ret_log2gamma(int h) { return log2f(1.0f - exp2f(-5.0f - (float)h)); }

DEV void stage_rot(const u16* src, size_t ld, const float* rc, const float* rs, int pos0, u16* dst, float sc, float l2g, int rowmode) {
  const int tid = my_tid();
  const int row = tid >> 2, d0 = (tid & 3) * 8;
  float lo[8], hi[8], olo[8], ohi[8];
  unpack8(*(const uint4*)(src + (size_t)row * ld + d0), lo);
  unpack8(*(const uint4*)(src + (size_t)row * ld + d0 + 32), hi);
  const float* cp = rc + (size_t)(pos0 + row) * 32 + d0;
  const float* sp = rs + (size_t)(pos0 + row) * 32 + d0;
  float4 c0 = *(const float4*)cp, c1 = *(const float4*)(cp + 4);
  float4 s0 = *(const float4*)sp, s1 = *(const float4*)(sp + 4);
  float cc[8] = {c0.x, c0.y, c0.z, c0.w, c1.x, c1.y, c1.z, c1.w};
  float sn[8] = {s0.x, s0.y, s0.z, s0.w, s1.x, s1.y, s1.z, s1.w};
  float rsc = sc;
  if (rowmode == 1) rsc *= exp2f((float)(row + 1) * l2g);
  if (rowmode == 2) rsc *= exp2f((float)(127 - row) * l2g);
#pragma unroll
  for (int j = 0; j < 8; ++j) {
    olo[j] = (lo[j] * cc[j] - hi[j] * sn[j]) * rsc;
    ohi[j] = (hi[j] * cc[j] + lo[j] * sn[j]) * rsc;
  }
  *(uint4*)(dst + row * 72 + d0) = pack8(olo);
  *(uint4*)(dst + row * 72 + d0 + 32) = pack8(ohi);
}
DEV void stage_rot_T(const u16* src, size_t ld, const float* rc, const float* rs, int pos0, u16* dst, float sc, float l2g) {
  const int tid = my_tid();
  const int row = tid >> 2, d0 = (tid & 3) * 8;
  float lo[8], hi[8];
  unpack8(*(const uint4*)(src + (size_t)row * ld + d0), lo);
  unpack8(*(const uint4*)(src + (size_t)row * ld + d0 + 32), hi);
  const float* cp = rc + (size_t)(pos0 + row) * 32 + d0;
  const float* sp = rs + (size_t)(pos0 + row) * 32 + d0;
  float4 c0 = *(const float4*)cp, c1 = *(const float4*)(cp + 4);
  float4 s0 = *(const float4*)sp, s1 = *(const float4*)(sp + 4);
  float cc[8] = {c0.x, c0.y, c0.z, c0.w, c1.x, c1.y, c1.z, c1.w};
  float sn[8] = {s0.x, s0.y, s0.z, s0.w, s1.x, s1.y, s1.z, s1.w};
  const float rsc = sc * exp2f((float)(127 - row) * l2g);
#pragma unroll
  for (int j = 0; j < 8; ++j) {
    dst[(d0 + j) * 136 + row] = f2bf((lo[j] * cc[j] - hi[j] * sn[j]) * rsc);
    dst[(d0 + j + 32) * 136 + row] = f2bf((hi[j] * cc[j] + lo[j] * sn[j]) * rsc);
  }
}
DEV void stage_vT(const u16* src, size_t ld, u16* dst) {
  const int tid = my_tid();
  const int row = tid >> 2, d0 = (tid & 3) * 32;
#pragma unroll
  for (int c = 0; c < 4; ++c) {
    uint4 v = *(const uint4*)(src + (size_t)row * ld + d0 + c * 8);
    unsigned w[4] = {v.x, v.y, v.z, v.w};
#pragma unroll
    for (int j = 0; j < 4; ++j) {
      dst[(d0 + c * 8 + 2 * j) * 136 + row] = (u16)(w[j] & 0xffffu);
      dst[(d0 + c * 8 + 2 * j + 1) * 136 + row] = (u16)(w[j] >> 16);
    }
  }
}

DEV void ret_kv_unit(const Params& p, int u, u16* smem) {
  const int tid = my_tid(), lane = tid & 63, wave = tid >> 6;
  const u16* prs = (const u16*)(p.ws + OFF_BIG + B_PRS);
  float* KV = (float*)(p.ws + OFF_BIG + B_KV);
  const float* rc = (const float*)(p.ws + OFF_ROPE);
  const float* rs = rc + SEQ * 32;
  const int n = u & 63, h = (u >> 6) & 3, b = u >> 8;
  const size_t t0 = (size_t)b * SEQ + n * 128;
  const float l2g = ret_log2gamma(h);
  u16* KT = smem;
  u16* VT = smem + 64 * 136;
  stage_rot_T(prs + t0 * 2560 + 256 + h * 64, 2560, rc, rs, n * 128, KT, 0.125f, l2g);
  stage_vT(prs + t0 * 2560 + 512 + h * 128, 2560, VT);
  __syncthreads();
  const int mi = wave >> 1, nj = wave & 1;
  f32x16 acc;
#pragma unroll
  for (int e = 0; e < 16; ++e) acc[e] = 0.f;
#pragma unroll
  for (int ks = 0; ks < 8; ++ks) {
    bf16x8 a = *(const bf16x8*)(VT + (mi * 32 + (lane & 31)) * 136 + ks * 16 + (lane >> 5) * 8);
    bf16x8 bb = *(const bf16x8*)(KT + (nj * 32 + (lane & 31)) * 136 + ks * 16 + (lane >> 5) * 8);
    acc = __builtin_amdgcn_mfma_f32_32x32x16_bf16(a, bb, acc, 0, 0, 0);
  }
  float* kv = KV + (size_t)u * 8192;
#pragma unroll
  for (int e = 0; e < 16; ++e) {
    int dv = mi * 32 + (e & 3) + 8 * (e >> 2) + 4 * (lane >> 5);
    int dk = nj * 32 + (lane & 31);
    kv[dv * 64 + dk] = acc[e];
  }
  __syncthreads();
}

DEV void sgu_unit(const Params& p, int l, int u, u16* smem) {
  const int tid = my_tid(), lane = tid & 63, wave = tid >> 6, wm = wave >> 1, wn = wave & 1;
  const u16* prs = (const u16*)(p.ws + OFF_BIG + B_PRS);
  u16* ysg = (u16*)(p.ws + OFF_BIG + B_YSG);
  const u16* sgw = (const u16*)(p.ws + OFF_W + (size_t)l * LW_BYTES + W_SGW);
  const float* lng = p.in[14] + l * 512;
  const float* lnb = p.in[15] + l * 512;
  const float* sgb = p.in[17] + l * 512;
  const size_t t0 = (size_t)u * 128;
  u16* VT = smem;
  u16* WT = smem + 128 * 136;
  float* st = (float*)(smem + 2 * 128 * 136);
  const int tok = tid >> 2, q = tid & 3;
  const u16* vrow = prs + (t0 + tok) * 2560 + 1536 + 512;
  {
    float s = 0.f, s2 = 0.f;
#pragma unroll 4
    for (int c = 0; c < 16; ++c) {
      float f[8];
      unpack8(*(const uint4*)(vrow + q * 128 + c * 8), f);
#pragma unroll
      for (int j = 0; j < 8; ++j) { float gl = geluf_(f[j]); s += gl; s2 += gl * gl; }
    }
    s = red4(s); s2 = red4(s2);
    const float mean = s * (1.f / 512.f);
    const float var = fmaxf(s2 * (1.f / 512.f) - mean * mean, 0.f);
    if (q == 0) { st[tok] = mean; st[128 + tok] = rsqrtf(var + 1e-6f); }
  }
  __syncthreads();
  const float mean = st[tok], rstd = st[128 + tok];
  for (int g = 0; g < 4; ++g) {
#pragma unroll
    for (int c = 0; c < 4; ++c) {
      const int d = q * 32 + c * 8;
      float f[8];
      unpack8(*(const uint4*)(vrow + g * 128 + d), f);
      float4 g0 = *(const float4*)(lng + g * 128 + d), g1 = *(const float4*)(lng + g * 128 + d + 4);
      float4 b0 = *(const float4*)(lnb + g * 128 + d), b1 = *(const float4*)(lnb + g * 128 + d + 4);
      float gg[8] = {g0.x, g0.y, g0.z, g0.w, g1.x, g1.y, g1.z, g1.w};
      float bb[8] = {b0.x, b0.y, b0.z, b0.w, b1.x, b1.y, b1.z, b1.w};
#pragma unroll
      for (int j = 0; j < 8; ++j) VT[(d + j) * 136 + tok] = f2bf((geluf_(f[j]) - mean) * rstd * gg[j] + bb[j]);
      *(uint4*)(WT + tok * 136 + d) = *(const uint4*)(sgw + (size_t)g * 16384 + tok * 128 + d);
    }
    __syncthreads();
    f32x16 acc[2];
#pragma unroll
    for (int j = 0; j < 2; ++j)
#pragma unroll
      for (int e = 0; e < 16; ++e) acc[j][e] = 0.f;
#pragma unroll
    for (int ks = 0; ks < 8; ++ks) {
      bf16x8 a = *(const bf16x8*)(WT + (wm * 32 + (lane & 31)) * 136 + ks * 16 + (lane >> 5) * 8);
#pragma unroll
      for (int j = 0; j < 2; ++j) {
        bf16x8 bb = *(const bf16x8*)(VT + (wn * 64 + j * 32 + (lane & 31)) * 136 + ks * 16 + (lane >> 5) * 8);
        acc[j] = __builtin_amdgcn_mfma_f32_32x32x16_bf16(a, bb, acc[j], 0, 0, 0);
      }
    }
#pragma unroll
    for (int e = 0; e < 16; ++e) {
      const int i = ACC_ROW(1, 0, e);
      const float bias = sgb[g * 128 + i];
#pragma unroll
      for (int j = 0; j < 2; ++j) {
        const int d = ACC_COL(j);
        const float uu = geluf_(bf2f(prs[(t0 + i) * 2560 + 1536 + g * 128 + d]));
        ysg[(t0 + i) * 512 + g * 128 + d] = f2bf(uu * (acc[j][e] + bias));
      }
    }
    __syncthreads();
  }
}

DEV void phase_retprefix(const Params& p, int bid, int nb) {
  float* KV = (float*)(p.ws + OFF_BIG + B_KV);
  for (int gid = bid * NTHR + my_tid(); gid < 16 * 8192; gid += nb * NTHR) {
    const int bh = gid >> 13, e = gid & 8191;
    const int h = bh & 3;
    const float cd = exp2f(128.f * ret_log2gamma(h));
    float R = 0.f;
    float* ptr = KV + (size_t)bh * 64 * 8192 + e;
    for (int n = 0; n < 64; ++n) {
      float kv = ptr[(size_t)n * 8192];
      ptr[(size_t)n * 8192] = R;
      R = R * cd + kv;
    }
  }
}

DEV void ret_out_unit(const Params& p, int u, u16* smem) {
  const int tid = my_tid(), lane = tid & 63, wave = tid >> 6, wm = wave >> 1, wn = wave & 1;
  const u16* prs = (const u16*)(p.ws + OFF_BIG + B_PRS);
  const float* KV = (const float*)(p.ws + OFF_BIG + B_KV);
  u16* yret = (u16*)(p.ws + OFF_BIG + B_YRET);
  const float* rc = (const float*)(p.ws + OFF_ROPE);
  const float* rs = rc + SEQ * 32;
  const int n = u & 63, h = (u >> 6) & 3, b = u >> 8;
  const size_t t0 = (size_t)b * SEQ + n * 128;
  const float l2g = ret_log2gamma(h);
  u16* Q = smem;
  u16* Kr = Q + 128 * 72;
  u16* VT = Kr + 128 * 72;
  u16* Qd = VT + 128 * 136;
  u16* RT = Qd + 128 * 72;
  u16* SP = RT + 128 * 72;
  float* OT = (float*)smem;
  stage_rot(prs + t0 * 2560 + h * 64, 2560, rc, rs, n * 128, Q, 1.0f, l2g, 0);
  stage_rot(prs + t0 * 2560 + h * 64, 2560, rc, rs, n * 128, Qd, 1.0f, l2g, 1);
  stage_rot(prs + t0 * 2560 + 256 + h * 64, 2560, rc, rs, n * 128, Kr, 0.125f, l2g, 0);
  stage_vT(prs + t0 * 2560 + 512 + h * 128, 2560, VT);
  {
    const int dv = tid >> 2, q = tid & 3;
    const float* src = KV + (size_t)u * 8192 + dv * 64 + q * 16;
    float4 a0 = *(const float4*)src, a1 = *(const float4*)(src + 4), a2 = *(const float4*)(src + 8), a3 = *(const float4*)(src + 12);
    float f0[8] = {a0.x, a0.y, a0.z, a0.w, a1.x, a1.y, a1.z, a1.w};
    float f1[8] = {a2.x, a2.y, a2.z, a2.w, a3.x, a3.y, a3.z, a3.w};
    *(uint4*)(RT + dv * 72 + q * 16) = pack8(f0);
    *(uint4*)(RT + dv * 72 + q * 16 + 8) = pack8(f1);
  }
  __syncthreads();
  f32x16 acc[2];
#pragma unroll
  for (int j = 0; j < 2; ++j)
#pragma unroll
    for (int e = 0; e < 16; ++e) acc[j][e] = 0.f;
#pragma unroll
  for (int ks = 0; ks < 4; ++ks) {
    bf16x8 a = *(const bf16x8*)(Q + (wm * 32 + (lane & 31)) * 72 + ks * 16 + (lane >> 5) * 8);
#pragma unroll
    for (int j = 0; j < 2; ++j) {
      bf16x8 bb = *(const bf16x8*)(Kr + (wn * 64 + j * 32 + (lane & 31)) * 72 + ks * 16 + (lane >> 5) * 8);
      acc[j] = __builtin_amdgcn_mfma_f32_32x32x16_bf16(a, bb, acc[j], 0, 0, 0);
    }
  }
#pragma unroll
  for (int j = 0; j < 2; ++j)
#pragma unroll
    for (int e = 0; e < 16; ++e) {
      const int i = ACC_ROW(1, 0, e), jj = ACC_COL(j);
      const float dcy = (i >= jj) ? exp2f((float)(i - jj) * l2g) : 0.f;
      SP[i * 136 + jj] = f2bf(acc[j][e] * dcy);
    }
  __syncthreads();
#pragma unroll
  for (int j = 0; j < 2; ++j)
#pragma unroll
    for (int e = 0; e < 16; ++e) acc[j][e] = 0.f;
#pragma unroll
  for (int ks = 0; ks < 8; ++ks) {
    bf16x8 a = *(const bf16x8*)(SP + (wm * 32 + (lane & 31)) * 136 + ks * 16 + (lane >> 5) * 8);
#pragma unroll
    for (int j = 0; j < 2; ++j) {
      bf16x8 bb = *(const bf16x8*)(VT + (wn * 64 + j * 32 + (lane & 31)) * 136 + ks * 16 + (lane >> 5) * 8);
      acc[j] = __builtin_amdgcn_mfma_f32_32x32x16_bf16(a, bb, acc[j], 0, 0, 0);
    }
  }
#pragma unroll
  for (int ks = 0; ks < 4; ++ks) {
    bf16x8 a = *(const bf16x8*)(Qd + (wm * 32 + (lane & 31)) * 72 + ks * 16 + (lane >> 5) * 8);
#pragma unroll
    for (int j = 0; j < 2; ++j) {
      bf16x8 bb = *(const bf16x8*)(RT + (wn * 64 + j * 32 + (lane & 31)) * 72 + ks * 16 + (lane >> 5) * 8);
      acc[j] = __builtin_amdgcn_mfma_f32_32x32x16_bf16(a, bb, acc[j], 0, 0, 0);
    }
  }
  __syncthreads();
#pragma unroll
  for (int j = 0; j < 2; ++j)
#pragma unroll
    for (int e = 0; e < 16; ++e) OT[ACC_ROW(1, 0, e) * 132 + ACC_COL(j)] = acc[j][e];
  __syncthreads();
  {
    const int row = tid >> 2, q = tid & 3;
    float o[32];
    float ssq = 0.f;
#pragma unroll
    for (int c = 0; c < 8; ++c) {
      float4 v = *(const float4*)(OT + row * 132 + q * 32 + c * 4);
      o[c * 4] = v.x; o[c * 4 + 1] = v.y; o[c * 4 + 2] = v.z; o[c * 4 + 3] = v.w;
      ssq += v.x * v.x + v.y * v.y + v.z * v.z + v.w * v.w;
    }
    ssq = red4(ssq);
    const float r = rsqrtf(ssq * (1.f / 128.f) + 1e-6f);
    const u16* gp = prs + (t0 + row) * 2560 + 1024 + h * 128 + q * 32;
    u16* op = yret + (t0 + row) * 512 + h * 128 + q * 32;
#pragma unroll
    for (int c = 0; c < 4; ++c) {
      float g[8], ov[8];
      unpack8(*(const uint4*)(gp + c * 8), g);
#pragma unroll
      for (int j = 0; j < 8; ++j) ov[j] = o[c * 8 + j] * r * siluf_(g[j]);
      if (!(n == 0 && row == 0)) *(uint4*)(op + c * 8) = pack8(ov);
    }
  }
  __syncthreads();
}

DEV void phase_merge(const Params& p, int l, const float* rstd, u16* smem, int bid, int nb) {
  const int tid = my_tid(), lane = tid & 63, wave = tid >> 6, wm = wave >> 1, wn = wave & 1;
  const u16* xb = (const u16*)(p.ws + OFF_XB);
  unsigned char* W = p.ws + OFF_W + (size_t)l * LW_BYTES;
  const u16* win = (const u16*)(W + W_IN);
  const u16* wbr = (const u16*)(W + W_BR);
  u16* M = (u16*)(p.ws + OFF_BIG + B_M);
  const int MTL = NTOK / 128, NTL = DM / 128;
  for (int t = vbid(bid, nb); t < MTL * NTL; t += nb) {
    int m, n;
    tile_map(t, MTL, NTL, m, n);
    f32x16 ms[1][2];
#pragma unroll
    for (int j = 0; j < 2; ++j)
#pragma unroll
      for (int e = 0; e < 16; ++e) ms[0][j][e] = 0.f;
    for (int g = 0; g < 3; ++g) {
      const u16* yg = (const u16*)(p.ws + OFF_BIG + (g == 0 ? B_YRW : (g == 1 ? B_YRET : B_YSG)));
      f32x16 ab[1][2], ag[1][2];
#pragma unroll
      for (int j = 0; j < 2; ++j)
#pragma unroll
        for (int e = 0; e < 16; ++e) { ab[0][j][e] = 0.f; ag[0][j][e] = 0.f; }
      gemm_tile<1>(ab, yg, 512, m * 128, -(1 << 30), NTOK - 1, wbr + ((size_t)g * DM + n * 128) * 512, 512, 512, smem);
      gemm_tile<1>(ag, xb, DM, m * 128, -(1 << 30), NTOK - 1, win + ((size_t)(4352 + g * DM + n * 128)) * DM, DM, DM, smem);
#pragma unroll
      for (int e = 0; e < 16; ++e) {
        const float rs = rstd_of(rstd, m * 128 + ACC_ROW(1, 0, e));
#pragma unroll
        for (int j = 0; j < 2; ++j) ms[0][j][e] += sigmoidf_(ag[0][j][e] * rs) * ab[0][j][e];
        if ((e & 3) == 3) __builtin_amdgcn_sched_barrier(0);
      }
    }
#pragma unroll
    for (int e = 0; e < 16; ++e) {
      const size_t row = m * 128 + ACC_ROW(1, 0, e);
#pragma unroll
      for (int j = 0; j < 2; ++j) M[row * DM + n * 128 + ACC_COL(j)] = f2bf(ms[0][j][e]);
    }
  }
}

DEV void phase_resgemm(const u16* A, int K, const u16* wt, const float* xin, float* xout, u16* xbo, float* ssq, u16* smem, int bid, int nb) {
  const int tid = my_tid(), lane = tid & 63, wave = tid >> 6, wm = wave >> 1, wn = wave & 1;
  const int MTL = NTOK / 256, NTL = DM / 256;
  for (int t = vbid(bid, nb); t < MTL * NTL; t += nb) {
    int m, n;
    tile_map(t, MTL, NTL, m, n);
    f32x16 acc[2][4];
    ZERO_BIG(acc);
    gemm_big(acc, A, K, m * 256, -(1 << 30), NTOK - 1, wt + (size_t)n * 256 * K, K, K, smem);
    float* F = (float*)smem;
#pragma unroll
    for (int i = 0; i < 2; ++i) {
#pragma unroll
      for (int e = 0; e < 16; ++e) {
        const int lr = wm * 32 + (e & 3) + 8 * (e >> 2) + 4 * (lane >> 5);
#pragma unroll
        for (int j = 0; j < 4; ++j) F[lr * 260 + BIG_COL(j)] = acc[i][j][e];
      }
      __syncthreads();
#pragma unroll 4
      for (int k = 0; k < 16; ++k) {
        const int c = tid + NTHR * k;
        const int lr = c >> 6, cc = c & 63;
        const size_t row = (size_t)m * 256 + (lr >> 5) * 64 + i * 32 + (lr & 31);
        const size_t o = row * DM + n * 256 + cc * 4;
        const float4 v = *(const float4*)(F + lr * 260 + cc * 4);
        const float4 x = *(const float4*)(xin + o);
        const float4 y = make_float4(x.x + v.x, x.y + v.y, x.z + v.z, x.w + v.w);
        *(float4*)(xout + o) = y;
        if (xbo) {
          *(uint2*)(xbo + o) = make_uint2(pack2(y.x, y.y), pack2(y.z, y.w));
          const float sq = wave_sum(y.x * y.x + y.y * y.y + y.z * y.z + y.w * y.w);
          if (lane == 0) atomicAdd(ssq + row, sq);
        }
      }
      __syncthreads();
    }
  }
}

DEV void phase_ffnup(const Params& p, int l, const float* rstd, u16* smem, int bid, int nb) {
  const int tid = my_tid(), lane = tid & 63, wave = tid >> 6, wm = wave >> 1, wn = wave & 1;
  const u16* xb = (const u16*)(p.ws + OFF_XB);
  const u16* wup = (const u16*)(p.ws + OFF_W + (size_t)l * LW_BYTES + W_UP);
  u16* act = (u16*)(p.ws + OFF_BIG + B_ACT);
  const float* cw = p.in[22] + (size_t)l * 3 * 2 * DFF;
  const float* cb = p.in[23] + (size_t)l * 2 * DFF;
  u16* U = smem;
  const int MPB = 33;
  const int MTL = 4 * MPB, NTL = DFF / 128;
  for (int t = vbid(bid, nb); t < MTL * NTL; t += nb) {
    int m, n;
    tile_map(t, MTL, NTL, m, n);
    const int b = m / MPB, mi = m % MPB;
    const int tokbase = b * SEQ + mi * 254 - 2;
    f32x16 acc[2][4];
    ZERO_BIG(acc);
    gemm_big(acc, xb, DM, tokbase, b * SEQ, NTOK - 1, wup + (size_t)n * 256 * DM, DM, DM, smem);
#pragma unroll
    for (int i = 0; i < 2; ++i)
#pragma unroll
      for (int e = 0; e < 16; ++e) {
        const int r = BIG_ROW(i, e);
        int tk = tokbase + r; tk = tk < 0 ? 0 : (tk > NTOK - 1 ? NTOK - 1 : tk);
        const float rs = rstd_of(rstd, tk);
#pragma unroll
        for (int j = 0; j < 4; ++j) U[r * 264 + BIG_COL(j)] = f2bf(acc[i][j][e] * rs);
      }
    __syncthreads();
    {
      const int c = (tid & 63) * 2, rg = tid >> 6;
      const int gcol = n * 128 + c, vcol = DFF + n * 128 + c;
      float wg0[2], wg1[2], wg2[2], bg[2], wv0[2], wv1[2], wv2[2], bv[2];
#pragma unroll
      for (int q = 0; q < 2; ++q) {
        wg0[q] = cw[gcol + q]; wg1[q] = cw[2 * DFF + gcol + q]; wg2[q] = cw[4 * DFF + gcol + q]; bg[q] = cb[gcol + q];
        wv0[q] = cw[vcol + q]; wv1[q] = cw[2 * DFF + vcol + q]; wv2[q] = cw[4 * DFF + vcol + q]; bv[q] = cb[vcol + q];
      }
      const int r0 = 2 + rg * 32;
      const int rend = (r0 + 32 > 256) ? 256 : r0 + 32;
      unsigned t;
      float g2[2], g1[2], v2[2], v1[2];
      t = *(const unsigned*)(U + (r0 - 2) * 264 + c); g2[0] = __uint_as_float(t << 16); g2[1] = __uint_as_float(t & 0xffff0000u);
      t = *(const unsigned*)(U + (r0 - 1) * 264 + c); g1[0] = __uint_as_float(t << 16); g1[1] = __uint_as_float(t & 0xffff0000u);
      t = *(const unsigned*)(U + (r0 - 2) * 264 + 128 + c); v2[0] = __uint_as_float(t << 16); v2[1] = __uint_as_float(t & 0xffff0000u);
      t = *(const unsigned*)(U + (r0 - 1) * 264 + 128 + c); v1[0] = __uint_as_float(t << 16); v1[1] = __uint_as_float(t & 0xffff0000u);
      const int tend = (b + 1) * SEQ;
      for (int r = r0; r < rend; ++r) {
        const unsigned ug = *(const unsigned*)(U + r * 264 + c), uv = *(const unsigned*)(U + r * 264 + 128 + c);
        const float g0[2] = {__uint_as_float(ug << 16), __uint_as_float(ug & 0xffff0000u)};
        const float v0[2] = {__uint_as_float(uv << 16), __uint_as_float(uv & 0xffff0000u)};
        float o[2];
#pragma unroll
        for (int q = 0; q < 2; ++q) {
          const float cg = bg[q] + wg0[q] * g2[q] + wg1[q] * g1[q] + wg2[q] * g0[q];
          const float cv = bv[q] + wv0[q] * v2[q] + wv1[q] * v1[q] + wv2[q] * v0[q];
          o[q] = siluf_(cg) * cv;
          g2[q] = g1[q]; g1[q] = g0[q]; v2[q] = v1[q]; v1[q] = v0[q];
        }
        const int tk = tokbase + r;
        if (tk < tend) *(unsigned*)(act + (size_t)tk * DFF + n * 128 + c) = pack2(o[0], o[1]);
      }
    }
    __syncthreads();
  }
}

#define PF_COLS 3328
DEV void first_tok_proj(const Params& p, int l, const float* xcur, int bid, int nb) {
  float* PF = (float*)(p.ws + OFF_PF);
  const float* w = p.in[2] + (size_t)l * DM * INC;
  const float* g1 = p.in[1] + l * DM;
  for (int task = bid; task < 4 * 7; task += nb) {
    const int b = task / 7, c = (task % 7) * 512 + my_tid();
    if (c < PF_COLS) {
      const float* xr = xcur + (size_t)b * SEQ * DM;
      float acc = 0.f, ss = 0.f;
      for (int k = 0; k < DM; ++k) {
        const float xv = xr[k];
        ss += xv * xv;
        acc += xv * g1[k] * w[(size_t)k * INC + c];
      }
      PF[b * PF_COLS + c] = acc * rsqrtf(ss * (1.0f / DM) + 1e-6f);
    }
  }
}
DEV void first_tok_fix(const Params& p, int l, float* smf, int bid, int nb) {
  const int tid = my_tid(), lane = tid & 63;
  const float* PF = (const float*)(p.ws + OFF_PF);
  u16* yrw = (u16*)(p.ws + OFF_BIG + B_YRW);
  u16* yret = (u16*)(p.ws + OFF_BIG + B_YRET);
  const float* mu = p.in[3] + l * 1792;
  for (int task = bid; task < 48; task += nb) {
    const int b = task / 12, hh = task % 12;
    const float* pf = PF + b * PF_COLS;
    const size_t t0 = (size_t)b * SEQ;
    __syncthreads();
    if (hh < 8) {
      const int h = hh;
      if (tid < 64) smf[tid] = pf[1600 + tid] * (1.f - mu[1600 + tid]);
      if (tid < 128) smf[64 + tid] = sigmoidf_(pf[1664 + tid] * (1.f - mu[1664 + tid]));
      __syncthreads();
      if (tid < 64) {
        const int ch = h * 64 + tid;
        const float r = pf[ch] * (1.f - mu[ch]);
        const float k = pf[512 + ch] * (1.f - mu[512 + ch]);
        const float v = pf[1024 + ch] * (1.f - mu[1024 + ch]);
        const float* aup = p.in[7] + (size_t)l * 64 * 512;
        const float* gup = p.in[8] + (size_t)l * 128 * 512;
        float al = p.in[6][l * 512 + ch], g = 0.f;
        for (int j = 0; j < 64; ++j) al += smf[j] * aup[j * 512 + ch];
        for (int j = 0; j < 128; ++j) g += smf[64 + j] * gup[j * 512 + ch];
        const float a = sigmoidf_(al);
        const float kp = k * (1.f + (a - 1.f) * p.in[10][l * 512 + ch]);
        const float s = wave_sum(kp * r);
        const float bon = wave_sum(r * kp * p.in[11][l * 512 + ch]);
        const float y = v * s;
        const float mean = wave_sum(y) * (1.f / 64.f);
        const float d = y - mean;
        const float var = wave_sum(d * d) * (1.f / 64.f);
        const float o = (d * rsqrtf(var + 64e-5f) * p.in[12][l * 512 + ch] + p.in[13][l * 512 + ch] + bon * v) * g;
        yrw[t0 * 512 + ch] = f2bf(o);
      }
    } else {
      const int h = hh - 8;
      float part = 0.f;
      if (tid < 64) part = pf[1792 + h * 64 + tid] * pf[1792 + 256 + h * 64 + tid];
      if (tid < 64) { part = wave_sum(part); if (lane == 0) smf[0] = part * 0.125f; }
      __syncthreads();
      const float s = smf[0];
      float y = 0.f;
      if (tid < 128) y = s * pf[1792 + 512 + h * 128 + tid];
      float q = wave_sum(y * y);
      if (tid < 128 && lane == 0) smf[1 + (tid >> 6)] = q;
      __syncthreads();
      if (tid < 128) {
        const float ms = (smf[1] + smf[2]) * (1.f / 128.f);
        const float g = pf[1792 + 1024 + h * 128 + tid];
        yret[t0 * 512 + h * 128 + tid] = f2bf(y * rsqrtf(ms + 1e-6f) * siluf_(g));
      }
    }
  }
}

#define NPHASE 32
template <int ph>
DEV void run_phase(const Params& p, unsigned char* smraw, int bid, int nb) {
  u16* smem = (u16*)smraw;
  float* smf = (float*)smraw;
  float* xo = p.out;
  u16* xb = (u16*)(p.ws + OFF_XB);
  float* ssq_all = (float*)(p.ws + OFF_RSTD);
  if (ph == 0) { phase_prep(p, smf, bid, nb); return; }
  if (ph == NPHASE - 1) { phase_final(xo, p.in[25], bid, nb); return; }
  const int l = (ph - 1) / 15, s = (ph - 1) % 15;
  const float* xcur = (l == 0) ? p.in[0] : xo;
  unsigned char* W = p.ws + OFF_W + (size_t)l * LW_BYTES;
  float* ssq1 = ssq_all + (size_t)(2 * l) * NTOK;
  float* ssq2 = ssq_all + (size_t)(2 * l + 1) * NTOK;
  switch (s) {
    case 0: if (l == 0) phase_norm(xcur, xb, ssq1, bid, nb); break;
    case 1: phase_inproj(xb, ssq1, (const u16*)(W + W_IN), 1792, (u16*)(p.ws + OFF_BIG + B_PRW), smem, bid, nb); break;
    case 2: phase_rwprep(p, l, smem, bid, nb); break;
    case 3: phase_scan<1>(p, l, smf, bid, nb); break;
    case 4: phase_scanprop(p, smf, bid, nb); first_tok_proj(p, l, xcur, nb - 1 - bid, nb); break;
    case 5: phase_scan<3>(p, l, smf, bid, nb); break;
    case 6: phase_inproj(xb, ssq1, (const u16*)(W + W_IN) + (size_t)1792 * DM, 2560, (u16*)(p.ws + OFF_BIG + B_PRS), smem, bid, nb); break;
    case 7:
      for (int u = bid; u < 1024; u += nb) ret_kv_unit(p, u, smem);
      for (int u = bid; u < 256; u += nb) sgu_unit(p, l, u, smem);
      break;
    case 8: phase_retprefix(p, bid, nb); break;
    case 9:
      for (int u = bid; u < 1024; u += nb) ret_out_unit(p, u, smem);
      first_tok_fix(p, l, smf, nb - 1 - bid, nb);
      break;
    case 10: phase_merge(p, l, ssq1, smem, bid, nb); break;
    case 11: phase_resgemm((const u16*)(p.ws + OFF_BIG + B_M), DM, (const u16*)(W + W_OUT), xcur, xo, xb, ssq2, smem, bid, nb); break;
    case 12: break;
    case 13: phase_ffnup(p, l, ssq2, smem, bid, nb); break;
    case 14:
      if (l == 0) phase_resgemm((const u16*)(p.ws + OFF_BIG + B_ACT), DFF, (const u16*)(W + W_DN), xo, xo, xb, ssq_all + (size_t)2 * NTOK, smem, bid, nb);
      else phase_resgemm((const u16*)(p.ws + OFF_BIG + B_ACT), DFF, (const u16*)(W + W_DN), xo, xo, nullptr, nullptr, smem, bid, nb);
      break;
  }
}
DEV constexpr bool phase_empty(int ph) {
  return ph >= 1 && ph < NPHASE - 1 && (((ph - 1) % 15 == 12) || ((ph - 1) % 15 == 0 && (ph - 1) / 15 == 1));
}

DEV void gsync(unsigned* ctr, unsigned& target) {
  asm volatile("s_waitcnt vmcnt(0)" ::: "memory");
  __syncthreads();
  if (my_tid() == 0) {
    target += gridDim.x;
    __builtin_amdgcn_fence(__ATOMIC_RELEASE, "agent");
    asm volatile("s_waitcnt vmcnt(0)" ::: "memory");
    __hip_atomic_fetch_add(ctr, 1u, __ATOMIC_RELAXED, __HIP_MEMORY_SCOPE_AGENT);
    while (__hip_atomic_load(ctr, __ATOMIC_RELAXED, __HIP_MEMORY_SCOPE_AGENT) < target) __builtin_amdgcn_s_sleep(2);
    __builtin_amdgcn_fence(__ATOMIC_ACQUIRE, "agent");
    asm volatile("s_waitcnt vmcnt(0)" ::: "memory");
  }
  __syncthreads();
}

#if COOP
template <int PH>
DEV void run_seq(const Params& p, unsigned char* smraw, cg::grid_group& grid, unsigned& target) {
  if constexpr (phase_empty(PH)) {
    run_seq<PH + 1>(p, smraw, grid, target);
  } else {
    int bid_ = blockIdx.x;
    asm volatile("" : "+s"(bid_));
    run_phase<PH>(p, smraw, bid_, gridDim.x);
    if constexpr (PH + 1 < NPHASE) {
      if constexpr (PH == 0) grid.sync();
      else gsync((unsigned*)p.ws, target);
      run_seq<PH + 1>(p, smraw, grid, target);
    }
  }
}
__global__ void __launch_bounds__(NTHR) mega(Params p) {
  __shared__ __align__(16) unsigned char smraw[147456];
  cg::grid_group grid = cg::this_grid();
  unsigned target = 0;
  run_seq<0>(p, smraw, grid, target);
}
#else
template <int PH>
__global__ void __launch_bounds__(NTHR) phk(Params p) {
  __shared__ __align__(16) unsigned char smraw[147456];
  run_phase<PH>(p, smraw, blockIdx.x, gridDim.x);
}
template <int PH>
static void launch_seq(const Params& p, hipStream_t stream) {
  phk<PH><<<256, NTHR, 0, stream>>>(p);
  if constexpr (PH + 1 < NPHASE) launch_seq<PH + 1>(p, stream);
}
#endif

extern "C" void kernel_launch(void* const* d_in, const int* in_sizes, int n_in, void* d_out, int out_size, void* d_ws,
                              size_t ws_size, hipStream_t stream) {
  Params p{};
  for (int i = 0; i < 26; ++i) p.in[i] = (const float*)d_in[i];
  p.out = (float*)d_out;
  p.ws = (unsigned char*)d_ws;
  if (ws_size < WS_NEED) { fprintf(stderr, "workspace too small: %zu < %llu\n", ws_size, (unsigned long long)WS_NEED); return; }
#if COOP
  static int grid_blocks = 0;
  if (!grid_blocks) {
    int dev = 0, cus = 0, per_cu = 0;
    hipGetDevice(&dev);
    hipDeviceGetAttribute(&cus, hipDeviceAttributeMultiprocessorCount, dev);
    hipOccupancyMaxActiveBlocksPerMultiprocessor(&per_cu, mega, NTHR, 0);
    if (per_cu > 1) per_cu = 1;
    grid_blocks = cus * per_cu;
  }
  hipMemsetAsync(d_ws, 0, 256, stream);
  void* args[] = {&p};
  hipError_t e = hipLaunchCooperativeKernel((void*)mega, dim3(grid_blocks), dim3(NTHR), args, 0, stream);
  if (e != hipSuccess) fprintf(stderr, "cooperative launch failed: %s (grid %d)\n", hipGetErrorString(e), grid_blocks);
#else
  launch_seq<0>(p, stream);
#endif
}
```

```cpp
#include <hip/hip_runtime.h>
#include <hip/hip_cooperative_groups.h>
#include <cstdio>
#include <cstdint>
namespace cg = cooperative_groups;

#ifndef COOP
#define COOP 1
#endif

#define DEV __device__ __forceinline__
typedef unsigned short u16;
typedef short bf16x8 __attribute__((ext_vector_type(8)));
typedef float f32x16 __attribute__((ext_vector_type(16)));

#define NTHR 512
#define NTOK 32768
#define SEQ 8192
#define DM 1024
#define INC 7424
#define DFF 2816
#define MiB (1048576ull)

#define OFF_ROPE (64ull * 1024)
#define OFF_RSTD (OFF_ROPE + 2 * MiB)
#define OFF_PF (OFF_RSTD + 640ull * 1024)
#define OFF_W (3 * MiB)
#define LW_BYTES (37 * MiB)
#define W_IN 0ull
#define W_BR 15204352ull
#define W_OUT 18350080ull
#define W_UP 20447232ull
#define W_DN 31981568ull
#define W_RWUP 37748736ull
#define W_RAUP 37814272ull
#define W_RGUP 37879808ull
#define W_SGW 38010880ull
#define OFF_XB (77 * MiB)
#define OFF_BIG (141 * MiB)
#define B_PRW 0ull
#define B_YRW 0ull
#define B_YRET (32 * MiB)
#define B_YSG (64 * MiB)
#define B_OPS (112 * MiB)
#define B_PRS (112 * MiB)
#define B_KV (272 * MiB)
#define B_M (112 * MiB)
#define B_PL (304 * MiB)
#define B_SINIT (320 * MiB)
#define B_ACT 0ull
#define WS_NEED (OFF_BIG + 328 * MiB)

struct Params {
  const float* in[26];
  float* out;
  unsigned char* ws;
};

DEV int my_tid() {
  int t = __builtin_amdgcn_workitem_id_x();
  asm volatile("" : "+v"(t));
  return t;
}
DEV u16 f2bf(float f) {
  unsigned u = __float_as_uint(f);
  u += 0x7fffu + ((u >> 16) & 1u);
  return (u16)(u >> 16);
}
DEV float bf2f(u16 h) { return __uint_as_float(((unsigned)h) << 16); }
DEV unsigned pack2(float a, float b) { return (unsigned)f2bf(a) | ((unsigned)f2bf(b) << 16); }
DEV void unpack8(uint4 v, float* f) {
  f[0] = __uint_as_float(v.x << 16); f[1] = __uint_as_float(v.x & 0xffff0000u);
  f[2] = __uint_as_float(v.y << 16); f[3] = __uint_as_float(v.y & 0xffff0000u);
  f[4] = __uint_as_float(v.z << 16); f[5] = __uint_as_float(v.z & 0xffff0000u);
  f[6] = __uint_as_float(v.w << 16); f[7] = __uint_as_float(v.w & 0xffff0000u);
}
DEV uint4 pack8(const float* f) {
  return make_uint4(pack2(f[0], f[1]), pack2(f[2], f[3]), pack2(f[4], f[5]), pack2(f[6], f[7]));
}
template <int CTRL>
DEV float dppmov(float x) {
  return __builtin_bit_cast(float, __builtin_amdgcn_update_dpp(0, __builtin_bit_cast(int, x), CTRL, 0xF, 0xF, true));
}
DEV float red4(float x) { x += dppmov<0xB1>(x); x += dppmov<0x4E>(x); return x; }
DEV float red8(float x) { x = red4(x); x += dppmov<0x141>(x); return x; }
DEV float wave_sum(float x) {
  x = red8(x);
  x += dppmov<0x140>(x);
  const int xi = __builtin_bit_cast(int, x);
  return __builtin_bit_cast(float, __builtin_amdgcn_readlane(xi, 0)) + __builtin_bit_cast(float, __builtin_amdgcn_readlane(xi, 16)) +
         __builtin_bit_cast(float, __builtin_amdgcn_readlane(xi, 32)) + __builtin_bit_cast(float, __builtin_amdgcn_readlane(xi, 48));
}
DEV float sigmoidf_(float x) { return 1.f / (1.f + __expf(-x)); }
DEV float siluf_(float x) { return x / (1.f + __expf(-x)); }
DEV float geluf_(float x) { return 0.5f * x * (1.f + erff(x * 0.70710678118654752f)); }

DEV float rstd_of(const float* ssq, int row) { return rsqrtf(ssq[row] * (1.0f / DM) + 1e-6f); }
DEV int vbid(int bid, int nb) { return ((nb & 7) == 0) ? (bid & 7) * (nb >> 3) + (bid >> 3) : bid; }
DEV void tile_map(int t, int MTL, int NTL, int& m, int& n) {
  int per = 8 * NTL;
  int g = t / per;
  int r = t - g * per;
  int gm = MTL - g * 8; gm = gm > 8 ? 8 : gm;
  m = g * 8 + r % gm;
  n = r / gm;
}

typedef unsigned u32x4 __attribute__((ext_vector_type(4)));
template <int NA>
struct GStage { u32x4 a0, a1, a2, a3, b0, b1; };
DEV u32x4 g_ld_a(const u16* A, long lda, int g, int azero_below, int arow_max, int ko) {
  const bool z = g < azero_below;
  g = g < 0 ? 0 : g;
  g = g > arow_max ? arow_max : g;
  u32x4 v = *(const u32x4*)(A + (long)g * lda + ko);
  const u32x4 zero = {0u, 0u, 0u, 0u};
  return z ? zero : v;
}
template <int NA>
DEV void g_load(GStage<NA>& S, const u16* A, long lda, int arow, int azero_below, int arow_max,
                const u16* bp0, const u16* bp1, int ko) {
  S.a0 = g_ld_a(A, lda, arow, azero_below, arow_max, ko);
  S.a1 = g_ld_a(A, lda, arow + 64, azero_below, arow_max, ko);
  if constexpr (NA == 4) {
    S.a2 = g_ld_a(A, lda, arow + 128, azero_below, arow_max, ko);
    S.a3 = g_ld_a(A, lda, arow + 192, azero_below, arow_max, ko);
  }
  S.b0 = *(const u32x4*)(bp0 + ko);
  S.b1 = *(const u32x4*)(bp1 + ko);
}
template <int NA>
DEV void g_store(const GStage<NA>& S, u16* An, u16* Bn, int st_off) {
  *(u32x4*)(An + st_off) = S.a0;
  *(u32x4*)(An + st_off + 64 * 72) = S.a1;
  if constexpr (NA == 4) {
    *(u32x4*)(An + st_off + 128 * 72) = S.a2;
    *(u32x4*)(An + st_off + 192 * 72) = S.a3;
  }
  *(u32x4*)(Bn + st_off) = S.b0;
  *(u32x4*)(Bn + st_off + 64 * 72) = S.b1;
}
template <int MT>
DEV void g_compute(f32x16 (&acc)[MT][2], const u16* Ab, const u16* Bb) {
#pragma unroll
  for (int ks = 0; ks < 4; ++ks) {
    bf16x8 a[MT], b[2];
#pragma unroll
    for (int i = 0; i < MT; ++i) a[i] = *(const bf16x8*)(Ab + i * 32 * 72 + ks * 16);
#pragma unroll
    for (int j = 0; j < 2; ++j) b[j] = *(const bf16x8*)(Bb + j * 32 * 72 + ks * 16);
#pragma unroll
    for (int i = 0; i < MT; ++i)
#pragma unroll
      for (int j = 0; j < 2; ++j) acc[i][j] = __builtin_amdgcn_mfma_f32_32x32x16_bf16(a[i], b[j], acc[i][j], 0, 0, 0);
  }
}
template <int MT>
DEV void gemm_tile(f32x16 (&acc)[MT][2], const u16* A, long lda, int arow0, int azero_below, int arow_max,
                   const u16* B, long ldb, int K, u16* smem) {
  constexpr int TM = 128 * MT;
  constexpr int ASZ = TM * 72, BSZ = 128 * 72;
  constexpr int NA = TM / 64;
  const int tid = my_tid(), lane = tid & 63, wave = tid >> 6, wm = wave >> 1, wn = wave & 1;
  const int crow = tid >> 3, ckc = tid & 7;
  GStage<NA> s0, s1;
  const u16* Ak = A + ckc * 8;
  const int arow = arow0 + crow;
  const u16* bp0 = B + (long)crow * ldb + ckc * 8;
  const u16* bp1 = B + (long)(crow + 64) * ldb + ckc * 8;
  const int nk = K >> 6;
  const int arow_l = (wm * 32 * MT + (lane & 31)) * 72 + (lane >> 5) * 8;
  const int brow_l = (wn * 64 + (lane & 31)) * 72 + (lane >> 5) * 8;
  const int st_off = crow * 72 + ckc * 8;
  g_load<NA>(s0, Ak, lda, arow, azero_below, arow_max, bp0, bp1, 0);
  g_store<NA>(s0, smem, smem + ASZ, st_off);
  g_load<NA>(s1, Ak, lda, arow, azero_below, arow_max, bp0, bp1, 64);
  __syncthreads();
  for (int kt = 0; kt < nk; kt += 2) {
    if (kt + 2 < nk) g_load<NA>(s0, Ak, lda, arow, azero_below, arow_max, bp0, bp1, (kt + 2) * 64);
    g_compute<MT>(acc, smem + arow_l, smem + ASZ + brow_l);
    g_store<NA>(s1, smem + (ASZ + BSZ), smem + (ASZ + BSZ) + ASZ, st_off);
    __syncthreads();
    if (kt + 3 < nk) g_load<NA>(s1, Ak, lda, arow, azero_below, arow_max, bp0, bp1, (kt + 3) * 64);
    g_compute<MT>(acc, smem + (ASZ + BSZ) + arow_l, smem + (ASZ + BSZ) + ASZ + brow_l);
    if (kt + 2 < nk) g_store<NA>(s0, smem, smem + ASZ, st_off);
    __syncthreads();
  }
}
struct GStageB { u32x4 a0, a1, a2, a3, b0, b1, b2, b3; };
DEV const u16* g_rowptr(const u16* A, long lda, int g, int arow_max) {
  g = g < 0 ? 0 : g;
  g = g > arow_max ? arow_max : g;
  return A + (long)g * lda;
}
DEV void gb_load(GStageB& S, const u16* A, long lda, int arow, int arow_max, const u16* Bk, long ldb, int ko) {
  S.a0 = *(const u32x4*)(g_rowptr(A, lda, arow, arow_max) + ko);
  S.a1 = *(const u32x4*)(g_rowptr(A, lda, arow + 64, arow_max) + ko);
  S.a2 = *(const u32x4*)(g_rowptr(A, lda, arow + 128, arow_max) + ko);
  S.a3 = *(const u32x4*)(g_rowptr(A, lda, arow + 192, arow_max) + ko);
  S.b0 = *(const u32x4*)(Bk + ko);
  S.b1 = *(const u32x4*)(Bk + 64 * ldb + ko);
  S.b2 = *(const u32x4*)(Bk + 128 * ldb + ko);
  S.b3 = *(const u32x4*)(Bk + 192 * ldb + ko);
}
DEV void gb_store(const GStageB& S, u16* An, u16* Bn, int st_off, int arow, int azero_below) {
  const u32x4 zero = {0u, 0u, 0u, 0u};
  *(u32x4*)(An + st_off) = (arow < azero_below) ? zero : S.a0;
  *(u32x4*)(An + st_off + 64 * 72) = (arow + 64 < azero_below) ? zero : S.a1;
  *(u32x4*)(An + st_off + 128 * 72) = (arow + 128 < azero_below) ? zero : S.a2;
  *(u32x4*)(An + st_off + 192 * 72) = (arow + 192 < azero_below) ? zero : S.a3;
  *(u32x4*)(Bn + st_off) = S.b0;
  *(u32x4*)(Bn + st_off + 64 * 72) = S.b1;
  *(u32x4*)(Bn + st_off + 128 * 72) = S.b2;
  *(u32x4*)(Bn + st_off + 192 * 72) = S.b3;
}
DEV void gb_compute(f32x16 (&acc)[2][4], const u16* Ab, const u16* Bb) {
#pragma unroll
  for (int ks = 0; ks < 4; ++ks) {
    bf16x8 a[2], b[4];
#pragma unroll
    for (int i = 0; i < 2; ++i) a[i] = *(const bf16x8*)(Ab + i * 32 * 72 + ks * 16);
#pragma unroll
    for (int j = 0; j < 4; ++j) b[j] = *(const bf16x8*)(Bb + j * 32 * 72 + ks * 16);
#pragma unroll
    for (int i = 0; i < 2; ++i)
#pragma unroll
      for (int j = 0; j < 4; ++j) acc[i][j] = __builtin_amdgcn_mfma_f32_32x32x16_bf16(a[i], b[j], acc[i][j], 0, 0, 0);
  }
}
DEV void gemm_big(f32x16 (&acc)[2][4], const u16* A, long lda, int arow0, int azero_below, int arow_max,
                  const u16* B, long ldb, int K, u16* smem) {
  constexpr int ASZ = 256 * 72, BSZ = 256 * 72;
  const int tid = my_tid(), lane = tid & 63, wave = tid >> 6, wm = wave >> 1, wn = wave & 1;
  const int crow = tid >> 3, ckc = tid & 7;
  const u16* Ak = A + ckc * 8;
  const int arow = arow0 + crow;
  const u16* Bk = B + (long)crow * ldb + ckc * 8;
  const int nk = K >> 6;
  const int arow_l = (wm * 64 + (lane & 31)) * 72 + (lane >> 5) * 8;
  const int brow_l = (wn * 128 + (lane & 31)) * 72 + (lane >> 5) * 8;
  const int st_off = crow * 72 + ckc * 8;
  GStageB s;
  gb_load(s, Ak, lda, arow, arow_max, Bk, ldb, 0);
  gb_store(s, smem, smem + ASZ, st_off, arow, azero_below);
  __syncthreads();
  for (int kt = 0; kt < nk; ++kt) {
    const bool more = kt + 1 < nk;
    if (more) gb_load(s, Ak, lda, arow, arow_max, Bk, ldb, (kt + 1) * 64);
    __builtin_amdgcn_sched_barrier(0);
    const u16* cb = smem + (kt & 1) * (ASZ + BSZ);
    gb_compute(acc, cb + arow_l, cb + ASZ + brow_l);
    __builtin_amdgcn_sched_barrier(0);
    if (more) {
      u16* nb_ = smem + ((kt + 1) & 1) * (ASZ + BSZ);
      gb_store(s, nb_, nb_ + ASZ, st_off, arow, azero_below);
    }
    __syncthreads();
  }
}
#define BIG_ROW(i, e) (wm * 64 + (i) * 32 + ((e) & 3) + 8 * ((e) >> 2) + 4 * (lane >> 5))
#define BIG_COL(j) (wn * 128 + (j) * 32 + (lane & 31))
#define ZERO_BIG(acc)                                   \
  _Pragma("unroll") for (int i_ = 0; i_ < 2; ++i_)      \
  _Pragma("unroll") for (int j_ = 0; j_ < 4; ++j_)      \
  _Pragma("unroll") for (int e_ = 0; e_ < 16; ++e_) acc[i_][j_][e_] = 0.f;

#define ACC_ROW(MT_, i, e) (wm * 32 * (MT_) + (i) * 32 + ((e) & 3) + 8 * ((e) >> 2) + 4 * (lane >> 5))
#define ACC_COL(j) (wn * 64 + (j) * 32 + (lane & 31))

DEV void tconv(const float* src, int K, int N, u16* dst, const float* scale, int mode, float* t, int bid, int nb) {
  const int tid = my_tid();
  const int KT = K >> 6, NT = N >> 6;
  for (int tt = bid; tt < KT * NT; tt += nb) {
    const int kt = tt % KT, nt = tt / KT;
    const int k0 = kt * 64, n0 = nt * 64;
    int sn0 = n0;
    if (mode == 1) { int j = n0 >> 8, c = n0 & 255; sn0 = (c < 128) ? (j * 128 + c) : (DFF + j * 128 + c - 128); }
    {
      const int kk = tid >> 6, n = tid & 63;
#pragma unroll
      for (int i = 0; i < 8; ++i) {
        int k = kk + 8 * i;
        float v = src[(long)(k0 + k) * N + sn0 + n];
        if (scale) v *= scale[k0 + k];
        t[k * 65 + n] = v;
      }
    }
    __syncthreads();
    {
      const int n = tid >> 3, k8 = tid & 7;
      float f[8];
#pragma unroll
      for (int j = 0; j < 8; ++j) f[j] = t[(k8 * 8 + j) * 65 + n];
      *(uint4*)(dst + (long)(n0 + n) * K + k0 + k8 * 8) = pack8(f);
    }
    __syncthreads();
  }
}

DEV void phase_prep(const Params& p, float* smf, int bid, int nb) {
  for (int l = 0; l < 2; ++l) {
    unsigned char* W = p.ws + OFF_W + (size_t)l * LW_BYTES;
    tconv(p.in[2] + (size_t)l * DM * INC, DM, INC, (u16*)(W + W_IN), p.in[1] + l * DM, 0, smf, bid, nb);
    for (int g = 0; g < 3; ++g)
      tconv(p.in[18] + (size_t)(l * 3 + g) * 512 * DM, 512, DM, (u16*)(W + W_BR) + (size_t)g * DM * 512, nullptr, 0, smf, bid, nb);
    tconv(p.in[19] + (size_t)l * DM * DM, DM, DM, (u16*)(W + W_OUT), nullptr, 0, smf, bid, nb);
    tconv(p.in[21] + (size_t)l * DM * 2 * DFF, DM, 2 * DFF, (u16*)(W + W_UP), p.in[20] + l * DM, 1, smf, bid, nb);
    tconv(p.in[24] + (size_t)l * DFF * DM, DFF, DM, (u16*)(W + W_DN), nullptr, 0, smf, bid, nb);
    tconv(p.in[5] + (size_t)l * 64 * 512, 64, 512, (u16*)(W + W_RWUP), nullptr, 0, smf, bid, nb);
    tconv(p.in[7] + (size_t)l * 64 * 512, 64, 512, (u16*)(W + W_RAUP), nullptr, 0, smf, bid, nb);
    tconv(p.in[8] + (size_t)l * 128 * 512, 128, 512, (u16*)(W + W_RGUP), nullptr, 0, smf, bid, nb);
    const float* sw = p.in[16] + (size_t)l * 4 * 128 * 128;
    u16* sd = (u16*)(W + W_SGW);
    for (int idx = bid * NTHR + my_tid(); idx < 4 * 128 * 128; idx += nb * NTHR) {
      int i = (idx >> 7) & 127, j = idx & 127;
      sd[idx] = f2bf(j <= i ? sw[idx] : 0.f);
    }
  }
  {
    float* sq = (float*)(p.ws + OFF_RSTD) + NTOK;
    for (int idx = bid * NTHR + my_tid(); idx < 3 * NTOK; idx += nb * NTHR) sq[idx] = 0.f;
  }
  float* rc = (float*)(p.ws + OFF_ROPE);
  float* rs = rc + SEQ * 32;
  for (int idx = bid * NTHR + my_tid(); idx < SEQ * 32; idx += nb * NTHR) {
    int pos = idx >> 5, d = idx & 31;
    float lin = (d == 31) ? 1.0f : (float)d * (1.0f / 31.0f);
    float invf = 1.0f / powf(10000.0f, lin);
    float ang = (float)pos * invf;
    double rev = (double)ang * 0.15915494309189533577;
    float fr = (float)(rev - floor(rev));
    rc[idx] = __builtin_amdgcn_cosf(fr);
    rs[idx] = __builtin_amdgcn_sinf(fr);
  }
}

DEV void phase_norm(const float* x, u16* xb, float* rstd, int bid, int nb) {
  const int lane = my_tid() & 63, wave = my_tid() >> 6;
  for (int row = bid * 8 + wave; row < NTOK; row += nb * 8) {
    const float4* xr = (const float4*)(x + (size_t)row * DM);
    float4 v[4];
    float ss = 0.f;
#pragma unroll
    for (int i = 0; i < 4; ++i) {
      v[i] = xr[lane + 64 * i];
      ss += v[i].x * v[i].x + v[i].y * v[i].y + v[i].z * v[i].z + v[i].w * v[i].w;
    }
    ss = wave_sum(ss);
    if (lane == 0) rstd[row] = ss;
    uint2* o = (uint2*)(xb + (size_t)row * DM);
#pragma unroll
    for (int i = 0; i < 4; ++i) o[lane + 64 * i] = make_uint2(pack2(v[i].x, v[i].y), pack2(v[i].z, v[i].w));
  }
}
DEV void phase_final(float* x, const float* g, int bid, int nb) {
  const int lane = my_tid() & 63, wave = my_tid() >> 6;
  for (int row = bid * 8 + wave; row < NTOK; row += nb * 8) {
    float4* xr = (float4*)(x + (size_t)row * DM);
    const float4* gr = (const float4*)g;
    float4 v[4];
    float ss = 0.f;
#pragma unroll
    for (int i = 0; i < 4; ++i) {
      v[i] = xr[lane + 64 * i];
      ss += v[i].x * v[i].x + v[i].y * v[i].y + v[i].z * v[i].z + v[i].w * v[i].w;
    }
    ss = wave_sum(ss);
    float r = rsqrtf(ss * (1.0f / DM) + 1e-6f);
#pragma unroll
    for (int i = 0; i < 4; ++i) {
      float4 gg = gr[lane + 64 * i];
      xr[lane + 64 * i] = make_float4(v[i].x * r * gg.x, v[i].y * r * gg.y, v[i].z * r * gg.z, v[i].w * r * gg.w);
    }
  }
}

DEV void phase_inproj(const u16* xb, const float* rstd, const u16* wt, int N, u16* out, u16* smem, int bid, int nb) {
  const int tid = my_tid(), lane = tid & 63, wave = tid >> 6, wm = wave >> 1, wn = wave & 1;
  const int MTL = NTOK / 256, NTL = N / 256;
  for (int t = vbid(bid, nb); t < MTL * NTL; t += nb) {
    int m, n;
    tile_map(t, MTL, NTL, m, n);
    f32x16 acc[2][4];
    ZERO_BIG(acc);
    gemm_big(acc, xb, DM, m * 256, -(1 << 30), NTOK - 1, wt + (size_t)n * 256 * DM, DM, DM, smem);
#pragma unroll
    for (int i = 0; i < 2; ++i)
#pragma unroll
      for (int e = 0; e < 16; ++e) {
        const int r = BIG_ROW(i, e);
        const float rs = rstd_of(rstd, m * 256 + r);
#pragma unroll
        for (int j = 0; j < 4; ++j) smem[r * 264 + BIG_COL(j)] = f2bf(acc[i][j][e] * rs);
      }
    __syncthreads();
#pragma unroll 4
    for (int k = 0; k < 16; ++k) {
      const int c = tid + NTHR * k;
      const int r = c >> 5, cc = c & 31;
      *(uint4*)(out + (size_t)(m * 256 + r) * N + n * 256 + cc * 8) = *(const uint4*)(smem + r * 264 + cc * 8);
    }
    __syncthreads();
  }
}

#define OPS_STRIDE ((size_t)NTOK * 512)
DEV void phase_rwprep(const Params& p, int l, u16* smem, int bid, int nb) {
  const int tid = my_tid(), lane = tid & 63, wave = tid >> 6, wm = wave >> 1, wn = wave & 1;
  const u16* prw = (const u16*)(p.ws + OFF_BIG + B_PRW);
  u16* ops = (u16*)(p.ws + OFF_BIG + B_OPS);
  unsigned char* W = p.ws + OFF_W + (size_t)l * LW_BYTES;
  const u16* wup = (const u16*)(W + W_RWUP);
  const u16* aup = (const u16*)(W + W_RAUP);
  const u16* gup = (const u16*)(W + W_RGUP);
  const float* mu = p.in[3] + l * 1792;
  const float* w0 = p.in[4] + l * 512;
  const float* a0 = p.in[6] + l * 512;
  u16* T = smem;
  for (int tile = bid; tile < NTOK / 128; tile += nb) {
    const int t0 = tile * 128;
    for (int c = tid; c < 128 * 224; c += NTHR) {
      int tok = c / 224, ch = (c % 224) * 8;
      int t = t0 + tok;
      float cur[8], prv[8], o[8];
      unpack8(*(const uint4*)(prw + (size_t)t * 1792 + ch), cur);
      if ((t & (SEQ - 1)) != 0) unpack8(*(const uint4*)(prw + (size_t)(t - 1) * 1792 + ch), prv);
      else {
#pragma unroll
        for (int j = 0; j < 8; ++j) prv[j] = 0.f;
      }
      float4 m0 = *(const float4*)(mu + ch), m1 = *(const float4*)(mu + ch + 4);
      float mm[8] = {m0.x, m0.y, m0.z, m0.w, m1.x, m1.y, m1.z, m1.w};
#pragma unroll
      for (int j = 0; j < 8; ++j) o[j] = cur[j] + mm[j] * (prv[j] - cur[j]);
      if (ch < 1536) {
        int arr = ch >> 9;
        *(uint4*)(ops + arr * OPS_STRIDE + (size_t)t * 512 + (ch & 511)) = pack8(o);
      } else {
        int cc = ch - 1536;
        if (cc < 64) {
#pragma unroll
          for (int j = 0; j < 8; ++j) o[j] = tanhf(o[j]);
        } else if (cc >= 128) {
#pragma unroll
          for (int j = 0; j < 8; ++j) o[j] = sigmoidf_(o[j]);
        }
        *(uint4*)(T + tok * 264 + cc) = pack8(o);
      }
    }
    __syncthreads();
    for (int nbk = 0; nbk < 4; ++nbk) {
      const int arow = (wm * 32 + (lane & 31)) * 264 + (lane >> 5) * 8;
      const int bn = nbk * 128 + wn * 64 + (lane & 31);
#pragma unroll 1
      for (int which = 0; which < 3; ++which) {
        f32x16 ac[2];
#pragma unroll
        for (int j = 0; j < 2; ++j)
#pragma unroll
          for (int e = 0; e < 16; ++e) ac[j][e] = 0.f;
        const int kd = (which == 2) ? 128 : 64;
        const int aoff = (which == 0) ? 0 : (which == 1 ? 64 : 128);
        const u16* wsrc = (which == 0) ? wup : (which == 1 ? aup : gup);
        for (int ks = 0; ks < kd / 16; ++ks) {
          bf16x8 a1 = *(const bf16x8*)(T + arow + aoff + ks * 16);
#pragma unroll
          for (int j = 0; j < 2; ++j) {
            bf16x8 b1 = *(const bf16x8*)(wsrc + (size_t)(bn + j * 32) * kd + ks * 16 + (lane >> 5) * 8);
            ac[j] = __builtin_amdgcn_mfma_f32_32x32x16_bf16(a1, b1, ac[j], 0, 0, 0);
          }
        }
#pragma unroll
        for (int j = 0; j < 2; ++j) {
          const int ch = nbk * 128 + ACC_COL(j);
          const float w0c = w0[ch], a0c = a0[ch];
#pragma unroll
          for (int e = 0; e < 16; ++e) {
            const int t = t0 + ACC_ROW(1, 0, e);
            const size_t o = (size_t)t * 512 + ch;
            float val;
            if (which == 0) {
              float z = -(w0c + ac[j][e]);
              float sp = fmaxf(z, 0.f) + log1pf(__expf(-fabsf(z)));
              val = __expf(-sp - 0.5f);
            } else if (which == 1) {
              val = sigmoidf_(a0c + ac[j][e]);
            } else {
              val = ac[j][e];
            }
            const int arr = (which == 0) ? 4 : (which == 1 ? 3 : 5);
            ops[(size_t)arr * OPS_STRIDE + o] = f2bf(val);
          }
        }
      }
    }
    __syncthreads();
  }
}

#define TS 32
struct ScanStage {
  float* W; float* KK; float* BB; float* KP; float* RR; float* VV; float* YY;
};
template <int PASS>
DEV void phase_scan(const Params& p, int l, float* smf, int bid, int nb) {
  const int tid = my_tid();
  const int half = tid >> 8, tu = tid & 255;
  const u16* ops = (const u16*)(p.ws + OFF_BIG + B_OPS);
  float* PL = (float*)(p.ws + OFF_BIG + B_PL);
  const float* SIN = (const float*)(p.ws + OFF_BIG + B_SINIT);
  u16* yrw = (u16*)(p.ws + OFF_BIG + B_YRW);
  const float* k_k = p.in[9] + l * 512;
  const float* k_a = p.in[10] + l * 512;
  const float* r_k = p.in[11] + l * 512;
  const float* lng = p.in[12] + l * 512;
  const float* lnb = p.in[13] + l * 512;
  float* base = smf + half * (7 * TS * 64);
  float* sW = base; float* sKK = base + TS * 64; float* sB = base + 2 * TS * 64; float* sKP = base + 3 * TS * 64;
  float* sR = base + 4 * TS * 64; float* sV = base + 5 * TS * 64; float* sY = base + 6 * TS * 64;
  const int ss = tu >> 3, c8 = tu & 7;
  const int ks = tu & 7, rp = tu >> 3;
  for (int u2 = bid; u2 < 256; u2 += nb) {
    const int u = u2 * 2 + half;
    const int bh = u >> 4, c = u & 15;
    const int b = bh >> 3, h = bh & 7;
    const int tok0 = b * SEQ + c * 512;
    const int chb = h * 64 + c8 * 8;
    float S0[8], S1[8], Q0[8], Q1[8];
    if (PASS == 1) {
#pragma unroll
      for (int j = 0; j < 8; ++j) {
        S0[j] = 0.f; S1[j] = 0.f;
        Q0[j] = (ks * 8 + j == 2 * rp) ? 1.f : 0.f;
        Q1[j] = (ks * 8 + j == 2 * rp + 1) ? 1.f : 0.f;
      }
    } else {
      const float* si = SIN + (size_t)u * 4096;
      float4 x0 = *(const float4*)(si + (2 * rp) * 64 + ks * 8), x1 = *(const float4*)(si + (2 * rp) * 64 + ks * 8 + 4);
      float4 y0 = *(const float4*)(si + (2 * rp + 1) * 64 + ks * 8), y1 = *(const float4*)(si + (2 * rp + 1) * 64 + ks * 8 + 4);
      S0[0] = x0.x; S0[1] = x0.y; S0[2] = x0.z; S0[3] = x0.w; S0[4] = x1.x; S0[5] = x1.y; S0[6] = x1.z; S0[7] = x1.w;
      S1[0] = y0.x; S1[1] = y0.y; S1[2] = y0.z; S1[3] = y0.w; S1[4] = y1.x; S1[5] = y1.y; S1[6] = y1.z; S1[7] = y1.w;
#pragma unroll
      for (int j = 0; j < 8; ++j) { Q0[j] = 0.f; Q1[j] = 0.f; }
    }
    float kkc[8], kac[8], rkc[8];
    {
      float4 q0 = *(const float4*)(k_k + chb), q1 = *(const float4*)(k_k + chb + 4);
      kkc[0] = q0.x; kkc[1] = q0.y; kkc[2] = q0.z; kkc[3] = q0.w; kkc[4] = q1.x; kkc[5] = q1.y; kkc[6] = q1.z; kkc[7] = q1.w;
      q0 = *(const float4*)(k_a + chb); q1 = *(const float4*)(k_a + chb + 4);
      kac[0] = q0.x; kac[1] = q0.y; kac[2] = q0.z; kac[3] = q0.w; kac[4] = q1.x; kac[5] = q1.y; kac[6] = q1.z; kac[7] = q1.w;
      q0 = *(const float4*)(r_k + chb); q1 = *(const float4*)(r_k + chb + 4);
      rkc[0] = q0.x; rkc[1] = q0.y; rkc[2] = q0.z; rkc[3] = q0.w; rkc[4] = q1.x; rkc[5] = q1.y; rkc[6] = q1.z; rkc[7] = q1.w;
    }
    uint4 pr_r, pr_k, pr_v, pr_a, pr_e, pr_g = make_uint4(0, 0, 0, 0);
    {
      const size_t o0 = (size_t)(tok0 + ss) * 512 + chb;
      pr_r = *(const uint4*)(ops + 0 * OPS_STRIDE + o0);
      pr_k = *(const uint4*)(ops + 1 * OPS_STRIDE + o0);
      pr_v = *(const uint4*)(ops + 2 * OPS_STRIDE + o0);
      pr_a = *(const uint4*)(ops + 3 * OPS_STRIDE + o0);
      pr_e = *(const uint4*)(ops + 4 * OPS_STRIDE + o0);
      if (PASS == 3) pr_g = *(const uint4*)(ops + 5 * OPS_STRIDE + o0);
    }
    for (int sc = 0; sc < 512 / TS; ++sc) {
      const size_t o = (size_t)(tok0 + sc * TS + ss) * 512 + chb;
      float fr[8], fk[8], fv[8], fa[8], fe[8];
      unpack8(pr_r, fr);
      unpack8(pr_k, fk);
      unpack8(pr_v, fv);
      unpack8(pr_a, fa);
      unpack8(pr_e, fe);
      const uint4 graw = pr_g;
      if (sc + 1 < 512 / TS) {
        const size_t o1 = o + (size_t)TS * 512;
        pr_r = *(const uint4*)(ops + 0 * OPS_STRIDE + o1);
        pr_k = *(const uint4*)(ops + 1 * OPS_STRIDE + o1);
        pr_v = *(const uint4*)(ops + 2 * OPS_STRIDE + o1);
        pr_a = *(const uint4*)(ops + 3 * OPS_STRIDE + o1);
        pr_e = *(const uint4*)(ops + 4 * OPS_STRIDE + o1);
        if (PASS == 3) pr_g = *(const uint4*)(ops + 5 * OPS_STRIDE + o1);
      }
      float kk[8], kp[8], ssq = 0.f, bon = 0.f;
#pragma unroll
      for (int j = 0; j < 8; ++j) {
        kk[j] = fk[j] * kkc[j];
        ssq += kk[j] * kk[j];
        kp[j] = fk[j] * (1.f + (fa[j] - 1.f) * kac[j]);
        bon += fr[j] * kp[j] * rkc[j];
      }
      ssq = red8(ssq);
      bon = red8(bon);
      const float inv = 1.f / fmaxf(sqrtf(ssq), 1e-12f);
      float fw[8], fb[8];
#pragma unroll
      for (int j = 0; j < 8; ++j) {
        kk[j] *= inv;
        fb[j] = fa[j] * kk[j];
        fw[j] = __expf(-fe[j]);
      }
      {
        const int so = ss * 64 + c8 * 8;
        *(float4*)(sW + so) = make_float4(fw[0], fw[1], fw[2], fw[3]); *(float4*)(sW + so + 4) = make_float4(fw[4], fw[5], fw[6], fw[7]);
        *(float4*)(sKK + so) = make_float4(kk[0], kk[1], kk[2], kk[3]); *(float4*)(sKK + so + 4) = make_float4(kk[4], kk[5], kk[6], kk[7]);
        *(float4*)(sB + so) = make_float4(fb[0], fb[1], fb[2], fb[3]); *(float4*)(sB + so + 4) = make_float4(fb[4], fb[5], fb[6], fb[7]);
        *(float4*)(sKP + so) = make_float4(kp[0], kp[1], kp[2], kp[3]); *(float4*)(sKP + so + 4) = make_float4(kp[4], kp[5], kp[6], kp[7]);
        *(float4*)(sV + so) = make_float4(fv[0], fv[1], fv[2], fv[3]); *(float4*)(sV + so + 4) = make_float4(fv[4], fv[5], fv[6], fv[7]);
        if (PASS == 3) {
          *(float4*)(sR + so) = make_float4(fr[0], fr[1], fr[2], fr[3]); *(float4*)(sR + so + 4) = make_float4(fr[4], fr[5], fr[6], fr[7]);
        }
      }
      __syncthreads();
#pragma unroll 2
      for (int s = 0; s < TS; ++s) {
        const int so = s * 64 + ks * 8;
        float4 t0 = *(const float4*)(sW + so), t1 = *(const float4*)(sW + so + 4);
        float w[8] = {t0.x, t0.y, t0.z, t0.w, t1.x, t1.y, t1.z, t1.w};
        t0 = *(const float4*)(sKK + so); t1 = *(const float4*)(sKK + so + 4);
        float kq[8] = {t0.x, t0.y, t0.z, t0.w, t1.x, t1.y, t1.z, t1.w};
        t0 = *(const float4*)(sB + so); t1 = *(const float4*)(sB + so + 4);
        float bq[8] = {t0.x, t0.y, t0.z, t0.w, t1.x, t1.y, t1.z, t1.w};
        t0 = *(const float4*)(sKP + so); t1 = *(const float4*)(sKP + so + 4);
        float kpq[8] = {t0.x, t0.y, t0.z, t0.w, t1.x, t1.y, t1.z, t1.w};
        const float2 vv = *(const float2*)(sV + s * 64 + 2 * rp);
        float sa0 = 0.f, sa1 = 0.f;
#pragma unroll
        for (int j = 0; j < 8; ++j) { sa0 += S0[j] * kq[j]; sa1 += S1[j] * kq[j]; }
        sa0 = red8(sa0); sa1 = red8(sa1);
#pragma unroll
        for (int j = 0; j < 8; ++j) {
          S0[j] = S0[j] * w[j] - sa0 * bq[j] + vv.x * kpq[j];
          S1[j] = S1[j] * w[j] - sa1 * bq[j] + vv.y * kpq[j];
        }
        if (PASS == 1) {
          float pa0 = 0.f, pa1 = 0.f;
#pragma unroll
          for (int j = 0; j < 8; ++j) { pa0 += Q0[j] * kq[j]; pa1 += Q1[j] * kq[j]; }
          pa0 = red8(pa0); pa1 = red8(pa1);
#pragma unroll
          for (int j = 0; j < 8; ++j) {
            Q0[j] = Q0[j] * w[j] - pa0 * bq[j];
            Q1[j] = Q1[j] * w[j] - pa1 * bq[j];
          }
        } else {
          t0 = *(const float4*)(sR + so); t1 = *(const float4*)(sR + so + 4);
          float rq[8] = {t0.x, t0.y, t0.z, t0.w, t1.x, t1.y, t1.z, t1.w};
          float y0 = 0.f, y1 = 0.f;
#pragma unroll
          for (int j = 0; j < 8; ++j) { y0 += S0[j] * rq[j]; y1 += S1[j] * rq[j]; }
          y0 = red8(y0); y1 = red8(y1);
          if (ks == 0) *(float2*)(sY + s * 64 + 2 * rp) = make_float2(y0, y1);
        }
      }
      __syncthreads();
      if (PASS == 3) {
        const int so = ss * 64 + c8 * 8;
        float4 y0 = *(const float4*)(sY + so), y1 = *(const float4*)(sY + so + 4);
        float y[8] = {y0.x, y0.y, y0.z, y0.w, y1.x, y1.y, y1.z, y1.w};
        float sm = 0.f;
#pragma unroll
        for (int j = 0; j < 8; ++j) sm += y[j];
        const float mean = red8(sm) * (1.f / 64.f);
        float sv = 0.f;
#pragma unroll
        for (int j = 0; j < 8; ++j) { y[j] -= mean; sv += y[j] * y[j]; }
        const float var = red8(sv) * (1.f / 64.f);
        const float rs = rsqrtf(var + 64e-5f);
        float g[8], outv[8];
        unpack8(graw, g);
        float4 l0 = *(const float4*)(lng + chb), l1 = *(const float4*)(lng + chb + 4);
        float4 b0 = *(const float4*)(lnb + chb), b1 = *(const float4*)(lnb + chb + 4);
        float lg[8] = {l0.x, l0.y, l0.z, l0.w, l1.x, l1.y, l1.z, l1.w};
        float lb[8] = {b0.x, b0.y, b0.z, b0.w, b1.x, b1.y, b1.z, b1.w};
#pragma unroll
        for (int j = 0; j < 8; ++j) outv[j] = (y[j] * rs * lg[j] + lb[j] + bon * fv[j]) * g[j];
        if (!(c == 0 && sc == 0 && ss == 0)) *(uint4*)(yrw + o) = pack8(outv);
      }
    }
    if (PASS == 1) {
      float* pl = PL + (size_t)u * 8192;
      float* Pm = pl;
      float* Lm = pl + 4096;
      *(float4*)(Pm + (2 * rp) * 64 + ks * 8) = make_float4(Q0[0], Q0[1], Q0[2], Q0[3]);
      *(float4*)(Pm + (2 * rp) * 64 + ks * 8 + 4) = make_float4(Q0[4], Q0[5], Q0[6], Q0[7]);
      *(float4*)(Pm + (2 * rp + 1) * 64 + ks * 8) = make_float4(Q1[0], Q1[1], Q1[2], Q1[3]);
      *(float4*)(Pm + (2 * rp + 1) * 64 + ks * 8 + 4) = make_float4(Q1[4], Q1[5], Q1[6], Q1[7]);
      *(float4*)(Lm + (2 * rp) * 64 + ks * 8) = make_float4(S0[0], S0[1], S0[2], S0[3]);
      *(float4*)(Lm + (2 * rp) * 64 + ks * 8 + 4) = make_float4(S0[4], S0[5], S0[6], S0[7]);
      *(float4*)(Lm + (2 * rp + 1) * 64 + ks * 8) = make_float4(S1[0], S1[1], S1[2], S1[3]);
      *(float4*)(Lm + (2 * rp + 1) * 64 + ks * 8 + 4) = make_float4(S1[4], S1[5], S1[6], S1[7]);
    }
  }
}

DEV void phase_scanprop(const Params& p, float* smf, int bid, int nb) {
  const int tid = my_tid();
  const float* PL = (const float*)(p.ws + OFF_BIG + B_PL);
  float* SIN = (float*)(p.ws + OFF_BIG + B_SINIT);
  float* sS = smf;
  float* sP = smf + 4096;
  const int i = tid >> 3, k8 = tid & 7;
  for (int bh = bid; bh < 32; bh += nb) {
    float cur[8];
#pragma unroll
    for (int j = 0; j < 8; ++j) cur[j] = 0.f;
    for (int c = 0; c < 16; ++c) {
      const int u = bh * 16 + c;
      float* so = SIN + (size_t)u * 4096 + i * 64 + k8 * 8;
      *(float4*)so = make_float4(cur[0], cur[1], cur[2], cur[3]);
      *(float4*)(so + 4) = make_float4(cur[4], cur[5], cur[6], cur[7]);
      if (c == 15) break;
      const float* pl = PL + (size_t)u * 8192;
      *(float4*)(sS + i * 64 + k8 * 8) = make_float4(cur[0], cur[1], cur[2], cur[3]);
      *(float4*)(sS + i * 64 + k8 * 8 + 4) = make_float4(cur[4], cur[5], cur[6], cur[7]);
      *(float4*)(sP + tid * 8) = *(const float4*)(pl + tid * 8);
      *(float4*)(sP + tid * 8 + 4) = *(const float4*)(pl + tid * 8 + 4);
      float4 l0 = *(const float4*)(pl + 4096 + i * 64 + k8 * 8), l1 = *(const float4*)(pl + 4096 + i * 64 + k8 * 8 + 4);
      __syncthreads();
      float nw[8] = {l0.x, l0.y, l0.z, l0.w, l1.x, l1.y, l1.z, l1.w};
#pragma unroll 8
      for (int j = 0; j < 64; ++j) {
        const float sij = sS[i * 64 + j];
        float4 p0 = *(const float4*)(sP + j * 64 + k8 * 8), p1 = *(const float4*)(sP + j * 64 + k8 * 8 + 4);
        nw[0] += sij * p0.x; nw[1] += sij * p0.y; nw[2] += sij * p0.z; nw[3] += sij * p0.w;
        nw[4] += sij * p1.x; nw[5] += sij * p1.y; nw[6] += sij * p1.z; nw[7] += sij * p1.w;
      }
#pragma unroll
      for (int j = 0; j < 8; ++j) cur[j] = nw[j];
      __syncthreads();
    }
  }
}

DEV float ret_log2gamma(int h) { return log2f(1.0f - exp2f(-5.0f - (float)h)); }

DEV void stage_rot(const u16* src, size_t ld, const float* rc, const float* rs, int pos0, u16* dst, float sc, float l2g, int rowmode) {
  const int tid = my_tid();
  const int row = tid >> 2, d0 = (tid & 3) * 8;
  float lo[8], hi[8], olo[8], ohi[8];
  unpack8(*(const uint4*)(src + (size_t)row * ld + d0), lo);
  unpack8(*(const uint4*)(src + (size_t)row * ld + d0 + 32), hi);
  const float* cp = rc + (size_t)(pos0 + row) * 32 + d0;
  const float* sp = rs + (size_t)(pos0 + row) * 32 + d0;
  float4 c0 = *(const float4*)cp, c1 = *(const float4*)(cp + 4);
  float4 s0 = *(const float4*)sp, s1 = *(const float4*)(sp + 4);
  float cc[8] = {c0.x, c0.y, c0.z, c0.w, c1.x, c1.y, c1.z, c1.w};
  float sn[8] = {s0.x, s0.y, s0.z, s0.w, s1.x, s1.y, s1.z, s1.w};
  float rsc = sc;
  if (rowmode == 1) rsc *= exp2f((float)(row + 1) * l2g);
  if (rowmode == 2) rsc *= exp2f((float)(127 - row) * l2g);
#pragma unroll
  for (int j = 0; j < 8; ++j) {
    olo[j] = (lo[j] * cc[j] - hi[j] * sn[j]) * rsc;
    ohi[j] = (hi[j] * cc[j] + lo[j] * sn[j]) * rsc;
  }
  *(uint4*)(dst + row * 72 + d0) = pack8(olo);
  *(uint4*)(dst + row * 72 + d0 + 32) = pack8(ohi);
}
DEV void stage_rot_T(const u16* src, size_t ld, const float* rc, const float* rs, int pos0, u16* dst, float sc, float l2g) {
  const int tid = my_tid();
  const int row = tid >> 2, d0 = (tid & 3) * 8;
  float lo[8], hi[8];
  unpack8(*(const uint4*)(src + (size_t)row * ld + d0), lo);
  unpack8(*(const uint4*)(src + (size_t)row * ld + d0 + 32), hi);
  const float* cp = rc + (size_t)(pos0 + row) * 32 + d0;
  const float* sp = rs + (size_t)(pos0 + row) * 32 + d0;
  float4 c0 = *(const float4*)cp, c1 = *(const float4*)(cp + 4);
  float4 s0 = *(const float4*)sp, s1 = *(const float4*)(sp + 4);
  float cc[8] = {c0.x, c0.y, c0.z, c0.w, c1.x, c1.y, c1.z, c1.w};
  float sn[8] = {s0.x, s0.y, s0.z, s0.w, s1.x, s1.y, s1.z, s1.w};
  const float rsc = sc * exp2f((float)(127 - row) * l2g);
#pragma unroll
  for (int j = 0; j < 8; ++j) {
    dst[(d0 + j) * 136 + row] = f2bf((lo[j] * cc[j] - hi[j] * sn[j]) * rsc);
    dst[(d0 + j + 32) * 136 + row] = f2bf((hi[j] * cc[j] + lo[j] * sn[j]) * rsc);
  }
}
DEV void stage_vT(const u16* src, size_t ld, u16* dst) {
  const int tid = my_tid();
  const int row = tid >> 2, d0 = (tid & 3) * 32;
#pragma unroll
  for (int c = 0; c < 4; ++c) {
    uint4 v = *(const uint4*)(src + (size_t)row * ld + d0 + c * 8);
    unsigned w[4] = {v.x, v.y, v.z, v.w};
#pragma unroll
    for (int j = 0; j < 4; ++j) {
      dst[(d0 + c * 8 + 2 * j) * 136 + row] = (u16)(w[j] & 0xffffu);
      dst[(d0 + c * 8 + 2 * j + 1) * 136 + row] = (u16)(w[j] >> 16);
    }
  }
}

DEV void ret_kv_unit(const Params& p, int u, u16* smem) {
  const int tid = my_tid(), lane = tid & 63, wave = tid >> 6;
  const u16* prs = (const u16*)(p.ws + OFF_BIG + B_PRS);
  float* KV = (float*)(p.ws + OFF_BIG + B_KV);
  const float* rc = (const float*)(p.ws + OFF_ROPE);
  const float* rs = rc + SEQ * 32;
  const int n = u & 63, h = (u >> 6) & 3, b = u >> 8;
  const size_t t0 = (size_t)b * SEQ + n * 128;
  const float l2g = ret_log2gamma(h);
  u16* KT = smem;
  u16* VT = smem + 64 * 136;
  stage_rot_T(prs + t0 * 2560 + 256 + h * 64, 2560, rc, rs, n * 128, KT, 0.125f, l2g);
  stage_vT(prs + t0 * 2560 + 512 + h * 128, 2560, VT);
  __syncthreads();
  const int mi = wave >> 1, nj = wave & 1;
  f32x16 acc;
#pragma unroll
  for (int e = 0; e < 16; ++e) acc[e] = 0.f;
#pragma unroll
  for (int ks = 0; ks < 8; ++ks) {
    bf16x8 a = *(const bf16x8*)(VT + (mi * 32 + (lane & 31)) * 136 + ks * 16 + (lane >> 5) * 8);
    bf16x8 bb = *(const bf16x8*)(KT + (nj * 32 + (lane & 31)) * 136 + ks * 16 + (lane >> 5) * 8);
    acc = __builtin_amdgcn_mfma_f32_32x32x16_bf16(a, bb, acc, 0, 0, 0);
  }
  float* kv = KV + (size_t)u * 8192;
#pragma unroll
  for (int e = 0; e < 16; ++e) {
    int dv = mi * 32 + (e & 3) + 8 * (e >> 2) + 4 * (lane >> 5);
    int dk = nj * 32 + (lane & 31);
    kv[dv * 64 + dk] = acc[e];
  }
  __syncthreads();
}

DEV void sgu_unit(const Params& p, int l, int u, u16* smem) {
  const int tid = my_tid(), lane = tid & 63, wave = tid >> 6, wm = wave >> 1, wn = wave & 1;
  const u16* prs = (const u16*)(p.ws + OFF_BIG + B_PRS);
  u16* ysg = (u16*)(p.ws + OFF_BIG + B_YSG);
  const u16* sgw = (const u16*)(p.ws + OFF_W + (size_t)l * LW_BYTES + W_SGW);
  const float* lng = p.in[14] + l * 512;
  const float* lnb = p.in[15] + l * 512;
  const float* sgb = p.in[17] + l * 512;
  const size_t t0 = (size_t)u * 128;
  u16* VT = smem;
  u16* WT = smem + 128 * 136;
  float* st = (float*)(smem + 2 * 128 * 136);
  const int tok = tid >> 2, q = tid & 3;
  const u16* vrow = prs + (t0 + tok) * 2560 + 1536 + 512;
  {
    float s = 0.f, s2 = 0.f;
#pragma unroll 4
    for (int c = 0; c < 16; ++c) {
      float f[8];
      unpack8(*(const uint4*)(vrow + q * 128 + c * 8), f);
#pragma unroll
      for (int j = 0; j < 8; ++j) { float gl = geluf_(f[j]); s += gl; s2 += gl * gl; }
    }
    s = red4(s); s2 = red4(s2);
    const float mean = s * (1.f / 512.f);
    const float var = fmaxf(s2 * (1.f / 512.f) - mean * mean, 0.f);
    if (q == 0) { st[tok] = mean; st[128 + tok] = rsqrtf(var + 1e-6f); }
  }
  __syncthreads();
  const float mean = st[tok], rstd = st[128 + tok];
  for (int g = 0; g < 4; ++g) {
#pragma unroll
    for (int c = 0; c < 4; ++c) {
      const int d = q * 32 + c * 8;
      float f[8];
      unpack8(*(const uint4*)(vrow + g * 128 + d), f);
      float4 g0 = *(const float4*)(lng + g * 128 + d), g1 = *(const float4*)(lng + g * 128 + d + 4);
      float4 b0 = *(const float4*)(lnb + g * 128 + d), b1 = *(const float4*)(lnb + g * 128 + d + 4);
      float gg[8] = {g0.x, g0.y, g0.z, g0.w, g1.x, g1.y, g1.z, g1.w};
      float bb[8] = {b0.x, b0.y, b0.z, b0.w, b1.x, b1.y, b1.z, b1.w};
#pragma unroll
      for (int j = 0; j < 8; ++j) VT[(d + j) * 136 + tok] = f2bf((geluf_(f[j]) - mean) * rstd * gg[j] + bb[j]);
      *(uint4*)(WT + tok * 136 + d) = *(const uint4*)(sgw + (size_t)g * 16384 + tok * 128 + d);
    }
    __syncthreads();
    f32x16 acc[2];
#pragma unroll
    for (int j = 0; j < 2; ++j)
#pragma unroll
      for (int e = 0; e < 16; ++e) acc[j][e] = 0.f;
#pragma unroll
    for (int ks = 0; ks < 8; ++ks) {
      bf16x8 a = *(const bf16x8*)(WT + (wm * 32 + (lane & 31)) * 136 + ks * 16 + (lane >> 5) * 8);
#pragma unroll
      for (int j = 0; j < 2; ++j) {
        bf16x8 bb = *(const bf16x8*)(VT + (wn * 64 + j * 32 + (lane & 31)) * 136 + ks * 16 + (lane >> 5) * 8);
        acc[j] = __builtin_amdgcn_mfma_f32_32x32x16_bf16(a, bb, acc[j], 0, 0, 0);
      }
    }
#pragma unroll
    for (int e = 0; e < 16; ++e) {
      const int i = ACC_ROW(1, 0, e);
      const float bias = sgb[g * 128 + i];
#pragma unroll
      for (int j = 0; j < 2; ++j) {
        const int d = ACC_COL(j);
        const float uu = geluf_(bf2f(prs[(t0 + i) * 2560 + 1536 + g * 128 + d]));
        ysg[(t0 + i) * 512 + g * 128 + d] = f2bf(uu * (acc[j][e] + bias));
      }
    }
    __syncthreads();
  }
}

DEV void phase_retprefix(const Params& p, int bid, int nb) {
  float* KV = (float*)(p.ws + OFF_BIG + B_KV);
  for (int gid = bid * NTHR + my_tid(); gid < 16 * 8192; gid += nb * NTHR) {
    const int bh = gid >> 13, e = gid & 8191;
    const int h = bh & 3;
    const float cd = exp2f(128.f * ret_log2gamma(h));
    float R = 0.f;
    float* ptr = KV + (size_t)bh * 64 * 8192 + e;
    for (int n = 0; n < 64; ++n) {
      float kv = ptr[(size_t)n * 8192];
      ptr[(size_t)n * 8192] = R;
      R = R * cd + kv;
    }
  }
}

DEV void ret_out_unit(const Params& p, int u, u16* smem) {
  const int tid = my_tid(), lane = tid & 63, wave = tid >> 6, wm = wave >> 1, wn = wave & 1;
  const u16* prs = (const u16*)(p.ws + OFF_BIG + B_PRS);
  const float* KV = (const float*)(p.ws + OFF_BIG + B_KV);
  u16* yret = (u16*)(p.ws + OFF_BIG + B_YRET);
  const float* rc = (const float*)(p.ws + OFF_ROPE);
  const float* rs = rc + SEQ * 32;
  const int n = u & 63, h = (u >> 6) & 3, b = u >> 8;
  const size_t t0 = (size_t)b * SEQ + n * 128;
  const float l2g = ret_log2gamma(h);
  u16* Q = smem;
  u16* Kr = Q + 128 * 72;
  u16* VT = Kr + 128 * 72;
  u16* Qd = VT + 128 * 136;
  u16* RT = Qd + 128 * 72;
  u16* SP = RT + 128 * 72;
  float* OT = (float*)smem;
  stage_rot(prs + t0 * 2560 + h * 64, 2560, rc, rs, n * 128, Q, 1.0f, l2g, 0);
  stage_rot(prs + t0 * 2560 + h * 64, 2560, rc, rs, n * 128, Qd, 1.0f, l2g, 1);
  stage_rot(prs + t0 * 2560 + 256 + h * 64, 2560, rc, rs, n * 128, Kr, 0.125f, l2g, 0);
  stage_vT(prs + t0 * 2560 + 512 + h * 128, 2560, VT);
  {
    const int dv = tid >> 2, q = tid & 3;
    const float* src = KV + (size_t)u * 8192 + dv * 64 + q * 16;
    float4 a0 = *(const float4*)src, a1 = *(const float4*)(src + 4), a2 = *(const float4*)(src + 8), a3 = *(const float4*)(src + 12);
    float f0[8] = {a0.x, a0.y, a0.z, a0.w, a1.x, a1.y, a1.z, a1.w};
    float f1[8] = {a2.x, a2.y, a2.z, a2.w, a3.x, a3.y, a3.z, a3.w};
    *(uint4*)(RT + dv * 72 + q * 16) = pack8(f0);
    *(uint4*)(RT + dv * 72 + q * 16 + 8) = pack8(f1);
  }
  __syncthreads();
  f32x16 acc[2];
#pragma unroll
  for (int j = 0; j < 2; ++j)
#pragma unroll
    for (int e = 0; e < 16; ++e) acc[j][e] = 0.f;
#pragma unroll
  for (int ks = 0; ks < 4; ++ks) {
    bf16x8 a = *(const bf16x8*)(Q + (wm * 32 + (lane & 31)) * 72 + ks * 16 + (lane >> 5) * 8);
#pragma unroll
    for (int j = 0; j < 2; ++j) {
      bf16x8 bb = *(const bf16x8*)(Kr + (wn * 64 + j * 32 + (lane & 31)) * 72 + ks * 16 + (lane >> 5) * 8);
      acc[j] = __builtin_amdgcn_mfma_f32_32x32x16_bf16(a, bb, acc[j], 0, 0, 0);
    }
  }
#pragma unroll
  for (int j = 0; j < 2; ++j)
#pragma unroll
    for (int e = 0; e < 16; ++e) {
      const int i = ACC_ROW(1, 0, e), jj = ACC_COL(j);
      const float dcy = (i >= jj) ? exp2f((float)(i - jj) * l2g) : 0.f;
      SP[i * 136 + jj] = f2bf(acc[j][e] * dcy);
    }
  __syncthreads();
#pragma unroll
  for (int j = 0; j < 2; ++j)
#pragma unroll
    for (int e = 0; e < 16; ++e) acc[j][e] = 0.f;
#pragma unroll
  for (int ks = 0; ks < 8; ++ks) {
    bf16x8 a = *(const bf16x8*)(SP + (wm * 32 + (lane & 31)) * 136 + ks * 16 + (lane >> 5) * 8);
#pragma unroll
    for (int j = 0; j < 2; ++j) {
      bf16x8 bb = *(const bf16x8*)(VT + (wn * 64 + j * 32 + (lane & 31)) * 136 + ks * 16 + (lane >> 5) * 8);
      acc[j] = __builtin_amdgcn_mfma_f32_32x32x16_bf16(a, bb, acc[j], 0, 0, 0);
    }
  }
#pragma unroll
  for (int ks = 0; ks < 4; ++ks) {
    bf16x8 a = *(const bf16x8*)(Qd + (wm * 32 + (lane & 31)) * 72 + ks * 16 + (lane >> 5) * 8);
#pragma unroll
    for (int j = 0; j < 2; ++j) {
      bf16x8 bb = *(const bf16x8*)(RT + (wn * 64 + j * 32 + (lane & 31)) * 72 + ks * 16 + (lane >> 5) * 8);
      acc[j] = __builtin_amdgcn_mfma_f32_32x32x16_bf16(a, bb, acc[j], 0, 0, 0);
    }
  }
  __syncthreads();
#pragma unroll
  for (int j = 0; j < 2; ++j)
#pragma unroll
    for (int e = 0; e < 16; ++e) OT[ACC_ROW(1, 0, e) * 132 + ACC_COL(j)] = acc[j][e];
  __syncthreads();
  {
    const int row = tid >> 2, q = tid & 3;
    float o[32];
    float ssq = 0.f;
#pragma unroll
    for (int c = 0; c < 8; ++c) {
      float4 v = *(const float4*)(OT + row * 132 + q * 32 + c * 4);
      o[c * 4] = v.x; o[c * 4 + 1] = v.y; o[c * 4 + 2] = v.z; o[c * 4 + 3] = v.w;
      ssq += v.x * v.x + v.y * v.y + v.z * v.z + v.w * v.w;
    }
    ssq = red4(ssq);
    const float r = rsqrtf(ssq * (1.f / 128.f) + 1e-6f);
    const u16* gp = prs + (t0 + row) * 2560 + 1024 + h * 128 + q * 32;
    u16* op = yret + (t0 + row) * 512 + h * 128 + q * 32;
#pragma unroll
    for (int c = 0; c < 4; ++c) {
      float g[8], ov[8];
      unpack8(*(const uint4*)(gp + c * 8), g);
#pragma unroll
      for (int j = 0; j < 8; ++j) ov[j] = o[c * 8 + j] * r * siluf_(g[j]);
      if (!(n == 0 && row == 0)) *(uint4*)(op + c * 8) = pack8(ov);
    }
  }
  __syncthreads();
}

DEV void phase_merge(const Params& p, int l, const float* rstd, u16* smem, int bid, int nb) {
  const int tid = my_tid(), lane = tid & 63, wave = tid >> 6, wm = wave >> 1, wn = wave & 1;
  const u16* xb = (const u16*)(p.ws + OFF_XB);
  unsigned char* W = p.ws + OFF_W + (size_t)l * LW_BYTES;
  const u16* win = (const u16*)(W + W_IN);
  const u16* wbr = (const u16*)(W + W_BR);
  u16* M = (u16*)(p.ws + OFF_BIG + B_M);
  const int MTL = NTOK / 128, NTL = DM / 128;
  for (int t = vbid(bid, nb); t < MTL * NTL; t += nb) {
    int m, n;
    tile_map(t, MTL, NTL, m, n);
    f32x16 ms[1][2];
#pragma unroll
    for (int j = 0; j < 2; ++j)
#pragma unroll
      for (int e = 0; e < 16; ++e) ms[0][j][e] = 0.f;
    for (int g = 0; g < 3; ++g) {
      const u16* yg = (const u16*)(p.ws + OFF_BIG + (g == 0 ? B_YRW : (g == 1 ? B_YRET : B_YSG)));
      f32x16 ab[1][2], ag[1][2];
#pragma unroll
      for (int j = 0; j < 2; ++j)
#pragma unroll
        for (int e = 0; e < 16; ++e) { ab[0][j][e] = 0.f; ag[0][j][e] = 0.f; }
      gemm_tile<1>(ab, yg, 512, m * 128, -(1 << 30), NTOK - 1, wbr + ((size_t)g * DM + n * 128) * 512, 512, 512, smem);
      gemm_tile<1>(ag, xb, DM, m * 128, -(1 << 30), NTOK - 1, win + ((size_t)(4352 + g * DM + n * 128)) * DM, DM, DM, smem);
#pragma unroll
      for (int e = 0; e < 16; ++e) {
        const float rs = rstd_of(rstd, m * 128 + ACC_ROW(1, 0, e));
#pragma unroll
        for (int j = 0; j < 2; ++j) ms[0][j][e] += sigmoidf_(ag[0][j][e] * rs) * ab[0][j][e];
        if ((e & 3) == 3) __builtin_amdgcn_sched_barrier(0);
      }
    }
#pragma unroll
    for (int e = 0; e < 16; ++e) {
      const size_t row = m * 128 + ACC_ROW(1, 0, e);
#pragma unroll
      for (int j = 0; j < 2; ++j) M[row * DM + n * 128 + ACC_COL(j)] = f2bf(ms[0][j][e]);
    }
  }
}

DEV void phase_resgemm(const u16* A, int K, const u16* wt, const float* xin, float* xout, u16* xbo, float* ssq, u16* smem, int bid, int nb) {
  const int tid = my_tid(), lane = tid & 63, wave = tid >> 6, wm = wave >> 1, wn = wave & 1;
  const int MTL = NTOK / 256, NTL = DM / 256;
  for (int t = vbid(bid, nb); t < MTL * NTL; t += nb) {
    int m, n;
    tile_map(t, MTL, NTL, m, n);
    f32x16 acc[2][4];
    ZERO_BIG(acc);
    gemm_big(acc, A, K, m * 256, -(1 << 30), NTOK - 1, wt + (size_t)n * 256 * K, K, K, smem);
    float* F = (float*)smem;
#pragma unroll
    for (int i = 0; i < 2; ++i) {
#pragma unroll
      for (int e = 0; e < 16; ++e) {
        const int lr = wm * 32 + (e & 3) + 8 * (e >> 2) + 4 * (lane >> 5);
#pragma unroll
        for (int j = 0; j < 4; ++j) F[lr * 260 + BIG_COL(j)] = acc[i][j][e];
      }
      __syncthreads();
#pragma unroll 4
      for (int k = 0; k < 16; ++k) {
        const int c = tid + NTHR * k;
        const int lr = c >> 6, cc = c & 63;
        const size_t row = (size_t)m * 256 + (lr >> 5) * 64 + i * 32 + (lr & 31);
        const size_t o = row * DM + n * 256 + cc * 4;
        const float4 v = *(const float4*)(F + lr * 260 + cc * 4);
        const float4 x = *(const float4*)(xin + o);
        const float4 y = make_float4(x.x + v.x, x.y + v.y, x.z + v.z, x.w + v.w);
        *(float4*)(xout + o) = y;
        if (xbo) {
          *(uint2*)(xbo + o) = make_uint2(pack2(y.x, y.y), pack2(y.z, y.w));
          const float sq = wave_sum(y.x * y.x + y.y * y.y + y.z * y.z + y.w * y.w);
          if (lane == 0) atomicAdd(ssq + row, sq);
        }
      }
      __syncthreads();
    }
  }
}

DEV void phase_ffnup(const Params& p, int l, const float* rstd, u16* smem, int bid, int nb) {
  const int tid = my_tid(), lane = tid & 63, wave = tid >> 6, wm = wave >> 1, wn = wave & 1;
  const u16* xb = (const u16*)(p.ws + OFF_XB);
  const u16* wup = (const u16*)(p.ws + OFF_W + (size_t)l * LW_BYTES + W_UP);
  u16* act = (u16*)(p.ws + OFF_BIG + B_ACT);
  const float* cw = p.in[22] + (size_t)l * 3 * 2 * DFF;
  const float* cb = p.in[23] + (size_t)l * 2 * DFF;
  u16* U = smem;
  const int MPB = 33;
  const int MTL = 4 * MPB, NTL = DFF / 128;
  for (int t = vbid(bid, nb); t < MTL * NTL; t += nb) {
    int m, n;
    tile_map(t, MTL, NTL, m, n);
    const int b = m / MPB, mi = m % MPB;
    const int tokbase = b * SEQ + mi * 254 - 2;
    f32x16 acc[2][4];
    ZERO_BIG(acc);
    gemm_big(acc, xb, DM, tokbase, b * SEQ, NTOK - 1, wup + (size_t)n * 256 * DM, DM, DM, smem);
#pragma unroll
    for (int i = 0; i < 2; ++i)
#pragma unroll
      for (int e = 0; e < 16; ++e) {
        const int r = BIG_ROW(i, e);
        int tk = tokbase + r; tk = tk < 0 ? 0 : (tk > NTOK - 1 ? NTOK - 1 : tk);
        const float rs = rstd_of(rstd, tk);
#pragma unroll
        for (int j = 0; j < 4; ++j) U[r * 264 + BIG_COL(j)] = f2bf(acc[i][j][e] * rs);
      }
    __syncthreads();
    {
      const int c = (tid & 63) * 2, rg = tid >> 6;
      const int gcol = n * 128 + c, vcol = DFF + n * 128 + c;
      float wg0[2], wg1[2], wg2[2], bg[2], wv0[2], wv1[2], wv2[2], bv[2];
#pragma unroll
      for (int q = 0; q < 2; ++q) {
        wg0[q] = cw[gcol + q]; wg1[q] = cw[2 * DFF + gcol + q]; wg2[q] = cw[4 * DFF + gcol + q]; bg[q] = cb[gcol + q];
        wv0[q] = cw[vcol + q]; wv1[q] = cw[2 * DFF + vcol + q]; wv2[q] = cw[4 * DFF + vcol + q]; bv[q] = cb[vcol + q];
      }
      const int r0 = 2 + rg * 32;
      const int rend = (r0 + 32 > 256) ? 256 : r0 + 32;
      unsigned t;
      float g2[2], g1[2], v2[2], v1[2];
      t = *(const unsigned*)(U + (r0 - 2) * 264 + c); g2[0] = __uint_as_float(t << 16); g2[1] = __uint_as_float(t & 0xffff0000u);
      t = *(const unsigned*)(U + (r0 - 1) * 264 + c); g1[0] = __uint_as_float(t << 16); g1[1] = __uint_as_float(t & 0xffff0000u);
      t = *(const unsigned*)(U + (r0 - 2) * 264 + 128 + c); v2[0] = __uint_as_float(t << 16); v2[1] = __uint_as_float(t & 0xffff0000u);
      t = *(const unsigned*)(U + (r0 - 1) * 264 + 128 + c); v1[0] = __uint_as_float(t << 16); v1[1] = __uint_as_float(t & 0xffff0000u);
      const int tend = (b + 1) * SEQ;
      for (int r = r0; r < rend; ++r) {
        const unsigned ug = *(const unsigned*)(U + r * 264 + c), uv = *(const unsigned*)(U + r * 264 + 128 + c);
        const float g0[2] = {__uint_as_float(ug << 16), __uint_as_float(ug & 0xffff0000u)};
        const float v0[2] = {__uint_as_float(uv << 16), __uint_as_float(uv & 0xffff0000u)};
        float o[2];
#pragma unroll
        for (int q = 0; q < 2; ++q) {
          const float cg = bg[q] + wg0[q] * g2[q] + wg1[q] * g1[q] + wg2[q] * g0[q];
          const float cv = bv[q] + wv0[q] * v2[q] + wv1[q] * v1[q] + wv2[q] * v0[q];
          o[q] = siluf_(cg) * cv;
          g2[q] = g1[q]; g1[q] = g0[q]; v2[q] = v1[q]; v1[q] = v0[q];
        }
        const int tk = tokbase + r;
        if (tk < tend) *(unsigned*)(act + (size_t)tk * DFF + n * 128 + c) = pack2(o[0], o[1]);
      }
    }
    __syncthreads();
  }
}

#define PF_COLS 3328
DEV void first_tok_proj(const Params& p, int l, const float* xcur, int bid, int nb) {
  float* PF = (float*)(p.ws + OFF_PF);
  const float* w = p.in[2] + (size_t)l * DM * INC;
  const float* g1 = p.in[1] + l * DM;
  for (int task = bid; task < 4 * 7; task += nb) {
    const int b = task / 7, c = (task % 7) * 512 + my_tid();
    if (c < PF_COLS) {
      const float* xr = xcur + (size_t)b * SEQ * DM;
      float acc = 0.f, ss = 0.f;
      for (int k = 0; k < DM; ++k) {
        const float xv = xr[k];
        ss += xv * xv;
        acc += xv * g1[k] * w[(size_t)k * INC + c];
      }
      PF[b * PF_COLS + c] = acc * rsqrtf(ss * (1.0f / DM) + 1e-6f);
    }
  }
}
DEV void first_tok_fix(const Params& p, int l, float* smf, int bid, int nb) {
  const int tid = my_tid(), lane = tid & 63;
  const float* PF = (const float*)(p.ws + OFF_PF);
  u16* yrw = (u16*)(p.ws + OFF_BIG + B_YRW);
  u16* yret = (u16*)(p.ws + OFF_BIG + B_YRET);
  const float* mu = p.in[3] + l * 1792;
  for (int task = bid; task < 48; task += nb) {
    const int b = task / 12, hh = task % 12;
    const float* pf = PF + b * PF_COLS;
    const size_t t0 = (size_t)b * SEQ;
    __syncthreads();
    if (hh < 8) {
      const int h = hh;
      if (tid < 64) smf[tid] = pf[1600 + tid] * (1.f - mu[1600 + tid]);
      if (tid < 128) smf[64 + tid] = sigmoidf_(pf[1664 + tid] * (1.f - mu[1664 + tid]));
      __syncthreads();
      if (tid < 64) {
        const int ch = h * 64 + tid;
        const float r = pf[ch] * (1.f - mu[ch]);
        const float k = pf[512 + ch] * (1.f - mu[512 + ch]);
        const float v = pf[1024 + ch] * (1.f - mu[1024 + ch]);
        const float* aup = p.in[7] + (size_t)l * 64 * 512;
        const float* gup = p.in[8] + (size_t)l * 128 * 512;
        float al = p.in[6][l * 512 + ch], g = 0.f;
        for (int j = 0; j < 64; ++j) al += smf[j] * aup[j * 512 + ch];
        for (int j = 0; j < 128; ++j) g += smf[64 + j] * gup[j * 512 + ch];
        const float a = sigmoidf_(al);
        const float kp = k * (1.f + (a - 1.f) * p.in[10][l * 512 + ch]);
        const float s = wave_sum(kp * r);
        const float bon = wave_sum(r * kp * p.in[11][l * 512 + ch]);
        const float y = v * s;
        const float mean = wave_sum(y) * (1.f / 64.f);
        const float d = y - mean;
        const float var = wave_sum(d * d) * (1.f / 64.f);
        const float o = (d * rsqrtf(var + 64e-5f) * p.in[12][l * 512 + ch] + p.in[13][l * 512 + ch] + bon * v) * g;
        yrw[t0 * 512 + ch] = f2bf(o);
      }
    } else {
      const int h = hh - 8;
      float part = 0.f;
      if (tid < 64) part = pf[1792 + h * 64 + tid] * pf[1792 + 256 + h * 64 + tid];
      if (tid < 64) { part = wave_sum(part); if (lane == 0) smf[0] = part * 0.125f; }
      __syncthreads();
      const float s = smf[0];
      float y = 0.f;
      if (tid < 128) y = s * pf[1792 + 512 + h * 128 + tid];
      float q = wave_sum(y * y);
      if (tid < 128 && lane == 0) smf[1 + (tid >> 6)] = q;
      __syncthreads();
      if (tid < 128) {
        const float ms = (smf[1] + smf[2]) * (1.f / 128.f);
        const float g = pf[1792 + 1024 + h * 128 + tid];
        yret[t0 * 512 + h * 128 + tid] = f2bf(y * rsqrtf(ms + 1e-6f) * siluf_(g));
      }
    }
  }
}

namespace pg8 {
#define PG8_LAS __attribute__((address_space(3)))
typedef unsigned short bf16_t;
typedef short bf16x8 __attribute__((ext_vector_type(8)));
typedef float f32x4 __attribute__((ext_vector_type(4)));
typedef unsigned u32x4 __attribute__((ext_vector_type(4)));
constexpr int BM = 256, BK = 64, HALF = 128, HTB = HALF * BK * 2  , STAGE_BYTES = 8 * HTB, NXCD = 8, WGM = 8;

__host__ __device__ __forceinline__ int lds_byte(int r, int c) { const int st = (r >> 4) * 2 + (c >> 5), rr = r & 15, cc = c & 31, ob = rr * 64 + cc * 2; return st * 1024 + (ob ^ (((ob >> 9) & 1) << 5)); }
__host__ __device__ __forceinline__ void stage_rc(int b, int& R, int& C) { const int st = b / 1024, sb = b % 1024, swz = sb ^ (((sb >> 9) & 1) << 5); R = (st >> 1) * 16 + swz / 64; C = (st & 1) * 32 + (swz % 64) / 2; }
__host__ __device__ __forceinline__ int perm32(int rho) { const int n = rho >> 4, i = rho & 15; return 8 * (i >> 2) + 4 * n + (i & 3); }

struct Unit { int pm, pn; };
struct Gemm { const bf16_t* A; const bf16_t* Bt; int M, N, K; };

struct StaticOrder {
    int nM, nN, nwg, G, c;
    __host__ __device__ void init(int M, int N, int G_, int c_) { nM = M / BM; nN = N / BM; nwg = nM * nN; G = G_; c = c_; }
    __host__ __device__ bool next(int i, Unit& u) const {
        const long L = (long)i * G + c; if (L >= nwg) return false;
        int wgid = (int)L; { const int q = nwg / NXCD, r = nwg % NXCD, xcd = wgid % NXCD, off = wgid / NXCD; wgid = (xcd < r ? xcd * (q + 1) : r * (q + 1) + (xcd - r) * q) + off; }
        const int nig = WGM * nN, gid = wgid / nig, fm = gid * WGM, gsz = (nM - fm) < WGM ? (nM - fm) : WGM;
        u.pm = fm + ((wgid % nig) % gsz); u.pn = (wgid % nig) / gsz; return true;
    }
    __device__ __forceinline__ void a_ready(const Unit&) const {}
    __device__ __forceinline__ void done(const Unit&) const {}
};

__device__ __forceinline__ unsigned cvt_pk_bf16(float lo, float hi) { unsigned r; asm volatile("v_cvt_pk_bf16_f32 %0, %1, %2" : "=v"(r) : "v"(lo), "v"(hi)); return r; }

template <class Epi, class Sched, bool STAMP = false>
__device__ __forceinline__ void gemm_phase(PG8_LAS unsigned char* lds, const Gemm g, const Sched& S, const Epi& E, unsigned long long* stamps) {
    const int tid = my_tid(), wid = __builtin_amdgcn_readfirstlane(tid >> 6), lane = tid & 63, wr = wid >> 2, wc = wid & 3, fr = lane & 15, fq = lane >> 4;
    const int K = g.K, nt = K / BK;
    int ts_lo = 0, ts_hi = 0, nts = 0; const unsigned long long rt_entry = STAMP ? (unsigned long long)wall_clock64() : 0ull;
#define PG8_STAMP() do { if (STAMP && wid == 0 && nts < 64) { const unsigned long long _c = (unsigned long long)clock64(); \
        ts_lo = (lane == nts) ? (int)(unsigned)_c : ts_lo; ts_hi = (lane == nts) ? (int)(unsigned)(_c >> 32) : ts_hi; ++nts; } } while (0)
    PG8_STAMP();
    unsigned voffA[2], voffB[2];
#pragma unroll
    for (int i = 0; i < 2; ++i) { int R, C; stage_rc(tid * 16 + i * 8192, R, C); const int Rb = Epi::PERM ? ((R & ~31) + perm32(R & 31)) : R;
        voffA[i] = (unsigned)(R * K + C) * 2u; voffB[i] = (unsigned)(Rb * K + C) * 2u; }
    const size_t kstep = (size_t)(BK * 2);
    const size_t hstep = (size_t)HALF * K * 2;
    const size_t tstep = 2 * hstep;
    const unsigned ldsw = (unsigned)wid * 1024u;
    const int aoff = lds_byte(wr * 64 + fr, fq * 8), boff = lds_byte(wc * 32 + fr, fq * 8);
#define PG8_SA(b, h) (((b) * 2 + (h)) * HTB)
#define PG8_SB(b, h) ((4 + (b) * 2 + (h)) * HTB)
#define PG8_STAGE(bufoff, gbase, voff) do { _Pragma("unroll") for (int _i = 0; _i < 2; ++_i) \
        __builtin_amdgcn_global_load_lds((const unsigned*)((const char*)(gbase) + (voff)[_i]), (PG8_LAS unsigned*)(lds + (bufoff) + ldsw + _i * 8192), 16, 0, 0); } while (0)
#define PG8_LDA(dst, b, h) do { _Pragma("unroll") for (int m = 0; m < 4; ++m) _Pragma("unroll") for (int k = 0; k < 2; ++k) dst[m][k] = *(const PG8_LAS bf16x8*)(lds + PG8_SA(b, h) + aoff + m * 2048 + k * 1024); } while (0)
#define PG8_LDB(dst, b, h) do { _Pragma("unroll") for (int n = 0; n < 2; ++n) _Pragma("unroll") for (int k = 0; k < 2; ++k) dst[n][k] = *(const PG8_LAS bf16x8*)(lds + PG8_SB(b, h) + boff + n * 2048 + k * 1024); } while (0)
#define PG8_MMA(ai, bj, At, Bt) do { __builtin_amdgcn_s_setprio(1); _Pragma("unroll") for (int m = 0; m < 4; ++m) _Pragma("unroll") for (int n = 0; n < 2; ++n) _Pragma("unroll") for (int k = 0; k < 2; ++k) \
        acc[ai][bj][m][n] = __builtin_amdgcn_mfma_f32_16x16x32_bf16(Bt[n][k], At[m][k], acc[ai][bj][m][n], 0, 0, 0); __builtin_amdgcn_s_setprio(0); } while (0)
#define PG8_WAIT_V(n) asm volatile("s_waitcnt vmcnt(" #n ")" ::: "memory")
#define PG8_WAIT_L(n) asm volatile("s_waitcnt lgkmcnt(" #n ")" ::: "memory")
#define PG8_BAR __builtin_amdgcn_s_barrier()
#define PG8_SCHED __builtin_amdgcn_sched_barrier(0)
    Unit cur, nxt; int ui = 0;
    if (!S.next(0, cur)) return;
    f32x4 acc[2][2][4][2];
#pragma unroll
    for (int a = 0; a < 2; ++a)
#pragma unroll
        for (int b = 0; b < 2; ++b)
#pragma unroll
            for (int m = 0; m < 4; ++m)
#pragma unroll
                for (int n = 0; n < 2; ++n) acc[a][b][m][n] = (f32x4){0.f, 0.f, 0.f, 0.f};
    bf16x8 At[4][2], B0[2][2], B1[2][2];
    const char* cA = (const char*)g.A + (size_t)cur.pm * tstep; const char* cB = (const char*)g.Bt + (size_t)cur.pn * tstep;
    S.a_ready(cur);
    PG8_STAGE(PG8_SB(0, 0), cB, voffB); PG8_STAGE(PG8_SA(0, 0), cA, voffA); PG8_STAGE(PG8_SB(0, 1), cB + hstep, voffB); PG8_STAGE(PG8_SA(0, 1), cA + hstep, voffA);
    if (wr == 1) PG8_BAR;
    PG8_WAIT_V(4); PG8_BAR;
    PG8_STAGE(PG8_SB(1, 0), cB + kstep, voffB); PG8_STAGE(PG8_SA(1, 0), cA + kstep, voffA); PG8_STAGE(PG8_SB(1, 1), cB + hstep + kstep, voffB);
    PG8_WAIT_V(6); PG8_BAR;
    PG8_STAMP();
    for (;;) {
        const bool has_next = S.next(ui + 1, nxt);
        const char* nA = has_next ? (const char*)g.A + (size_t)nxt.pm * tstep : cA; const char* nB = has_next ? (const char*)g.Bt + (size_t)nxt.pn * tstep : cB;
        for (int t = 0; t < nt; t += 2) {
            const bool last = (t == nt - 2);
            const char* a1 = cA + (size_t)(t + 1) * kstep;
            const char* a2 = last ? nA : cA + (size_t)(t + 2) * kstep; const char* b2 = last ? nB : cB + (size_t)(t + 2) * kstep;
            const char* a3 = a2 + kstep; const char* b3 = b2 + kstep;
            if (last && has_next) S.a_ready(nxt);
            PG8_LDB(B0, 0, 0); PG8_SCHED; PG8_LDA(At, 0, 0); PG8_STAGE(PG8_SA(1, 1), a1 + hstep, voffA);
            PG8_WAIT_L(8); PG8_BAR; PG8_WAIT_L(0); PG8_MMA(0, 0, At, B0); PG8_BAR; PG8_SCHED;
            PG8_LDB(B1, 0, 1); PG8_STAGE(PG8_SB(0, 0), b2, voffB);
            PG8_BAR; PG8_WAIT_L(0); PG8_MMA(0, 1, At, B1); PG8_BAR;
            PG8_LDA(At, 0, 1); PG8_STAGE(PG8_SA(0, 0), a2, voffA);
            PG8_BAR; PG8_WAIT_L(0); PG8_MMA(1, 0, At, B0); PG8_BAR; PG8_SCHED;
            PG8_STAGE(PG8_SB(0, 1), b2 + hstep, voffB);
            PG8_WAIT_V(6); PG8_BAR; PG8_MMA(1, 1, At, B1); PG8_BAR;
            PG8_LDB(B0, 1, 0); PG8_SCHED; PG8_LDA(At, 1, 0); PG8_STAGE(PG8_SA(0, 1), a2 + hstep, voffA);
            PG8_WAIT_L(8); PG8_BAR; PG8_WAIT_L(0); PG8_MMA(0, 0, At, B0); PG8_BAR; PG8_SCHED;
            PG8_LDB(B1, 1, 1); PG8_STAGE(PG8_SB(1, 0), b3, voffB);
            PG8_BAR; PG8_WAIT_L(0); PG8_MMA(0, 1, At, B1); PG8_BAR;
            PG8_LDA(At, 1, 1); PG8_STAGE(PG8_SA(1, 0), a3, voffA);
            PG8_BAR; PG8_WAIT_L(0); PG8_MMA(1, 0, At, B0); PG8_BAR; PG8_SCHED;
            PG8_STAGE(PG8_SB(1, 1), b3 + hstep, voffB);
            PG8_WAIT_V(6); PG8_BAR; PG8_MMA(1, 1, At, B1); PG8_BAR;
        }
        PG8_STAMP();
        if constexpr (!Epi::AFTER_DRAIN) { E(acc, cur, wr, wc, fr, fq); S.done(cur); }
        PG8_STAMP();
        if (!has_next) break;
#pragma unroll
        for (int a = 0; a < 2; ++a)
#pragma unroll
            for (int b = 0; b < 2; ++b)
#pragma unroll
                for (int m = 0; m < 4; ++m)
#pragma unroll
                    for (int n = 0; n < 2; ++n) acc[a][b][m][n] = (f32x4){0.f, 0.f, 0.f, 0.f};
        cur = nxt; cA = nA; cB = nB; ++ui;
    }
    PG8_WAIT_V(0);
    if (wr == 0) PG8_BAR;
    PG8_BAR;
    if constexpr (Epi::AFTER_DRAIN) { E.fused(acc, cur, wr, wc, fr, fq, lds, wid, lane); S.done(cur); }
    PG8_STAMP();
    if (STAMP && wid == 0) { stamps[lane] = lane < nts ? (((unsigned long long)(unsigned)ts_hi << 32) | (unsigned)ts_lo) : 0ull;
        if (lane == 62) stamps[62] = rt_entry; if (lane == 63) stamps[63] = (unsigned long long)wall_clock64(); }
#undef PG8_STAMP
#undef PG8_SA
#undef PG8_SB
#undef PG8_STAGE
#undef PG8_LDA
#undef PG8_LDB
#undef PG8_MMA
#undef PG8_WAIT_V
#undef PG8_WAIT_L
#undef PG8_BAR
#undef PG8_SCHED
}
}

struct EpiInproj {
  static constexpr bool PERM = true, AFTER_DRAIN = false;
  u16* O; int ldc; const float* ssq;
  __device__ __forceinline__ void operator()(const pg8::f32x4 (&acc)[2][2][4][2], const pg8::Unit& u, int wr, int wc, int fr, int fq) const {
    const int row0 = u.pm * 256 + wr * 64 + fr, col0 = u.pn * 256 + wc * 32 + 8 * fq;
#pragma unroll
    for (int ai = 0; ai < 2; ++ai)
#pragma unroll
      for (int m = 0; m < 4; ++m) {
        const int row = row0 + ai * 128 + m * 16;
        const float rs = rsqrtf(ssq[row] * (1.0f / DM) + 1e-6f);
        u16* rowp = O + (size_t)row * ldc + col0;
#pragma unroll
        for (int bj = 0; bj < 2; ++bj) {
          const pg8::f32x4 v0 = acc[ai][bj][m][0] * rs, v1 = acc[ai][bj][m][1] * rs;
          u32x4 w;
          w.x = pack2(v0[0], v0[1]); w.y = pack2(v0[2], v0[3]); w.z = pack2(v1[0], v1[1]); w.w = pack2(v1[2], v1[3]);
          *(u32x4*)(rowp + bj * 128) = w;
        }
      }
  }
};
struct EpiRes {
  static constexpr bool PERM = false, AFTER_DRAIN = false;
  const float* xin; float* xout; u16* xbo; float* ssq;
  __device__ __forceinline__ void operator()(const pg8::f32x4 (&acc)[2][2][4][2], const pg8::Unit& u, int wr, int wc, int fr, int fq) const {
    const int row0 = u.pm * 256 + wr * 64 + fr, col0 = u.pn * 256 + wc * 32 + 4 * fq;
#pragma unroll
    for (int ai = 0; ai < 2; ++ai)
#pragma unroll
      for (int m = 0; m < 4; ++m) {
        const int row = row0 + ai * 128 + m * 16;
        float sq = 0.f;
#pragma unroll
        for (int bj = 0; bj < 2; ++bj)
#pragma unroll
          for (int n = 0; n < 2; ++n) {
            const size_t o = (size_t)row * DM + col0 + bj * 128 + n * 16;
            const pg8::f32x4 y = *(const pg8::f32x4*)(xin + o) + acc[ai][bj][m][n];
            *(pg8::f32x4*)(xout + o) = y;
            if (xbo) {
              *(uint2*)(xbo + o) = make_uint2(pack2(y[0], y[1]), pack2(y[2], y[3]));
              sq += y[0] * y[0] + y[1] * y[1] + y[2] * y[2] + y[3] * y[3];
            }
          }
        if (xbo) {
          sq += __shfl_xor(sq, 16);
          sq += __shfl_xor(sq, 32);
          if (fq == 0) atomicAdd(ssq + row, sq);
        }
        __builtin_amdgcn_sched_barrier(0);
      }
  }
};
template <class Epi>
DEV void pg8_gemm(unsigned char* smraw, const u16* A, const u16* Bt, int M, int N, int K, const Epi& E, int bid, int nb) {
  pg8::Gemm g{A, Bt, M, N, K};
  pg8::StaticOrder S;
  S.init(M, N, nb, bid);
  pg8::gemm_phase<Epi, pg8::StaticOrder, false>((PG8_LAS unsigned char*)smraw, g, S, E, nullptr);
}

#define NPHASE 32
template <int ph>
DEV void run_phase(const Params& p, unsigned char* smraw, int bid, int nb) {
  u16* smem = (u16*)smraw;
  float* smf = (float*)smraw;
  float* xo = p.out;
  u16* xb = (u16*)(p.ws + OFF_XB);
  float* ssq_all = (float*)(p.ws + OFF_RSTD);
  if (ph == 0) { phase_prep(p, smf, bid, nb); return; }
  if (ph == NPHASE - 1) { phase_final(xo, p.in[25], bid, nb); return; }
  const int l = (ph - 1) / 15, s = (ph - 1) % 15;
  const float* xcur = (l == 0) ? p.in[0] : xo;
  unsigned char* W = p.ws + OFF_W + (size_t)l * LW_BYTES;
  float* ssq1 = ssq_all + (size_t)(2 * l) * NTOK;
  float* ssq2 = ssq_all + (size_t)(2 * l + 1) * NTOK;
  switch (s) {
    case 0: if (l == 0) phase_norm(xcur, xb, ssq1, bid, nb); break;
    case 1: { EpiInproj E{(u16*)(p.ws + OFF_BIG + B_PRW), 1792, ssq1}; pg8_gemm(smraw, xb, (const u16*)(W + W_IN), NTOK, 1792, DM, E, bid, nb); } break;
    case 2: phase_rwprep(p, l, smem, bid, nb); break;
    case 3: phase_scan<1>(p, l, smf, bid, nb); break;
    case 4: phase_scanprop(p, smf, bid, nb); first_tok_proj(p, l, xcur, nb - 1 - bid, nb); break;
    case 5: phase_scan<3>(p, l, smf, bid, nb); break;
    case 6: { EpiInproj E{(u16*)(p.ws + OFF_BIG + B_PRS), 2560, ssq1}; pg8_gemm(smraw, xb, (const u16*)(W + W_IN) + (size_t)1792 * DM, NTOK, 2560, DM, E, bid, nb); } break;
    case 7:
      for (int u = bid; u < 1024; u += nb) ret_kv_unit(p, u, smem);
      for (int u = bid; u < 256; u += nb) sgu_unit(p, l, u, smem);
      break;
    case 8: phase_retprefix(p, bid, nb); break;
    case 9:
      for (int u = bid; u < 1024; u += nb) ret_out_unit(p, u, smem);
      first_tok_fix(p, l, smf, nb - 1 - bid, nb);
      break;
    case 10: phase_merge(p, l, ssq1, smem, bid, nb); break;
    case 11: { EpiRes E{xcur, xo, xb, ssq2}; pg8_gemm(smraw, (const u16*)(p.ws + OFF_BIG + B_M), (const u16*)(W + W_OUT), NTOK, DM, DM, E, bid, nb); } break;
    case 12: break;
    case 13: phase_ffnup(p, l, ssq2, smem, bid, nb); break;
    case 14: {
      EpiRes E{xo, xo, (l == 0) ? xb : nullptr, (l == 0) ? ssq_all + (size_t)2 * NTOK : nullptr};
      pg8_gemm(smraw, (const u16*)(p.ws + OFF_BIG + B_ACT), (const u16*)(W + W_DN), NTOK, DM, DFF, E, bid, nb);
    } break;
  }
}
DEV constexpr bool phase_empty(int ph) {
  return ph >= 1 && ph < NPHASE - 1 && (((ph - 1) % 15 == 12) || ((ph - 1) % 15 == 0 && (ph - 1) / 15 == 1));
}

DEV void gsync(unsigned* ctr, unsigned& target) {
  asm volatile("s_waitcnt vmcnt(0)" ::: "memory");
  __syncthreads();
  if (my_tid() == 0) {
    target += gridDim.x;
    __builtin_amdgcn_fence(__ATOMIC_RELEASE, "agent");
    asm volatile("s_waitcnt vmcnt(0)" ::: "memory");
    __hip_atomic_fetch_add(ctr, 1u, __ATOMIC_RELAXED, __HIP_MEMORY_SCOPE_AGENT);
    while (__hip_atomic_load(ctr, __ATOMIC_RELAXED, __HIP_MEMORY_SCOPE_AGENT) < target) __builtin_amdgcn_s_sleep(2);
    __builtin_amdgcn_fence(__ATOMIC_ACQUIRE, "agent");
    asm volatile("s_waitcnt vmcnt(0)" ::: "memory");
  }
  __syncthreads();
}

#if COOP
template <int PH>
DEV void run_seq(const Params& p, unsigned char* smraw, cg::grid_group& grid, unsigned& target) {
  if constexpr (phase_empty(PH)) {
    run_seq<PH + 1>(p, smraw, grid, target);
  } else {
    int bid_ = blockIdx.x;
    asm volatile("" : "+s"(bid_));
    run_phase<PH>(p, smraw, bid_, gridDim.x);
    if constexpr (PH + 1 < NPHASE) {
      if constexpr (PH == 0) grid.sync();
      else gsync((unsigned*)p.ws, target);
      run_seq<PH + 1>(p, smraw, grid, target);
    }
  }
}
__global__ void __launch_bounds__(NTHR) mega(Params p) {
  __shared__ __align__(16) unsigned char smraw[147456];
  cg::grid_group grid = cg::this_grid();
  unsigned target = 0;
  run_seq<0>(p, smraw, grid, target);
}
#else
template <int PH>
__global__ void __launch_bounds__(NTHR) phk(Params p) {
  __shared__ __align__(16) unsigned char smraw[147456];
  run_phase<PH>(p, smraw, blockIdx.x, gridDim.x);
}
template <int PH>
static void launch_seq(const Params& p, hipStream_t stream) {
  phk<PH><<<256, NTHR, 0, stream>>>(p);
  if constexpr (PH + 1 < NPHASE) launch_seq<PH + 1>(p, stream);
}
#endif

extern "C" void kernel_launch(void* const* d_in, const int* in_sizes, int n_in, void* d_out, int out_size, void* d_ws,
                              size_t ws_size, hipStream_t stream) {
  Params p{};
  for (int i = 0; i < 26; ++i) p.in[i] = (const float*)d_in[i];
  p.out = (float*)d_out;
  p.ws = (unsigned char*)d_ws;
  if (ws_size < WS_NEED) { fprintf(stderr, "workspace too small: %zu < %llu\n", ws_size, (unsigned long long)WS_NEED); return; }
#if COOP
  static int grid_blocks = 0;
  if (!grid_blocks) {
    int dev = 0, cus = 0, per_cu = 0;
    hipGetDevice(&dev);
    hipDeviceGetAttribute(&cus, hipDeviceAttributeMultiprocessorCount, dev);
    hipOccupancyMaxActiveBlocksPerMultiprocessor(&per_cu, mega, NTHR, 0);
    if (per_cu > 1) per_cu = 1;
    grid_blocks = cus * per_cu;
  }
  hipMemsetAsync(d_ws, 0, 256, stream);
  void* args[] = {&p};
  hipError_t e = hipLaunchCooperativeKernel((void*)mega, dim3(grid_blocks), dim3(NTHR), args, 0, stream);
  if (e != hipSuccess) fprintf(stderr, "cooperative launch failed: %s (grid %d)\n", hipGetErrorString(e), grid_blocks);
#else
  launch_seq<0>(p, stream);
#endif
}
```

```cpp
#include <hip/hip_runtime.h>
#include <hip/hip_cooperative_groups.h>
#include <cstdio>
#include <cstdint>
namespace cg = cooperative_groups;

#ifndef COOP
#define COOP 1
#endif

#define DEV __device__ __forceinline__
typedef unsigned short u16;
typedef short bf16x8 __attribute__((ext_vector_type(8)));
typedef float f32x16 __attribute__((ext_vector_type(16)));

#define NTHR 512
#define NTOK 32768
#define SEQ 8192
#define DM 1024
#define INC 7424
#define DFF 2816
#define MiB (1048576ull)

#define OFF_ROPE (64ull * 1024)
#define OFF_RSTD (OFF_ROPE + 2 * MiB)
#define OFF_PF (OFF_RSTD + 640ull * 1024)
#define OFF_W (3 * MiB)
#define LW_BYTES (37 * MiB)
#define W_IN 0ull
#define W_BR 15204352ull
#define W_OUT 18350080ull
#define W_UP 20447232ull
#define W_DN 31981568ull
#define W_RWUP 37748736ull
#define W_RAUP 37814272ull
#define W_RGUP 37879808ull
#define W_SGW 38010880ull
#define OFF_XB (77 * MiB)
#define OFF_BIG (141 * MiB)
#define B_PRW 0ull
#define B_YRW 0ull
#define B_YRET (32 * MiB)
#define B_YSG (64 * MiB)
#define B_OPS (112 * MiB)
#define B_PRS (112 * MiB)
#define B_KV (272 * MiB)
#define B_M 0ull
#define B_P (128 * MiB)
#define B_PL (304 * MiB)
#define B_SINIT (320 * MiB)
#define B_ACT 0ull
#define WS_NEED (OFF_BIG + 328 * MiB)

struct Params {
  const float* in[26];
  float* out;
  unsigned char* ws;
};

DEV int my_tid() {
  int t = __builtin_amdgcn_workitem_id_x();
  asm volatile("" : "+v"(t));
  return t;
}
DEV u16 f2bf(float f) {
  unsigned u = __float_as_uint(f);
  u += 0x7fffu + ((u >> 16) & 1u);
  return (u16)(u >> 16);
}
DEV float bf2f(u16 h) { return __uint_as_float(((unsigned)h) << 16); }
DEV unsigned pack2(float a, float b) { return (unsigned)f2bf(a) | ((unsigned)f2bf(b) << 16); }
DEV void unpack8(uint4 v, float* f) {
  f[0] = __uint_as_float(v.x << 16); f[1] = __uint_as_float(v.x & 0xffff0000u);
  f[2] = __uint_as_float(v.y << 16); f[3] = __uint_as_float(v.y & 0xffff0000u);
  f[4] = __uint_as_float(v.z << 16); f[5] = __uint_as_float(v.z & 0xffff0000u);
  f[6] = __uint_as_float(v.w << 16); f[7] = __uint_as_float(v.w & 0xffff0000u);
}
DEV uint4 pack8(const float* f) {
  return make_uint4(pack2(f[0], f[1]), pack2(f[2], f[3]), pack2(f[4], f[5]), pack2(f[6], f[7]));
}
template <int CTRL>
DEV float dppmov(float x) {
  return __builtin_bit_cast(float, __builtin_amdgcn_update_dpp(0, __builtin_bit_cast(int, x), CTRL, 0xF, 0xF, true));
}
DEV float red4(float x) { x += dppmov<0xB1>(x); x += dppmov<0x4E>(x); return x; }
DEV float red8(float x) { x = red4(x); x += dppmov<0x141>(x); return x; }
DEV float wave_sum(float x) {
  x = red8(x);
  x += dppmov<0x140>(x);
  const int xi = __builtin_bit_cast(int, x);
  return __builtin_bit_cast(float, __builtin_amdgcn_readlane(xi, 0)) + __builtin_bit_cast(float, __builtin_amdgcn_readlane(xi, 16)) +
         __builtin_bit_cast(float, __builtin_amdgcn_readlane(xi, 32)) + __builtin_bit_cast(float, __builtin_amdgcn_readlane(xi, 48));
}
DEV float sigmoidf_(float x) { return 1.f / (1.f + __expf(-x)); }
DEV float siluf_(float x) { return x / (1.f + __expf(-x)); }
DEV float geluf_(float x) { return 0.5f * x * (1.f + erff(x * 0.70710678118654752f)); }

DEV float rstd_of(const float* ssq, int row) { return rsqrtf(ssq[row] * (1.0f / DM) + 1e-6f); }
DEV int vbid(int bid, int nb) { return ((nb & 7) == 0) ? (bid & 7) * (nb >> 3) + (bid >> 3) : bid; }
DEV void tile_map(int t, int MTL, int NTL, int& m, int& n) {
  int per = 8 * NTL;
  int g = t / per;
  int r = t - g * per;
  int gm = MTL - g * 8; gm = gm > 8 ? 8 : gm;
  m = g * 8 + r % gm;
  n = r / gm;
}

typedef unsigned u32x4 __attribute__((ext_vector_type(4)));
template <int NA>
struct GStage { u32x4 a0, a1, a2, a3, b0, b1; };
DEV u32x4 g_ld_a(const u16* A, long lda, int g, int azero_below, int arow_max, int ko) {
  const bool z = g < azero_below;
  g = g < 0 ? 0 : g;
  g = g > arow_max ? arow_max : g;
  u32x4 v = *(const u32x4*)(A + (long)g * lda + ko);
  const u32x4 zero = {0u, 0u, 0u, 0u};
  return z ? zero : v;
}
template <int NA>
DEV void g_load(GStage<NA>& S, const u16* A, long lda, int arow, int azero_below, int arow_max,
                const u16* bp0, const u16* bp1, int ko) {
  S.a0 = g_ld_a(A, lda, arow, azero_below, arow_max, ko);
  S.a1 = g_ld_a(A, lda, arow + 64, azero_below, arow_max, ko);
  if constexpr (NA == 4) {
    S.a2 = g_ld_a(A, lda, arow + 128, azero_below, arow_max, ko);
    S.a3 = g_ld_a(A, lda, arow + 192, azero_below, arow_max, ko);
  }
  S.b0 = *(const u32x4*)(bp0 + ko);
  S.b1 = *(const u32x4*)(bp1 + ko);
}
template <int NA>
DEV void g_store(const GStage<NA>& S, u16* An, u16* Bn, int st_off) {
  *(u32x4*)(An + st_off) = S.a0;
  *(u32x4*)(An + st_off + 64 * 72) = S.a1;
  if constexpr (NA == 4) {
    *(u32x4*)(An + st_off + 128 * 72) = S.a2;
    *(u32x4*)(An + st_off + 192 * 72) = S.a3;
  }
  *(u32x4*)(Bn + st_off) = S.b0;
  *(u32x4*)(Bn + st_off + 64 * 72) = S.b1;
}
template <int MT>
DEV void g_compute(f32x16 (&acc)[MT][2], const u16* Ab, const u16* Bb) {
#pragma unroll
  for (int ks = 0; ks < 4; ++ks) {
    bf16x8 a[MT], b[2];
#pragma unroll
    for (int i = 0; i < MT; ++i) a[i] = *(const bf16x8*)(Ab + i * 32 * 72 + ks * 16);
#pragma unroll
    for (int j = 0; j < 2; ++j) b[j] = *(const bf16x8*)(Bb + j * 32 * 72 + ks * 16);
#pragma unroll
    for (int i = 0; i < MT; ++i)
#pragma unroll
      for (int j = 0; j < 2; ++j) acc[i][j] = __builtin_amdgcn_mfma_f32_32x32x16_bf16(a[i], b[j], acc[i][j], 0, 0, 0);
  }
}
template <int MT>
DEV void gemm_tile(f32x16 (&acc)[MT][2], const u16* A, long lda, int arow0, int azero_below, int arow_max,
                   const u16* B, long ldb, int K, u16* smem) {
  constexpr int TM = 128 * MT;
  constexpr int ASZ = TM * 72, BSZ = 128 * 72;
  constexpr int NA = TM / 64;
  const int tid = my_tid(), lane = tid & 63, wave = tid >> 6, wm = wave >> 1, wn = wave & 1;
  const int crow = tid >> 3, ckc = tid & 7;
  GStage<NA> s0, s1;
  const u16* Ak = A + ckc * 8;
  const int arow = arow0 + crow;
  const u16* bp0 = B + (long)crow * ldb + ckc * 8;
  const u16* bp1 = B + (long)(crow + 64) * ldb + ckc * 8;
  const int nk = K >> 6;
  const int arow_l = (wm * 32 * MT + (lane & 31)) * 72 + (lane >> 5) * 8;
  const int brow_l = (wn * 64 + (lane & 31)) * 72 + (lane >> 5) * 8;
  const int st_off = crow * 72 + ckc * 8;
  g_load<NA>(s0, Ak, lda, arow, azero_below, arow_max, bp0, bp1, 0);
  g_store<NA>(s0, smem, smem + ASZ, st_off);
  g_load<NA>(s1, Ak, lda, arow, azero_below, arow_max, bp0, bp1, 64);
  __syncthreads();
  for (int kt = 0; kt < nk; kt += 2) {
    if (kt + 2 < nk) g_load<NA>(s0, Ak, lda, arow, azero_below, arow_max, bp0, bp1, (kt + 2) * 64);
    g_compute<MT>(acc, smem + arow_l, smem + ASZ + brow_l);
    g_store<NA>(s1, smem + (ASZ + BSZ), smem + (ASZ + BSZ) + ASZ, st_off);
    __syncthreads();
    if (kt + 3 < nk) g_load<NA>(s1, Ak, lda, arow, azero_below, arow_max, bp0, bp1, (kt + 3) * 64);
    g_compute<MT>(acc, smem + (ASZ + BSZ) + arow_l, smem + (ASZ + BSZ) + ASZ + brow_l);
    if (kt + 2 < nk) g_store<NA>(s0, smem, smem + ASZ, st_off);
    __syncthreads();
  }
}
struct GStageB { u32x4 a0, a1, a2, a3, b0, b1, b2, b3; };
DEV const u16* g_rowptr(const u16* A, long lda, int g, int arow_max) {
  g = g < 0 ? 0 : g;
  g = g > arow_max ? arow_max : g;
  return A + (long)g * lda;
}
DEV void gb_load(GStageB& S, const u16* A, long lda, int arow, int arow_max, const u16* Bk, long ldb, int ko) {
  S.a0 = *(const u32x4*)(g_rowptr(A, lda, arow, arow_max) + ko);
  S.a1 = *(const u32x4*)(g_rowptr(A, lda, arow + 64, arow_max) + ko);
  S.a2 = *(const u32x4*)(g_rowptr(A, lda, arow + 128, arow_max) + ko);
  S.a3 = *(const u32x4*)(g_rowptr(A, lda, arow + 192, arow_max) + ko);
  S.b0 = *(const u32x4*)(Bk + ko);
  S.b1 = *(const u32x4*)(Bk + 64 * ldb + ko);
  S.b2 = *(const u32x4*)(Bk + 128 * ldb + ko);
  S.b3 = *(const u32x4*)(Bk + 192 * ldb + ko);
}
DEV void gb_store(const GStageB& S, u16* An, u16* Bn, int st_off, int arow, int azero_below) {
  const u32x4 zero = {0u, 0u, 0u, 0u};
  *(u32x4*)(An + st_off) = (arow < azero_below) ? zero : S.a0;
  *(u32x4*)(An + st_off + 64 * 72) = (arow + 64 < azero_below) ? zero : S.a1;
  *(u32x4*)(An + st_off + 128 * 72) = (arow + 128 < azero_below) ? zero : S.a2;
  *(u32x4*)(An + st_off + 192 * 72) = (arow + 192 < azero_below) ? zero : S.a3;
  *(u32x4*)(Bn + st_off) = S.b0;
  *(u32x4*)(Bn + st_off + 64 * 72) = S.b1;
  *(u32x4*)(Bn + st_off + 128 * 72) = S.b2;
  *(u32x4*)(Bn + st_off + 192 * 72) = S.b3;
}
DEV void gb_compute(f32x16 (&acc)[2][4], const u16* Ab, const u16* Bb) {
#pragma unroll
  for (int ks = 0; ks < 4; ++ks) {
    bf16x8 a[2], b[4];
#pragma unroll
    for (int i = 0; i < 2; ++i) a[i] = *(const bf16x8*)(Ab + i * 32 * 72 + ks * 16);
#pragma unroll
    for (int j = 0; j < 4; ++j) b[j] = *(const bf16x8*)(Bb + j * 32 * 72 + ks * 16);
#pragma unroll
    for (int i = 0; i < 2; ++i)
#pragma unroll
      for (int j = 0; j < 4; ++j) acc[i][j] = __builtin_amdgcn_mfma_f32_32x32x16_bf16(a[i], b[j], acc[i][j], 0, 0, 0);
  }
}
DEV void gemm_big(f32x16 (&acc)[2][4], const u16* A, long lda, int arow0, int azero_below, int arow_max,
                  const u16* B, long ldb, int K, u16* smem) {
  constexpr int ASZ = 256 * 72, BSZ = 256 * 72;
  const int tid = my_tid(), lane = tid & 63, wave = tid >> 6, wm = wave >> 1, wn = wave & 1;
  const int crow = tid >> 3, ckc = tid & 7;
  const u16* Ak = A + ckc * 8;
  const int arow = arow0 + crow;
  const u16* Bk = B + (long)crow * ldb + ckc * 8;
  const int nk = K >> 6;
  const int arow_l = (wm * 64 + (lane & 31)) * 72 + (lane >> 5) * 8;
  const int brow_l = (wn * 128 + (lane & 31)) * 72 + (lane >> 5) * 8;
  const int st_off = crow * 72 + ckc * 8;
  GStageB s;
  gb_load(s, Ak, lda, arow, arow_max, Bk, ldb, 0);
  gb_store(s, smem, smem + ASZ, st_off, arow, azero_below);
  __syncthreads();
  for (int kt = 0; kt < nk; ++kt) {
    const bool more = kt + 1 < nk;
    if (more) gb_load(s, Ak, lda, arow, arow_max, Bk, ldb, (kt + 1) * 64);
    __builtin_amdgcn_sched_barrier(0);
    const u16* cb = smem + (kt & 1) * (ASZ + BSZ);
    gb_compute(acc, cb + arow_l, cb + ASZ + brow_l);
    __builtin_amdgcn_sched_barrier(0);
    if (more) {
      u16* nb_ = smem + ((kt + 1) & 1) * (ASZ + BSZ);
      gb_store(s, nb_, nb_ + ASZ, st_off, arow, azero_below);
    }
    __syncthreads();
  }
}
#define BIG_ROW(i, e) (wm * 64 + (i) * 32 + ((e) & 3) + 8 * ((e) >> 2) + 4 * (lane >> 5))
#define BIG_COL(j) (wn * 128 + (j) * 32 + (lane & 31))
#define ZERO_BIG(acc)                                   \
  _Pragma("unroll") for (int i_ = 0; i_ < 2; ++i_)      \
  _Pragma("unroll") for (int j_ = 0; j_ < 4; ++j_)      \
  _Pragma("unroll") for (int e_ = 0; e_ < 16; ++e_) acc[i_][j_][e_] = 0.f;

#define ACC_ROW(MT_, i, e) (wm * 32 * (MT_) + (i) * 32 + ((e) & 3) + 8 * ((e) >> 2) + 4 * (lane >> 5))
#define ACC_COL(j) (wn * 64 + (j) * 32 + (lane & 31))

DEV void tconv(const float* src, int K, int N, u16* dst, const float* scale, int mode, float* t, int bid, int nb) {
  const int tid = my_tid();
  const int KT = K >> 6, NT = N >> 6;
  for (int tt = bid; tt < KT * NT; tt += nb) {
    const int kt = tt % KT, nt = tt / KT;
    const int k0 = kt * 64, n0 = nt * 64;
    int sn0 = n0;
    if (mode == 1) { int j = n0 >> 8, c = n0 & 255; sn0 = (c < 128) ? (j * 128 + c) : (DFF + j * 128 + c - 128); }
    {
      const int kk = tid >> 6, n = tid & 63;
#pragma unroll
      for (int i = 0; i < 8; ++i) {
        int k = kk + 8 * i;
        float v = src[(long)(k0 + k) * N + sn0 + n];
        if (scale) v *= scale[k0 + k];
        t[k * 65 + n] = v;
      }
    }
    __syncthreads();
    {
      const int n = tid >> 3, k8 = tid & 7;
      float f[8];
#pragma unroll
      for (int j = 0; j < 8; ++j) f[j] = t[(k8 * 8 + j) * 65 + n];
      *(uint4*)(dst + (long)(n0 + n) * K + k0 + k8 * 8) = pack8(f);
    }
    __syncthreads();
  }
}

DEV void phase_prep(const Params& p, float* smf, int bid, int nb) {
  for (int l = 0; l < 2; ++l) {
    unsigned char* W = p.ws + OFF_W + (size_t)l * LW_BYTES;
    tconv(p.in[2] + (size_t)l * DM * INC, DM, INC, (u16*)(W + W_IN), p.in[1] + l * DM, 0, smf, bid, nb);
    for (int g = 0; g < 3; ++g)
      tconv(p.in[18] + (size_t)(l * 3 + g) * 512 * DM, 512, DM, (u16*)(W + W_BR) + (size_t)g * DM * 512, nullptr, 0, smf, bid, nb);
    tconv(p.in[19] + (size_t)l * DM * DM, DM, DM, (u16*)(W + W_OUT), nullptr, 0, smf, bid, nb);
    tconv(p.in[21] + (size_t)l * DM * 2 * DFF, DM, 2 * DFF, (u16*)(W + W_UP), p.in[20] + l * DM, 1, smf, bid, nb);
    tconv(p.in[24] + (size_t)l * DFF * DM, DFF, DM, (u16*)(W + W_DN), nullptr, 0, smf, bid, nb);
    tconv(p.in[5] + (size_t)l * 64 * 512, 64, 512, (u16*)(W + W_RWUP), nullptr, 0, smf, bid, nb);
    tconv(p.in[7] + (size_t)l * 64 * 512, 64, 512, (u16*)(W + W_RAUP), nullptr, 0, smf, bid, nb);
    tconv(p.in[8] + (size_t)l * 128 * 512, 128, 512, (u16*)(W + W_RGUP), nullptr, 0, smf, bid, nb);
    const float* sw = p.in[16] + (size_t)l * 4 * 128 * 128;
    u16* sd = (u16*)(W + W_SGW);
    for (int idx = bid * NTHR + my_tid(); idx < 4 * 128 * 128; idx += nb * NTHR) {
      int i = (idx >> 7) & 127, j = idx & 127;
      sd[idx] = f2bf(j <= i ? sw[idx] : 0.f);
    }
  }
  {
    float* sq = (float*)(p.ws + OFF_RSTD) + NTOK;
    for (int idx = bid * NTHR + my_tid(); idx < 3 * NTOK; idx += nb * NTHR) sq[idx] = 0.f;
  }
  float* rc = (float*)(p.ws + OFF_ROPE);
  float* rs = rc + SEQ * 32;
  for (int idx = bid * NTHR + my_tid(); idx < SEQ * 32; idx += nb * NTHR) {
    int pos = idx >> 5, d = idx & 31;
    float lin = (d == 31) ? 1.0f : (float)d * (1.0f / 31.0f);
    float invf = 1.0f / powf(10000.0f, lin);
    float ang = (float)pos * invf;
    double rev = (double)ang * 0.15915494309189533577;
    float fr = (float)(rev - floor(rev));
    rc[idx] = __builtin_amdgcn_cosf(fr);
    rs[idx] = __builtin_amdgcn_sinf(fr);
  }
}

DEV void phase_norm(const float* x, u16* xb, float* rstd, int bid, int nb) {
  const int lane = my_tid() & 63, wave = my_tid() >> 6;
  for (int row = bid * 8 + wave; row < NTOK; row += nb * 8) {
    const float4* xr = (const float4*)(x + (size_t)row * DM);
    float4 v[4];
    float ss = 0.f;
#pragma unroll
    for (int i = 0; i < 4; ++i) {
      v[i] = xr[lane + 64 * i];
      ss += v[i].x * v[i].x + v[i].y * v[i].y + v[i].z * v[i].z + v[i].w * v[i].w;
    }
    ss = wave_sum(ss);
    if (lane == 0) rstd[row] = ss;
    uint2* o = (uint2*)(xb + (size_t)row * DM);
#pragma unroll
    for (int i = 0; i < 4; ++i) o[lane + 64 * i] = make_uint2(pack2(v[i].x, v[i].y), pack2(v[i].z, v[i].w));
  }
}
DEV void phase_final(float* x, const float* g, int bid, int nb) {
  const int lane = my_tid() & 63, wave = my_tid() >> 6;
  for (int row = bid * 8 + wave; row < NTOK; row += nb * 8) {
    float4* xr = (float4*)(x + (size_t)row * DM);
    const float4* gr = (const float4*)g;
    float4 v[4];
    float ss = 0.f;
#pragma unroll
    for (int i = 0; i < 4; ++i) {
      v[i] = xr[lane + 64 * i];
      ss += v[i].x * v[i].x + v[i].y * v[i].y + v[i].z * v[i].z + v[i].w * v[i].w;
    }
    ss = wave_sum(ss);
    float r = rsqrtf(ss * (1.0f / DM) + 1e-6f);
#pragma unroll
    for (int i = 0; i < 4; ++i) {
      float4 gg = gr[lane + 64 * i];
      xr[lane + 64 * i] = make_float4(v[i].x * r * gg.x, v[i].y * r * gg.y, v[i].z * r * gg.z, v[i].w * r * gg.w);
    }
  }
}

DEV void phase_inproj(const u16* xb, const float* rstd, const u16* wt, int N, u16* out, u16* smem, int bid, int nb) {
  const int tid = my_tid(), lane = tid & 63, wave = tid >> 6, wm = wave >> 1, wn = wave & 1;
  const int MTL = NTOK / 256, NTL = N / 256;
  for (int t = vbid(bid, nb); t < MTL * NTL; t += nb) {
    int m, n;
    tile_map(t, MTL, NTL, m, n);
    f32x16 acc[2][4];
    ZERO_BIG(acc);
    gemm_big(acc, xb, DM, m * 256, -(1 << 30), NTOK - 1, wt + (size_t)n * 256 * DM, DM, DM, smem);
#pragma unroll
    for (int i = 0; i < 2; ++i)
#pragma unroll
      for (int e = 0; e < 16; ++e) {
        const int r = BIG_ROW(i, e);
        const float rs = rstd_of(rstd, m * 256 + r);
#pragma unroll
        for (int j = 0; j < 4; ++j) smem[r * 264 + BIG_COL(j)] = f2bf(acc[i][j][e] * rs);
      }
    __syncthreads();
#pragma unroll 4
    for (int k = 0; k < 16; ++k) {
      const int c = tid + NTHR * k;
      const int r = c >> 5, cc = c & 31;
      *(uint4*)(out + (size_t)(m * 256 + r) * N + n * 256 + cc * 8) = *(const uint4*)(smem + r * 264 + cc * 8);
    }
    __syncthreads();
  }
}

#define OPS_STRIDE ((size_t)NTOK * 512)
DEV void phase_rwprep(const Params& p, int l, u16* smem, int bid, int nb) {
  const int tid = my_tid(), lane = tid & 63, wave = tid >> 6, wm = wave >> 1, wn = wave & 1;
  const u16* prw = (const u16*)(p.ws + OFF_BIG + B_PRW);
  u16* ops = (u16*)(p.ws + OFF_BIG + B_OPS);
  unsigned char* W = p.ws + OFF_W + (size_t)l * LW_BYTES;
  const u16* wup = (const u16*)(W + W_RWUP);
  const u16* aup = (const u16*)(W + W_RAUP);
  const u16* gup = (const u16*)(W + W_RGUP);
  const float* mu = p.in[3] + l * 1792;
  const float* w0 = p.in[4] + l * 512;
  const float* a0 = p.in[6] + l * 512;
  u16* T = smem;
  for (int tile = bid; tile < NTOK / 128; tile += nb) {
    const int t0 = tile * 128;
    for (int c = tid; c < 128 * 224; c += NTHR) {
      int tok = c / 224, ch = (c % 224) * 8;
      int t = t0 + tok;
      float cur[8], prv[8], o[8];
      unpack8(*(const uint4*)(prw + (size_t)t * 1792 + ch), cur);
      if ((t & (SEQ - 1)) != 0) unpack8(*(const uint4*)(prw + (size_t)(t - 1) * 1792 + ch), prv);
      else {
#pragma unroll
        for (int j = 0; j < 8; ++j) prv[j] = 0.f;
      }
      float4 m0 = *(const float4*)(mu + ch), m1 = *(const float4*)(mu + ch + 4);
      float mm[8] = {m0.x, m0.y, m0.z, m0.w, m1.x, m1.y, m1.z, m1.w};
#pragma unroll
      for (int j = 0; j < 8; ++j) o[j] = cur[j] + mm[j] * (prv[j] - cur[j]);
      if (ch < 1536) {
        int arr = ch >> 9;
        *(uint4*)(ops + arr * OPS_STRIDE + (size_t)t * 512 + (ch & 511)) = pack8(o);
      } else {
        int cc = ch - 1536;
        if (cc < 64) {
#pragma unroll
          for (int j = 0; j < 8; ++j) o[j] = tanhf(o[j]);
        } else if (cc >= 128) {
#pragma unroll
          for (int j = 0; j < 8; ++j) o[j] = sigmoidf_(o[j]);
        }
        *(uint4*)(T + tok * 264 + cc) = pack8(o);
      }
    }
    __syncthreads();
    for (int nbk = 0; nbk < 4; ++nbk) {
      const int arow = (wm * 32 + (lane & 31)) * 264 + (lane >> 5) * 8;
      const int bn = nbk * 128 + wn * 64 + (lane & 31);
#pragma unroll 1
      for (int which = 0; which < 3; ++which) {
        f32x16 ac[2];
#pragma unroll
        for (int j = 0; j < 2; ++j)
#pragma unroll
          for (int e = 0; e < 16; ++e) ac[j][e] = 0.f;
        const int kd = (which == 2) ? 128 : 64;
        const int aoff = (which == 0) ? 0 : (which == 1 ? 64 : 128);
        const u16* wsrc = (which == 0) ? wup : (which == 1 ? aup : gup);
        for (int ks = 0; ks < kd / 16; ++ks) {
          bf16x8 a1 = *(const bf16x8*)(T + arow + aoff + ks * 16);
#pragma unroll
          for (int j = 0; j < 2; ++j) {
            bf16x8 b1 = *(const bf16x8*)(wsrc + (size_t)(bn + j * 32) * kd + ks * 16 + (lane >> 5) * 8);
            ac[j] = __builtin_amdgcn_mfma_f32_32x32x16_bf16(a1, b1, ac[j], 0, 0, 0);
          }
        }
#pragma unroll
        for (int j = 0; j < 2; ++j) {
          const int ch = nbk * 128 + ACC_COL(j);
          const float w0c = w0[ch], a0c = a0[ch];
#pragma unroll
          for (int e = 0; e < 16; ++e) {
            const int t = t0 + ACC_ROW(1, 0, e);
            const size_t o = (size_t)t * 512 + ch;
            float val;
            if (which == 0) {
              float z = -(w0c + ac[j][e]);
              float sp = fmaxf(z, 0.f) + log1pf(__expf(-fabsf(z)));
              val = __expf(-sp - 0.5f);
            } else if (which == 1) {
              val = sigmoidf_(a0c + ac[j][e]);
            } else {
              val = ac[j][e];
            }
            const int arr = (which == 0) ? 4 : (which == 1 ? 3 : 5);
            ops[(size_t)arr * OPS_STRIDE + o] = f2bf(val);
          }
        }
      }
    }
    __syncthreads();
  }
}

#define TS 32
struct ScanStage {
  float* W; float* KK; float* BB; float* KP; float* RR; float* VV; float* YY;
};
template <int PASS>
DEV void phase_scan(const Params& p, int l, float* smf, int bid, int nb) {
  const int tid = my_tid();
  const int half = tid >> 8, tu = tid & 255;
  const u16* ops = (const u16*)(p.ws + OFF_BIG + B_OPS);
  float* PL = (float*)(p.ws + OFF_BIG + B_PL);
  const float* SIN = (const float*)(p.ws + OFF_BIG + B_SINIT);
  u16* yrw = (u16*)(p.ws + OFF_BIG + B_YRW);
  const float* k_k = p.in[9] + l * 512;
  const float* k_a = p.in[10] + l * 512;
  const float* r_k = p.in[11] + l * 512;
  const float* lng = p.in[12] + l * 512;
  const float* lnb = p.in[13] + l * 512;
  float* base = smf + half * (7 * TS * 64);
  float* sW = base; float* sKK = base + TS * 64; float* sB = base + 2 * TS * 64; float* sKP = base + 3 * TS * 64;
  float* sR = base + 4 * TS * 64; float* sV = base + 5 * TS * 64; float* sY = base + 6 * TS * 64;
  const int ss = tu >> 3, c8 = tu & 7;
  const int ks = tu & 7, rp = tu >> 3;
  for (int u2 = bid; u2 < 256; u2 += nb) {
    const int u = u2 * 2 + half;
    const int bh = u >> 4, c = u & 15;
    const int b = bh >> 3, h = bh & 7;
    const int tok0 = b * SEQ + c * 512;
    const int chb = h * 64 + c8 * 8;
    float S0[8], S1[8], Q0[8], Q1[8];
    if (PASS == 1) {
#pragma unroll
      for (int j = 0; j < 8; ++j) {
        S0[j] = 0.f; S1[j] = 0.f;
        Q0[j] = (ks * 8 + j == 2 * rp) ? 1.f : 0.f;
        Q1[j] = (ks * 8 + j == 2 * rp + 1) ? 1.f : 0.f;
      }
    } else {
      const float* si = SIN + (size_t)u * 4096;
      float4 x0 = *(const float4*)(si + (2 * rp) * 64 + ks * 8), x1 = *(const float4*)(si + (2 * rp) * 64 + ks * 8 + 4);
      float4 y0 = *(const float4*)(si + (2 * rp + 1) * 64 + ks * 8), y1 = *(const float4*)(si + (2 * rp + 1) * 64 + ks * 8 + 4);
      S0[0] = x0.x; S0[1] = x0.y; S0[2] = x0.z; S0[3] = x0.w; S0[4] = x1.x; S0[5] = x1.y; S0[6] = x1.z; S0[7] = x1.w;
      S1[0] = y0.x; S1[1] = y0.y; S1[2] = y0.z; S1[3] = y0.w; S1[4] = y1.x; S1[5] = y1.y; S1[6] = y1.z; S1[7] = y1.w;
#pragma unroll
      for (int j = 0; j < 8; ++j) { Q0[j] = 0.f; Q1[j] = 0.f; }
    }
    float kkc[8], kac[8], rkc[8];
    {
      float4 q0 = *(const float4*)(k_k + chb), q1 = *(const float4*)(k_k + chb + 4);
      kkc[0] = q0.x; kkc[1] = q0.y; kkc[2] = q0.z; kkc[3] = q0.w; kkc[4] = q1.x; kkc[5] = q1.y; kkc[6] = q1.z; kkc[7] = q1.w;
      q0 = *(const float4*)(k_a + chb); q1 = *(const float4*)(k_a + chb + 4);
      kac[0] = q0.x; kac[1] = q0.y; kac[2] = q0.z; kac[3] = q0.w; kac[4] = q1.x; kac[5] = q1.y; kac[6] = q1.z; kac[7] = q1.w;
      q0 = *(const float4*)(r_k + chb); q1 = *(const float4*)(r_k + chb + 4);
      rkc[0] = q0.x; rkc[1] = q0.y; rkc[2] = q0.z; rkc[3] = q0.w; rkc[4] = q1.x; rkc[5] = q1.y; rkc[6] = q1.z; rkc[7] = q1.w;
    }
    uint4 pr_r, pr_k, pr_v, pr_a, pr_e, pr_g = make_uint4(0, 0, 0, 0);
    {
      const size_t o0 = (size_t)(tok0 + ss) * 512 + chb;
      pr_r = *(const uint4*)(ops + 0 * OPS_STRIDE + o0);
      pr_k = *(const uint4*)(ops + 1 * OPS_STRIDE + o0);
      pr_v = *(const uint4*)(ops + 2 * OPS_STRIDE + o0);
      pr_a = *(const uint4*)(ops + 3 * OPS_STRIDE + o0);
      pr_e = *(const uint4*)(ops + 4 * OPS_STRIDE + o0);
      if (PASS == 3) pr_g = *(const uint4*)(ops + 5 * OPS_STRIDE + o0);
    }
    for (int sc = 0; sc < 512 / TS; ++sc) {
      const size_t o = (size_t)(tok0 + sc * TS + ss) * 512 + chb;
      float fr[8], fk[8], fv[8], fa[8], fe[8];
      unpack8(pr_r, fr);
      unpack8(pr_k, fk);
      unpack8(pr_v, fv);
      unpack8(pr_a, fa);
      unpack8(pr_e, fe);
      const uint4 graw = pr_g;
      if (sc + 1 < 512 / TS) {
        const size_t o1 = o + (size_t)TS * 512;
        pr_r = *(const uint4*)(ops + 0 * OPS_STRIDE + o1);
        pr_k = *(const uint4*)(ops + 1 * OPS_STRIDE + o1);
        pr_v = *(const uint4*)(ops + 2 * OPS_STRIDE + o1);
        pr_a = *(const uint4*)(ops + 3 * OPS_STRIDE + o1);
        pr_e = *(const uint4*)(ops + 4 * OPS_STRIDE + o1);
        if (PASS == 3) pr_g = *(const uint4*)(ops + 5 * OPS_STRIDE + o1);
      }
      float kk[8], kp[8], ssq = 0.f, bon = 0.f;
#pragma unroll
      for (int j = 0; j < 8; ++j) {
        kk[j] = fk[j] * kkc[j];
        ssq += kk[j] * kk[j];
        kp[j] = fk[j] * (1.f + (fa[j] - 1.f) * kac[j]);
        bon += fr[j] * kp[j] * rkc[j];
      }
      ssq = red8(ssq);
      bon = red8(bon);
      const float inv = 1.f / fmaxf(sqrtf(ssq), 1e-12f);
      float fw[8], fb[8];
#pragma unroll
      for (int j = 0; j < 8; ++j) {
        kk[j] *= inv;
        fb[j] = fa[j] * kk[j];
        fw[j] = __expf(-fe[j]);
      }
      {
        const int so = ss * 64 + c8 * 8;
        *(float4*)(sW + so) = make_float4(fw[0], fw[1], fw[2], fw[3]); *(float4*)(sW + so + 4) = make_float4(fw[4], fw[5], fw[6], fw[7]);
        *(float4*)(sKK + so) = make_float4(kk[0], kk[1], kk[2], kk[3]); *(float4*)(sKK + so + 4) = make_float4(kk[4], kk[5], kk[6], kk[7]);
        *(float4*)(sB + so) = make_float4(fb[0], fb[1], fb[2], fb[3]); *(float4*)(sB + so + 4) = make_float4(fb[4], fb[5], fb[6], fb[7]);
        *(float4*)(sKP + so) = make_float4(kp[0], kp[1], kp[2], kp[3]); *(float4*)(sKP + so + 4) = make_float4(kp[4], kp[5], kp[6], kp[7]);
        *(float4*)(sV + so) = make_float4(fv[0], fv[1], fv[2], fv[3]); *(float4*)(sV + so + 4) = make_float4(fv[4], fv[5], fv[6], fv[7]);
        if (PASS == 3) {
          *(float4*)(sR + so) = make_float4(fr[0], fr[1], fr[2], fr[3]); *(float4*)(sR + so + 4) = make_float4(fr[4], fr[5], fr[6], fr[7]);
        }
      }
      __syncthreads();
#pragma unroll 2
      for (int s = 0; s < TS; ++s) {
        const int so = s * 64 + ks * 8;
        float4 t0 = *(const float4*)(sW + so), t1 = *(const float4*)(sW + so + 4);
        float w[8] = {t0.x, t0.y, t0.z, t0.w, t1.x, t1.y, t1.z, t1.w};
        t0 = *(const float4*)(sKK + so); t1 = *(const float4*)(sKK + so + 4);
        float kq[8] = {t0.x, t0.y, t0.z, t0.w, t1.x, t1.y, t1.z, t1.w};
        t0 = *(const float4*)(sB + so); t1 = *(const float4*)(sB + so + 4);
        float bq[8] = {t0.x, t0.y, t0.z, t0.w, t1.x, t1.y, t1.z, t1.w};
        t0 = *(const float4*)(sKP + so); t1 = *(const float4*)(sKP + so + 4);
        float kpq[8] = {t0.x, t0.y, t0.z, t0.w, t1.x, t1.y, t1.z, t1.w};
        const float2 vv = *(const float2*)(sV + s * 64 + 2 * rp);
        float sa0 = 0.f, sa1 = 0.f;
#pragma unroll
        for (int j = 0; j < 8; ++j) { sa0 += S0[j] * kq[j]; sa1 += S1[j] * kq[j]; }
        sa0 = red8(sa0); sa1 = red8(sa1);
#pragma unroll
        for (int j = 0; j < 8; ++j) {
          S0[j] = S0[j] * w[j] - sa0 * bq[j] + vv.x * kpq[j];
          S1[j] = S1[j] * w[j] - sa1 * bq[j] + vv.y * kpq[j];
        }
        if (PASS == 1) {
          float pa0 = 0.f, pa1 = 0.f;
#pragma unroll
          for (int j = 0; j < 8; ++j) { pa0 += Q0[j] * kq[j]; pa1 += Q1[j] * kq[j]; }
          pa0 = red8(pa0); pa1 = red8(pa1);
#pragma unroll
          for (int j = 0; j < 8; ++j) {
            Q0[j] = Q0[j] * w[j] - pa0 * bq[j];
            Q1[j] = Q1[j] * w[j] - pa1 * bq[j];
          }
        } else {
          t0 = *(const float4*)(sR + so); t1 = *(const float4*)(sR + so + 4);
          float rq[8] = {t0.x, t0.y, t0.z, t0.w, t1.x, t1.y, t1.z, t1.w};
          float y0 = 0.f, y1 = 0.f;
#pragma unroll
          for (int j = 0; j < 8; ++j) { y0 += S0[j] * rq[j]; y1 += S1[j] * rq[j]; }
          y0 = red8(y0); y1 = red8(y1);
          if (ks == 0) *(float2*)(sY + s * 64 + 2 * rp) = make_float2(y0, y1);
        }
      }
      __syncthreads();
      if (PASS == 3) {
        const int so = ss * 64 + c8 * 8;
        float4 y0 = *(const float4*)(sY + so), y1 = *(const float4*)(sY + so + 4);
        float y[8] = {y0.x, y0.y, y0.z, y0.w, y1.x, y1.y, y1.z, y1.w};
        float sm = 0.f;
#pragma unroll
        for (int j = 0; j < 8; ++j) sm += y[j];
        const float mean = red8(sm) * (1.f / 64.f);
        float sv = 0.f;
#pragma unroll
        for (int j = 0; j < 8; ++j) { y[j] -= mean; sv += y[j] * y[j]; }
        const float var = red8(sv) * (1.f / 64.f);
        const float rs = rsqrtf(var + 64e-5f);
        float g[8], outv[8];
        unpack8(graw, g);
        float4 l0 = *(const float4*)(lng + chb), l1 = *(const float4*)(lng + chb + 4);
        float4 b0 = *(const float4*)(lnb + chb), b1 = *(const float4*)(lnb + chb + 4);
        float lg[8] = {l0.x, l0.y, l0.z, l0.w, l1.x, l1.y, l1.z, l1.w};
        float lb[8] = {b0.x, b0.y, b0.z, b0.w, b1.x, b1.y, b1.z, b1.w};
#pragma unroll
        for (int j = 0; j < 8; ++j) outv[j] = (y[j] * rs * lg[j] + lb[j] + bon * fv[j]) * g[j];
        if (!(c == 0 && sc == 0 && ss == 0)) *(uint4*)(yrw + o) = pack8(outv);
      }
    }
    if (PASS == 1) {
      float* pl = PL + (size_t)u * 8192;
      float* Pm = pl;
      float* Lm = pl + 4096;
      *(float4*)(Pm + (2 * rp) * 64 + ks * 8) = make_float4(Q0[0], Q0[1], Q0[2], Q0[3]);
      *(float4*)(Pm + (2 * rp) * 64 + ks * 8 + 4) = make_float4(Q0[4], Q0[5], Q0[6], Q0[7]);
      *(float4*)(Pm + (2 * rp + 1) * 64 + ks * 8) = make_float4(Q1[0], Q1[1], Q1[2], Q1[3]);
      *(float4*)(Pm + (2 * rp + 1) * 64 + ks * 8 + 4) = make_float4(Q1[4], Q1[5], Q1[6], Q1[7]);
      *(float4*)(Lm + (2 * rp) * 64 + ks * 8) = make_float4(S0[0], S0[1], S0[2], S0[3]);
      *(float4*)(Lm + (2 * rp) * 64 + ks * 8 + 4) = make_float4(S0[4], S0[5], S0[6], S0[7]);
      *(float4*)(Lm + (2 * rp + 1) * 64 + ks * 8) = make_float4(S1[0], S1[1], S1[2], S1[3]);
      *(float4*)(Lm + (2 * rp + 1) * 64 + ks * 8 + 4) = make_float4(S1[4], S1[5], S1[6], S1[7]);
    }
  }
}

DEV void phase_scanprop(const Params& p, float* smf, int bid, int nb) {
  const int tid = my_tid();
  const float* PL = (const float*)(p.ws + OFF_BIG + B_PL);
  float* SIN = (float*)(p.ws + OFF_BIG + B_SINIT);
  float* sS = smf;
  float* sP = smf + 4096;
  const int i = tid >> 3, k8 = tid & 7;
  for (int bh = bid; bh < 32; bh += nb) {
    float cur[8];
#pragma unroll
    for (int j = 0; j < 8; ++j) cur[j] = 0.f;
    for (int c = 0; c < 16; ++c) {
      const int u = bh * 16 + c;
      float* so = SIN + (size_t)u * 4096 + i * 64 + k8 * 8;
      *(float4*)so = make_float4(cur[0], cur[1], cur[2], cur[3]);
      *(float4*)(so + 4) = make_float4(cur[4], cur[5], cur[6], cur[7]);
      if (c == 15) break;
      const float* pl = PL + (size_t)u * 8192;
      *(float4*)(sS + i * 64 + k8 * 8) = make_float4(cur[0], cur[1], cur[2], cur[3]);
      *(float4*)(sS + i * 64 + k8 * 8 + 4) = make_float4(cur[4], cur[5], cur[6], cur[7]);
      *(float4*)(sP + tid * 8) = *(const float4*)(pl + tid * 8);
      *(float4*)(sP + tid * 8 + 4) = *(const float4*)(pl + tid * 8 + 4);
      float4 l0 = *(const float4*)(pl + 4096 + i * 64 + k8 * 8), l1 = *(const float4*)(pl + 4096 + i * 64 + k8 * 8 + 4);
      __syncthreads();
      float nw[8] = {l0.x, l0.y, l0.z, l0.w, l1.x, l1.y, l1.z, l1.w};
#pragma unroll 8
      for (int j = 0; j < 64; ++j) {
        const float sij = sS[i * 64 + j];
        float4 p0 = *(const float4*)(sP + j * 64 + k8 * 8), p1 = *(const float4*)(sP + j * 64 + k8 * 8 + 4);
        nw[0] += sij * p0.x; nw[1] += sij * p0.y; nw[2] += sij * p0.z; nw[3] += sij * p0.w;
        nw[4] += sij * p1.x; nw[5] += sij * p1.y; nw[6] += sij * p1.z; nw[7] += sij * p1.w;
      }
#pragma unroll
      for (int j = 0; j < 8; ++j) cur[j] = nw[j];
      __syncthreads();
    }
  }
}

DEV float ret_log2gamma(int h) { return log2f(1.0f - exp2f(-5.0f - (float)h)); }

DEV void stage_rot(const u16* src, size_t ld, const float* rc, const float* rs, int pos0, u16* dst, float sc, float l2g, int rowmode) {
  const int tid = my_tid();
  const int row = tid >> 2, d0 = (tid & 3) * 8;
  float lo[8], hi[8], olo[8], ohi[8];
  unpack8(*(const uint4*)(src + (size_t)row * ld + d0), lo);
  unpack8(*(const uint4*)(src + (size_t)row * ld + d0 + 32), hi);
  const float* cp = rc + (size_t)(pos0 + row) * 32 + d0;
  const float* sp = rs + (size_t)(pos0 + row) * 32 + d0;
  float4 c0 = *(const float4*)cp, c1 = *(const float4*)(cp + 4);
  float4 s0 = *(const float4*)sp, s1 = *(const float4*)(sp + 4);
  float cc[8] = {c0.x, c0.y, c0.z, c0.w, c1.x, c1.y, c1.z, c1.w};
  float sn[8] = {s0.x, s0.y, s0.z, s0.w, s1.x, s1.y, s1.z, s1.w};
  float rsc = sc;
  if (rowmode == 1) rsc *= exp2f((float)(row + 1) * l2g);
  if (rowmode == 2) rsc *= exp2f((float)(127 - row) * l2g);
#pragma unroll
  for (int j = 0; j < 8; ++j) {
    olo[j] = (lo[j] * cc[j] - hi[j] * sn[j]) * rsc;
    ohi[j] = (hi[j] * cc[j] + lo[j] * sn[j]) * rsc;
  }
  *(uint4*)(dst + row * 72 + d0) = pack8(olo);
  *(uint4*)(dst + row * 72 + d0 + 32) = pack8(ohi);
}
DEV void stage_rot_T(const u16* src, size_t ld, const float* rc, const float* rs, int pos0, u16* dst, float sc, float l2g) {
  const int tid = my_tid();
  const int row = tid >> 2, d0 = (tid & 3) * 8;
  float lo[8], hi[8];
  unpack8(*(const uint4*)(src + (size_t)row * ld + d0), lo);
  unpack8(*(const uint4*)(src + (size_t)row * ld + d0 + 32), hi);
  const float* cp = rc + (size_t)(pos0 + row) * 32 + d0;
  const float* sp = rs + (size_t)(pos0 + row) * 32 + d0;
  float4 c0 = *(const float4*)cp, c1 = *(const float4*)(cp + 4);
  float4 s0 = *(const float4*)sp, s1 = *(const float4*)(sp + 4);
  float cc[8] = {c0.x, c0.y, c0.z, c0.w, c1.x, c1.y, c1.z, c1.w};
  float sn[8] = {s0.x, s0.y, s0.z, s0.w, s1.x, s1.y, s1.z, s1.w};
  const float rsc = sc * exp2f((float)(127 - row) * l2g);
#pragma unroll
  for (int j = 0; j < 8; ++j) {
    dst[(d0 + j) * 136 + row] = f2bf((lo[j] * cc[j] - hi[j] * sn[j]) * rsc);
    dst[(d0 + j + 32) * 136 + row] = f2bf((hi[j] * cc[j] + lo[j] * sn[j]) * rsc);
  }
}
DEV void stage_vT(const u16* src, size_t ld, u16* dst) {
  const int tid = my_tid();
  const int row = tid >> 2, d0 = (tid & 3) * 32;
#pragma unroll
  for (int c = 0; c < 4; ++c) {
    uint4 v = *(const uint4*)(src + (size_t)row * ld + d0 + c * 8);
    unsigned w[4] = {v.x, v.y, v.z, v.w};
#pragma unroll
    for (int j = 0; j < 4; ++j) {
      dst[(d0 + c * 8 + 2 * j) * 136 + row] = (u16)(w[j] & 0xffffu);
      dst[(d0 + c * 8 + 2 * j + 1) * 136 + row] = (u16)(w[j] >> 16);
    }
  }
}

DEV void ret_kv_unit(const Params& p, int u, u16* smem) {
  const int tid = my_tid(), lane = tid & 63, wave = tid >> 6;
  const u16* prs = (const u16*)(p.ws + OFF_BIG + B_PRS);
  float* KV = (float*)(p.ws + OFF_BIG + B_KV);
  const float* rc = (const float*)(p.ws + OFF_ROPE);
  const float* rs = rc + SEQ * 32;
  const int n = u & 63, h = (u >> 6) & 3, b = u >> 8;
  const size_t t0 = (size_t)b * SEQ + n * 128;
  const float l2g = ret_log2gamma(h);
  u16* KT = smem;
  u16* VT = smem + 64 * 136;
  stage_rot_T(prs + t0 * 2560 + 256 + h * 64, 2560, rc, rs, n * 128, KT, 0.125f, l2g);
  stage_vT(prs + t0 * 2560 + 512 + h * 128, 2560, VT);
  __syncthreads();
  const int mi = wave >> 1, nj = wave & 1;
  f32x16 acc;
#pragma unroll
  for (int e = 0; e < 16; ++e) acc[e] = 0.f;
#pragma unroll
  for (int ks = 0; ks < 8; ++ks) {
    bf16x8 a = *(const bf16x8*)(VT + (mi * 32 + (lane & 31)) * 136 + ks * 16 + (lane >> 5) * 8);
    bf16x8 bb = *(const bf16x8*)(KT + (nj * 32 + (lane & 31)) * 136 + ks * 16 + (lane >> 5) * 8);
    acc = __builtin_amdgcn_mfma_f32_32x32x16_bf16(a, bb, acc, 0, 0, 0);
  }
  float* kv = KV + (size_t)u * 8192;
#pragma unroll
  for (int e = 0; e < 16; ++e) {
    int dv = mi * 32 + (e & 3) + 8 * (e >> 2) + 4 * (lane >> 5);
    int dk = nj * 32 + (lane & 31);
    kv[dv * 64 + dk] = acc[e];
  }
  __syncthreads();
}

DEV void sgu_unit(const Params& p, int l, int u, u16* smem) {
  const int tid = my_tid(), lane = tid & 63, wave = tid >> 6, wm = wave >> 1, wn = wave & 1;
  const u16* prs = (const u16*)(p.ws + OFF_BIG + B_PRS);
  u16* ysg = (u16*)(p.ws + OFF_BIG + B_YSG);
  const u16* sgw = (const u16*)(p.ws + OFF_W + (size_t)l * LW_BYTES + W_SGW);
  const float* lng = p.in[14] + l * 512;
  const float* lnb = p.in[15] + l * 512;
  const float* sgb = p.in[17] + l * 512;
  const size_t t0 = (size_t)u * 128;
  u16* VT = smem;
  u16* WT = smem + 128 * 136;
  float* st = (float*)(smem + 2 * 128 * 136);
  const int tok = tid >> 2, q = tid & 3;
  const u16* vrow = prs + (t0 + tok) * 2560 + 1536 + 512;
  {
    float s = 0.f, s2 = 0.f;
#pragma unroll 4
    for (int c = 0; c < 16; ++c) {
      float f[8];
      unpack8(*(const uint4*)(vrow + q * 128 + c * 8), f);
#pragma unroll
      for (int j = 0; j < 8; ++j) { float gl = geluf_(f[j]); s += gl; s2 += gl * gl; }
    }
    s = red4(s); s2 = red4(s2);
    const float mean = s * (1.f / 512.f);
    const float var = fmaxf(s2 * (1.f / 512.f) - mean * mean, 0.f);
    if (q == 0) { st[tok] = mean; st[128 + tok] = rsqrtf(var + 1e-6f); }
  }
  __syncthreads();
  const float mean = st[tok], rstd = st[128 + tok];
  for (int g = 0; g < 4; ++g) {
#pragma unroll
    for (int c = 0; c < 4; ++c) {
      const int d = q * 32 + c * 8;
      float f[8];
      unpack8(*(const uint4*)(vrow + g * 128 + d), f);
      float4 g0 = *(const float4*)(lng + g * 128 + d), g1 = *(const float4*)(lng + g * 128 + d + 4);
      float4 b0 = *(const float4*)(lnb + g * 128 + d), b1 = *(const float4*)(lnb + g * 128 + d + 4);
      float gg[8] = {g0.x, g0.y, g0.z, g0.w, g1.x, g1.y, g1.z, g1.w};
      float bb[8] = {b0.x, b0.y, b0.z, b0.w, b1.x, b1.y, b1.z, b1.w};
#pragma unroll
      for (int j = 0; j < 8; ++j) VT[(d + j) * 136 + tok] = f2bf((geluf_(f[j]) - mean) * rstd * gg[j] + bb[j]);
      *(uint4*)(WT + tok * 136 + d) = *(const uint4*)(sgw + (size_t)g * 16384 + tok * 128 + d);
    }
    __syncthreads();
    f32x16 acc[2];
#pragma unroll
    for (int j = 0; j < 2; ++j)
#pragma unroll
      for (int e = 0; e < 16; ++e) acc[j][e] = 0.f;
#pragma unroll
    for (int ks = 0; ks < 8; ++ks) {
      bf16x8 a = *(const bf16x8*)(WT + (wm * 32 + (lane & 31)) * 136 + ks * 16 + (lane >> 5) * 8);
#pragma unroll
      for (int j = 0; j < 2; ++j) {
        bf16x8 bb = *(const bf16x8*)(VT + (wn * 64 + j * 32 + (lane & 31)) * 136 + ks * 16 + (lane >> 5) * 8);
        acc[j] = __builtin_amdgcn_mfma_f32_32x32x16_bf16(a, bb, acc[j], 0, 0, 0);
      }
    }
#pragma unroll
    for (int e = 0; e < 16; ++e) {
      const int i = ACC_ROW(1, 0, e);
      const float bias = sgb[g * 128 + i];
#pragma unroll
      for (int j = 0; j < 2; ++j) {
        const int d = ACC_COL(j);
        const float uu = geluf_(bf2f(prs[(t0 + i) * 2560 + 1536 + g * 128 + d]));
        ysg[(t0 + i) * 512 + g * 128 + d] = f2bf(uu * (acc[j][e] + bias));
      }
    }
    __syncthreads();
  }
}

DEV void phase_retprefix(const Params& p, int bid, int nb) {
  float* KV = (float*)(p.ws + OFF_BIG + B_KV);
  for (int gid = bid * NTHR + my_tid(); gid < 16 * 8192; gid += nb * NTHR) {
    const int bh = gid >> 13, e = gid & 8191;
    const int h = bh & 3;
    const float cd = exp2f(128.f * ret_log2gamma(h));
    float R = 0.f;
    float* ptr = KV + (size_t)bh * 64 * 8192 + e;
    for (int n = 0; n < 64; ++n) {
      float kv = ptr[(size_t)n * 8192];
      ptr[(size_t)n * 8192] = R;
      R = R * cd + kv;
    }
  }
}

DEV void ret_out_unit(const Params& p, int u, u16* smem) {
  const int tid = my_tid(), lane = tid & 63, wave = tid >> 6, wm = wave >> 1, wn = wave & 1;
  const u16* prs = (const u16*)(p.ws + OFF_BIG + B_PRS);
  const float* KV = (const float*)(p.ws + OFF_BIG + B_KV);
  u16* yret = (u16*)(p.ws + OFF_BIG + B_YRET);
  const float* rc = (const float*)(p.ws + OFF_ROPE);
  const float* rs = rc + SEQ * 32;
  const int n = u & 63, h = (u >> 6) & 3, b = u >> 8;
  const size_t t0 = (size_t)b * SEQ + n * 128;
  const float l2g = ret_log2gamma(h);
  u16* Q = smem;
  u16* Kr = Q + 128 * 72;
  u16* VT = Kr + 128 * 72;
  u16* Qd = VT + 128 * 136;
  u16* RT = Qd + 128 * 72;
  u16* SP = RT + 128 * 72;
  float* OT = (float*)smem;
  stage_rot(prs + t0 * 2560 + h * 64, 2560, rc, rs, n * 128, Q, 1.0f, l2g, 0);
  stage_rot(prs + t0 * 2560 + h * 64, 2560, rc, rs, n * 128, Qd, 1.0f, l2g, 1);
  stage_rot(prs + t0 * 2560 + 256 + h * 64, 2560, rc, rs, n * 128, Kr, 0.125f, l2g, 0);
  stage_vT(prs + t0 * 2560 + 512 + h * 128, 2560, VT);
  {
    const int dv = tid >> 2, q = tid & 3;
    const float* src = KV + (size_t)u * 8192 + dv * 64 + q * 16;
    float4 a0 = *(const float4*)src, a1 = *(const float4*)(src + 4), a2 = *(const float4*)(src + 8), a3 = *(const float4*)(src + 12);
    float f0[8] = {a0.x, a0.y, a0.z, a0.w, a1.x, a1.y, a1.z, a1.w};
    float f1[8] = {a2.x, a2.y, a2.z, a2.w, a3.x, a3.y, a3.z, a3.w};
    *(uint4*)(RT + dv * 72 + q * 16) = pack8(f0);
    *(uint4*)(RT + dv * 72 + q * 16 + 8) = pack8(f1);
  }
  __syncthreads();
  f32x16 acc[2];
#pragma unroll
  for (int j = 0; j < 2; ++j)
#pragma unroll
    for (int e = 0; e < 16; ++e) acc[j][e] = 0.f;
#pragma unroll
  for (int ks = 0; ks < 4; ++ks) {
    bf16x8 a = *(const bf16x8*)(Q + (wm * 32 + (lane & 31)) * 72 + ks * 16 + (lane >> 5) * 8);
#pragma unroll
    for (int j = 0; j < 2; ++j) {
      bf16x8 bb = *(const bf16x8*)(Kr + (wn * 64 + j * 32 + (lane & 31)) * 72 + ks * 16 + (lane >> 5) * 8);
      acc[j] = __builtin_amdgcn_mfma_f32_32x32x16_bf16(a, bb, acc[j], 0, 0, 0);
    }
  }
#pragma unroll
  for (int j = 0; j < 2; ++j)
#pragma unroll
    for (int e = 0; e < 16; ++e) {
      const int i = ACC_ROW(1, 0, e), jj = ACC_COL(j);
      const float dcy = (i >= jj) ? exp2f((float)(i - jj) * l2g) : 0.f;
      SP[i * 136 + jj] = f2bf(acc[j][e] * dcy);
    }
  __syncthreads();
#pragma unroll
  for (int j = 0; j < 2; ++j)
#pragma unroll
    for (int e = 0; e < 16; ++e) acc[j][e] = 0.f;
#pragma unroll
  for (int ks = 0; ks < 8; ++ks) {
    bf16x8 a = *(const bf16x8*)(SP + (wm * 32 + (lane & 31)) * 136 + ks * 16 + (lane >> 5) * 8);
#pragma unroll
    for (int j = 0; j < 2; ++j) {
      bf16x8 bb = *(const bf16x8*)(VT + (wn * 64 + j * 32 + (lane & 31)) * 136 + ks * 16 + (lane >> 5) * 8);
      acc[j] = __builtin_amdgcn_mfma_f32_32x32x16_bf16(a, bb, acc[j], 0, 0, 0);
    }
  }
#pragma unroll
  for (int ks = 0; ks < 4; ++ks) {
    bf16x8 a = *(const bf16x8*)(Qd + (wm * 32 + (lane & 31)) * 72 + ks * 16 + (lane >> 5) * 8);
#pragma unroll
    for (int j = 0; j < 2; ++j) {
      bf16x8 bb = *(const bf16x8*)(RT + (wn * 64 + j * 32 + (lane & 31)) * 72 + ks * 16 + (lane >> 5) * 8);
      acc[j] = __builtin_amdgcn_mfma_f32_32x32x16_bf16(a, bb, acc[j], 0, 0, 0);
    }
  }
  __syncthreads();
#pragma unroll
  for (int j = 0; j < 2; ++j)
#pragma unroll
    for (int e = 0; e < 16; ++e) OT[ACC_ROW(1, 0, e) * 132 + ACC_COL(j)] = acc[j][e];
  __syncthreads();
  {
    const int row = tid >> 2, q = tid & 3;
    float o[32];
    float ssq = 0.f;
#pragma unroll
    for (int c = 0; c < 8; ++c) {
      float4 v = *(const float4*)(OT + row * 132 + q * 32 + c * 4);
      o[c * 4] = v.x; o[c * 4 + 1] = v.y; o[c * 4 + 2] = v.z; o[c * 4 + 3] = v.w;
      ssq += v.x * v.x + v.y * v.y + v.z * v.z + v.w * v.w;
    }
    ssq = red4(ssq);
    const float r = rsqrtf(ssq * (1.f / 128.f) + 1e-6f);
    const u16* gp = prs + (t0 + row) * 2560 + 1024 + h * 128 + q * 32;
    u16* op = yret + (t0 + row) * 512 + h * 128 + q * 32;
#pragma unroll
    for (int c = 0; c < 4; ++c) {
      float g[8], ov[8];
      unpack8(*(const uint4*)(gp + c * 8), g);
#pragma unroll
      for (int j = 0; j < 8; ++j) ov[j] = o[c * 8 + j] * r * siluf_(g[j]);
      if (!(n == 0 && row == 0)) *(uint4*)(op + c * 8) = pack8(ov);
    }
  }
  __syncthreads();
}

DEV void phase_merge(const Params& p, int l, const float* rstd, u16* smem, int bid, int nb) {
  const int tid = my_tid(), lane = tid & 63, wave = tid >> 6, wm = wave >> 1, wn = wave & 1;
  const u16* xb = (const u16*)(p.ws + OFF_XB);
  unsigned char* W = p.ws + OFF_W + (size_t)l * LW_BYTES;
  const u16* win = (const u16*)(W + W_IN);
  const u16* wbr = (const u16*)(W + W_BR);
  u16* M = (u16*)(p.ws + OFF_BIG + B_M);
  const int MTL = NTOK / 128, NTL = DM / 128;
  for (int t = vbid(bid, nb); t < MTL * NTL; t += nb) {
    int m, n;
    tile_map(t, MTL, NTL, m, n);
    f32x16 ms[1][2];
#pragma unroll
    for (int j = 0; j < 2; ++j)
#pragma unroll
      for (int e = 0; e < 16; ++e) ms[0][j][e] = 0.f;
    for (int g = 0; g < 3; ++g) {
      const u16* yg = (const u16*)(p.ws + OFF_BIG + (g == 0 ? B_YRW : (g == 1 ? B_YRET : B_YSG)));
      f32x16 ab[1][2], ag[1][2];
#pragma unroll
      for (int j = 0; j < 2; ++j)
#pragma unroll
        for (int e = 0; e < 16; ++e) { ab[0][j][e] = 0.f; ag[0][j][e] = 0.f; }
      gemm_tile<1>(ab, yg, 512, m * 128, -(1 << 30), NTOK - 1, wbr + ((size_t)g * DM + n * 128) * 512, 512, 512, smem);
      gemm_tile<1>(ag, xb, DM, m * 128, -(1 << 30), NTOK - 1, win + ((size_t)(4352 + g * DM + n * 128)) * DM, DM, DM, smem);
#pragma unroll
      for (int e = 0; e < 16; ++e) {
        const float rs = rstd_of(rstd, m * 128 + ACC_ROW(1, 0, e));
#pragma unroll
        for (int j = 0; j < 2; ++j) ms[0][j][e] += sigmoidf_(ag[0][j][e] * rs) * ab[0][j][e];
        if ((e & 3) == 3) __builtin_amdgcn_sched_barrier(0);
      }
    }
#pragma unroll
    for (int e = 0; e < 16; ++e) {
      const size_t row = m * 128 + ACC_ROW(1, 0, e);
#pragma unroll
      for (int j = 0; j < 2; ++j) M[row * DM + n * 128 + ACC_COL(j)] = f2bf(ms[0][j][e]);
    }
  }
}

DEV void phase_resgemm(const u16* A, int K, const u16* wt, const float* xin, float* xout, u16* xbo, float* ssq, u16* smem, int bid, int nb) {
  const int tid = my_tid(), lane = tid & 63, wave = tid >> 6, wm = wave >> 1, wn = wave & 1;
  const int MTL = NTOK / 256, NTL = DM / 256;
  for (int t = vbid(bid, nb); t < MTL * NTL; t += nb) {
    int m, n;
    tile_map(t, MTL, NTL, m, n);
    f32x16 acc[2][4];
    ZERO_BIG(acc);
    gemm_big(acc, A, K, m * 256, -(1 << 30), NTOK - 1, wt + (size_t)n * 256 * K, K, K, smem);
    float* F = (float*)smem;
#pragma unroll
    for (int i = 0; i < 2; ++i) {
#pragma unroll
      for (int e = 0; e < 16; ++e) {
        const int lr = wm * 32 + (e & 3) + 8 * (e >> 2) + 4 * (lane >> 5);
#pragma unroll
        for (int j = 0; j < 4; ++j) F[lr * 260 + BIG_COL(j)] = acc[i][j][e];
      }
      __syncthreads();
#pragma unroll 4
      for (int k = 0; k < 16; ++k) {
        const int c = tid + NTHR * k;
        const int lr = c >> 6, cc = c & 63;
        const size_t row = (size_t)m * 256 + (lr >> 5) * 64 + i * 32 + (lr & 31);
        const size_t o = row * DM + n * 256 + cc * 4;
        const float4 v = *(const float4*)(F + lr * 260 + cc * 4);
        const float4 x = *(const float4*)(xin + o);
        const float4 y = make_float4(x.x + v.x, x.y + v.y, x.z + v.z, x.w + v.w);
        *(float4*)(xout + o) = y;
        if (xbo) {
          *(uint2*)(xbo + o) = make_uint2(pack2(y.x, y.y), pack2(y.z, y.w));
          const float sq = wave_sum(y.x * y.x + y.y * y.y + y.z * y.z + y.w * y.w);
          if (lane == 0) atomicAdd(ssq + row, sq);
        }
      }
      __syncthreads();
    }
  }
}

DEV void phase_ffnup(const Params& p, int l, const float* rstd, u16* smem, int bid, int nb) {
  const int tid = my_tid(), lane = tid & 63, wave = tid >> 6, wm = wave >> 1, wn = wave & 1;
  const u16* xb = (const u16*)(p.ws + OFF_XB);
  const u16* wup = (const u16*)(p.ws + OFF_W + (size_t)l * LW_BYTES + W_UP);
  u16* act = (u16*)(p.ws + OFF_BIG + B_ACT);
  const float* cw = p.in[22] + (size_t)l * 3 * 2 * DFF;
  const float* cb = p.in[23] + (size_t)l * 2 * DFF;
  u16* U = smem;
  const int MPB = 33;
  const int MTL = 4 * MPB, NTL = DFF / 128;
  for (int t = vbid(bid, nb); t < MTL * NTL; t += nb) {
    int m, n;
    tile_map(t, MTL, NTL, m, n);
    const int b = m / MPB, mi = m % MPB;
    const int tokbase = b * SEQ + mi * 254 - 2;
    f32x16 acc[2][4];
    ZERO_BIG(acc);
    gemm_big(acc, xb, DM, tokbase, b * SEQ, NTOK - 1, wup + (size_t)n * 256 * DM, DM, DM, smem);
#pragma unroll
    for (int i = 0; i < 2; ++i)
#pragma unroll
      for (int e = 0; e < 16; ++e) {
        const int r = BIG_ROW(i, e);
        int tk = tokbase + r; tk = tk < 0 ? 0 : (tk > NTOK - 1 ? NTOK - 1 : tk);
        const float rs = rstd_of(rstd, tk);
#pragma unroll
        for (int j = 0; j < 4; ++j) U[r * 264 + BIG_COL(j)] = f2bf(acc[i][j][e] * rs);
      }
    __syncthreads();
    {
      const int c = (tid & 63) * 2, rg = tid >> 6;
      const int gcol = n * 128 + c, vcol = DFF + n * 128 + c;
      float wg0[2], wg1[2], wg2[2], bg[2], wv0[2], wv1[2], wv2[2], bv[2];
#pragma unroll
      for (int q = 0; q < 2; ++q) {
        wg0[q] = cw[gcol + q]; wg1[q] = cw[2 * DFF + gcol + q]; wg2[q] = cw[4 * DFF + gcol + q]; bg[q] = cb[gcol + q];
        wv0[q] = cw[vcol + q]; wv1[q] = cw[2 * DFF + vcol + q]; wv2[q] = cw[4 * DFF + vcol + q]; bv[q] = cb[vcol + q];
      }
      const int r0 = 2 + rg * 32;
      const int rend = (r0 + 32 > 256) ? 256 : r0 + 32;
      unsigned t;
      float g2[2], g1[2], v2[2], v1[2];
      t = *(const unsigned*)(U + (r0 - 2) * 264 + c); g2[0] = __uint_as_float(t << 16); g2[1] = __uint_as_float(t & 0xffff0000u);
      t = *(const unsigned*)(U + (r0 - 1) * 264 + c); g1[0] = __uint_as_float(t << 16); g1[1] = __uint_as_float(t & 0xffff0000u);
      t = *(const unsigned*)(U + (r0 - 2) * 264 + 128 + c); v2[0] = __uint_as_float(t << 16); v2[1] = __uint_as_float(t & 0xffff0000u);
      t = *(const unsigned*)(U + (r0 - 1) * 264 + 128 + c); v1[0] = __uint_as_float(t << 16); v1[1] = __uint_as_float(t & 0xffff0000u);
      const int tend = (b + 1) * SEQ;
      for (int r = r0; r < rend; ++r) {
        const unsigned ug = *(const unsigned*)(U + r * 264 + c), uv = *(const unsigned*)(U + r * 264 + 128 + c);
        const float g0[2] = {__uint_as_float(ug << 16), __uint_as_float(ug & 0xffff0000u)};
        const float v0[2] = {__uint_as_float(uv << 16), __uint_as_float(uv & 0xffff0000u)};
        float o[2];
#pragma unroll
        for (int q = 0; q < 2; ++q) {
          const float cg = bg[q] + wg0[q] * g2[q] + wg1[q] * g1[q] + wg2[q] * g0[q];
          const float cv = bv[q] + wv0[q] * v2[q] + wv1[q] * v1[q] + wv2[q] * v0[q];
          o[q] = siluf_(cg) * cv;
          g2[q] = g1[q]; g1[q] = g0[q]; v2[q] = v1[q]; v1[q] = v0[q];
        }
        const int tk = tokbase + r;
        if (tk < tend) *(unsigned*)(act + (size_t)tk * DFF + n * 128 + c) = pack2(o[0], o[1]);
      }
    }
    __syncthreads();
  }
}

#define PF_COLS 3328
DEV void first_tok_proj(const Params& p, int l, const float* xcur, int bid, int nb) {
  float* PF = (float*)(p.ws + OFF_PF);
  const float* w = p.in[2] + (size_t)l * DM * INC;
  const float* g1 = p.in[1] + l * DM;
  for (int task = bid; task < 4 * 7; task += nb) {
    const int b = task / 7, c = (task % 7) * 512 + my_tid();
    if (c < PF_COLS) {
      const float* xr = xcur + (size_t)b * SEQ * DM;
      float acc = 0.f, ss = 0.f;
      for (int k = 0; k < DM; ++k) {
        const float xv = xr[k];
        ss += xv * xv;
        acc += xv * g1[k] * w[(size_t)k * INC + c];
      }
      PF[b * PF_COLS + c] = acc * rsqrtf(ss * (1.0f / DM) + 1e-6f);
    }
  }
}
DEV void first_tok_fix(const Params& p, int l, float* smf, int bid, int nb) {
  const int tid = my_tid(), lane = tid & 63;
  const float* PF = (const float*)(p.ws + OFF_PF);
  u16* yrw = (u16*)(p.ws + OFF_BIG + B_YRW);
  u16* yret = (u16*)(p.ws + OFF_BIG + B_YRET);
  const float* mu = p.in[3] + l * 1792;
  for (int task = bid; task < 48; task += nb) {
    const int b = task / 12, hh = task % 12;
    const float* pf = PF + b * PF_COLS;
    const size_t t0 = (size_t)b * SEQ;
    __syncthreads();
    if (hh < 8) {
      const int h = hh;
      if (tid < 64) smf[tid] = pf[1600 + tid] * (1.f - mu[1600 + tid]);
      if (tid < 128) smf[64 + tid] = sigmoidf_(pf[1664 + tid] * (1.f - mu[1664 + tid]));
      __syncthreads();
      if (tid < 64) {
        const int ch = h * 64 + tid;
        const float r = pf[ch] * (1.f - mu[ch]);
        const float k = pf[512 + ch] * (1.f - mu[512 + ch]);
        const float v = pf[1024 + ch] * (1.f - mu[1024 + ch]);
        const float* aup = p.in[7] + (size_t)l * 64 * 512;
        const float* gup = p.in[8] + (size_t)l * 128 * 512;
        float al = p.in[6][l * 512 + ch], g = 0.f;
        for (int j = 0; j < 64; ++j) al += smf[j] * aup[j * 512 + ch];
        for (int j = 0; j < 128; ++j) g += smf[64 + j] * gup[j * 512 + ch];
        const float a = sigmoidf_(al);
        const float kp = k * (1.f + (a - 1.f) * p.in[10][l * 512 + ch]);
        const float s = wave_sum(kp * r);
        const float bon = wave_sum(r * kp * p.in[11][l * 512 + ch]);
        const float y = v * s;
        const float mean = wave_sum(y) * (1.f / 64.f);
        const float d = y - mean;
        const float var = wave_sum(d * d) * (1.f / 64.f);
        const float o = (d * rsqrtf(var + 64e-5f) * p.in[12][l * 512 + ch] + p.in[13][l * 512 + ch] + bon * v) * g;
        yrw[t0 * 512 + ch] = f2bf(o);
      }
    } else {
      const int h = hh - 8;
      float part = 0.f;
      if (tid < 64) part = pf[1792 + h * 64 + tid] * pf[1792 + 256 + h * 64 + tid];
      if (tid < 64) { part = wave_sum(part); if (lane == 0) smf[0] = part * 0.125f; }
      __syncthreads();
      const float s = smf[0];
      float y = 0.f;
      if (tid < 128) y = s * pf[1792 + 512 + h * 128 + tid];
      float q = wave_sum(y * y);
      if (tid < 128 && lane == 0) smf[1 + (tid >> 6)] = q;
      __syncthreads();
      if (tid < 128) {
        const float ms = (smf[1] + smf[2]) * (1.f / 128.f);
        const float g = pf[1792 + 1024 + h * 128 + tid];
        yret[t0 * 512 + h * 128 + tid] = f2bf(y * rsqrtf(ms + 1e-6f) * siluf_(g));
      }
    }
  }
}

namespace pg8 {
#define PG8_LAS __attribute__((address_space(3)))
typedef unsigned short bf16_t;
typedef short bf16x8 __attribute__((ext_vector_type(8)));
typedef float f32x4 __attribute__((ext_vector_type(4)));
typedef unsigned u32x4 __attribute__((ext_vector_type(4)));
constexpr int BM = 256, BK = 64, HALF = 128, HTB = HALF * BK * 2  , STAGE_BYTES = 8 * HTB, NXCD = 8, WGM = 8;

__host__ __device__ __forceinline__ int lds_byte(int r, int c) { const int st = (r >> 4) * 2 + (c >> 5), rr = r & 15, cc = c & 31, ob = rr * 64 + cc * 2; return st * 1024 + (ob ^ (((ob >> 9) & 1) << 5)); }
__host__ __device__ __forceinline__ void stage_rc(int b, int& R, int& C) { const int st = b / 1024, sb = b % 1024, swz = sb ^ (((sb >> 9) & 1) << 5); R = (st >> 1) * 16 + swz / 64; C = (st & 1) * 32 + (swz % 64) / 2; }
__host__ __device__ __forceinline__ int perm32(int rho) { const int n = rho >> 4, i = rho & 15; return 8 * (i >> 2) + 4 * n + (i & 3); }

struct Unit { int pm, pn; };
struct Gemm { const bf16_t* A; const bf16_t* Bt; int M, N, K; };

struct StaticOrder {
    int nM, nN, nwg, G, c;
    __host__ __device__ void init(int M, int N, int G_, int c_) { nM = M / BM; nN = N / BM; nwg = nM * nN; G = G_; c = c_; }
    __host__ __device__ bool next(int i, Unit& u) const {
        const long L = (long)i * G + c; if (L >= nwg) return false;
        int wgid = (int)L; { const int q = nwg / NXCD, r = nwg % NXCD, xcd = wgid % NXCD, off = wgid / NXCD; wgid = (xcd < r ? xcd * (q + 1) : r * (q + 1) + (xcd - r) * q) + off; }
        const int nig = WGM * nN, gid = wgid / nig, fm = gid * WGM, gsz = (nM - fm) < WGM ? (nM - fm) : WGM;
        u.pm = fm + ((wgid % nig) % gsz); u.pn = (wgid % nig) / gsz; return true;
    }
    __device__ __forceinline__ void a_ready(const Unit&) const {}
    __device__ __forceinline__ void done(const Unit&) const {}
};

__device__ __forceinline__ unsigned cvt_pk_bf16(float lo, float hi) { unsigned r; asm volatile("v_cvt_pk_bf16_f32 %0, %1, %2" : "=v"(r) : "v"(lo), "v"(hi)); return r; }

template <class Epi, class Sched, bool STAMP = false>
__device__ __forceinline__ void gemm_phase(PG8_LAS unsigned char* lds, const Gemm g, const Sched& S, const Epi& E, unsigned long long* stamps) {
    const int tid = my_tid(), wid = __builtin_amdgcn_readfirstlane(tid >> 6), lane = tid & 63, wr = wid >> 2, wc = wid & 3, fr = lane & 15, fq = lane >> 4;
    const int K = g.K, nt = K / BK;
    int ts_lo = 0, ts_hi = 0, nts = 0; const unsigned long long rt_entry = STAMP ? (unsigned long long)wall_clock64() : 0ull;
#define PG8_STAMP() do { if (STAMP && wid == 0 && nts < 64) { const unsigned long long _c = (unsigned long long)clock64(); \
        ts_lo = (lane == nts) ? (int)(unsigned)_c : ts_lo; ts_hi = (lane == nts) ? (int)(unsigned)(_c >> 32) : ts_hi; ++nts; } } while (0)
    PG8_STAMP();
    unsigned voffA[2], voffB[2];
#pragma unroll
    for (int i = 0; i < 2; ++i) { int R, C; stage_rc(tid * 16 + i * 8192, R, C); const int Rb = Epi::PERM ? ((R & ~31) + perm32(R & 31)) : R;
        voffA[i] = (unsigned)(R * K + C) * 2u; voffB[i] = (unsigned)(Rb * K + C) * 2u; }
    const size_t kstep = (size_t)(BK * 2);
    const size_t hstep = (size_t)HALF * K * 2;
    const size_t tstep = 2 * hstep;
    const unsigned ldsw = (unsigned)wid * 1024u;
    const int aoff = lds_byte(wr * 64 + fr, fq * 8), boff = lds_byte(wc * 32 + fr, fq * 8);
#define PG8_SA(b, h) (((b) * 2 + (h)) * HTB)
#define PG8_SB(b, h) ((4 + (b) * 2 + (h)) * HTB)
#define PG8_STAGE(bufoff, gbase, voff) do { _Pragma("unroll") for (int _i = 0; _i < 2; ++_i) \
        __builtin_amdgcn_global_load_lds((const unsigned*)((const char*)(gbase) + (voff)[_i]), (PG8_LAS unsigned*)(lds + (bufoff) + ldsw + _i * 8192), 16, 0, 0); } while (0)
#define PG8_LDA(dst, b, h) do { _Pragma("unroll") for (int m = 0; m < 4; ++m) _Pragma("unroll") for (int k = 0; k < 2; ++k) dst[m][k] = *(const PG8_LAS bf16x8*)(lds + PG8_SA(b, h) + aoff + m * 2048 + k * 1024); } while (0)
#define PG8_LDB(dst, b, h) do { _Pragma("unroll") for (int n = 0; n < 2; ++n) _Pragma("unroll") for (int k = 0; k < 2; ++k) dst[n][k] = *(const PG8_LAS bf16x8*)(lds + PG8_SB(b, h) + boff + n * 2048 + k * 1024); } while (0)
#define PG8_MMA(ai, bj, At, Bt) do { __builtin_amdgcn_s_setprio(1); _Pragma("unroll") for (int m = 0; m < 4; ++m) _Pragma("unroll") for (int n = 0; n < 2; ++n) _Pragma("unroll") for (int k = 0; k < 2; ++k) \
        acc[ai][bj][m][n] = __builtin_amdgcn_mfma_f32_16x16x32_bf16(Bt[n][k], At[m][k], acc[ai][bj][m][n], 0, 0, 0); __builtin_amdgcn_s_setprio(0); } while (0)
#define PG8_WAIT_V(n) asm volatile("s_waitcnt vmcnt(" #n ")" ::: "memory")
#define PG8_WAIT_L(n) asm volatile("s_waitcnt lgkmcnt(" #n ")" ::: "memory")
#define PG8_BAR __builtin_amdgcn_s_barrier()
#define PG8_SCHED __builtin_amdgcn_sched_barrier(0)
    Unit cur, nxt; int ui = 0;
    if (!S.next(0, cur)) return;
    f32x4 acc[2][2][4][2];
#pragma unroll
    for (int a = 0; a < 2; ++a)
#pragma unroll
        for (int b = 0; b < 2; ++b)
#pragma unroll
            for (int m = 0; m < 4; ++m)
#pragma unroll
                for (int n = 0; n < 2; ++n) acc[a][b][m][n] = (f32x4){0.f, 0.f, 0.f, 0.f};
    bf16x8 At[4][2], B0[2][2], B1[2][2];
    const char* cA = (const char*)g.A + (size_t)cur.pm * tstep; const char* cB = (const char*)g.Bt + (size_t)cur.pn * tstep;
    S.a_ready(cur);
    PG8_STAGE(PG8_SB(0, 0), cB, voffB); PG8_STAGE(PG8_SA(0, 0), cA, voffA); PG8_STAGE(PG8_SB(0, 1), cB + hstep, voffB); PG8_STAGE(PG8_SA(0, 1), cA + hstep, voffA);
    if (wr == 1) PG8_BAR;
    PG8_WAIT_V(4); PG8_BAR;
    PG8_STAGE(PG8_SB(1, 0), cB + kstep, voffB); PG8_STAGE(PG8_SA(1, 0), cA + kstep, voffA); PG8_STAGE(PG8_SB(1, 1), cB + hstep + kstep, voffB);
    PG8_WAIT_V(6); PG8_BAR;
    PG8_STAMP();
    for (;;) {
        const bool has_next = S.next(ui + 1, nxt);
        const char* nA = has_next ? (const char*)g.A + (size_t)nxt.pm * tstep : cA; const char* nB = has_next ? (const char*)g.Bt + (size_t)nxt.pn * tstep : cB;
        for (int t = 0; t < nt; t += 2) {
            const bool last = (t == nt - 2);
            const char* a1 = cA + (size_t)(t + 1) * kstep;
            const char* a2 = last ? nA : cA + (size_t)(t + 2) * kstep; const char* b2 = last ? nB : cB + (size_t)(t + 2) * kstep;
            const char* a3 = a2 + kstep; const char* b3 = b2 + kstep;
            if (last && has_next) S.a_ready(nxt);
            PG8_LDB(B0, 0, 0); PG8_SCHED; PG8_LDA(At, 0, 0); PG8_STAGE(PG8_SA(1, 1), a1 + hstep, voffA);
            PG8_WAIT_L(8); PG8_BAR; PG8_WAIT_L(0); PG8_MMA(0, 0, At, B0); PG8_BAR; PG8_SCHED;
            PG8_LDB(B1, 0, 1); PG8_STAGE(PG8_SB(0, 0), b2, voffB);
            PG8_BAR; PG8_WAIT_L(0); PG8_MMA(0, 1, At, B1); PG8_BAR;
            PG8_LDA(At, 0, 1); PG8_STAGE(PG8_SA(0, 0), a2, voffA);
            PG8_BAR; PG8_WAIT_L(0); PG8_MMA(1, 0, At, B0); PG8_BAR; PG8_SCHED;
            PG8_STAGE(PG8_SB(0, 1), b2 + hstep, voffB);
            PG8_WAIT_V(6); PG8_BAR; PG8_MMA(1, 1, At, B1); PG8_BAR;
            PG8_LDB(B0, 1, 0); PG8_SCHED; PG8_LDA(At, 1, 0); PG8_STAGE(PG8_SA(0, 1), a2 + hstep, voffA);
            PG8_WAIT_L(8); PG8_BAR; PG8_WAIT_L(0); PG8_MMA(0, 0, At, B0); PG8_BAR; PG8_SCHED;
            PG8_LDB(B1, 1, 1); PG8_STAGE(PG8_SB(1, 0), b3, voffB);
            PG8_BAR; PG8_WAIT_L(0); PG8_MMA(0, 1, At, B1); PG8_BAR;
            PG8_LDA(At, 1, 1); PG8_STAGE(PG8_SA(1, 0), a3, voffA);
            PG8_BAR; PG8_WAIT_L(0); PG8_MMA(1, 0, At, B0); PG8_BAR; PG8_SCHED;
            PG8_STAGE(PG8_SB(1, 1), b3 + hstep, voffB);
            PG8_WAIT_V(6); PG8_BAR; PG8_MMA(1, 1, At, B1); PG8_BAR;
        }
        PG8_STAMP();
        if constexpr (!Epi::AFTER_DRAIN) { E(acc, cur, wr, wc, fr, fq); S.done(cur); }
        PG8_STAMP();
        if (!has_next) break;
#pragma unroll
        for (int a = 0; a < 2; ++a)
#pragma unroll
            for (int b = 0; b < 2; ++b)
#pragma unroll
                for (int m = 0; m < 4; ++m)
#pragma unroll
                    for (int n = 0; n < 2; ++n) acc[a][b][m][n] = (f32x4){0.f, 0.f, 0.f, 0.f};
        cur = nxt; cA = nA; cB = nB; ++ui;
    }
    PG8_WAIT_V(0);
    if (wr == 0) PG8_BAR;
    PG8_BAR;
    if constexpr (Epi::AFTER_DRAIN) { E.fused(acc, cur, wr, wc, fr, fq, lds, wid, lane); S.done(cur); }
    PG8_STAMP();
    if (STAMP && wid == 0) { stamps[lane] = lane < nts ? (((unsigned long long)(unsigned)ts_hi << 32) | (unsigned)ts_lo) : 0ull;
        if (lane == 62) stamps[62] = rt_entry; if (lane == 63) stamps[63] = (unsigned long long)wall_clock64(); }
#undef PG8_STAMP
#undef PG8_SA
#undef PG8_SB
#undef PG8_STAGE
#undef PG8_LDA
#undef PG8_LDB
#undef PG8_MMA
#undef PG8_WAIT_V
#undef PG8_WAIT_L
#undef PG8_BAR
#undef PG8_SCHED
}
}

struct EpiInproj {
  static constexpr bool PERM = true, AFTER_DRAIN = false;
  u16* O; int ldc; const float* ssq;
  __device__ __forceinline__ void operator()(const pg8::f32x4 (&acc)[2][2][4][2], const pg8::Unit& u, int wr, int wc, int fr, int fq) const {
    const int row0 = u.pm * 256 + wr * 64 + fr, col0 = u.pn * 256 + wc * 32 + 8 * fq;
#pragma unroll
    for (int ai = 0; ai < 2; ++ai)
#pragma unroll
      for (int m = 0; m < 4; ++m) {
        const int row = row0 + ai * 128 + m * 16;
        const float rs = ssq ? rsqrtf(ssq[row] * (1.0f / DM) + 1e-6f) : 1.0f;
        u16* rowp = O + (size_t)row * ldc + col0;
#pragma unroll
        for (int bj = 0; bj < 2; ++bj) {
          const pg8::f32x4 v0 = acc[ai][bj][m][0] * rs, v1 = acc[ai][bj][m][1] * rs;
          u32x4 w;
          w.x = pack2(v0[0], v0[1]); w.y = pack2(v0[2], v0[3]); w.z = pack2(v1[0], v1[1]); w.w = pack2(v1[2], v1[3]);
          *(u32x4*)(rowp + bj * 128) = w;
        }
      }
  }
};
struct EpiRes {
  static constexpr bool PERM = false, AFTER_DRAIN = false;
  const float* xin; float* xout; u16* xbo; float* ssq;
  __device__ __forceinline__ void operator()(const pg8::f32x4 (&acc)[2][2][4][2], const pg8::Unit& u, int wr, int wc, int fr, int fq) const {
    const int row0 = u.pm * 256 + wr * 64 + fr, col0 = u.pn * 256 + wc * 32 + 4 * fq;
#pragma unroll
    for (int ai = 0; ai < 2; ++ai)
#pragma unroll
      for (int m = 0; m < 4; ++m) {
        const int row = row0 + ai * 128 + m * 16;
        float sq = 0.f;
#pragma unroll
        for (int bj = 0; bj < 2; ++bj)
#pragma unroll
          for (int n = 0; n < 2; ++n) {
            const size_t o = (size_t)row * DM + col0 + bj * 128 + n * 16;
            const pg8::f32x4 y = *(const pg8::f32x4*)(xin + o) + acc[ai][bj][m][n];
            *(pg8::f32x4*)(xout + o) = y;
            if (xbo) {
              *(uint2*)(xbo + o) = make_uint2(pack2(y[0], y[1]), pack2(y[2], y[3]));
              sq += y[0] * y[0] + y[1] * y[1] + y[2] * y[2] + y[3] * y[3];
            }
          }
        if (xbo) {
          sq += __shfl_xor(sq, 16);
          sq += __shfl_xor(sq, 32);
          if (fq == 0) atomicAdd(ssq + row, sq);
        }
        __builtin_amdgcn_sched_barrier(0);
      }
  }
};
struct EpiGate {
  static constexpr bool PERM = true, AFTER_DRAIN = false;
  u16* Mo; const u16* P; const float* ssq; int first;
  __device__ __forceinline__ void operator()(const pg8::f32x4 (&acc)[2][2][4][2], const pg8::Unit& u, int wr, int wc, int fr, int fq) const {
    const int row0 = u.pm * 256 + wr * 64 + fr, col0 = u.pn * 256 + wc * 32 + 8 * fq;
#pragma unroll
    for (int ai = 0; ai < 2; ++ai)
#pragma unroll
      for (int m = 0; m < 4; ++m) {
        const int row = row0 + ai * 128 + m * 16;
        const float rs = rsqrtf(ssq[row] * (1.0f / DM) + 1e-6f);
#pragma unroll
        for (int bj = 0; bj < 2; ++bj) {
          const size_t o = (size_t)row * DM + col0 + bj * 128;
          float pv[8], mv[8];
          unpack8(*(const uint4*)(P + o), pv);
          if (!first) unpack8(*(const uint4*)(Mo + o), mv);
          else {
#pragma unroll
            for (int j = 0; j < 8; ++j) mv[j] = 0.f;
          }
#pragma unroll
          for (int j = 0; j < 4; ++j) {
            mv[j] += sigmoidf_(acc[ai][bj][m][0][j] * rs) * pv[j];
            mv[4 + j] += sigmoidf_(acc[ai][bj][m][1][j] * rs) * pv[4 + j];
          }
          *(uint4*)(Mo + o) = pack8(mv);
        }
        __builtin_amdgcn_sched_barrier(0);
      }
  }
};
template <class Epi>
DEV void pg8_gemm(unsigned char* smraw, const u16* A, const u16* Bt, int M, int N, int K, const Epi& E, int bid, int nb) {
  pg8::Gemm g{A, Bt, M, N, K};
  pg8::StaticOrder S;
  S.init(M, N, nb, bid);
  pg8::gemm_phase<Epi, pg8::StaticOrder, false>((PG8_LAS unsigned char*)smraw, g, S, E, nullptr);
}

#define PPL 17
#define NPHASE (2 + 2 * PPL)
template <int ph>
DEV void run_phase(const Params& p, unsigned char* smraw, int bid, int nb) {
  u16* smem = (u16*)smraw;
  float* smf = (float*)smraw;
  float* xo = p.out;
  u16* xb = (u16*)(p.ws + OFF_XB);
  float* ssq_all = (float*)(p.ws + OFF_RSTD);
  if (ph == 0) { phase_prep(p, smf, bid, nb); return; }
  if (ph == NPHASE - 1) { phase_final(xo, p.in[25], bid, nb); return; }
  const int l = (ph - 1) / PPL, s = (ph - 1) % PPL;
  const float* xcur = (l == 0) ? p.in[0] : xo;
  unsigned char* W = p.ws + OFF_W + (size_t)l * LW_BYTES;
  float* ssq1 = ssq_all + (size_t)(2 * l) * NTOK;
  float* ssq2 = ssq_all + (size_t)(2 * l + 1) * NTOK;
  switch (s) {
    case 0: if (l == 0) phase_norm(xcur, xb, ssq1, bid, nb); break;
    case 1: { EpiInproj E{(u16*)(p.ws + OFF_BIG + B_PRW), 1792, ssq1}; pg8_gemm(smraw, xb, (const u16*)(W + W_IN), NTOK, 1792, DM, E, bid, nb); } break;
    case 2: phase_rwprep(p, l, smem, bid, nb); break;
    case 3: phase_scan<1>(p, l, smf, bid, nb); break;
    case 4: phase_scanprop(p, smf, bid, nb); first_tok_proj(p, l, xcur, nb - 1 - bid, nb); break;
    case 5: phase_scan<3>(p, l, smf, bid, nb); break;
    case 6: { EpiInproj E{(u16*)(p.ws + OFF_BIG + B_PRS), 2560, ssq1}; pg8_gemm(smraw, xb, (const u16*)(W + W_IN) + (size_t)1792 * DM, NTOK, 2560, DM, E, bid, nb); } break;
    case 7:
      for (int u = bid; u < 1024; u += nb) ret_kv_unit(p, u, smem);
      for (int u = bid; u < 256; u += nb) sgu_unit(p, l, u, smem);
      break;
    case 8: phase_retprefix(p, bid, nb); break;
    case 9:
      for (int u = bid; u < 1024; u += nb) ret_out_unit(p, u, smem);
      first_tok_fix(p, l, smf, nb - 1 - bid, nb);
      break;
    case 10: {
      const u16* wbr = (const u16*)(W + W_BR);
      for (int g = 0; g < 3; ++g) {
        const u16* yg = (const u16*)(p.ws + OFF_BIG + (g == 0 ? B_YRW : (g == 1 ? B_YRET : B_YSG)));
        EpiInproj E{(u16*)(p.ws + OFF_BIG + B_P) + (size_t)g * NTOK * DM, DM, nullptr};
        pg8_gemm(smraw, yg, wbr + (size_t)g * DM * 512, NTOK, DM, 512, E, bid, nb);
      }
    } break;
    case 11: case 12: case 13: {
      const int g = s - 11;
      EpiGate E{(u16*)(p.ws + OFF_BIG + B_M), (const u16*)(p.ws + OFF_BIG + B_P) + (size_t)g * NTOK * DM, ssq1, g == 0 ? 1 : 0};
      pg8_gemm(smraw, xb, (const u16*)(W + W_IN) + (size_t)(4352 + g * DM) * DM, NTOK, DM, DM, E, bid, nb);
    } break;
    case 14: { EpiRes E{xcur, xo, xb, ssq2}; pg8_gemm(smraw, (const u16*)(p.ws + OFF_BIG + B_M), (const u16*)(W + W_OUT), NTOK, DM, DM, E, bid, nb); } break;
    case 15: phase_ffnup(p, l, ssq2, smem, bid, nb); break;
    case 16: {
      EpiRes E{xo, xo, (l == 0) ? xb : nullptr, (l == 0) ? ssq_all + (size_t)2 * NTOK : nullptr};
      pg8_gemm(smraw, (const u16*)(p.ws + OFF_BIG + B_ACT), (const u16*)(W + W_DN), NTOK, DM, DFF, E, bid, nb);
    } break;
  }
}
DEV constexpr bool phase_empty(int ph) {
  return ph >= 1 && ph < NPHASE - 1 && ((ph - 1) % PPL == 0 && (ph - 1) / PPL == 1);
}

DEV void gsync(unsigned* ctr, unsigned& target) {
  asm volatile("s_waitcnt vmcnt(0)" ::: "memory");
  __syncthreads();
  if (my_tid() == 0) {
    target += gridDim.x;
    __builtin_amdgcn_fence(__ATOMIC_RELEASE, "agent");
    asm volatile("s_waitcnt vmcnt(0)" ::: "memory");
    __hip_atomic_fetch_add(ctr, 1u, __ATOMIC_RELAXED, __HIP_MEMORY_SCOPE_AGENT);
    while (__hip_atomic_load(ctr, __ATOMIC_RELAXED, __HIP_MEMORY_SCOPE_AGENT) < target) __builtin_amdgcn_s_sleep(2);
    __builtin_amdgcn_fence(__ATOMIC_ACQUIRE, "agent");
    asm volatile("s_waitcnt vmcnt(0)" ::: "memory");
  }
  __syncthreads();
}

#if COOP
template <int PH>
DEV void run_seq(const Params& p, unsigned char* smraw, cg::grid_group& grid, unsigned& target) {
  if constexpr (phase_empty(PH)) {
    run_seq<PH + 1>(p, smraw, grid, target);
  } else {
    int bid_ = blockIdx.x;
    asm volatile("" : "+s"(bid_));
    run_phase<PH>(p, smraw, bid_, gridDim.x);
    if constexpr (PH + 1 < NPHASE) {
      if constexpr (PH == 0) grid.sync();
      else gsync((unsigned*)p.ws, target);
      run_seq<PH + 1>(p, smraw, grid, target);
    }
  }
}
__global__ void __launch_bounds__(NTHR) mega(Params p) {
  __shared__ __align__(16) unsigned char smraw[147456];
  cg::grid_group grid = cg::this_grid();
  unsigned target = 0;
  run_seq<0>(p, smraw, grid, target);
}
#else
template <int PH>
__global__ void __launch_bounds__(NTHR) phk(Params p) {
  __shared__ __align__(16) unsigned char smraw[147456];
  run_phase<PH>(p, smraw, blockIdx.x, gridDim.x);
}
template <int PH>
static void launch_seq(const Params& p, hipStream_t stream) {
  phk<PH><<<256, NTHR, 0, stream>>>(p);
  if constexpr (PH + 1 < NPHASE) launch_seq<PH + 1>(p, stream);
}
#endif

extern "C" void kernel_launch(void* const* d_in, const int* in_sizes, int n_in, void* d_out, int out_size, void* d_ws,
                              size_t ws_size, hipStream_t stream) {
  Params p{};
  for (int i = 0; i < 26; ++i) p.in[i] = (const float*)d_in[i];
  p.out = (float*)d_out;
  p.ws = (unsigned char*)d_ws;
  if (ws_size < WS_NEED) { fprintf(stderr, "workspace too small: %zu < %llu\n", ws_size, (unsigned long long)WS_NEED); return; }
#if COOP
  static int grid_blocks = 0;
  if (!grid_blocks) {
    int dev = 0, cus = 0, per_cu = 0;
    hipGetDevice(&dev);
    hipDeviceGetAttribute(&cus, hipDeviceAttributeMultiprocessorCount, dev);
    hipOccupancyMaxActiveBlocksPerMultiprocessor(&per_cu, mega, NTHR, 0);
    if (per_cu > 1) per_cu = 1;
    grid_blocks = cus * per_cu;
  }
  hipMemsetAsync(d_ws, 0, 256, stream);
  void* args[] = {&p};
  hipError_t e = hipLaunchCooperativeKernel((void*)mega, dim3(grid_blocks), dim3(NTHR), args, 0, stream);
  if (e != hipSuccess) fprintf(stderr, "cooperative launch failed: %s (grid %d)\n", hipGetErrorString(e), grid_blocks);
#else
  launch_seq<0>(p, stream);
#endif
}
```

```cpp
#include <hip/hip_runtime.h>
#include <hip/hip_cooperative_groups.h>
#include <cstdio>
#include <cstdint>
namespace cg = cooperative_groups;

#ifndef COOP
#define COOP 1
#endif

#define DEV __device__ __forceinline__
typedef unsigned short u16;
typedef short bf16x8 __attribute__((ext_vector_type(8)));
typedef float f32x16 __attribute__((ext_vector_type(16)));

#define NTHR 512
#define NTOK 32768
#define SEQ 8192
#define DM 1024
#define INC 7424
#define DFF 2816
#define MiB (1048576ull)

#define OFF_ROPE (64ull * 1024)
#define OFF_RSTD (OFF_ROPE + 2 * MiB)
#define OFF_PF (OFF_RSTD + 640ull * 1024)
#define OFF_W (3 * MiB)
#define LW_BYTES (37 * MiB)
#define W_IN 0ull
#define W_BR 15204352ull
#define W_OUT 18350080ull
#define W_UP 20447232ull
#define W_DN 31981568ull
#define W_RWUP 37748736ull
#define W_RAUP 37814272ull
#define W_RGUP 37879808ull
#define W_SGW 38010880ull
#define OFF_XB (77 * MiB)
#define OFF_BIG (141 * MiB)
#define B_PRW 0ull
#define B_YRW 0ull
#define B_YRET (32 * MiB)
#define B_YSG (64 * MiB)
#define B_OPS (112 * MiB)
#define B_PRS (112 * MiB)
#define B_KV (272 * MiB)
#define B_M 0ull
#define B_P (128 * MiB)
#define B_PL (304 * MiB)
#define B_SINIT (320 * MiB)
#define B_ACT 0ull
#define WS_NEED (OFF_BIG + 328 * MiB)

struct Params {
  const float* in[26];
  float* out;
  unsigned char* ws;
};

DEV int my_tid() {
  int t = __builtin_amdgcn_workitem_id_x();
  asm volatile("" : "+v"(t));
  return t;
}
DEV u16 f2bf(float f) {
  unsigned u = __float_as_uint(f);
  u += 0x7fffu + ((u >> 16) & 1u);
  return (u16)(u >> 16);
}
DEV float bf2f(u16 h) { return __uint_as_float(((unsigned)h) << 16); }
DEV unsigned pack2(float a, float b) { return (unsigned)f2bf(a) | ((unsigned)f2bf(b) << 16); }
DEV void unpack8(uint4 v, float* f) {
  f[0] = __uint_as_float(v.x << 16); f[1] = __uint_as_float(v.x & 0xffff0000u);
  f[2] = __uint_as_float(v.y << 16); f[3] = __uint_as_float(v.y & 0xffff0000u);
  f[4] = __uint_as_float(v.z << 16); f[5] = __uint_as_float(v.z & 0xffff0000u);
  f[6] = __uint_as_float(v.w << 16); f[7] = __uint_as_float(v.w & 0xffff0000u);
}
DEV uint4 pack8(const float* f) {
  return make_uint4(pack2(f[0], f[1]), pack2(f[2], f[3]), pack2(f[4], f[5]), pack2(f[6], f[7]));
}
template <int CTRL>
DEV float dppmov(float x) {
  return __builtin_bit_cast(float, __builtin_amdgcn_update_dpp(0, __builtin_bit_cast(int, x), CTRL, 0xF, 0xF, true));
}
DEV float red4(float x) { x += dppmov<0xB1>(x); x += dppmov<0x4E>(x); return x; }
DEV float red8(float x) { x = red4(x); x += dppmov<0x141>(x); return x; }
DEV float wave_sum(float x) {
  x = red8(x);
  x += dppmov<0x140>(x);
  const int xi = __builtin_bit_cast(int, x);
  return __builtin_bit_cast(float, __builtin_amdgcn_readlane(xi, 0)) + __builtin_bit_cast(float, __builtin_amdgcn_readlane(xi, 16)) +
         __builtin_bit_cast(float, __builtin_amdgcn_readlane(xi, 32)) + __builtin_bit_cast(float, __builtin_amdgcn_readlane(xi, 48));
}
DEV float sigmoidf_(float x) { return 1.f / (1.f + __expf(-x)); }
DEV float siluf_(float x) { return x / (1.f + __expf(-x)); }
DEV float geluf_(float x) { return 0.5f * x * (1.f + erff(x * 0.70710678118654752f)); }

DEV float rstd_of(const float* ssq, int row) { return rsqrtf(ssq[row] * (1.0f / DM) + 1e-6f); }
DEV int vbid(int bid, int nb) { return ((nb & 7) == 0) ? (bid & 7) * (nb >> 3) + (bid >> 3) : bid; }
DEV void tile_map(int t, int MTL, int NTL, int& m, int& n) {
  int per = 8 * NTL;
  int g = t / per;
  int r = t - g * per;
  int gm = MTL - g * 8; gm = gm > 8 ? 8 : gm;
  m = g * 8 + r % gm;
  n = r / gm;
}

typedef unsigned u32x4 __attribute__((ext_vector_type(4)));
template <int NA>
struct GStage { u32x4 a0, a1, a2, a3, b0, b1; };
DEV u32x4 g_ld_a(const u16* A, long lda, int g, int azero_below, int arow_max, int ko) {
  const bool z = g < azero_below;
  g = g < 0 ? 0 : g;
  g = g > arow_max ? arow_max : g;
  u32x4 v = *(const u32x4*)(A + (long)g * lda + ko);
  const u32x4 zero = {0u, 0u, 0u, 0u};
  return z ? zero : v;
}
template <int NA>
DEV void g_load(GStage<NA>& S, const u16* A, long lda, int arow, int azero_below, int arow_max,
                const u16* bp0, const u16* bp1, int ko) {
  S.a0 = g_ld_a(A, lda, arow, azero_below, arow_max, ko);
  S.a1 = g_ld_a(A, lda, arow + 64, azero_below, arow_max, ko);
  if constexpr (NA == 4) {
    S.a2 = g_ld_a(A, lda, arow + 128, azero_below, arow_max, ko);
    S.a3 = g_ld_a(A, lda, arow + 192, azero_below, arow_max, ko);
  }
  S.b0 = *(const u32x4*)(bp0 + ko);
  S.b1 = *(const u32x4*)(bp1 + ko);
}
template <int NA>
DEV void g_store(const GStage<NA>& S, u16* An, u16* Bn, int st_off) {
  *(u32x4*)(An + st_off) = S.a0;
  *(u32x4*)(An + st_off + 64 * 72) = S.a1;
  if constexpr (NA == 4) {
    *(u32x4*)(An + st_off + 128 * 72) = S.a2;
    *(u32x4*)(An + st_off + 192 * 72) = S.a3;
  }
  *(u32x4*)(Bn + st_off) = S.b0;
  *(u32x4*)(Bn + st_off + 64 * 72) = S.b1;
}
template <int MT>
DEV void g_compute(f32x16 (&acc)[MT][2], const u16* Ab, const u16* Bb) {
#pragma unroll
  for (int ks = 0; ks < 4; ++ks) {
    bf16x8 a[MT], b[2];
#pragma unroll
    for (int i = 0; i < MT; ++i) a[i] = *(const bf16x8*)(Ab + i * 32 * 72 + ks * 16);
#pragma unroll
    for (int j = 0; j < 2; ++j) b[j] = *(const bf16x8*)(Bb + j * 32 * 72 + ks * 16);
#pragma unroll
    for (int i = 0; i < MT; ++i)
#pragma unroll
      for (int j = 0; j < 2; ++j) acc[i][j] = __builtin_amdgcn_mfma_f32_32x32x16_bf16(a[i], b[j], acc[i][j], 0, 0, 0);
  }
}
template <int MT>
DEV void gemm_tile(f32x16 (&acc)[MT][2], const u16* A, long lda, int arow0, int azero_below, int arow_max,
                   const u16* B, long ldb, int K, u16* smem) {
  constexpr int TM = 128 * MT;
  constexpr int ASZ = TM * 72, BSZ = 128 * 72;
  constexpr int NA = TM / 64;
  const int tid = my_tid(), lane = tid & 63, wave = tid >> 6, wm = wave >> 1, wn = wave & 1;
  const int crow = tid >> 3, ckc = tid & 7;
  GStage<NA> s0, s1;
  const u16* Ak = A + ckc * 8;
  const int arow = arow0 + crow;
  const u16* bp0 = B + (long)crow * ldb + ckc * 8;
  const u16* bp1 = B + (long)(crow + 64) * ldb + ckc * 8;
  const int nk = K >> 6;
  const int arow_l = (wm * 32 * MT + (lane & 31)) * 72 + (lane >> 5) * 8;
  const int brow_l = (wn * 64 + (lane & 31)) * 72 + (lane >> 5) * 8;
  const int st_off = crow * 72 + ckc * 8;
  g_load<NA>(s0, Ak, lda, arow, azero_below, arow_max, bp0, bp1, 0);
  g_store<NA>(s0, smem, smem + ASZ, st_off);
  g_load<NA>(s1, Ak, lda, arow, azero_below, arow_max, bp0, bp1, 64);
  __syncthreads();
  for (int kt = 0; kt < nk; kt += 2) {
    if (kt + 2 < nk) g_load<NA>(s0, Ak, lda, arow, azero_below, arow_max, bp0, bp1, (kt + 2) * 64);
    g_compute<MT>(acc, smem + arow_l, smem + ASZ + brow_l);
    g_store<NA>(s1, smem + (ASZ + BSZ), smem + (ASZ + BSZ) + ASZ, st_off);
    __syncthreads();
    if (kt + 3 < nk) g_load<NA>(s1, Ak, lda, arow, azero_below, arow_max, bp0, bp1, (kt + 3) * 64);
    g_compute<MT>(acc, smem + (ASZ + BSZ) + arow_l, smem + (ASZ + BSZ) + ASZ + brow_l);
    if (kt + 2 < nk) g_store<NA>(s0, smem, smem + ASZ, st_off);
    __syncthreads();
  }
}
struct GStageB { u32x4 a0, a1, a2, a3, b0, b1, b2, b3; };
DEV const u16* g_rowptr(const u16* A, long lda, int g, int arow_max) {
  g = g < 0 ? 0 : g;
  g = g > arow_max ? arow_max : g;
  return A + (long)g * lda;
}
DEV void gb_load(GStageB& S, const u16* A, long lda, int arow, int arow_max, const u16* Bk, long ldb, int ko) {
  S.a0 = *(const u32x4*)(g_rowptr(A, lda, arow, arow_max) + ko);
  S.a1 = *(const u32x4*)(g_rowptr(A, lda, arow + 64, arow_max) + ko);
  S.a2 = *(const u32x4*)(g_rowptr(A, lda, arow + 128, arow_max) + ko);
  S.a3 = *(const u32x4*)(g_rowptr(A, lda, arow + 192, arow_max) + ko);
  S.b0 = *(const u32x4*)(Bk + ko);
  S.b1 = *(const u32x4*)(Bk + 64 * ldb + ko);
  S.b2 = *(const u32x4*)(Bk + 128 * ldb + ko);
  S.b3 = *(const u32x4*)(Bk + 192 * ldb + ko);
}
DEV void gb_store(const GStageB& S, u16* An, u16* Bn, int st_off, int arow, int azero_below) {
  const u32x4 zero = {0u, 0u, 0u, 0u};
  *(u32x4*)(An + st_off) = (arow < azero_below) ? zero : S.a0;
  *(u32x4*)(An + st_off + 64 * 72) = (arow + 64 < azero_below) ? zero : S.a1;
  *(u32x4*)(An + st_off + 128 * 72) = (arow + 128 < azero_below) ? zero : S.a2;
  *(u32x4*)(An + st_off + 192 * 72) = (arow + 192 < azero_below) ? zero : S.a3;
  *(u32x4*)(Bn + st_off) = S.b0;
  *(u32x4*)(Bn + st_off + 64 * 72) = S.b1;
  *(u32x4*)(Bn + st_off + 128 * 72) = S.b2;
  *(u32x4*)(Bn + st_off + 192 * 72) = S.b3;
}
DEV void gb_compute(f32x16 (&acc)[2][4], const u16* Ab, const u16* Bb) {
#pragma unroll
  for (int ks = 0; ks < 4; ++ks) {
    bf16x8 a[2], b[4];
#pragma unroll
    for (int i = 0; i < 2; ++i) a[i] = *(const bf16x8*)(Ab + i * 32 * 72 + ks * 16);
#pragma unroll
    for (int j = 0; j < 4; ++j) b[j] = *(const bf16x8*)(Bb + j * 32 * 72 + ks * 16);
#pragma unroll
    for (int i = 0; i < 2; ++i)
#pragma unroll
      for (int j = 0; j < 4; ++j) acc[i][j] = __builtin_amdgcn_mfma_f32_32x32x16_bf16(a[i], b[j], acc[i][j], 0, 0, 0);
  }
}
DEV void gemm_big(f32x16 (&acc)[2][4], const u16* A, long lda, int arow0, int azero_below, int arow_max,
                  const u16* B, long ldb, int K, u16* smem) {
  constexpr int ASZ = 256 * 72, BSZ = 256 * 72;
  const int tid = my_tid(), lane = tid & 63, wave = tid >> 6, wm = wave >> 1, wn = wave & 1;
  const int crow = tid >> 3, ckc = tid & 7;
  const u16* Ak = A + ckc * 8;
  const int arow = arow0 + crow;
  const u16* Bk = B + (long)crow * ldb + ckc * 8;
  const int nk = K >> 6;
  const int arow_l = (wm * 64 + (lane & 31)) * 72 + (lane >> 5) * 8;
  const int brow_l = (wn * 128 + (lane & 31)) * 72 + (lane >> 5) * 8;
  const int st_off = crow * 72 + ckc * 8;
  GStageB s;
  gb_load(s, Ak, lda, arow, arow_max, Bk, ldb, 0);
  gb_store(s, smem, smem + ASZ, st_off, arow, azero_below);
  __syncthreads();
  for (int kt = 0; kt < nk; ++kt) {
    const bool more = kt + 1 < nk;
    if (more) gb_load(s, Ak, lda, arow, arow_max, Bk, ldb, (kt + 1) * 64);
    __builtin_amdgcn_sched_barrier(0);
    const u16* cb = smem + (kt & 1) * (ASZ + BSZ);
    gb_compute(acc, cb + arow_l, cb + ASZ + brow_l);
    __builtin_amdgcn_sched_barrier(0);
    if (more) {
      u16* nb_ = smem + ((kt + 1) & 1) * (ASZ + BSZ);
      gb_store(s, nb_, nb_ + ASZ, st_off, arow, azero_below);
    }
    __syncthreads();
  }
}
#define BIG_ROW(i, e) (wm * 64 + (i) * 32 + ((e) & 3) + 8 * ((e) >> 2) + 4 * (lane >> 5))
#define BIG_COL(j) (wn * 128 + (j) * 32 + (lane & 31))
#define ZERO_BIG(acc)                                   \
  _Pragma("unroll") for (int i_ = 0; i_ < 2; ++i_)      \
  _Pragma("unroll") for (int j_ = 0; j_ < 4; ++j_)      \
  _Pragma("unroll") for (int e_ = 0; e_ < 16; ++e_) acc[i_][j_][e_] = 0.f;

#define ACC_ROW(MT_, i, e) (wm * 32 * (MT_) + (i) * 32 + ((e) & 3) + 8 * ((e) >> 2) + 4 * (lane >> 5))
#define ACC_COL(j) (wn * 64 + (j) * 32 + (lane & 31))

DEV void tconv(const float* src, int K, int N, u16* dst, const float* scale, int mode, float* t, int bid, int nb) {
  const int tid = my_tid();
  const int KT = K >> 6, NT = N >> 6;
  for (int tt = bid; tt < KT * NT; tt += nb) {
    const int kt = tt % KT, nt = tt / KT;
    const int k0 = kt * 64, n0 = nt * 64;
    int sn0 = n0;
    if (mode == 1) { int j = n0 >> 8, c = n0 & 255; sn0 = (c < 128) ? (j * 128 + c) : (DFF + j * 128 + c - 128); }
    {
      const int kk = tid >> 6, n = tid & 63;
#pragma unroll
      for (int i = 0; i < 8; ++i) {
        int k = kk + 8 * i;
        float v = src[(long)(k0 + k) * N + sn0 + n];
        if (scale) v *= scale[k0 + k];
        t[k * 65 + n] = v;
      }
    }
    __syncthreads();
    {
      const int n = tid >> 3, k8 = tid & 7;
      float f[8];
#pragma unroll
      for (int j = 0; j < 8; ++j) f[j] = t[(k8 * 8 + j) * 65 + n];
      *(uint4*)(dst + (long)(n0 + n) * K + k0 + k8 * 8) = pack8(f);
    }
    __syncthreads();
  }
}

DEV void phase_prep(const Params& p, float* smf, int bid, int nb) {
  for (int l = 0; l < 2; ++l) {
    unsigned char* W = p.ws + OFF_W + (size_t)l * LW_BYTES;
    tconv(p.in[2] + (size_t)l * DM * INC, DM, INC, (u16*)(W + W_IN), p.in[1] + l * DM, 0, smf, bid, nb);
    for (int g = 0; g < 3; ++g)
      tconv(p.in[18] + (size_t)(l * 3 + g) * 512 * DM, 512, DM, (u16*)(W + W_BR) + (size_t)g * DM * 512, nullptr, 0, smf, bid, nb);
    tconv(p.in[19] + (size_t)l * DM * DM, DM, DM, (u16*)(W + W_OUT), nullptr, 0, smf, bid, nb);
    tconv(p.in[21] + (size_t)l * DM * 2 * DFF, DM, 2 * DFF, (u16*)(W + W_UP), p.in[20] + l * DM, 1, smf, bid, nb);
    tconv(p.in[24] + (size_t)l * DFF * DM, DFF, DM, (u16*)(W + W_DN), nullptr, 0, smf, bid, nb);
    tconv(p.in[5] + (size_t)l * 64 * 512, 64, 512, (u16*)(W + W_RWUP), nullptr, 0, smf, bid, nb);
    tconv(p.in[7] + (size_t)l * 64 * 512, 64, 512, (u16*)(W + W_RAUP), nullptr, 0, smf, bid, nb);
    tconv(p.in[8] + (size_t)l * 128 * 512, 128, 512, (u16*)(W + W_RGUP), nullptr, 0, smf, bid, nb);
    const float* sw = p.in[16] + (size_t)l * 4 * 128 * 128;
    u16* sd = (u16*)(W + W_SGW);
    for (int idx = bid * NTHR + my_tid(); idx < 4 * 128 * 128; idx += nb * NTHR) {
      int i = (idx >> 7) & 127, j = idx & 127;
      sd[idx] = f2bf(j <= i ? sw[idx] : 0.f);
    }
  }
  {
    float* sq = (float*)(p.ws + OFF_RSTD) + NTOK;
    for (int idx = bid * NTHR + my_tid(); idx < 3 * NTOK; idx += nb * NTHR) sq[idx] = 0.f;
  }
  float* rc = (float*)(p.ws + OFF_ROPE);
  float* rs = rc + SEQ * 32;
  for (int idx = bid * NTHR + my_tid(); idx < SEQ * 32; idx += nb * NTHR) {
    int pos = idx >> 5, d = idx & 31;
    float lin = (d == 31) ? 1.0f : (float)d * (1.0f / 31.0f);
    float invf = 1.0f / powf(10000.0f, lin);
    float ang = (float)pos * invf;
    double rev = (double)ang * 0.15915494309189533577;
    float fr = (float)(rev - floor(rev));
    rc[idx] = __builtin_amdgcn_cosf(fr);
    rs[idx] = __builtin_amdgcn_sinf(fr);
  }
}

DEV void phase_norm(const float* x, u16* xb, float* rstd, int bid, int nb) {
  const int lane = my_tid() & 63, wave = my_tid() >> 6;
  for (int row = bid * 8 + wave; row < NTOK; row += nb * 8) {
    const float4* xr = (const float4*)(x + (size_t)row * DM);
    float4 v[4];
    float ss = 0.f;
#pragma unroll
    for (int i = 0; i < 4; ++i) {
      v[i] = xr[lane + 64 * i];
      ss += v[i].x * v[i].x + v[i].y * v[i].y + v[i].z * v[i].z + v[i].w * v[i].w;
    }
    ss = wave_sum(ss);
    if (lane == 0) rstd[row] = ss;
    uint2* o = (uint2*)(xb + (size_t)row * DM);
#pragma unroll
    for (int i = 0; i < 4; ++i) o[lane + 64 * i] = make_uint2(pack2(v[i].x, v[i].y), pack2(v[i].z, v[i].w));
  }
}
DEV void phase_final(float* x, const float* g, int bid, int nb) {
  const int lane = my_tid() & 63, wave = my_tid() >> 6;
  for (int row = bid * 8 + wave; row < NTOK; row += nb * 8) {
    float4* xr = (float4*)(x + (size_t)row * DM);
    const float4* gr = (const float4*)g;
    float4 v[4];
    float ss = 0.f;
#pragma unroll
    for (int i = 0; i < 4; ++i) {
      v[i] = xr[lane + 64 * i];
      ss += v[i].x * v[i].x + v[i].y * v[i].y + v[i].z * v[i].z + v[i].w * v[i].w;
    }
    ss = wave_sum(ss);
    float r = rsqrtf(ss * (1.0f / DM) + 1e-6f);
#pragma unroll
    for (int i = 0; i < 4; ++i) {
      float4 gg = gr[lane + 64 * i];
      xr[lane + 64 * i] = make_float4(v[i].x * r * gg.x, v[i].y * r * gg.y, v[i].z * r * gg.z, v[i].w * r * gg.w);
    }
  }
}

DEV void phase_inproj(const u16* xb, const float* rstd, const u16* wt, int N, u16* out, u16* smem, int bid, int nb) {
  const int tid = my_tid(), lane = tid & 63, wave = tid >> 6, wm = wave >> 1, wn = wave & 1;
  const int MTL = NTOK / 256, NTL = N / 256;
  for (int t = vbid(bid, nb); t < MTL * NTL; t += nb) {
    int m, n;
    tile_map(t, MTL, NTL, m, n);
    f32x16 acc[2][4];
    ZERO_BIG(acc);
    gemm_big(acc, xb, DM, m * 256, -(1 << 30), NTOK - 1, wt + (size_t)n * 256 * DM, DM, DM, smem);
#pragma unroll
    for (int i = 0; i < 2; ++i)
#pragma unroll
      for (int e = 0; e < 16; ++e) {
        const int r = BIG_ROW(i, e);
        const float rs = rstd_of(rstd, m * 256 + r);
#pragma unroll
        for (int j = 0; j < 4; ++j) smem[r * 264 + BIG_COL(j)] = f2bf(acc[i][j][e] * rs);
      }
    __syncthreads();
#pragma unroll 4
    for (int k = 0; k < 16; ++k) {
      const int c = tid + NTHR * k;
      const int r = c >> 5, cc = c & 31;
      *(uint4*)(out + (size_t)(m * 256 + r) * N + n * 256 + cc * 8) = *(const uint4*)(smem + r * 264 + cc * 8);
    }
    __syncthreads();
  }
}

#define OPS_STRIDE ((size_t)NTOK * 512)
template <int WHICH>
DEV void rwprep_gemm(const u16* T, u16* OS, const u16* wsrc, const float* w0, const float* a0, u16* ops, int t0, int nbk) {
  const int tid = my_tid(), lane = tid & 63, wave = tid >> 6, wm = wave >> 1, wn = wave & 1;
  constexpr int kd = (WHICH == 2) ? 128 : 64;
  constexpr int aoff = (WHICH == 0) ? 0 : (WHICH == 1 ? 64 : 128);
  constexpr int arr = (WHICH == 0) ? 4 : (WHICH == 1 ? 3 : 5);
  const int arow = (wm * 32 + (lane & 31)) * 264 + (lane >> 5) * 8;
  const int bn = nbk * 128 + wn * 64 + (lane & 31);
  bf16x8 bfr[kd / 16][2];
#pragma unroll
  for (int ks = 0; ks < kd / 16; ++ks)
#pragma unroll
    for (int j = 0; j < 2; ++j) bfr[ks][j] = *(const bf16x8*)(wsrc + (size_t)(bn + j * 32) * kd + ks * 16 + (lane >> 5) * 8);
  f32x16 ac[2];
#pragma unroll
  for (int j = 0; j < 2; ++j)
#pragma unroll
    for (int e = 0; e < 16; ++e) ac[j][e] = 0.f;
#pragma unroll
  for (int ks = 0; ks < kd / 16; ++ks) {
    const bf16x8 a1 = *(const bf16x8*)(T + arow + aoff + ks * 16);
#pragma unroll
    for (int j = 0; j < 2; ++j) ac[j] = __builtin_amdgcn_mfma_f32_32x32x16_bf16(a1, bfr[ks][j], ac[j], 0, 0, 0);
  }
#pragma unroll
  for (int j = 0; j < 2; ++j) {
    const int cl = ACC_COL(j);
    const int ch = nbk * 128 + cl;
    const float w0c = w0[ch], a0c = a0[ch];
#pragma unroll
    for (int e = 0; e < 16; ++e) {
      float val;
      if (WHICH == 0) {
        const float z = -(w0c + ac[j][e]);
        const float sp = fmaxf(z, 0.f) + log1pf(__expf(-fabsf(z)));
        val = __expf(-sp - 0.5f);
      } else if (WHICH == 1) {
        val = sigmoidf_(a0c + ac[j][e]);
      } else {
        val = ac[j][e];
      }
      OS[ACC_ROW(1, 0, e) * 136 + cl] = f2bf(val);
    }
  }
  __syncthreads();
#pragma unroll
  for (int k = 0; k < 4; ++k) {
    const int c = tid + NTHR * k;
    const int r = c >> 4, cc = c & 15;
    *(uint4*)(ops + (size_t)arr * OPS_STRIDE + (size_t)(t0 + r) * 512 + nbk * 128 + cc * 8) = *(const uint4*)(OS + r * 136 + cc * 8);
  }
  __syncthreads();
}

DEV void phase_rwprep(const Params& p, int l, u16* smem, int bid, int nb) {
  const int tid = my_tid(), lane = tid & 63, wave = tid >> 6, wm = wave >> 1, wn = wave & 1;
  const u16* prw = (const u16*)(p.ws + OFF_BIG + B_PRW);
  u16* ops = (u16*)(p.ws + OFF_BIG + B_OPS);
  unsigned char* W = p.ws + OFF_W + (size_t)l * LW_BYTES;
  const u16* wup = (const u16*)(W + W_RWUP);
  const u16* aup = (const u16*)(W + W_RAUP);
  const u16* gup = (const u16*)(W + W_RGUP);
  const float* mu = p.in[3] + l * 1792;
  const float* w0 = p.in[4] + l * 512;
  const float* a0 = p.in[6] + l * 512;
  u16* T = smem;
  for (int tile = bid; tile < NTOK / 128; tile += nb) {
    const int t0 = tile * 128;
    for (int c = tid; c < 128 * 224; c += NTHR) {
      int tok = c / 224, ch = (c % 224) * 8;
      int t = t0 + tok;
      float cur[8], prv[8], o[8];
      unpack8(*(const uint4*)(prw + (size_t)t * 1792 + ch), cur);
      if ((t & (SEQ - 1)) != 0) unpack8(*(const uint4*)(prw + (size_t)(t - 1) * 1792 + ch), prv);
      else {
#pragma unroll
        for (int j = 0; j < 8; ++j) prv[j] = 0.f;
      }
      float4 m0 = *(const float4*)(mu + ch), m1 = *(const float4*)(mu + ch + 4);
      float mm[8] = {m0.x, m0.y, m0.z, m0.w, m1.x, m1.y, m1.z, m1.w};
#pragma unroll
      for (int j = 0; j < 8; ++j) o[j] = cur[j] + mm[j] * (prv[j] - cur[j]);
      if (ch < 1536) {
        int arr = ch >> 9;
        *(uint4*)(ops + arr * OPS_STRIDE + (size_t)t * 512 + (ch & 511)) = pack8(o);
      } else {
        int cc = ch - 1536;
        if (cc < 64) {
#pragma unroll
          for (int j = 0; j < 8; ++j) o[j] = tanhf(o[j]);
        } else if (cc >= 128) {
#pragma unroll
          for (int j = 0; j < 8; ++j) o[j] = sigmoidf_(o[j]);
        }
        *(uint4*)(T + tok * 264 + cc) = pack8(o);
      }
    }
    __syncthreads();
    u16* OS = smem + 128 * 264;
    for (int nbk = 0; nbk < 4; ++nbk) {
      rwprep_gemm<0>(T, OS, wup, w0, a0, ops, t0, nbk);
      rwprep_gemm<1>(T, OS, aup, w0, a0, ops, t0, nbk);
      rwprep_gemm<2>(T, OS, gup, w0, a0, ops, t0, nbk);
    }
    __syncthreads();
  }
}

#define TS 32
struct ScanStage {
  float* W; float* KK; float* BB; float* KP; float* RR; float* VV; float* YY;
};
template <int PASS>
DEV void phase_scan(const Params& p, int l, float* smf, int bid, int nb) {
  const int tid = my_tid();
  const int half = tid >> 8, tu = tid & 255;
  const u16* ops = (const u16*)(p.ws + OFF_BIG + B_OPS);
  float* PL = (float*)(p.ws + OFF_BIG + B_PL);
  const float* SIN = (const float*)(p.ws + OFF_BIG + B_SINIT);
  u16* yrw = (u16*)(p.ws + OFF_BIG + B_YRW);
  const float* k_k = p.in[9] + l * 512;
  const float* k_a = p.in[10] + l * 512;
  const float* r_k = p.in[11] + l * 512;
  const float* lng = p.in[12] + l * 512;
  const float* lnb = p.in[13] + l * 512;
  float* base = smf + half * (7 * TS * 64);
  float* sW = base; float* sKK = base + TS * 64; float* sB = base + 2 * TS * 64; float* sKP = base + 3 * TS * 64;
  float* sR = base + 4 * TS * 64; float* sV = base + 5 * TS * 64; float* sY = base + 6 * TS * 64;
  const int ss = tu >> 3, c8 = tu & 7;
  const int ks = tu & 7, rp = tu >> 3;
  for (int u2 = bid; u2 < 256; u2 += nb) {
    const int u = u2 * 2 + half;
    const int bh = u >> 4, c = u & 15;
    const int b = bh >> 3, h = bh & 7;
    const int tok0 = b * SEQ + c * 512;
    const int chb = h * 64 + c8 * 8;
    float S0[8], S1[8], Q0[8], Q1[8];
    if (PASS == 1) {
#pragma unroll
      for (int j = 0; j < 8; ++j) {
        S0[j] = 0.f; S1[j] = 0.f;
        Q0[j] = (ks * 8 + j == 2 * rp) ? 1.f : 0.f;
        Q1[j] = (ks * 8 + j == 2 * rp + 1) ? 1.f : 0.f;
      }
    } else {
      const float* si = SIN + (size_t)u * 4096;
      float4 x0 = *(const float4*)(si + (2 * rp) * 64 + ks * 8), x1 = *(const float4*)(si + (2 * rp) * 64 + ks * 8 + 4);
      float4 y0 = *(const float4*)(si + (2 * rp + 1) * 64 + ks * 8), y1 = *(const float4*)(si + (2 * rp + 1) * 64 + ks * 8 + 4);
      S0[0] = x0.x; S0[1] = x0.y; S0[2] = x0.z; S0[3] = x0.w; S0[4] = x1.x; S0[5] = x1.y; S0[6] = x1.z; S0[7] = x1.w;
      S1[0] = y0.x; S1[1] = y0.y; S1[2] = y0.z; S1[3] = y0.w; S1[4] = y1.x; S1[5] = y1.y; S1[6] = y1.z; S1[7] = y1.w;
#pragma unroll
      for (int j = 0; j < 8; ++j) { Q0[j] = 0.f; Q1[j] = 0.f; }
    }
    float kkc[8], kac[8], rkc[8];
    {
      float4 q0 = *(const float4*)(k_k + chb), q1 = *(const float4*)(k_k + chb + 4);
      kkc[0] = q0.x; kkc[1] = q0.y; kkc[2] = q0.z; kkc[3] = q0.w; kkc[4] = q1.x; kkc[5] = q1.y; kkc[6] = q1.z; kkc[7] = q1.w;
      q0 = *(const float4*)(k_a + chb); q1 = *(const float4*)(k_a + chb + 4);
      kac[0] = q0.x; kac[1] = q0.y; kac[2] = q0.z; kac[3] = q0.w; kac[4] = q1.x; kac[5] = q1.y; kac[6] = q1.z; kac[7] = q1.w;
      q0 = *(const float4*)(r_k + chb); q1 = *(const float4*)(r_k + chb + 4);
      rkc[0] = q0.x; rkc[1] = q0.y; rkc[2] = q0.z; rkc[3] = q0.w; rkc[4] = q1.x; rkc[5] = q1.y; rkc[6] = q1.z; rkc[7] = q1.w;
    }
    uint4 pr_r, pr_k, pr_v, pr_a, pr_e, pr_g = make_uint4(0, 0, 0, 0);
    {
      const size_t o0 = (size_t)(tok0 + ss) * 512 + chb;
      pr_r = *(const uint4*)(ops + 0 * OPS_STRIDE + o0);
      pr_k = *(const uint4*)(ops + 1 * OPS_STRIDE + o0);
      pr_v = *(const uint4*)(ops + 2 * OPS_STRIDE + o0);
      pr_a = *(const uint4*)(ops + 3 * OPS_STRIDE + o0);
      pr_e = *(const uint4*)(ops + 4 * OPS_STRIDE + o0);
      if (PASS == 3) pr_g = *(const uint4*)(ops + 5 * OPS_STRIDE + o0);
    }
    for (int sc = 0; sc < 512 / TS; ++sc) {
      const size_t o = (size_t)(tok0 + sc * TS + ss) * 512 + chb;
      float fr[8], fk[8], fv[8], fa[8], fe[8];
      unpack8(pr_r, fr);
      unpack8(pr_k, fk);
      unpack8(pr_v, fv);
      unpack8(pr_a, fa);
      unpack8(pr_e, fe);
      const uint4 graw = pr_g;
      if (sc + 1 < 512 / TS) {
        const size_t o1 = o + (size_t)TS * 512;
        pr_r = *(const uint4*)(ops + 0 * OPS_STRIDE + o1);
        pr_k = *(const uint4*)(ops + 1 * OPS_STRIDE + o1);
        pr_v = *(const uint4*)(ops + 2 * OPS_STRIDE + o1);
        pr_a = *(const uint4*)(ops + 3 * OPS_STRIDE + o1);
        pr_e = *(const uint4*)(ops + 4 * OPS_STRIDE + o1);
        if (PASS == 3) pr_g = *(const uint4*)(ops + 5 * OPS_STRIDE + o1);
      }
      float kk[8], kp[8], ssq = 0.f, bon = 0.f;
#pragma unroll
      for (int j = 0; j < 8; ++j) {
        kk[j] = fk[j] * kkc[j];
        ssq += kk[j] * kk[j];
        kp[j] = fk[j] * (1.f + (fa[j] - 1.f) * kac[j]);
        bon += fr[j] * kp[j] * rkc[j];
      }
      ssq = red8(ssq);
      bon = red8(bon);
      const float inv = 1.f / fmaxf(sqrtf(ssq), 1e-12f);
      float fw[8], fb[8];
#pragma unroll
      for (int j = 0; j < 8; ++j) {
        kk[j] *= inv;
        fb[j] = fa[j] * kk[j];
        fw[j] = __expf(-fe[j]);
      }
      {
        const int so = ss * 64 + c8 * 8;
        *(float4*)(sW + so) = make_float4(fw[0], fw[1], fw[2], fw[3]); *(float4*)(sW + so + 4) = make_float4(fw[4], fw[5], fw[6], fw[7]);
        *(float4*)(sKK + so) = make_float4(kk[0], kk[1], kk[2], kk[3]); *(float4*)(sKK + so + 4) = make_float4(kk[4], kk[5], kk[6], kk[7]);
        *(float4*)(sB + so) = make_float4(fb[0], fb[1], fb[2], fb[3]); *(float4*)(sB + so + 4) = make_float4(fb[4], fb[5], fb[6], fb[7]);
        *(float4*)(sKP + so) = make_float4(kp[0], kp[1], kp[2], kp[3]); *(float4*)(sKP + so + 4) = make_float4(kp[4], kp[5], kp[6], kp[7]);
        *(float4*)(sV + so) = make_float4(fv[0], fv[1], fv[2], fv[3]); *(float4*)(sV + so + 4) = make_float4(fv[4], fv[5], fv[6], fv[7]);
        if (PASS == 3) {
          *(float4*)(sR + so) = make_float4(fr[0], fr[1], fr[2], fr[3]); *(float4*)(sR + so + 4) = make_float4(fr[4], fr[5], fr[6], fr[7]);
        }
      }
      __syncthreads();
#pragma unroll 2
      for (int s = 0; s < TS; ++s) {
        const int so = s * 64 + ks * 8;
        float4 t0 = *(const float4*)(sW + so), t1 = *(const float4*)(sW + so + 4);
        float w[8] = {t0.x, t0.y, t0.z, t0.w, t1.x, t1.y, t1.z, t1.w};
        t0 = *(const float4*)(sKK + so); t1 = *(const float4*)(sKK + so + 4);
        float kq[8] = {t0.x, t0.y, t0.z, t0.w, t1.x, t1.y, t1.z, t1.w};
        t0 = *(const float4*)(sB + so); t1 = *(const float4*)(sB + so + 4);
        float bq[8] = {t0.x, t0.y, t0.z, t0.w, t1.x, t1.y, t1.z, t1.w};
        t0 = *(const float4*)(sKP + so); t1 = *(const float4*)(sKP + so + 4);
        float kpq[8] = {t0.x, t0.y, t0.z, t0.w, t1.x, t1.y, t1.z, t1.w};
        const float2 vv = *(const float2*)(sV + s * 64 + 2 * rp);
        float sa0 = 0.f, sa1 = 0.f;
#pragma unroll
        for (int j = 0; j < 8; ++j) { sa0 += S0[j] * kq[j]; sa1 += S1[j] * kq[j]; }
        sa0 = red8(sa0); sa1 = red8(sa1);
#pragma unroll
        for (int j = 0; j < 8; ++j) {
          S0[j] = S0[j] * w[j] - sa0 * bq[j] + vv.x * kpq[j];
          S1[j] = S1[j] * w[j] - sa1 * bq[j] + vv.y * kpq[j];
        }
        if (PASS == 1) {
          float pa0 = 0.f, pa1 = 0.f;
#pragma unroll
          for (int j = 0; j < 8; ++j) { pa0 += Q0[j] * kq[j]; pa1 += Q1[j] * kq[j]; }
          pa0 = red8(pa0); pa1 = red8(pa1);
#pragma unroll
          for (int j = 0; j < 8; ++j) {
            Q0[j] = Q0[j] * w[j] - pa0 * bq[j];
            Q1[j] = Q1[j] * w[j] - pa1 * bq[j];
          }
        } else {
          t0 = *(const float4*)(sR + so); t1 = *(const float4*)(sR + so + 4);
          float rq[8] = {t0.x, t0.y, t0.z, t0.w, t1.x, t1.y, t1.z, t1.w};
          float y0 = 0.f, y1 = 0.f;
#pragma unroll
          for (int j = 0; j < 8; ++j) { y0 += S0[j] * rq[j]; y1 += S1[j] * rq[j]; }
          y0 = red8(y0); y1 = red8(y1);
          if (ks == 0) *(float2*)(sY + s * 64 + 2 * rp) = make_float2(y0, y1);
        }
      }
      __syncthreads();
      if (PASS == 3) {
        const int so = ss * 64 + c8 * 8;
        float4 y0 = *(const float4*)(sY + so), y1 = *(const float4*)(sY + so + 4);
        float y[8] = {y0.x, y0.y, y0.z, y0.w, y1.x, y1.y, y1.z, y1.w};
        float sm = 0.f;
#pragma unroll
        for (int j = 0; j < 8; ++j) sm += y[j];
        const float mean = red8(sm) * (1.f / 64.f);
        float sv = 0.f;
#pragma unroll
        for (int j = 0; j < 8; ++j) { y[j] -= mean; sv += y[j] * y[j]; }
        const float var = red8(sv) * (1.f / 64.f);
        const float rs = rsqrtf(var + 64e-5f);
        float g[8], outv[8];
        unpack8(graw, g);
        float4 l0 = *(const float4*)(lng + chb), l1 = *(const float4*)(lng + chb + 4);
        float4 b0 = *(const float4*)(lnb + chb), b1 = *(const float4*)(lnb + chb + 4);
        float lg[8] = {l0.x, l0.y, l0.z, l0.w, l1.x, l1.y, l1.z, l1.w};
        float lb[8] = {b0.x, b0.y, b0.z, b0.w, b1.x, b1.y, b1.z, b1.w};
#pragma unroll
        for (int j = 0; j < 8; ++j) outv[j] = (y[j] * rs * lg[j] + lb[j] + bon * fv[j]) * g[j];
        if (!(c == 0 && sc == 0 && ss == 0)) *(uint4*)(yrw + o) = pack8(outv);
      }
    }
    if (PASS == 1) {
      float* pl = PL + (size_t)u * 8192;
      float* Pm = pl;
      float* Lm = pl + 4096;
      *(float4*)(Pm + (2 * rp) * 64 + ks * 8) = make_float4(Q0[0], Q0[1], Q0[2], Q0[3]);
      *(float4*)(Pm + (2 * rp) * 64 + ks * 8 + 4) = make_float4(Q0[4], Q0[5], Q0[6], Q0[7]);
      *(float4*)(Pm + (2 * rp + 1) * 64 + ks * 8) = make_float4(Q1[0], Q1[1], Q1[2], Q1[3]);
      *(float4*)(Pm + (2 * rp + 1) * 64 + ks * 8 + 4) = make_float4(Q1[4], Q1[5], Q1[6], Q1[7]);
      *(float4*)(Lm + (2 * rp) * 64 + ks * 8) = make_float4(S0[0], S0[1], S0[2], S0[3]);
      *(float4*)(Lm + (2 * rp) * 64 + ks * 8 + 4) = make_float4(S0[4], S0[5], S0[6], S0[7]);
      *(float4*)(Lm + (2 * rp + 1) * 64 + ks * 8) = make_float4(S1[0], S1[1], S1[2], S1[3]);
      *(float4*)(Lm + (2 * rp + 1) * 64 + ks * 8 + 4) = make_float4(S1[4], S1[5], S1[6], S1[7]);
    }
  }
}

DEV void phase_scanprop(const Params& p, float* smf, int bid, int nb) {
  const int tid = my_tid();
  const float* PL = (const float*)(p.ws + OFF_BIG + B_PL);
  float* SIN = (float*)(p.ws + OFF_BIG + B_SINIT);
  float* sS = smf;
  float* sP = smf + 4096;
  const int i = tid >> 3, k8 = tid & 7;
  for (int bh = bid; bh < 32; bh += nb) {
    float cur[8];
#pragma unroll
    for (int j = 0; j < 8; ++j) cur[j] = 0.f;
    for (int c = 0; c < 16; ++c) {
      const int u = bh * 16 + c;
      float* so = SIN + (size_t)u * 4096 + i * 64 + k8 * 8;
      *(float4*)so = make_float4(cur[0], cur[1], cur[2], cur[3]);
      *(float4*)(so + 4) = make_float4(cur[4], cur[5], cur[6], cur[7]);
      if (c == 15) break;
      const float* pl = PL + (size_t)u * 8192;
      *(float4*)(sS + i * 64 + k8 * 8) = make_float4(cur[0], cur[1], cur[2], cur[3]);
      *(float4*)(sS + i * 64 + k8 * 8 + 4) = make_float4(cur[4], cur[5], cur[6], cur[7]);
      *(float4*)(sP + tid * 8) = *(const float4*)(pl + tid * 8);
      *(float4*)(sP + tid * 8 + 4) = *(const float4*)(pl + tid * 8 + 4);
      float4 l0 = *(const float4*)(pl + 4096 + i * 64 + k8 * 8), l1 = *(const float4*)(pl + 4096 + i * 64 + k8 * 8 + 4);
      __syncthreads();
      float nw[8] = {l0.x, l0.y, l0.z, l0.w, l1.x, l1.y, l1.z, l1.w};
#pragma unroll 8
      for (int j = 0; j < 64; ++j) {
        const float sij = sS[i * 64 + j];
        float4 p0 = *(const float4*)(sP + j * 64 + k8 * 8), p1 = *(const float4*)(sP + j * 64 + k8 * 8 + 4);
        nw[0] += sij * p0.x; nw[1] += sij * p0.y; nw[2] += sij * p0.z; nw[3] += sij * p0.w;
        nw[4] += sij * p1.x; nw[5] += sij * p1.y; nw[6] += sij * p1.z; nw[7] += sij * p1.w;
      }
#pragma unroll
      for (int j = 0; j < 8; ++j) cur[j] = nw[j];
      __syncthreads();
    }
  }
}

DEV float ret_log2gamma(int h) { return log2f(1.0f - exp2f(-5.0f - (float)h)); }

DEV void stage_rot(const u16* src, size_t ld, const float* rc, const float* rs, int pos0, u16* dst, float sc, float l2g, int rowmode) {
  const int tid = my_tid();
  const int row = tid >> 2, d0 = (tid & 3) * 8;
  float lo[8], hi[8], olo[8], ohi[8];
  unpack8(*(const uint4*)(src + (size_t)row * ld + d0), lo);
  unpack8(*(const uint4*)(src + (size_t)row * ld + d0 + 32), hi);
  const float* cp = rc + (size_t)(pos0 + row) * 32 + d0;
  const float* sp = rs + (size_t)(pos0 + row) * 32 + d0;
  float4 c0 = *(const float4*)cp, c1 = *(const float4*)(cp + 4);
  float4 s0 = *(const float4*)sp, s1 = *(const float4*)(sp + 4);
  float cc[8] = {c0.x, c0.y, c0.z, c0.w, c1.x, c1.y, c1.z, c1.w};
  float sn[8] = {s0.x, s0.y, s0.z, s0.w, s1.x, s1.y, s1.z, s1.w};
  float rsc = sc;
  if (rowmode == 1) rsc *= exp2f((float)(row + 1) * l2g);
  if (rowmode == 2) rsc *= exp2f((float)(127 - row) * l2g);
#pragma unroll
  for (int j = 0; j < 8; ++j) {
    olo[j] = (lo[j] * cc[j] - hi[j] * sn[j]) * rsc;
    ohi[j] = (hi[j] * cc[j] + lo[j] * sn[j]) * rsc;
  }
  *(uint4*)(dst + row * 72 + d0) = pack8(olo);
  *(uint4*)(dst + row * 72 + d0 + 32) = pack8(ohi);
}
DEV void stage_rot_T(const u16* src, size_t ld, const float* rc, const float* rs, int pos0, u16* dst, float sc, float l2g) {
  const int tid = my_tid();
  const int row = tid >> 2, d0 = (tid & 3) * 8;
  float lo[8], hi[8];
  unpack8(*(const uint4*)(src + (size_t)row * ld + d0), lo);
  unpack8(*(const uint4*)(src + (size_t)row * ld + d0 + 32), hi);
  const float* cp = rc + (size_t)(pos0 + row) * 32 + d0;
  const float* sp = rs + (size_t)(pos0 + row) * 32 + d0;
  float4 c0 = *(const float4*)cp, c1 = *(const float4*)(cp + 4);
  float4 s0 = *(const float4*)sp, s1 = *(const float4*)(sp + 4);
  float cc[8] = {c0.x, c0.y, c0.z, c0.w, c1.x, c1.y, c1.z, c1.w};
  float sn[8] = {s0.x, s0.y, s0.z, s0.w, s1.x, s1.y, s1.z, s1.w};
  const float rsc = sc * exp2f((float)(127 - row) * l2g);
#pragma unroll
  for (int j = 0; j < 8; ++j) {
    dst[(d0 + j) * 136 + row] = f2bf((lo[j] * cc[j] - hi[j] * sn[j]) * rsc);
    dst[(d0 + j + 32) * 136 + row] = f2bf((hi[j] * cc[j] + lo[j] * sn[j]) * rsc);
  }
}
DEV void stage_vT(const u16* src, size_t ld, u16* dst) {
  const int tid = my_tid();
  const int row = tid >> 2, d0 = (tid & 3) * 32;
#pragma unroll
  for (int c = 0; c < 4; ++c) {
    uint4 v = *(const uint4*)(src + (size_t)row * ld + d0 + c * 8);
    unsigned w[4] = {v.x, v.y, v.z, v.w};
#pragma unroll
    for (int j = 0; j < 4; ++j) {
      dst[(d0 + c * 8 + 2 * j) * 136 + row] = (u16)(w[j] & 0xffffu);
      dst[(d0 + c * 8 + 2 * j + 1) * 136 + row] = (u16)(w[j] >> 16);
    }
  }
}

DEV void ret_kv_unit(const Params& p, int u, u16* smem) {
  const int tid = my_tid(), lane = tid & 63, wave = tid >> 6;
  const u16* prs = (const u16*)(p.ws + OFF_BIG + B_PRS);
  float* KV = (float*)(p.ws + OFF_BIG + B_KV);
  const float* rc = (const float*)(p.ws + OFF_ROPE);
  const float* rs = rc + SEQ * 32;
  const int n = u & 63, h = (u >> 6) & 3, b = u >> 8;
  const size_t t0 = (size_t)b * SEQ + n * 128;
  const float l2g = ret_log2gamma(h);
  u16* KT = smem;
  u16* VT = smem + 64 * 136;
  stage_rot_T(prs + t0 * 2560 + 256 + h * 64, 2560, rc, rs, n * 128, KT, 0.125f, l2g);
  stage_vT(prs + t0 * 2560 + 512 + h * 128, 2560, VT);
  __syncthreads();
  const int mi = wave >> 1, nj = wave & 1;
  f32x16 acc;
#pragma unroll
  for (int e = 0; e < 16; ++e) acc[e] = 0.f;
#pragma unroll
  for (int ks = 0; ks < 8; ++ks) {
    bf16x8 a = *(const bf16x8*)(VT + (mi * 32 + (lane & 31)) * 136 + ks * 16 + (lane >> 5) * 8);
    bf16x8 bb = *(const bf16x8*)(KT + (nj * 32 + (lane & 31)) * 136 + ks * 16 + (lane >> 5) * 8);
    acc = __builtin_amdgcn_mfma_f32_32x32x16_bf16(a, bb, acc, 0, 0, 0);
  }
  float* kv = KV + (size_t)u * 8192;
#pragma unroll
  for (int e = 0; e < 16; ++e) {
    int dv = mi * 32 + (e & 3) + 8 * (e >> 2) + 4 * (lane >> 5);
    int dk = nj * 32 + (lane & 31);
    kv[dv * 64 + dk] = acc[e];
  }
  __syncthreads();
}

DEV void sgu_unit(const Params& p, int l, int u, u16* smem) {
  const int tid = my_tid(), lane = tid & 63, wave = tid >> 6, wm = wave >> 1, wn = wave & 1;
  const u16* prs = (const u16*)(p.ws + OFF_BIG + B_PRS);
  u16* ysg = (u16*)(p.ws + OFF_BIG + B_YSG);
  const u16* sgw = (const u16*)(p.ws + OFF_W + (size_t)l * LW_BYTES + W_SGW);
  const float* lng = p.in[14] + l * 512;
  const float* lnb = p.in[15] + l * 512;
  const float* sgb = p.in[17] + l * 512;
  const size_t t0 = (size_t)u * 128;
  u16* VT = smem;
  u16* WT = smem + 128 * 136;
  float* st = (float*)(smem + 2 * 128 * 136);
  const int tok = tid >> 2, q = tid & 3;
  const u16* vrow = prs + (t0 + tok) * 2560 + 1536 + 512;
  {
    float s = 0.f, s2 = 0.f;
#pragma unroll 4
    for (int c = 0; c < 16; ++c) {
      float f[8];
      unpack8(*(const uint4*)(vrow + q * 128 + c * 8), f);
#pragma unroll
      for (int j = 0; j < 8; ++j) { float gl = geluf_(f[j]); s += gl; s2 += gl * gl; }
    }
    s = red4(s); s2 = red4(s2);
    const float mean = s * (1.f / 512.f);
    const float var = fmaxf(s2 * (1.f / 512.f) - mean * mean, 0.f);
    if (q == 0) { st[tok] = mean; st[128 + tok] = rsqrtf(var + 1e-6f); }
  }
  __syncthreads();
  const float mean = st[tok], rstd = st[128 + tok];
  for (int g = 0; g < 4; ++g) {
#pragma unroll
    for (int c = 0; c < 4; ++c) {
      const int d = q * 32 + c * 8;
      float f[8];
      unpack8(*(const uint4*)(vrow + g * 128 + d), f);
      float4 g0 = *(const float4*)(lng + g * 128 + d), g1 = *(const float4*)(lng + g * 128 + d + 4);
      float4 b0 = *(const float4*)(lnb + g * 128 + d), b1 = *(const float4*)(lnb + g * 128 + d + 4);
      float gg[8] = {g0.x, g0.y, g0.z, g0.w, g1.x, g1.y, g1.z, g1.w};
      float bb[8] = {b0.x, b0.y, b0.z, b0.w, b1.x, b1.y, b1.z, b1.w};
#pragma unroll
      for (int j = 0; j < 8; ++j) VT[(d + j) * 136 + tok] = f2bf((geluf_(f[j]) - mean) * rstd * gg[j] + bb[j]);
      *(uint4*)(WT + tok * 136 + d) = *(const uint4*)(sgw + (size_t)g * 16384 + tok * 128 + d);
    }
    __syncthreads();
    f32x16 acc[2];
#pragma unroll
    for (int j = 0; j < 2; ++j)
#pragma unroll
      for (int e = 0; e < 16; ++e) acc[j][e] = 0.f;
#pragma unroll
    for (int ks = 0; ks < 8; ++ks) {
      bf16x8 a = *(const bf16x8*)(WT + (wm * 32 + (lane & 31)) * 136 + ks * 16 + (lane >> 5) * 8);
#pragma unroll
      for (int j = 0; j < 2; ++j) {
        bf16x8 bb = *(const bf16x8*)(VT + (wn * 64 + j * 32 + (lane & 31)) * 136 + ks * 16 + (lane >> 5) * 8);
        acc[j] = __builtin_amdgcn_mfma_f32_32x32x16_bf16(a, bb, acc[j], 0, 0, 0);
      }
    }
#pragma unroll
    for (int e = 0; e < 16; ++e) {
      const int i = ACC_ROW(1, 0, e);
      const float bias = sgb[g * 128 + i];
#pragma unroll
      for (int j = 0; j < 2; ++j) {
        const int d = ACC_COL(j);
        const float uu = geluf_(bf2f(prs[(t0 + i) * 2560 + 1536 + g * 128 + d]));
        ysg[(t0 + i) * 512 + g * 128 + d] = f2bf(uu * (acc[j][e] + bias));
      }
    }
    __syncthreads();
  }
}

DEV void phase_retprefix(const Params& p, int bid, int nb) {
  float* KV = (float*)(p.ws + OFF_BIG + B_KV);
  for (int gid = bid * NTHR + my_tid(); gid < 16 * 8192; gid += nb * NTHR) {
    const int bh = gid >> 13, e = gid & 8191;
    const int h = bh & 3;
    const float cd = exp2f(128.f * ret_log2gamma(h));
    float R = 0.f;
    float* ptr = KV + (size_t)bh * 64 * 8192 + e;
    for (int n = 0; n < 64; ++n) {
      float kv = ptr[(size_t)n * 8192];
      ptr[(size_t)n * 8192] = R;
      R = R * cd + kv;
    }
  }
}

DEV void ret_out_unit(const Params& p, int u, u16* smem) {
  const int tid = my_tid(), lane = tid & 63, wave = tid >> 6, wm = wave >> 1, wn = wave & 1;
  const u16* prs = (const u16*)(p.ws + OFF_BIG + B_PRS);
  const float* KV = (const float*)(p.ws + OFF_BIG + B_KV);
  u16* yret = (u16*)(p.ws + OFF_BIG + B_YRET);
  const float* rc = (const float*)(p.ws + OFF_ROPE);
  const float* rs = rc + SEQ * 32;
  const int n = u & 63, h = (u >> 6) & 3, b = u >> 8;
  const size_t t0 = (size_t)b * SEQ + n * 128;
  const float l2g = ret_log2gamma(h);
  u16* Q = smem;
  u16* Kr = Q + 128 * 72;
  u16* VT = Kr + 128 * 72;
  u16* Qd = VT + 128 * 136;
  u16* RT = Qd + 128 * 72;
  u16* SP = RT + 128 * 72;
  float* OT = (float*)smem;
  stage_rot(prs + t0 * 2560 + h * 64, 2560, rc, rs, n * 128, Q, 1.0f, l2g, 0);
  stage_rot(prs + t0 * 2560 + h * 64, 2560, rc, rs, n * 128, Qd, 1.0f, l2g, 1);
  stage_rot(prs + t0 * 2560 + 256 + h * 64, 2560, rc, rs, n * 128, Kr, 0.125f, l2g, 0);
  stage_vT(prs + t0 * 2560 + 512 + h * 128, 2560, VT);
  {
    const int dv = tid >> 2, q = tid & 3;
    const float* src = KV + (size_t)u * 8192 + dv * 64 + q * 16;
    float4 a0 = *(const float4*)src, a1 = *(const float4*)(src + 4), a2 = *(const float4*)(src + 8), a3 = *(const float4*)(src + 12);
    float f0[8] = {a0.x, a0.y, a0.z, a0.w, a1.x, a1.y, a1.z, a1.w};
    float f1[8] = {a2.x, a2.y, a2.z, a2.w, a3.x, a3.y, a3.z, a3.w};
    *(uint4*)(RT + dv * 72 + q * 16) = pack8(f0);
    *(uint4*)(RT + dv * 72 + q * 16 + 8) = pack8(f1);
  }
  __syncthreads();
  f32x16 acc[2];
#pragma unroll
  for (int j = 0; j < 2; ++j)
#pragma unroll
    for (int e = 0; e < 16; ++e) acc[j][e] = 0.f;
#pragma unroll
  for (int ks = 0; ks < 4; ++ks) {
    bf16x8 a = *(const bf16x8*)(Q + (wm * 32 + (lane & 31)) * 72 + ks * 16 + (lane >> 5) * 8);
#pragma unroll
    for (int j = 0; j < 2; ++j) {
      bf16x8 bb = *(const bf16x8*)(Kr + (wn * 64 + j * 32 + (lane & 31)) * 72 + ks * 16 + (lane >> 5) * 8);
      acc[j] = __builtin_amdgcn_mfma_f32_32x32x16_bf16(a, bb, acc[j], 0, 0, 0);
    }
  }
#pragma unroll
  for (int j = 0; j < 2; ++j)
#pragma unroll
    for (int e = 0; e < 16; ++e) {
      const int i = ACC_ROW(1, 0, e), jj = ACC_COL(j);
      const float dcy = (i >= jj) ? exp2f((float)(i - jj) * l2g) : 0.f;
      SP[i * 136 + jj] = f2bf(acc[j][e] * dcy);
    }
  __syncthreads();
#pragma unroll
  for (int j = 0; j < 2; ++j)
#pragma unroll
    for (int e = 0; e < 16; ++e) acc[j][e] = 0.f;
#pragma unroll
  for (int ks = 0; ks < 8; ++ks) {
    bf16x8 a = *(const bf16x8*)(SP + (wm * 32 + (lane & 31)) * 136 + ks * 16 + (lane >> 5) * 8);
#pragma unroll
    for (int j = 0; j < 2; ++j) {
      bf16x8 bb = *(const bf16x8*)(VT + (wn * 64 + j * 32 + (lane & 31)) * 136 + ks * 16 + (lane >> 5) * 8);
      acc[j] = __builtin_amdgcn_mfma_f32_32x32x16_bf16(a, bb, acc[j], 0, 0, 0);
    }
  }
#pragma unroll
  for (int ks = 0; ks < 4; ++ks) {
    bf16x8 a = *(const bf16x8*)(Qd + (wm * 32 + (lane & 31)) * 72 + ks * 16 + (lane >> 5) * 8);
#pragma unroll
    for (int j = 0; j < 2; ++j) {
      bf16x8 bb = *(const bf16x8*)(RT + (wn * 64 + j * 32 + (lane & 31)) * 72 + ks * 16 + (lane >> 5) * 8);
      acc[j] = __builtin_amdgcn_mfma_f32_32x32x16_bf16(a, bb, acc[j], 0, 0, 0);
    }
  }
  __syncthreads();
#pragma unroll
  for (int j = 0; j < 2; ++j)
#pragma unroll
    for (int e = 0; e < 16; ++e) OT[ACC_ROW(1, 0, e) * 132 + ACC_COL(j)] = acc[j][e];
  __syncthreads();
  {
    const int row = tid >> 2, q = tid & 3;
    float o[32];
    float ssq = 0.f;
#pragma unroll
    for (int c = 0; c < 8; ++c) {
      float4 v = *(const float4*)(OT + row * 132 + q * 32 + c * 4);
      o[c * 4] = v.x; o[c * 4 + 1] = v.y; o[c * 4 + 2] = v.z; o[c * 4 + 3] = v.w;
      ssq += v.x * v.x + v.y * v.y + v.z * v.z + v.w * v.w;
    }
    ssq = red4(ssq);
    const float r = rsqrtf(ssq * (1.f / 128.f) + 1e-6f);
    const u16* gp = prs + (t0 + row) * 2560 + 1024 + h * 128 + q * 32;
    u16* op = yret + (t0 + row) * 512 + h * 128 + q * 32;
#pragma unroll
    for (int c = 0; c < 4; ++c) {
      float g[8], ov[8];
      unpack8(*(const uint4*)(gp + c * 8), g);
#pragma unroll
      for (int j = 0; j < 8; ++j) ov[j] = o[c * 8 + j] * r * siluf_(g[j]);
      if (!(n == 0 && row == 0)) *(uint4*)(op + c * 8) = pack8(ov);
    }
  }
  __syncthreads();
}

DEV void phase_merge(const Params& p, int l, const float* rstd, u16* smem, int bid, int nb) {
  const int tid = my_tid(), lane = tid & 63, wave = tid >> 6, wm = wave >> 1, wn = wave & 1;
  const u16* xb = (const u16*)(p.ws + OFF_XB);
  unsigned char* W = p.ws + OFF_W + (size_t)l * LW_BYTES;
  const u16* win = (const u16*)(W + W_IN);
  const u16* wbr = (const u16*)(W + W_BR);
  u16* M = (u16*)(p.ws + OFF_BIG + B_M);
  const int MTL = NTOK / 128, NTL = DM / 128;
  for (int t = vbid(bid, nb); t < MTL * NTL; t += nb) {
    int m, n;
    tile_map(t, MTL, NTL, m, n);
    f32x16 ms[1][2];
#pragma unroll
    for (int j = 0; j < 2; ++j)
#pragma unroll
      for (int e = 0; e < 16; ++e) ms[0][j][e] = 0.f;
    for (int g = 0; g < 3; ++g) {
      const u16* yg = (const u16*)(p.ws + OFF_BIG + (g == 0 ? B_YRW : (g == 1 ? B_YRET : B_YSG)));
      f32x16 ab[1][2], ag[1][2];
#pragma unroll
      for (int j = 0; j < 2; ++j)
#pragma unroll
        for (int e = 0; e < 16; ++e) { ab[0][j][e] = 0.f; ag[0][j][e] = 0.f; }
      gemm_tile<1>(ab, yg, 512, m * 128, -(1 << 30), NTOK - 1, wbr + ((size_t)g * DM + n * 128) * 512, 512, 512, smem);
      gemm_tile<1>(ag, xb, DM, m * 128, -(1 << 30), NTOK - 1, win + ((size_t)(4352 + g * DM + n * 128)) * DM, DM, DM, smem);
#pragma unroll
      for (int e = 0; e < 16; ++e) {
        const float rs = rstd_of(rstd, m * 128 + ACC_ROW(1, 0, e));
#pragma unroll
        for (int j = 0; j < 2; ++j) ms[0][j][e] += sigmoidf_(ag[0][j][e] * rs) * ab[0][j][e];
        if ((e & 3) == 3) __builtin_amdgcn_sched_barrier(0);
      }
    }
#pragma unroll
    for (int e = 0; e < 16; ++e) {
      const size_t row = m * 128 + ACC_ROW(1, 0, e);
#pragma unroll
      for (int j = 0; j < 2; ++j) M[row * DM + n * 128 + ACC_COL(j)] = f2bf(ms[0][j][e]);
    }
  }
}

DEV void phase_resgemm(const u16* A, int K, const u16* wt, const float* xin, float* xout, u16* xbo, float* ssq, u16* smem, int bid, int nb) {
  const int tid = my_tid(), lane = tid & 63, wave = tid >> 6, wm = wave >> 1, wn = wave & 1;
  const int MTL = NTOK / 256, NTL = DM / 256;
  for (int t = vbid(bid, nb); t < MTL * NTL; t += nb) {
    int m, n;
    tile_map(t, MTL, NTL, m, n);
    f32x16 acc[2][4];
    ZERO_BIG(acc);
    gemm_big(acc, A, K, m * 256, -(1 << 30), NTOK - 1, wt + (size_t)n * 256 * K, K, K, smem);
    float* F = (float*)smem;
#pragma unroll
    for (int i = 0; i < 2; ++i) {
#pragma unroll
      for (int e = 0; e < 16; ++e) {
        const int lr = wm * 32 + (e & 3) + 8 * (e >> 2) + 4 * (lane >> 5);
#pragma unroll
        for (int j = 0; j < 4; ++j) F[lr * 260 + BIG_COL(j)] = acc[i][j][e];
      }
      __syncthreads();
#pragma unroll 4
      for (int k = 0; k < 16; ++k) {
        const int c = tid + NTHR * k;
        const int lr = c >> 6, cc = c & 63;
        const size_t row = (size_t)m * 256 + (lr >> 5) * 64 + i * 32 + (lr & 31);
        const size_t o = row * DM + n * 256 + cc * 4;
        const float4 v = *(const float4*)(F + lr * 260 + cc * 4);
        const float4 x = *(const float4*)(xin + o);
        const float4 y = make_float4(x.x + v.x, x.y + v.y, x.z + v.z, x.w + v.w);
        *(float4*)(xout + o) = y;
        if (xbo) {
          *(uint2*)(xbo + o) = make_uint2(pack2(y.x, y.y), pack2(y.z, y.w));
          const float sq = wave_sum(y.x * y.x + y.y * y.y + y.z * y.z + y.w * y.w);
          if (lane == 0) atomicAdd(ssq + row, sq);
        }
      }
      __syncthreads();
    }
  }
}

DEV void phase_ffnup(const Params& p, int l, const float* rstd, u16* smem, int bid, int nb) {
  const int tid = my_tid(), lane = tid & 63, wave = tid >> 6, wm = wave >> 1, wn = wave & 1;
  const u16* xb = (const u16*)(p.ws + OFF_XB);
  const u16* wup = (const u16*)(p.ws + OFF_W + (size_t)l * LW_BYTES + W_UP);
  u16* act = (u16*)(p.ws + OFF_BIG + B_ACT);
  const float* cw = p.in[22] + (size_t)l * 3 * 2 * DFF;
  const float* cb = p.in[23] + (size_t)l * 2 * DFF;
  u16* U = smem;
  const int MPB = 33;
  const int MTL = 4 * MPB, NTL = DFF / 128;
  for (int t = vbid(bid, nb); t < MTL * NTL; t += nb) {
    int m, n;
    tile_map(t, MTL, NTL, m, n);
    const int b = m / MPB, mi = m % MPB;
    const int tokbase = b * SEQ + mi * 254 - 2;
    f32x16 acc[2][4];
    ZERO_BIG(acc);
    gemm_big(acc, xb, DM, tokbase, b * SEQ, NTOK - 1, wup + (size_t)n * 256 * DM, DM, DM, smem);
#pragma unroll
    for (int i = 0; i < 2; ++i)
#pragma unroll
      for (int e = 0; e < 16; ++e) {
        const int r = BIG_ROW(i, e);
        int tk = tokbase + r; tk = tk < 0 ? 0 : (tk > NTOK - 1 ? NTOK - 1 : tk);
        const float rs = rstd_of(rstd, tk);
#pragma unroll
        for (int j = 0; j < 4; ++j) U[r * 264 + BIG_COL(j)] = f2bf(acc[i][j][e] * rs);
      }
    __syncthreads();
    {
      const int c = (tid & 63) * 2, rg = tid >> 6;
      const int gcol = n * 128 + c, vcol = DFF + n * 128 + c;
      float wg0[2], wg1[2], wg2[2], bg[2], wv0[2], wv1[2], wv2[2], bv[2];
#pragma unroll
      for (int q = 0; q < 2; ++q) {
        wg0[q] = cw[gcol + q]; wg1[q] = cw[2 * DFF + gcol + q]; wg2[q] = cw[4 * DFF + gcol + q]; bg[q] = cb[gcol + q];
        wv0[q] = cw[vcol + q]; wv1[q] = cw[2 * DFF + vcol + q]; wv2[q] = cw[4 * DFF + vcol + q]; bv[q] = cb[vcol + q];
      }
      const int r0 = 2 + rg * 32;
      const int rend = (r0 + 32 > 256) ? 256 : r0 + 32;
      unsigned t;
      float g2[2], g1[2], v2[2], v1[2];
      t = *(const unsigned*)(U + (r0 - 2) * 264 + c); g2[0] = __uint_as_float(t << 16); g2[1] = __uint_as_float(t & 0xffff0000u);
      t = *(const unsigned*)(U + (r0 - 1) * 264 + c); g1[0] = __uint_as_float(t << 16); g1[1] = __uint_as_float(t & 0xffff0000u);
      t = *(const unsigned*)(U + (r0 - 2) * 264 + 128 + c); v2[0] = __uint_as_float(t << 16); v2[1] = __uint_as_float(t & 0xffff0000u);
      t = *(const unsigned*)(U + (r0 - 1) * 264 + 128 + c); v1[0] = __uint_as_float(t << 16); v1[1] = __uint_as_float(t & 0xffff0000u);
      const int tend = (b + 1) * SEQ;
      for (int r = r0; r < rend; ++r) {
        const unsigned ug = *(const unsigned*)(U + r * 264 + c), uv = *(const unsigned*)(U + r * 264 + 128 + c);
        const float g0[2] = {__uint_as_float(ug << 16), __uint_as_float(ug & 0xffff0000u)};
        const float v0[2] = {__uint_as_float(uv << 16), __uint_as_float(uv & 0xffff0000u)};
        float o[2];
#pragma unroll
        for (int q = 0; q < 2; ++q) {
          const float cg = bg[q] + wg0[q] * g2[q] + wg1[q] * g1[q] + wg2[q] * g0[q];
          const float cv = bv[q] + wv0[q] * v2[q] + wv1[q] * v1[q] + wv2[q] * v0[q];
          o[q] = siluf_(cg) * cv;
          g2[q] = g1[q]; g1[q] = g0[q]; v2[q] = v1[q]; v1[q] = v0[q];
        }
        const int tk = tokbase + r;
        if (tk < tend) *(unsigned*)(act + (size_t)tk * DFF + n * 128 + c) = pack2(o[0], o[1]);
      }
    }
    __syncthreads();
  }
}

#define PF_COLS 3328
DEV void first_tok_proj(const Params& p, int l, const float* xcur, float* smf, int bid, int nb) {
  float* PF = (float*)(p.ws + OFF_PF);
  const float* w = p.in[2] + (size_t)l * DM * INC;
  const float* g1 = p.in[1] + l * DM;
  const int tid = my_tid(), lane = tid & 63, wave = tid >> 6;
  for (int task = bid; task < 4 * 52; task += nb) {
    const int b = task / 52, c = (task % 52) * 64 + lane;
    const float* xr = xcur + (size_t)b * SEQ * DM;
    float acc = 0.f, ss = 0.f;
    const int k0 = wave * 128;
#pragma unroll 16
    for (int k = k0; k < k0 + 128; ++k) {
      const float xv = xr[k];
      ss += xv * xv;
      acc += xv * g1[k] * w[(size_t)k * INC + c];
    }
    smf[wave * 64 + lane] = acc;
    smf[512 + wave * 64 + lane] = ss;
    __syncthreads();
    if (wave == 0) {
      float ta = 0.f, ts = 0.f;
#pragma unroll
      for (int q = 0; q < 8; ++q) { ta += smf[q * 64 + lane]; ts += smf[512 + q * 64 + lane]; }
      PF[b * PF_COLS + c] = ta * rsqrtf(ts * (1.0f / DM) + 1e-6f);
    }
    __syncthreads();
  }
}
DEV void first_tok_fix(const Params& p, int l, float* smf, int bid, int nb) {
  const int tid = my_tid(), lane = tid & 63;
  const float* PF = (const float*)(p.ws + OFF_PF);
  u16* yrw = (u16*)(p.ws + OFF_BIG + B_YRW);
  u16* yret = (u16*)(p.ws + OFF_BIG + B_YRET);
  const float* mu = p.in[3] + l * 1792;
  for (int task = bid; task < 48; task += nb) {
    const int b = task / 12, hh = task % 12;
    const float* pf = PF + b * PF_COLS;
    const size_t t0 = (size_t)b * SEQ;
    __syncthreads();
    if (hh < 8) {
      const int h = hh;
      if (tid < 64) smf[tid] = pf[1600 + tid] * (1.f - mu[1600 + tid]);
      if (tid < 128) smf[64 + tid] = sigmoidf_(pf[1664 + tid] * (1.f - mu[1664 + tid]));
      __syncthreads();
      if (tid < 64) {
        const int ch = h * 64 + tid;
        const float r = pf[ch] * (1.f - mu[ch]);
        const float k = pf[512 + ch] * (1.f - mu[512 + ch]);
        const float v = pf[1024 + ch] * (1.f - mu[1024 + ch]);
        const float* aup = p.in[7] + (size_t)l * 64 * 512;
        const float* gup = p.in[8] + (size_t)l * 128 * 512;
        float al = p.in[6][l * 512 + ch], g = 0.f;
        for (int j = 0; j < 64; ++j) al += smf[j] * aup[j * 512 + ch];
        for (int j = 0; j < 128; ++j) g += smf[64 + j] * gup[j * 512 + ch];
        const float a = sigmoidf_(al);
        const float kp = k * (1.f + (a - 1.f) * p.in[10][l * 512 + ch]);
        const float s = wave_sum(kp * r);
        const float bon = wave_sum(r * kp * p.in[11][l * 512 + ch]);
        const float y = v * s;
        const float mean = wave_sum(y) * (1.f / 64.f);
        const float d = y - mean;
        const float var = wave_sum(d * d) * (1.f / 64.f);
        const float o = (d * rsqrtf(var + 64e-5f) * p.in[12][l * 512 + ch] + p.in[13][l * 512 + ch] + bon * v) * g;
        yrw[t0 * 512 + ch] = f2bf(o);
      }
    } else {
      const int h = hh - 8;
      float part = 0.f;
      if (tid < 64) part = pf[1792 + h * 64 + tid] * pf[1792 + 256 + h * 64 + tid];
      if (tid < 64) { part = wave_sum(part); if (lane == 0) smf[0] = part * 0.125f; }
      __syncthreads();
      const float s = smf[0];
      float y = 0.f;
      if (tid < 128) y = s * pf[1792 + 512 + h * 128 + tid];
      float q = wave_sum(y * y);
      if (tid < 128 && lane == 0) smf[1 + (tid >> 6)] = q;
      __syncthreads();
      if (tid < 128) {
        const float ms = (smf[1] + smf[2]) * (1.f / 128.f);
        const float g = pf[1792 + 1024 + h * 128 + tid];
        yret[t0 * 512 + h * 128 + tid] = f2bf(y * rsqrtf(ms + 1e-6f) * siluf_(g));
      }
    }
  }
}

namespace pg8 {
#define PG8_LAS __attribute__((address_space(3)))
typedef unsigned short bf16_t;
typedef short bf16x8 __attribute__((ext_vector_type(8)));
typedef float f32x4 __attribute__((ext_vector_type(4)));
typedef unsigned u32x4 __attribute__((ext_vector_type(4)));
constexpr int BM = 256, BK = 64, HALF = 128, HTB = HALF * BK * 2  , STAGE_BYTES = 8 * HTB, NXCD = 8, WGM = 8;

__host__ __device__ __forceinline__ int lds_byte(int r, int c) { const int st = (r >> 4) * 2 + (c >> 5), rr = r & 15, cc = c & 31, ob = rr * 64 + cc * 2; return st * 1024 + (ob ^ (((ob >> 9) & 1) << 5)); }
__host__ __device__ __forceinline__ void stage_rc(int b, int& R, int& C) { const int st = b / 1024, sb = b % 1024, swz = sb ^ (((sb >> 9) & 1) << 5); R = (st >> 1) * 16 + swz / 64; C = (st & 1) * 32 + (swz % 64) / 2; }
__host__ __device__ __forceinline__ int perm32(int rho) { const int n = rho >> 4, i = rho & 15; return 8 * (i >> 2) + 4 * n + (i & 3); }

struct Unit { int pm, pn; };
struct Gemm { const bf16_t* A; const bf16_t* Bt; int M, N, K; };

struct StaticOrder {
    int nM, nN, nwg, G, c;
    __host__ __device__ void init(int M, int N, int G_, int c_) { nM = M / BM; nN = N / BM; nwg = nM * nN; G = G_; c = c_; }
    __host__ __device__ bool next(int i, Unit& u) const {
        const long L = (long)i * G + c; if (L >= nwg) return false;
        int wgid = (int)L; { const int q = nwg / NXCD, r = nwg % NXCD, xcd = wgid % NXCD, off = wgid / NXCD; wgid = (xcd < r ? xcd * (q + 1) : r * (q + 1) + (xcd - r) * q) + off; }
        const int nig = WGM * nN, gid = wgid / nig, fm = gid * WGM, gsz = (nM - fm) < WGM ? (nM - fm) : WGM;
        u.pm = fm + ((wgid % nig) % gsz); u.pn = (wgid % nig) / gsz; return true;
    }
    __device__ __forceinline__ void a_ready(const Unit&) const {}
    __device__ __forceinline__ void done(const Unit&) const {}
};

__device__ __forceinline__ unsigned cvt_pk_bf16(float lo, float hi) { unsigned r; asm volatile("v_cvt_pk_bf16_f32 %0, %1, %2" : "=v"(r) : "v"(lo), "v"(hi)); return r; }

template <class Epi, class Sched, bool STAMP = false>
__device__ __forceinline__ void gemm_phase(PG8_LAS unsigned char* lds, const Gemm g, const Sched& S, const Epi& E, unsigned long long* stamps) {
    const int tid = my_tid(), wid = __builtin_amdgcn_readfirstlane(tid >> 6), lane = tid & 63, wr = wid >> 2, wc = wid & 3, fr = lane & 15, fq = lane >> 4;
    const int K = g.K, nt = K / BK;
    int ts_lo = 0, ts_hi = 0, nts = 0; const unsigned long long rt_entry = STAMP ? (unsigned long long)wall_clock64() : 0ull;
#define PG8_STAMP() do { if (STAMP && wid == 0 && nts < 64) { const unsigned long long _c = (unsigned long long)clock64(); \
        ts_lo = (lane == nts) ? (int)(unsigned)_c : ts_lo; ts_hi = (lane == nts) ? (int)(unsigned)(_c >> 32) : ts_hi; ++nts; } } while (0)
    PG8_STAMP();
    unsigned voffA[2], voffB[2];
#pragma unroll
    for (int i = 0; i < 2; ++i) { int R, C; stage_rc(tid * 16 + i * 8192, R, C); const int Rb = Epi::PERM ? ((R & ~31) + perm32(R & 31)) : R;
        voffA[i] = (unsigned)(R * K + C) * 2u; voffB[i] = (unsigned)(Rb * K + C) * 2u; }
    const size_t kstep = (size_t)(BK * 2);
    const size_t hstep = (size_t)HALF * K * 2;
    const size_t tstep = 2 * hstep;
    const unsigned ldsw = (unsigned)wid * 1024u;
    const int aoff = lds_byte(wr * 64 + fr, fq * 8), boff = lds_byte(wc * 32 + fr, fq * 8);
#define PG8_SA(b, h) (((b) * 2 + (h)) * HTB)
#define PG8_SB(b, h) ((4 + (b) * 2 + (h)) * HTB)
#define PG8_STAGE(bufoff, gbase, voff) do { _Pragma("unroll") for (int _i = 0; _i < 2; ++_i) \
        __builtin_amdgcn_global_load_lds((const unsigned*)((const char*)(gbase) + (voff)[_i]), (PG8_LAS unsigned*)(lds + (bufoff) + ldsw + _i * 8192), 16, 0, 0); } while (0)
#define PG8_LDA(dst, b, h) do { _Pragma("unroll") for (int m = 0; m < 4; ++m) _Pragma("unroll") for (int k = 0; k < 2; ++k) dst[m][k] = *(const PG8_LAS bf16x8*)(lds + PG8_SA(b, h) + aoff + m * 2048 + k * 1024); } while (0)
#define PG8_LDB(dst, b, h) do { _Pragma("unroll") for (int n = 0; n < 2; ++n) _Pragma("unroll") for (int k = 0; k < 2; ++k) dst[n][k] = *(const PG8_LAS bf16x8*)(lds + PG8_SB(b, h) + boff + n * 2048 + k * 1024); } while (0)
#define PG8_MMA(ai, bj, At, Bt) do { __builtin_amdgcn_s_setprio(1); _Pragma("unroll") for (int m = 0; m < 4; ++m) _Pragma("unroll") for (int n = 0; n < 2; ++n) _Pragma("unroll") for (int k = 0; k < 2; ++k) \
        acc[ai][bj][m][n] = __builtin_amdgcn_mfma_f32_16x16x32_bf16(Bt[n][k], At[m][k], acc[ai][bj][m][n], 0, 0, 0); __builtin_amdgcn_s_setprio(0); } while (0)
#define PG8_WAIT_V(n) asm volatile("s_waitcnt vmcnt(" #n ")" ::: "memory")
#define PG8_WAIT_L(n) asm volatile("s_waitcnt lgkmcnt(" #n ")" ::: "memory")
#define PG8_BAR __builtin_amdgcn_s_barrier()
#define PG8_SCHED __builtin_amdgcn_sched_barrier(0)
    Unit cur, nxt; int ui = 0;
    if (!S.next(0, cur)) return;
    f32x4 acc[2][2][4][2];
#pragma unroll
    for (int a = 0; a < 2; ++a)
#pragma unroll
        for (int b = 0; b < 2; ++b)
#pragma unroll
            for (int m = 0; m < 4; ++m)
#pragma unroll
                for (int n = 0; n < 2; ++n) acc[a][b][m][n] = (f32x4){0.f, 0.f, 0.f, 0.f};
    bf16x8 At[4][2], B0[2][2], B1[2][2];
    const char* cA = (const char*)g.A + (size_t)cur.pm * tstep; const char* cB = (const char*)g.Bt + (size_t)cur.pn * tstep;
    S.a_ready(cur);
    PG8_STAGE(PG8_SB(0, 0), cB, voffB); PG8_STAGE(PG8_SA(0, 0), cA, voffA); PG8_STAGE(PG8_SB(0, 1), cB + hstep, voffB); PG8_STAGE(PG8_SA(0, 1), cA + hstep, voffA);
    if (wr == 1) PG8_BAR;
    PG8_WAIT_V(4); PG8_BAR;
    PG8_STAGE(PG8_SB(1, 0), cB + kstep, voffB); PG8_STAGE(PG8_SA(1, 0), cA + kstep, voffA); PG8_STAGE(PG8_SB(1, 1), cB + hstep + kstep, voffB);
    PG8_WAIT_V(6); PG8_BAR;
    PG8_STAMP();
    for (;;) {
        const bool has_next = S.next(ui + 1, nxt);
        const char* nA = has_next ? (const char*)g.A + (size_t)nxt.pm * tstep : cA; const char* nB = has_next ? (const char*)g.Bt + (size_t)nxt.pn * tstep : cB;
        for (int t = 0; t < nt; t += 2) {
            const bool last = (t == nt - 2);
            const char* a1 = cA + (size_t)(t + 1) * kstep;
            const char* a2 = last ? nA : cA + (size_t)(t + 2) * kstep; const char* b2 = last ? nB : cB + (size_t)(t + 2) * kstep;
            const char* a3 = a2 + kstep; const char* b3 = b2 + kstep;
            if (last && has_next) S.a_ready(nxt);
            PG8_LDB(B0, 0, 0); PG8_SCHED; PG8_LDA(At, 0, 0); PG8_STAGE(PG8_SA(1, 1), a1 + hstep, voffA);
            PG8_WAIT_L(8); PG8_BAR; PG8_WAIT_L(0); PG8_MMA(0, 0, At, B0); PG8_BAR; PG8_SCHED;
            PG8_LDB(B1, 0, 1); PG8_STAGE(PG8_SB(0, 0), b2, voffB);
            PG8_BAR; PG8_WAIT_L(0); PG8_MMA(0, 1, At, B1); PG8_BAR;
            PG8_LDA(At, 0, 1); PG8_STAGE(PG8_SA(0, 0), a2, voffA);
            PG8_BAR; PG8_WAIT_L(0); PG8_MMA(1, 0, At, B0); PG8_BAR; PG8_SCHED;
            PG8_STAGE(PG8_SB(0, 1), b2 + hstep, voffB);
            PG8_WAIT_V(6); PG8_BAR; PG8_MMA(1, 1, At, B1); PG8_BAR;
            PG8_LDB(B0, 1, 0); PG8_SCHED; PG8_LDA(At, 1, 0); PG8_STAGE(PG8_SA(0, 1), a2 + hstep, voffA);
            PG8_WAIT_L(8); PG8_BAR; PG8_WAIT_L(0); PG8_MMA(0, 0, At, B0); PG8_BAR; PG8_SCHED;
            PG8_LDB(B1, 1, 1); PG8_STAGE(PG8_SB(1, 0), b3, voffB);
            PG8_BAR; PG8_WAIT_L(0); PG8_MMA(0, 1, At, B1); PG8_BAR;
            PG8_LDA(At, 1, 1); PG8_STAGE(PG8_SA(1, 0), a3, voffA);
            PG8_BAR; PG8_WAIT_L(0); PG8_MMA(1, 0, At, B0); PG8_BAR; PG8_SCHED;
            PG8_STAGE(PG8_SB(1, 1), b3 + hstep, voffB);
            PG8_WAIT_V(6); PG8_BAR; PG8_MMA(1, 1, At, B1); PG8_BAR;
        }
        PG8_STAMP();
        if constexpr (!Epi::AFTER_DRAIN) { E(acc, cur, wr, wc, fr, fq); S.done(cur); }
        PG8_STAMP();
        if (!has_next) break;
#pragma unroll
        for (int a = 0; a < 2; ++a)
#pragma unroll
            for (int b = 0; b < 2; ++b)
#pragma unroll
                for (int m = 0; m < 4; ++m)
#pragma unroll
                    for (int n = 0; n < 2; ++n) acc[a][b][m][n] = (f32x4){0.f, 0.f, 0.f, 0.f};
        cur = nxt; cA = nA; cB = nB; ++ui;
    }
    PG8_WAIT_V(0);
    if (wr == 0) PG8_BAR;
    PG8_BAR;
    if constexpr (Epi::AFTER_DRAIN) { E.fused(acc, cur, wr, wc, fr, fq, lds, wid, lane); S.done(cur); }
    PG8_STAMP();
    if (STAMP && wid == 0) { stamps[lane] = lane < nts ? (((unsigned long long)(unsigned)ts_hi << 32) | (unsigned)ts_lo) : 0ull;
        if (lane == 62) stamps[62] = rt_entry; if (lane == 63) stamps[63] = (unsigned long long)wall_clock64(); }
#undef PG8_STAMP
#undef PG8_SA
#undef PG8_SB
#undef PG8_STAGE
#undef PG8_LDA
#undef PG8_LDB
#undef PG8_MMA
#undef PG8_WAIT_V
#undef PG8_WAIT_L
#undef PG8_BAR
#undef PG8_SCHED
}
}

struct EpiInproj {
  static constexpr bool PERM = true, AFTER_DRAIN = false;
  u16* O; int ldc; const float* ssq;
  __device__ __forceinline__ void operator()(const pg8::f32x4 (&acc)[2][2][4][2], const pg8::Unit& u, int wr, int wc, int fr, int fq) const {
    const int row0 = u.pm * 256 + wr * 64 + fr, col0 = u.pn * 256 + wc * 32 + 8 * fq;
#pragma unroll
    for (int ai = 0; ai < 2; ++ai)
#pragma unroll
      for (int m = 0; m < 4; ++m) {
        const int row = row0 + ai * 128 + m * 16;
        const float rs = ssq ? rsqrtf(ssq[row] * (1.0f / DM) + 1e-6f) : 1.0f;
        u16* rowp = O + (size_t)row * ldc + col0;
#pragma unroll
        for (int bj = 0; bj < 2; ++bj) {
          const pg8::f32x4 v0 = acc[ai][bj][m][0] * rs, v1 = acc[ai][bj][m][1] * rs;
          u32x4 w;
          w.x = pack2(v0[0], v0[1]); w.y = pack2(v0[2], v0[3]); w.z = pack2(v1[0], v1[1]); w.w = pack2(v1[2], v1[3]);
          *(u32x4*)(rowp + bj * 128) = w;
        }
      }
  }
};
struct EpiRes {
  static constexpr bool PERM = false, AFTER_DRAIN = false;
  const float* xin; float* xout; u16* xbo; float* ssq;
  __device__ __forceinline__ void operator()(const pg8::f32x4 (&acc)[2][2][4][2], const pg8::Unit& u, int wr, int wc, int fr, int fq) const {
    const int row0 = u.pm * 256 + wr * 64 + fr, col0 = u.pn * 256 + wc * 32 + 4 * fq;
#pragma unroll
    for (int ai = 0; ai < 2; ++ai)
#pragma unroll
      for (int m = 0; m < 4; ++m) {
        const int row = row0 + ai * 128 + m * 16;
        float sq = 0.f;
#pragma unroll
        for (int bj = 0; bj < 2; ++bj)
#pragma unroll
          for (int n = 0; n < 2; ++n) {
            const size_t o = (size_t)row * DM + col0 + bj * 128 + n * 16;
            const pg8::f32x4 y = *(const pg8::f32x4*)(xin + o) + acc[ai][bj][m][n];
            *(pg8::f32x4*)(xout + o) = y;
            if (xbo) {
              *(uint2*)(xbo + o) = make_uint2(pack2(y[0], y[1]), pack2(y[2], y[3]));
              sq += y[0] * y[0] + y[1] * y[1] + y[2] * y[2] + y[3] * y[3];
            }
          }
        if (xbo) {
          sq += __shfl_xor(sq, 16);
          sq += __shfl_xor(sq, 32);
          if (fq == 0) atomicAdd(ssq + row, sq);
        }
        __builtin_amdgcn_sched_barrier(0);
      }
  }
};
struct EpiGate {
  static constexpr bool PERM = true, AFTER_DRAIN = false;
  u16* Mo; const u16* P; const float* ssq; int first;
  __device__ __forceinline__ void operator()(const pg8::f32x4 (&acc)[2][2][4][2], const pg8::Unit& u, int wr, int wc, int fr, int fq) const {
    const int row0 = u.pm * 256 + wr * 64 + fr, col0 = u.pn * 256 + wc * 32 + 8 * fq;
#pragma unroll
    for (int ai = 0; ai < 2; ++ai)
#pragma unroll
      for (int m = 0; m < 4; ++m) {
        const int row = row0 + ai * 128 + m * 16;
        const float rs = rsqrtf(ssq[row] * (1.0f / DM) + 1e-6f);
#pragma unroll
        for (int bj = 0; bj < 2; ++bj) {
          const size_t o = (size_t)row * DM + col0 + bj * 128;
          float pv[8], mv[8];
          unpack8(*(const uint4*)(P + o), pv);
          if (!first) unpack8(*(const uint4*)(Mo + o), mv);
          else {
#pragma unroll
            for (int j = 0; j < 8; ++j) mv[j] = 0.f;
          }
#pragma unroll
          for (int j = 0; j < 4; ++j) {
            mv[j] += sigmoidf_(acc[ai][bj][m][0][j] * rs) * pv[j];
            mv[4 + j] += sigmoidf_(acc[ai][bj][m][1][j] * rs) * pv[4 + j];
          }
          *(uint4*)(Mo + o) = pack8(mv);
        }
        __builtin_amdgcn_sched_barrier(0);
      }
  }
};
template <class Epi>
DEV void pg8_gemm(unsigned char* smraw, const u16* A, const u16* Bt, int M, int N, int K, const Epi& E, int bid, int nb) {
  pg8::Gemm g{A, Bt, M, N, K};
  pg8::StaticOrder S;
  S.init(M, N, nb, bid);
  pg8::gemm_phase<Epi, pg8::StaticOrder, false>((PG8_LAS unsigned char*)smraw, g, S, E, nullptr);
}

#define PPL 17
#define NPHASE (2 + 2 * PPL)
template <int ph>
DEV void run_phase(const Params& p, unsigned char* smraw, int bid, int nb) {
  u16* smem = (u16*)smraw;
  float* smf = (float*)smraw;
  float* xo = p.out;
  u16* xb = (u16*)(p.ws + OFF_XB);
  float* ssq_all = (float*)(p.ws + OFF_RSTD);
  if (ph == 0) { phase_prep(p, smf, bid, nb); return; }
  if (ph == NPHASE - 1) { phase_final(xo, p.in[25], bid, nb); return; }
  const int l = (ph - 1) / PPL, s = (ph - 1) % PPL;
  const float* xcur = (l == 0) ? p.in[0] : xo;
  unsigned char* W = p.ws + OFF_W + (size_t)l * LW_BYTES;
  float* ssq1 = ssq_all + (size_t)(2 * l) * NTOK;
  float* ssq2 = ssq_all + (size_t)(2 * l + 1) * NTOK;
  switch (s) {
    case 0: if (l == 0) phase_norm(xcur, xb, ssq1, bid, nb); break;
    case 1: { EpiInproj E{(u16*)(p.ws + OFF_BIG + B_PRW), 1792, ssq1}; pg8_gemm(smraw, xb, (const u16*)(W + W_IN), NTOK, 1792, DM, E, bid, nb); } break;
    case 2: phase_rwprep(p, l, smem, bid, nb); break;
    case 3: phase_scan<1>(p, l, smf, bid, nb); break;
    case 4: phase_scanprop(p, smf, bid, nb); first_tok_proj(p, l, xcur, smf, nb - 1 - bid, nb); break;
    case 5: phase_scan<3>(p, l, smf, bid, nb); break;
    case 6: { EpiInproj E{(u16*)(p.ws + OFF_BIG + B_PRS), 2560, ssq1}; pg8_gemm(smraw, xb, (const u16*)(W + W_IN) + (size_t)1792 * DM, NTOK, 2560, DM, E, bid, nb); } break;
    case 7:
      for (int u = bid; u < 1024; u += nb) ret_kv_unit(p, u, smem);
      for (int u = bid; u < 256; u += nb) sgu_unit(p, l, u, smem);
      break;
    case 8: phase_retprefix(p, bid, nb); break;
    case 9:
      for (int u = bid; u < 1024; u += nb) ret_out_unit(p, u, smem);
      first_tok_fix(p, l, smf, nb - 1 - bid, nb);
      break;
    case 10: {
      const u16* wbr = (const u16*)(W + W_BR);
      for (int g = 0; g < 3; ++g) {
        const u16* yg = (const u16*)(p.ws + OFF_BIG + (g == 0 ? B_YRW : (g == 1 ? B_YRET : B_YSG)));
        EpiInproj E{(u16*)(p.ws + OFF_BIG + B_P) + (size_t)g * NTOK * DM, DM, nullptr};
        pg8_gemm(smraw, yg, wbr + (size_t)g * DM * 512, NTOK, DM, 512, E, bid, nb);
      }
    } break;
    case 11: case 12: case 13: {
      const int g = s - 11;
      EpiGate E{(u16*)(p.ws + OFF_BIG + B_M), (const u16*)(p.ws + OFF_BIG + B_P) + (size_t)g * NTOK * DM, ssq1, g == 0 ? 1 : 0};
      pg8_gemm(smraw, xb, (const u16*)(W + W_IN) + (size_t)(4352 + g * DM) * DM, NTOK, DM, DM, E, bid, nb);
    } break;
    case 14: { EpiRes E{xcur, xo, xb, ssq2}; pg8_gemm(smraw, (const u16*)(p.ws + OFF_BIG + B_M), (const u16*)(W + W_OUT), NTOK, DM, DM, E, bid, nb); } break;
    case 15: phase_ffnup(p, l, ssq2, smem, bid, nb); break;
    case 16: {
      EpiRes E{xo, xo, (l == 0) ? xb : nullptr, (l == 0) ? ssq_all + (size_t)2 * NTOK : nullptr};
      pg8_gemm(smraw, (const u16*)(p.ws + OFF_BIG + B_ACT), (const u16*)(W + W_DN), NTOK, DM, DFF, E, bid, nb);
    } break;
  }
}
DEV constexpr bool phase_empty(int ph) {
  return ph >= 1 && ph < NPHASE - 1 && ((ph - 1) % PPL == 0 && (ph - 1) / PPL == 1);
}

DEV void gsync(unsigned* ctr, unsigned& target) {
  asm volatile("s_waitcnt vmcnt(0)" ::: "memory");
  __syncthreads();
  if (my_tid() == 0) {
    target += gridDim.x;
    __builtin_amdgcn_fence(__ATOMIC_RELEASE, "agent");
    asm volatile("s_waitcnt vmcnt(0)" ::: "memory");
    __hip_atomic_fetch_add(ctr, 1u, __ATOMIC_RELAXED, __HIP_MEMORY_SCOPE_AGENT);
    while (__hip_atomic_load(ctr, __ATOMIC_RELAXED, __HIP_MEMORY_SCOPE_AGENT) < target) __builtin_amdgcn_s_sleep(2);
    __builtin_amdgcn_fence(__ATOMIC_ACQUIRE, "agent");
    asm volatile("s_waitcnt vmcnt(0)" ::: "memory");
  }
  __syncthreads();
}

#if COOP
template <int PH>
DEV void run_seq(const Params& p, unsigned char* smraw, cg::grid_group& grid, unsigned& target) {
  if constexpr (phase_empty(PH)) {
    run_seq<PH + 1>(p, smraw, grid, target);
  } else {
    int bid_ = blockIdx.x;
    asm volatile("" : "+s"(bid_));
    run_phase<PH>(p, smraw, bid_, gridDim.x);
    if constexpr (PH + 1 < NPHASE) {
      if constexpr (PH == 0) grid.sync();
      else gsync((unsigned*)p.ws, target);
      run_seq<PH + 1>(p, smraw, grid, target);
    }
  }
}
__global__ void __launch_bounds__(NTHR) mega(Params p) {
  __shared__ __align__(16) unsigned char smraw[147456];
  cg::grid_group grid = cg::this_grid();
  unsigned target = 0;
  run_seq<0>(p, smraw, grid, target);
}
#else
template <int PH>
__global__ void __launch_bounds__(NTHR) phk(Params p) {
  __shared__ __align__(16) unsigned char smraw[147456];
  run_phase<PH>(p, smraw, blockIdx.x, gridDim.x);
}
template <int PH>
static void launch_seq(const Params& p, hipStream_t stream) {
  phk<PH><<<256, NTHR, 0, stream>>>(p);
  if constexpr (PH + 1 < NPHASE) launch_seq<PH + 1>(p, stream);
}
#endif

extern "C" void kernel_launch(void* const* d_in, const int* in_sizes, int n_in, void* d_out, int out_size, void* d_ws,
                              size_t ws_size, hipStream_t stream) {
  Params p{};
  for (int i = 0; i < 26; ++i) p.in[i] = (const float*)d_in[i];
  p.out = (float*)d_out;
  p.ws = (unsigned char*)d_ws;
  if (ws_size < WS_NEED) { fprintf(stderr, "workspace too small: %zu < %llu\n", ws_size, (unsigned long long)WS_NEED); return; }
#if COOP
  static int grid_blocks = 0;
  if (!grid_blocks) {
    int dev = 0, cus = 0, per_cu = 0;
    hipGetDevice(&dev);
    hipDeviceGetAttribute(&cus, hipDeviceAttributeMultiprocessorCount, dev);
    hipOccupancyMaxActiveBlocksPerMultiprocessor(&per_cu, mega, NTHR, 0);
    if (per_cu > 1) per_cu = 1;
    grid_blocks = cus * per_cu;
  }
  hipMemsetAsync(d_ws, 0, 256, stream);
  void* args[] = {&p};
  hipError_t e = hipLaunchCooperativeKernel((void*)mega, dim3(grid_blocks), dim3(NTHR), args, 0, stream);
  if (e != hipSuccess) fprintf(stderr, "cooperative launch failed: %s (grid %d)\n", hipGetErrorString(e), grid_blocks);
#else
  launch_seq<0>(p, stream);
#endif
}
```

```cpp
#include <hip/hip_runtime.h>
#include <hip/hip_cooperative_groups.h>
#include <cstdio>
#include <cstdint>
namespace cg = cooperative_groups;

#ifndef COOP
#define COOP 1
#endif

#define DEV __device__ __forceinline__
typedef unsigned short u16;
typedef short bf16x8 __attribute__((ext_vector_type(8)));
typedef float f32x16 __attribute__((ext_vector_type(16)));

#define NTHR 512
#define NTOK 32768
#define SEQ 8192
#define DM 1024
#define INC 7424
#define DFF 2816
#define MiB (1048576ull)

#define OFF_ROPE (64ull * 1024)
#define OFF_RSTD (OFF_ROPE + 2 * MiB)
#define OFF_PF (OFF_RSTD + 640ull * 1024)
#define OFF_W (3 * MiB)
#define LW_BYTES (37 * MiB)
#define W_IN 0ull
#define W_BR 15204352ull
#define W_OUT 18350080ull
#define W_UP 20447232ull
#define W_DN 31981568ull
#define W_RWUP 37748736ull
#define W_RAUP 37814272ull
#define W_RGUP 37879808ull
#define W_SGW 38010880ull
#define OFF_XB (77 * MiB)
#define OFF_BIG (141 * MiB)
#define B_PRW 0ull
#define B_YRW 0ull
#define B_YRET (32 * MiB)
#define B_YSG (64 * MiB)
#define B_OPS (112 * MiB)
#define B_PRS (112 * MiB)
#define B_KV (272 * MiB)
#define B_M 0ull
#define B_P (128 * MiB)
#define B_PL (304 * MiB)
#define B_SINIT (320 * MiB)
#define B_ACT 0ull
#define WS_NEED (OFF_BIG + 328 * MiB)

struct Params {
  const float* in[26];
  float* out;
  unsigned char* ws;
};

DEV int my_tid() {
  int t = __builtin_amdgcn_workitem_id_x();
  asm volatile("" : "+v"(t));
  return t;
}
DEV u16 f2bf(float f) {
  unsigned u = __float_as_uint(f);
  u += 0x7fffu + ((u >> 16) & 1u);
  return (u16)(u >> 16);
}
DEV float bf2f(u16 h) { return __uint_as_float(((unsigned)h) << 16); }
DEV unsigned pack2(float a, float b) { return (unsigned)f2bf(a) | ((unsigned)f2bf(b) << 16); }
DEV void unpack8(uint4 v, float* f) {
  f[0] = __uint_as_float(v.x << 16); f[1] = __uint_as_float(v.x & 0xffff0000u);
  f[2] = __uint_as_float(v.y << 16); f[3] = __uint_as_float(v.y & 0xffff0000u);
  f[4] = __uint_as_float(v.z << 16); f[5] = __uint_as_float(v.z & 0xffff0000u);
  f[6] = __uint_as_float(v.w << 16); f[7] = __uint_as_float(v.w & 0xffff0000u);
}
DEV uint4 pack8(const float* f) {
  return make_uint4(pack2(f[0], f[1]), pack2(f[2], f[3]), pack2(f[4], f[5]), pack2(f[6], f[7]));
}
template <int CTRL>
DEV float dppmov(float x) {
  return __builtin_bit_cast(float, __builtin_amdgcn_update_dpp(0, __builtin_bit_cast(int, x), CTRL, 0xF, 0xF, true));
}
DEV float red4(float x) { x += dppmov<0xB1>(x); x += dppmov<0x4E>(x); return x; }
DEV float red8(float x) { x = red4(x); x += dppmov<0x141>(x); return x; }
DEV float wave_sum(float x) {
  x = red8(x);
  x += dppmov<0x140>(x);
  const int xi = __builtin_bit_cast(int, x);
  return __builtin_bit_cast(float, __builtin_amdgcn_readlane(xi, 0)) + __builtin_bit_cast(float, __builtin_amdgcn_readlane(xi, 16)) +
         __builtin_bit_cast(float, __builtin_amdgcn_readlane(xi, 32)) + __builtin_bit_cast(float, __builtin_amdgcn_readlane(xi, 48));
}
DEV float sigmoidf_(float x) { return 1.f / (1.f + __expf(-x)); }
DEV float siluf_(float x) { return x / (1.f + __expf(-x)); }
DEV float geluf_(float x) { return 0.5f * x * (1.f + erff(x * 0.70710678118654752f)); }

DEV float rstd_of(const float* ssq, int row) { return rsqrtf(ssq[row] * (1.0f / DM) + 1e-6f); }
DEV int vbid(int bid, int nb) { return ((nb & 7) == 0) ? (bid & 7) * (nb >> 3) + (bid >> 3) : bid; }
DEV void tile_map(int t, int MTL, int NTL, int& m, int& n) {
  int per = 8 * NTL;
  int g = t / per;
  int r = t - g * per;
  int gm = MTL - g * 8; gm = gm > 8 ? 8 : gm;
  m = g * 8 + r % gm;
  n = r / gm;
}

typedef unsigned u32x4 __attribute__((ext_vector_type(4)));
template <int NA>
struct GStage { u32x4 a0, a1, a2, a3, b0, b1; };
DEV u32x4 g_ld_a(const u16* A, long lda, int g, int azero_below, int arow_max, int ko) {
  const bool z = g < azero_below;
  g = g < 0 ? 0 : g;
  g = g > arow_max ? arow_max : g;
  u32x4 v = *(const u32x4*)(A + (long)g * lda + ko);
  const u32x4 zero = {0u, 0u, 0u, 0u};
  return z ? zero : v;
}
template <int NA>
DEV void g_load(GStage<NA>& S, const u16* A, long lda, int arow, int azero_below, int arow_max,
                const u16* bp0, const u16* bp1, int ko) {
  S.a0 = g_ld_a(A, lda, arow, azero_below, arow_max, ko);
  S.a1 = g_ld_a(A, lda, arow + 64, azero_below, arow_max, ko);
  if constexpr (NA == 4) {
    S.a2 = g_ld_a(A, lda, arow + 128, azero_below, arow_max, ko);
    S.a3 = g_ld_a(A, lda, arow + 192, azero_below, arow_max, ko);
  }
  S.b0 = *(const u32x4*)(bp0 + ko);
  S.b1 = *(const u32x4*)(bp1 + ko);
}
template <int NA>
DEV void g_store(const GStage<NA>& S, u16* An, u16* Bn, int st_off) {
  *(u32x4*)(An + st_off) = S.a0;
  *(u32x4*)(An + st_off + 64 * 72) = S.a1;
  if constexpr (NA == 4) {
    *(u32x4*)(An + st_off + 128 * 72) = S.a2;
    *(u32x4*)(An + st_off + 192 * 72) = S.a3;
  }
  *(u32x4*)(Bn + st_off) = S.b0;
  *(u32x4*)(Bn + st_off + 64 * 72) = S.b1;
}
template <int MT>
DEV void g_compute(f32x16 (&acc)[MT][2], const u16* Ab, const u16* Bb) {
#pragma unroll
  for (int ks = 0; ks < 4; ++ks) {
    bf16x8 a[MT], b[2];
#pragma unroll
    for (int i = 0; i < MT; ++i) a[i] = *(const bf16x8*)(Ab + i * 32 * 72 + ks * 16);
#pragma unroll
    for (int j = 0; j < 2; ++j) b[j] = *(const bf16x8*)(Bb + j * 32 * 72 + ks * 16);
#pragma unroll
    for (int i = 0; i < MT; ++i)
#pragma unroll
      for (int j = 0; j < 2; ++j) acc[i][j] = __builtin_amdgcn_mfma_f32_32x32x16_bf16(a[i], b[j], acc[i][j], 0, 0, 0);
  }
}
template <int MT>
DEV void gemm_tile(f32x16 (&acc)[MT][2], const u16* A, long lda, int arow0, int azero_below, int arow_max,
                   const u16* B, long ldb, int K, u16* smem) {
  constexpr int TM = 128 * MT;
  constexpr int ASZ = TM * 72, BSZ = 128 * 72;
  constexpr int NA = TM / 64;
  const int tid = my_tid(), lane = tid & 63, wave = tid >> 6, wm = wave >> 1, wn = wave & 1;
  const int crow = tid >> 3, ckc = tid & 7;
  GStage<NA> s0, s1;
  const u16* Ak = A + ckc * 8;
  const int arow = arow0 + crow;
  const u16* bp0 = B + (long)crow * ldb + ckc * 8;
  const u16* bp1 = B + (long)(crow + 64) * ldb + ckc * 8;
  const int nk = K >> 6;
  const int arow_l = (wm * 32 * MT + (lane & 31)) * 72 + (lane >> 5) * 8;
  const int brow_l = (wn * 64 + (lane & 31)) * 72 + (lane >> 5) * 8;
  const int st_off = crow * 72 + ckc * 8;
  g_load<NA>(s0, Ak, lda, arow, azero_below, arow_max, bp0, bp1, 0);
  g_store<NA>(s0, smem, smem + ASZ, st_off);
  g_load<NA>(s1, Ak, lda, arow, azero_below, arow_max, bp0, bp1, 64);
  __syncthreads();
  for (int kt = 0; kt < nk; kt += 2) {
    if (kt + 2 < nk) g_load<NA>(s0, Ak, lda, arow, azero_below, arow_max, bp0, bp1, (kt + 2) * 64);
    g_compute<MT>(acc, smem + arow_l, smem + ASZ + brow_l);
    g_store<NA>(s1, smem + (ASZ + BSZ), smem + (ASZ + BSZ) + ASZ, st_off);
    __syncthreads();
    if (kt + 3 < nk) g_load<NA>(s1, Ak, lda, arow, azero_below, arow_max, bp0, bp1, (kt + 3) * 64);
    g_compute<MT>(acc, smem + (ASZ + BSZ) + arow_l, smem + (ASZ + BSZ) + ASZ + brow_l);
    if (kt + 2 < nk) g_store<NA>(s0, smem, smem + ASZ, st_off);
    __syncthreads();
  }
}
struct GStageB { u32x4 a0, a1, a2, a3, b0, b1, b2, b3; };
DEV const u16* g_rowptr(const u16* A, long lda, int g, int arow_max) {
  g = g < 0 ? 0 : g;
  g = g > arow_max ? arow_max : g;
  return A + (long)g * lda;
}
DEV void gb_load(GStageB& S, const u16* A, long lda, int arow, int arow_max, const u16* Bk, long ldb, int ko) {
  S.a0 = *(const u32x4*)(g_rowptr(A, lda, arow, arow_max) + ko);
  S.a1 = *(const u32x4*)(g_rowptr(A, lda, arow + 64, arow_max) + ko);
  S.a2 = *(const u32x4*)(g_rowptr(A, lda, arow + 128, arow_max) + ko);
  S.a3 = *(const u32x4*)(g_rowptr(A, lda, arow + 192, arow_max) + ko);
  S.b0 = *(const u32x4*)(Bk + ko);
  S.b1 = *(const u32x4*)(Bk + 64 * ldb + ko);
  S.b2 = *(const u32x4*)(Bk + 128 * ldb + ko);
  S.b3 = *(const u32x4*)(Bk + 192 * ldb + ko);
}
DEV void gb_store(const GStageB& S, u16* An, u16* Bn, int st_off, int arow, int azero_below) {
  const u32x4 zero = {0u, 0u, 0u, 0u};
  *(u32x4*)(An + st_off) = (arow < azero_below) ? zero : S.a0;
  *(u32x4*)(An + st_off + 64 * 72) = (arow + 64 < azero_below) ? zero : S.a1;
  *(u32x4*)(An + st_off + 128 * 72) = (arow + 128 < azero_below) ? zero : S.a2;
  *(u32x4*)(An + st_off + 192 * 72) = (arow + 192 < azero_below) ? zero : S.a3;
  *(u32x4*)(Bn + st_off) = S.b0;
  *(u32x4*)(Bn + st_off + 64 * 72) = S.b1;
  *(u32x4*)(Bn + st_off + 128 * 72) = S.b2;
  *(u32x4*)(Bn + st_off + 192 * 72) = S.b3;
}
DEV void gb_compute(f32x16 (&acc)[2][4], const u16* Ab, const u16* Bb) {
#pragma unroll
  for (int ks = 0; ks < 4; ++ks) {
    bf16x8 a[2], b[4];
#pragma unroll
    for (int i = 0; i < 2; ++i) a[i] = *(const bf16x8*)(Ab + i * 32 * 72 + ks * 16);
#pragma unroll
    for (int j = 0; j < 4; ++j) b[j] = *(const bf16x8*)(Bb + j * 32 * 72 + ks * 16);
#pragma unroll
    for (int i = 0; i < 2; ++i)
#pragma unroll
      for (int j = 0; j < 4; ++j) acc[i][j] = __builtin_amdgcn_mfma_f32_32x32x16_bf16(a[i], b[j], acc[i][j], 0, 0, 0);
  }
}
DEV void gemm_big(f32x16 (&acc)[2][4], const u16* A, long lda, int arow0, int azero_below, int arow_max,
                  const u16* B, long ldb, int K, u16* smem) {
  constexpr int ASZ = 256 * 72, BSZ = 256 * 72;
  const int tid = my_tid(), lane = tid & 63, wave = tid >> 6, wm = wave >> 1, wn = wave & 1;
  const int crow = tid >> 3, ckc = tid & 7;
  const u16* Ak = A + ckc * 8;
  const int arow = arow0 + crow;
  const u16* Bk = B + (long)crow * ldb + ckc * 8;
  const int nk = K >> 6;
  const int arow_l = (wm * 64 + (lane & 31)) * 72 + (lane >> 5) * 8;
  const int brow_l = (wn * 128 + (lane & 31)) * 72 + (lane >> 5) * 8;
  const int st_off = crow * 72 + ckc * 8;
  GStageB s;
  gb_load(s, Ak, lda, arow, arow_max, Bk, ldb, 0);
  gb_store(s, smem, smem + ASZ, st_off, arow, azero_below);
  __syncthreads();
  for (int kt = 0; kt < nk; ++kt) {
    const bool more = kt + 1 < nk;
    if (more) gb_load(s, Ak, lda, arow, arow_max, Bk, ldb, (kt + 1) * 64);
    __builtin_amdgcn_sched_barrier(0);
    const u16* cb = smem + (kt & 1) * (ASZ + BSZ);
    gb_compute(acc, cb + arow_l, cb + ASZ + brow_l);
    __builtin_amdgcn_sched_barrier(0);
    if (more) {
      u16* nb_ = smem + ((kt + 1) & 1) * (ASZ + BSZ);
      gb_store(s, nb_, nb_ + ASZ, st_off, arow, azero_below);
    }
    __syncthreads();
  }
}
#define BIG_ROW(i, e) (wm * 64 + (i) * 32 + ((e) & 3) + 8 * ((e) >> 2) + 4 * (lane >> 5))
#define BIG_COL(j) (wn * 128 + (j) * 32 + (lane & 31))
#define ZERO_BIG(acc)                                   \
  _Pragma("unroll") for (int i_ = 0; i_ < 2; ++i_)      \
  _Pragma("unroll") for (int j_ = 0; j_ < 4; ++j_)      \
  _Pragma("unroll") for (int e_ = 0; e_ < 16; ++e_) acc[i_][j_][e_] = 0.f;

#define ACC_ROW(MT_, i, e) (wm * 32 * (MT_) + (i) * 32 + ((e) & 3) + 8 * ((e) >> 2) + 4 * (lane >> 5))
#define ACC_COL(j) (wn * 64 + (j) * 32 + (lane & 31))

DEV void tconv(const float* src, int K, int N, u16* dst, const float* scale, int mode, float* t, int bid, int nb) {
  const int tid = my_tid();
  const int KT = K >> 6, NT = N >> 6;
  for (int tt = bid; tt < KT * NT; tt += nb) {
    const int kt = tt % KT, nt = tt / KT;
    const int k0 = kt * 64, n0 = nt * 64;
    int sn0 = n0;
    if (mode == 1) { int j = n0 >> 8, c = n0 & 255; sn0 = (c < 128) ? (j * 128 + c) : (DFF + j * 128 + c - 128); }
    {
      const int kk = tid >> 6, n = tid & 63;
#pragma unroll
      for (int i = 0; i < 8; ++i) {
        int k = kk + 8 * i;
        float v = src[(long)(k0 + k) * N + sn0 + n];
        if (scale) v *= scale[k0 + k];
        t[k * 65 + n] = v;
      }
    }
    __syncthreads();
    {
      const int n = tid >> 3, k8 = tid & 7;
      float f[8];
#pragma unroll
      for (int j = 0; j < 8; ++j) f[j] = t[(k8 * 8 + j) * 65 + n];
      *(uint4*)(dst + (long)(n0 + n) * K + k0 + k8 * 8) = pack8(f);
    }
    __syncthreads();
  }
}

DEV void phase_prep(const Params& p, float* smf, int bid, int nb) {
  for (int l = 0; l < 2; ++l) {
    unsigned char* W = p.ws + OFF_W + (size_t)l * LW_BYTES;
    tconv(p.in[2] + (size_t)l * DM * INC, DM, INC, (u16*)(W + W_IN), p.in[1] + l * DM, 0, smf, bid, nb);
    for (int g = 0; g < 3; ++g)
      tconv(p.in[18] + (size_t)(l * 3 + g) * 512 * DM, 512, DM, (u16*)(W + W_BR) + (size_t)g * DM * 512, nullptr, 0, smf, bid, nb);
    tconv(p.in[19] + (size_t)l * DM * DM, DM, DM, (u16*)(W + W_OUT), nullptr, 0, smf, bid, nb);
    tconv(p.in[21] + (size_t)l * DM * 2 * DFF, DM, 2 * DFF, (u16*)(W + W_UP), p.in[20] + l * DM, 1, smf, bid, nb);
    tconv(p.in[24] + (size_t)l * DFF * DM, DFF, DM, (u16*)(W + W_DN), nullptr, 0, smf, bid, nb);
    tconv(p.in[5] + (size_t)l * 64 * 512, 64, 512, (u16*)(W + W_RWUP), nullptr, 0, smf, bid, nb);
    tconv(p.in[7] + (size_t)l * 64 * 512, 64, 512, (u16*)(W + W_RAUP), nullptr, 0, smf, bid, nb);
    tconv(p.in[8] + (size_t)l * 128 * 512, 128, 512, (u16*)(W + W_RGUP), nullptr, 0, smf, bid, nb);
    const float* sw = p.in[16] + (size_t)l * 4 * 128 * 128;
    u16* sd = (u16*)(W + W_SGW);
    for (int idx = bid * NTHR + my_tid(); idx < 4 * 128 * 128; idx += nb * NTHR) {
      int i = (idx >> 7) & 127, j = idx & 127;
      sd[idx] = f2bf(j <= i ? sw[idx] : 0.f);
    }
  }
  {
    float* sq = (float*)(p.ws + OFF_RSTD) + NTOK;
    for (int idx = bid * NTHR + my_tid(); idx < 3 * NTOK; idx += nb * NTHR) sq[idx] = 0.f;
  }
  float* rc = (float*)(p.ws + OFF_ROPE);
  float* rs = rc + SEQ * 32;
  for (int idx = bid * NTHR + my_tid(); idx < SEQ * 32; idx += nb * NTHR) {
    int pos = idx >> 5, d = idx & 31;
    float lin = (d == 31) ? 1.0f : (float)d * (1.0f / 31.0f);
    float invf = 1.0f / powf(10000.0f, lin);
    float ang = (float)pos * invf;
    double rev = (double)ang * 0.15915494309189533577;
    float fr = (float)(rev - floor(rev));
    rc[idx] = __builtin_amdgcn_cosf(fr);
    rs[idx] = __builtin_amdgcn_sinf(fr);
  }
}

DEV void phase_norm(const float* x, u16* xb, float* rstd, int bid, int nb) {
  const int lane = my_tid() & 63, wave = my_tid() >> 6;
  for (int row = bid * 8 + wave; row < NTOK; row += nb * 8) {
    const float4* xr = (const float4*)(x + (size_t)row * DM);
    float4 v[4];
    float ss = 0.f;
#pragma unroll
    for (int i = 0; i < 4; ++i) {
      v[i] = xr[lane + 64 * i];
      ss += v[i].x * v[i].x + v[i].y * v[i].y + v[i].z * v[i].z + v[i].w * v[i].w;
    }
    ss = wave_sum(ss);
    if (lane == 0) rstd[row] = ss;
    uint2* o = (uint2*)(xb + (size_t)row * DM);
#pragma unroll
    for (int i = 0; i < 4; ++i) o[lane + 64 * i] = make_uint2(pack2(v[i].x, v[i].y), pack2(v[i].z, v[i].w));
  }
}
DEV void phase_final(float* x, const float* g, int bid, int nb) {
  const int lane = my_tid() & 63, wave = my_tid() >> 6;
  for (int row = bid * 8 + wave; row < NTOK; row += nb * 8) {
    float4* xr = (float4*)(x + (size_t)row * DM);
    const float4* gr = (const float4*)g;
    float4 v[4];
    float ss = 0.f;
#pragma unroll
    for (int i = 0; i < 4; ++i) {
      v[i] = xr[lane + 64 * i];
      ss += v[i].x * v[i].x + v[i].y * v[i].y + v[i].z * v[i].z + v[i].w * v[i].w;
    }
    ss = wave_sum(ss);
    float r = rsqrtf(ss * (1.0f / DM) + 1e-6f);
#pragma unroll
    for (int i = 0; i < 4; ++i) {
      float4 gg = gr[lane + 64 * i];
      xr[lane + 64 * i] = make_float4(v[i].x * r * gg.x, v[i].y * r * gg.y, v[i].z * r * gg.z, v[i].w * r * gg.w);
    }
  }
}

DEV void phase_inproj(const u16* xb, const float* rstd, const u16* wt, int N, u16* out, u16* smem, int bid, int nb) {
  const int tid = my_tid(), lane = tid & 63, wave = tid >> 6, wm = wave >> 1, wn = wave & 1;
  const int MTL = NTOK / 256, NTL = N / 256;
  for (int t = vbid(bid, nb); t < MTL * NTL; t += nb) {
    int m, n;
    tile_map(t, MTL, NTL, m, n);
    f32x16 acc[2][4];
    ZERO_BIG(acc);
    gemm_big(acc, xb, DM, m * 256, -(1 << 30), NTOK - 1, wt + (size_t)n * 256 * DM, DM, DM, smem);
#pragma unroll
    for (int i = 0; i < 2; ++i)
#pragma unroll
      for (int e = 0; e < 16; ++e) {
        const int r = BIG_ROW(i, e);
        const float rs = rstd_of(rstd, m * 256 + r);
#pragma unroll
        for (int j = 0; j < 4; ++j) smem[r * 264 + BIG_COL(j)] = f2bf(acc[i][j][e] * rs);
      }
    __syncthreads();
#pragma unroll 4
    for (int k = 0; k < 16; ++k) {
      const int c = tid + NTHR * k;
      const int r = c >> 5, cc = c & 31;
      *(uint4*)(out + (size_t)(m * 256 + r) * N + n * 256 + cc * 8) = *(const uint4*)(smem + r * 264 + cc * 8);
    }
    __syncthreads();
  }
}

#define OPS_STRIDE ((size_t)NTOK * 512)
template <int WHICH>
DEV void rwprep_gemm(const u16* T, u16* OS, const u16* wsrc, const float* w0, const float* a0, u16* ops, int t0, int nbk) {
  const int tid = my_tid(), lane = tid & 63, wave = tid >> 6, wm = wave >> 1, wn = wave & 1;
  constexpr int kd = (WHICH == 2) ? 128 : 64;
  constexpr int aoff = (WHICH == 0) ? 0 : (WHICH == 1 ? 64 : 128);
  constexpr int arr = (WHICH == 0) ? 4 : (WHICH == 1 ? 3 : 5);
  const int arow = (wm * 32 + (lane & 31)) * 264 + (lane >> 5) * 8;
  const int bn = nbk * 128 + wn * 64 + (lane & 31);
  bf16x8 bfr[kd / 16][2];
#pragma unroll
  for (int ks = 0; ks < kd / 16; ++ks)
#pragma unroll
    for (int j = 0; j < 2; ++j) bfr[ks][j] = *(const bf16x8*)(wsrc + (size_t)(bn + j * 32) * kd + ks * 16 + (lane >> 5) * 8);
  f32x16 ac[2];
#pragma unroll
  for (int j = 0; j < 2; ++j)
#pragma unroll
    for (int e = 0; e < 16; ++e) ac[j][e] = 0.f;
#pragma unroll
  for (int ks = 0; ks < kd / 16; ++ks) {
    const bf16x8 a1 = *(const bf16x8*)(T + arow + aoff + ks * 16);
#pragma unroll
    for (int j = 0; j < 2; ++j) ac[j] = __builtin_amdgcn_mfma_f32_32x32x16_bf16(a1, bfr[ks][j], ac[j], 0, 0, 0);
  }
#pragma unroll
  for (int j = 0; j < 2; ++j) {
    const int cl = ACC_COL(j);
    const int ch = nbk * 128 + cl;
    const float w0c = w0[ch], a0c = a0[ch];
#pragma unroll
    for (int e = 0; e < 16; ++e) {
      float val;
      if (WHICH == 0) {
        const float z = -(w0c + ac[j][e]);
        const float sp = fmaxf(z, 0.f) + log1pf(__expf(-fabsf(z)));
        val = __expf(-sp - 0.5f);
      } else if (WHICH == 1) {
        val = sigmoidf_(a0c + ac[j][e]);
      } else {
        val = ac[j][e];
      }
      OS[ACC_ROW(1, 0, e) * 136 + cl] = f2bf(val);
    }
  }
  __syncthreads();
#pragma unroll
  for (int k = 0; k < 4; ++k) {
    const int c = tid + NTHR * k;
    const int r = c >> 4, cc = c & 15;
    *(uint4*)(ops + (size_t)arr * OPS_STRIDE + (size_t)(t0 + r) * 512 + nbk * 128 + cc * 8) = *(const uint4*)(OS + r * 136 + cc * 8);
  }
  __syncthreads();
}

DEV void phase_rwprep(const Params& p, int l, u16* smem, int bid, int nb) {
  const int tid = my_tid(), lane = tid & 63, wave = tid >> 6, wm = wave >> 1, wn = wave & 1;
  const u16* prw = (const u16*)(p.ws + OFF_BIG + B_PRW);
  u16* ops = (u16*)(p.ws + OFF_BIG + B_OPS);
  unsigned char* W = p.ws + OFF_W + (size_t)l * LW_BYTES;
  const u16* wup = (const u16*)(W + W_RWUP);
  const u16* aup = (const u16*)(W + W_RAUP);
  const u16* gup = (const u16*)(W + W_RGUP);
  const float* mu = p.in[3] + l * 1792;
  const float* w0 = p.in[4] + l * 512;
  const float* a0 = p.in[6] + l * 512;
  u16* T = smem;
  for (int tile = bid; tile < NTOK / 128; tile += nb) {
    const int t0 = tile * 128;
    for (int c0 = tid; c0 < 128 * 224; c0 += NTHR * 8) {
      u32x4 cu[8], pv[8];
#pragma unroll
      for (int q = 0; q < 8; ++q) {
        const int c = c0 + NTHR * q;
        const int tok = c / 224, ch = (c % 224) * 8;
        const int t = t0 + tok;
        cu[q] = *(const u32x4*)(prw + (size_t)t * 1792 + ch);
        const int tp = ((t & (SEQ - 1)) != 0) ? t - 1 : t;
        pv[q] = *(const u32x4*)(prw + (size_t)tp * 1792 + ch);
      }
#pragma unroll
      for (int q = 0; q < 8; ++q) {
        const int c = c0 + NTHR * q;
        const int tok = c / 224, ch = (c % 224) * 8;
        const int t = t0 + tok;
        float cur[8], prv[8], o[8];
        unpack8(make_uint4(cu[q].x, cu[q].y, cu[q].z, cu[q].w), cur);
        unpack8(make_uint4(pv[q].x, pv[q].y, pv[q].z, pv[q].w), prv);
        if ((t & (SEQ - 1)) == 0) {
#pragma unroll
          for (int j = 0; j < 8; ++j) prv[j] = 0.f;
        }
        float4 m0 = *(const float4*)(mu + ch), m1 = *(const float4*)(mu + ch + 4);
        float mm[8] = {m0.x, m0.y, m0.z, m0.w, m1.x, m1.y, m1.z, m1.w};
#pragma unroll
        for (int j = 0; j < 8; ++j) o[j] = cur[j] + mm[j] * (prv[j] - cur[j]);
        if (ch < 1536) {
          int arr = ch >> 9;
          *(uint4*)(ops + arr * OPS_STRIDE + (size_t)t * 512 + (ch & 511)) = pack8(o);
        } else {
          int cc = ch - 1536;
          if (cc < 64) {
#pragma unroll
            for (int j = 0; j < 8; ++j) o[j] = tanhf(o[j]);
          } else if (cc >= 128) {
#pragma unroll
            for (int j = 0; j < 8; ++j) o[j] = sigmoidf_(o[j]);
          }
          *(uint4*)(T + tok * 264 + cc) = pack8(o);
        }
      }
    }
    __syncthreads();
    u16* OS = smem + 128 * 264;
    for (int nbk = 0; nbk < 4; ++nbk) {
      rwprep_gemm<0>(T, OS, wup, w0, a0, ops, t0, nbk);
      rwprep_gemm<1>(T, OS, aup, w0, a0, ops, t0, nbk);
      rwprep_gemm<2>(T, OS, gup, w0, a0, ops, t0, nbk);
    }
    __syncthreads();
  }
}

#define TS 32
struct ScanStage {
  float* W; float* KK; float* BB; float* KP; float* RR; float* VV; float* YY;
};
template <int PASS>
DEV void phase_scan(const Params& p, int l, float* smf, int bid, int nb) {
  const int tid = my_tid();
  const int half = tid >> 8, tu = tid & 255;
  const u16* ops = (const u16*)(p.ws + OFF_BIG + B_OPS);
  float* PL = (float*)(p.ws + OFF_BIG + B_PL);
  const float* SIN = (const float*)(p.ws + OFF_BIG + B_SINIT);
  u16* yrw = (u16*)(p.ws + OFF_BIG + B_YRW);
  const float* k_k = p.in[9] + l * 512;
  const float* k_a = p.in[10] + l * 512;
  const float* r_k = p.in[11] + l * 512;
  const float* lng = p.in[12] + l * 512;
  const float* lnb = p.in[13] + l * 512;
  float* base = smf + half * (7 * TS * 64);
  float* sW = base; float* sKK = base + TS * 64; float* sB = base + 2 * TS * 64; float* sKP = base + 3 * TS * 64;
  float* sR = base + 4 * TS * 64; float* sV = base + 5 * TS * 64; float* sY = base + 6 * TS * 64;
  const int ss = tu >> 3, c8 = tu & 7;
  const int ks = tu & 7, rp = tu >> 3;
  for (int u2 = bid; u2 < 256; u2 += nb) {
    const int u = u2 * 2 + half;
    const int bh = u >> 4, c = u & 15;
    const int b = bh >> 3, h = bh & 7;
    const int tok0 = b * SEQ + c * 512;
    const int chb = h * 64 + c8 * 8;
    float S0[8], S1[8], Q0[8], Q1[8];
    if (PASS == 1) {
#pragma unroll
      for (int j = 0; j < 8; ++j) {
        S0[j] = 0.f; S1[j] = 0.f;
        Q0[j] = (ks * 8 + j == 2 * rp) ? 1.f : 0.f;
        Q1[j] = (ks * 8 + j == 2 * rp + 1) ? 1.f : 0.f;
      }
    } else {
      const float* si = SIN + (size_t)u * 4096;
      float4 x0 = *(const float4*)(si + (2 * rp) * 64 + ks * 8), x1 = *(const float4*)(si + (2 * rp) * 64 + ks * 8 + 4);
      float4 y0 = *(const float4*)(si + (2 * rp + 1) * 64 + ks * 8), y1 = *(const float4*)(si + (2 * rp + 1) * 64 + ks * 8 + 4);
      S0[0] = x0.x; S0[1] = x0.y; S0[2] = x0.z; S0[3] = x0.w; S0[4] = x1.x; S0[5] = x1.y; S0[6] = x1.z; S0[7] = x1.w;
      S1[0] = y0.x; S1[1] = y0.y; S1[2] = y0.z; S1[3] = y0.w; S1[4] = y1.x; S1[5] = y1.y; S1[6] = y1.z; S1[7] = y1.w;
#pragma unroll
      for (int j = 0; j < 8; ++j) { Q0[j] = 0.f; Q1[j] = 0.f; }
    }
    float kkc[8], kac[8], rkc[8];
    {
      float4 q0 = *(const float4*)(k_k + chb), q1 = *(const float4*)(k_k + chb + 4);
      kkc[0] = q0.x; kkc[1] = q0.y; kkc[2] = q0.z; kkc[3] = q0.w; kkc[4] = q1.x; kkc[5] = q1.y; kkc[6] = q1.z; kkc[7] = q1.w;
      q0 = *(const float4*)(k_a + chb); q1 = *(const float4*)(k_a + chb + 4);
      kac[0] = q0.x; kac[1] = q0.y; kac[2] = q0.z; kac[3] = q0.w; kac[4] = q1.x; kac[5] = q1.y; kac[6] = q1.z; kac[7] = q1.w;
      q0 = *(const float4*)(r_k + chb); q1 = *(const float4*)(r_k + chb + 4);
      rkc[0] = q0.x; rkc[1] = q0.y; rkc[2] = q0.z; rkc[3] = q0.w; rkc[4] = q1.x; rkc[5] = q1.y; rkc[6] = q1.z; rkc[7] = q1.w;
    }
    uint4 pr_r, pr_k, pr_v, pr_a, pr_e, pr_g = make_uint4(0, 0, 0, 0);
    {
      const size_t o0 = (size_t)(tok0 + ss) * 512 + chb;
      pr_r = *(const uint4*)(ops + 0 * OPS_STRIDE + o0);
      pr_k = *(const uint4*)(ops + 1 * OPS_STRIDE + o0);
      pr_v = *(const uint4*)(ops + 2 * OPS_STRIDE + o0);
      pr_a = *(const uint4*)(ops + 3 * OPS_STRIDE + o0);
      pr_e = *(const uint4*)(ops + 4 * OPS_STRIDE + o0);
      if (PASS == 3) pr_g = *(const uint4*)(ops + 5 * OPS_STRIDE + o0);
    }
    for (int sc = 0; sc < 512 / TS; ++sc) {
      const size_t o = (size_t)(tok0 + sc * TS + ss) * 512 + chb;
      float fr[8], fk[8], fv[8], fa[8], fe[8];
      unpack8(pr_r, fr);
      unpack8(pr_k, fk);
      unpack8(pr_v, fv);
      unpack8(pr_a, fa);
      unpack8(pr_e, fe);
      const uint4 graw = pr_g;
      if (sc + 1 < 512 / TS) {
        const size_t o1 = o + (size_t)TS * 512;
        pr_r = *(const uint4*)(ops + 0 * OPS_STRIDE + o1);
        pr_k = *(const uint4*)(ops + 1 * OPS_STRIDE + o1);
        pr_v = *(const uint4*)(ops + 2 * OPS_STRIDE + o1);
        pr_a = *(const uint4*)(ops + 3 * OPS_STRIDE + o1);
        pr_e = *(const uint4*)(ops + 4 * OPS_STRIDE + o1);
        if (PASS == 3) pr_g = *(const uint4*)(ops + 5 * OPS_STRIDE + o1);
      }
      float kk[8], kp[8], ssq = 0.f, bon = 0.f;
#pragma unroll
      for (int j = 0; j < 8; ++j) {
        kk[j] = fk[j] * kkc[j];
        ssq += kk[j] * kk[j];
        kp[j] = fk[j] * (1.f + (fa[j] - 1.f) * kac[j]);
        bon += fr[j] * kp[j] * rkc[j];
      }
      ssq = red8(ssq);
      bon = red8(bon);
      const float inv = 1.f / fmaxf(sqrtf(ssq), 1e-12f);
      float fw[8], fb[8];
#pragma unroll
      for (int j = 0; j < 8; ++j) {
        kk[j] *= inv;
        fb[j] = fa[j] * kk[j];
        fw[j] = __expf(-fe[j]);
      }
      {
        const int so = ss * 64 + c8 * 8;
        *(float4*)(sW + so) = make_float4(fw[0], fw[1], fw[2], fw[3]); *(float4*)(sW + so + 4) = make_float4(fw[4], fw[5], fw[6], fw[7]);
        *(float4*)(sKK + so) = make_float4(kk[0], kk[1], kk[2], kk[3]); *(float4*)(sKK + so + 4) = make_float4(kk[4], kk[5], kk[6], kk[7]);
        *(float4*)(sB + so) = make_float4(fb[0], fb[1], fb[2], fb[3]); *(float4*)(sB + so + 4) = make_float4(fb[4], fb[5], fb[6], fb[7]);
        *(float4*)(sKP + so) = make_float4(kp[0], kp[1], kp[2], kp[3]); *(float4*)(sKP + so + 4) = make_float4(kp[4], kp[5], kp[6], kp[7]);
        *(float4*)(sV + so) = make_float4(fv[0], fv[1], fv[2], fv[3]); *(float4*)(sV + so + 4) = make_float4(fv[4], fv[5], fv[6], fv[7]);
        if (PASS == 3) {
          *(float4*)(sR + so) = make_float4(fr[0], fr[1], fr[2], fr[3]); *(float4*)(sR + so + 4) = make_float4(fr[4], fr[5], fr[6], fr[7]);
        }
      }
      __syncthreads();
#pragma unroll 2
      for (int s = 0; s < TS; ++s) {
        const int so = s * 64 + ks * 8;
        float4 t0 = *(const float4*)(sW + so), t1 = *(const float4*)(sW + so + 4);
        float w[8] = {t0.x, t0.y, t0.z, t0.w, t1.x, t1.y, t1.z, t1.w};
        t0 = *(const float4*)(sKK + so); t1 = *(const float4*)(sKK + so + 4);
        float kq[8] = {t0.x, t0.y, t0.z, t0.w, t1.x, t1.y, t1.z, t1.w};
        t0 = *(const float4*)(sB + so); t1 = *(const float4*)(sB + so + 4);
        float bq[8] = {t0.x, t0.y, t0.z, t0.w, t1.x, t1.y, t1.z, t1.w};
        t0 = *(const float4*)(sKP + so); t1 = *(const float4*)(sKP + so + 4);
        float kpq[8] = {t0.x, t0.y, t0.z, t0.w, t1.x, t1.y, t1.z, t1.w};
        const float2 vv = *(const float2*)(sV + s * 64 + 2 * rp);
        float sa0 = 0.f, sa1 = 0.f;
#pragma unroll
        for (int j = 0; j < 8; ++j) { sa0 += S0[j] * kq[j]; sa1 += S1[j] * kq[j]; }
        sa0 = red8(sa0); sa1 = red8(sa1);
#pragma unroll
        for (int j = 0; j < 8; ++j) {
          S0[j] = S0[j] * w[j] - sa0 * bq[j] + vv.x * kpq[j];
          S1[j] = S1[j] * w[j] - sa1 * bq[j] + vv.y * kpq[j];
        }
        if (PASS == 1) {
          float pa0 = 0.f, pa1 = 0.f;
#pragma unroll
          for (int j = 0; j < 8; ++j) { pa0 += Q0[j] * kq[j]; pa1 += Q1[j] * kq[j]; }
          pa0 = red8(pa0); pa1 = red8(pa1);
#pragma unroll
          for (int j = 0; j < 8; ++j) {
            Q0[j] = Q0[j] * w[j] - pa0 * bq[j];
            Q1[j] = Q1[j] * w[j] - pa1 * bq[j];
          }
        } else {
          t0 = *(const float4*)(sR + so); t1 = *(const float4*)(sR + so + 4);
          float rq[8] = {t0.x, t0.y, t0.z, t0.w, t1.x, t1.y, t1.z, t1.w};
          float y0 = 0.f, y1 = 0.f;
#pragma unroll
          for (int j = 0; j < 8; ++j) { y0 += S0[j] * rq[j]; y1 += S1[j] * rq[j]; }
          y0 = red8(y0); y1 = red8(y1);
          if (ks == 0) *(float2*)(sY + s * 64 + 2 * rp) = make_float2(y0, y1);
        }
      }
      __syncthreads();
      if (PASS == 3) {
        const int so = ss * 64 + c8 * 8;
        float4 y0 = *(const float4*)(sY + so), y1 = *(const float4*)(sY + so + 4);
        float y[8] = {y0.x, y0.y, y0.z, y0.w, y1.x, y1.y, y1.z, y1.w};
        float sm = 0.f;
#pragma unroll
        for (int j = 0; j < 8; ++j) sm += y[j];
        const float mean = red8(sm) * (1.f / 64.f);
        float sv = 0.f;
#pragma unroll
        for (int j = 0; j < 8; ++j) { y[j] -= mean; sv += y[j] * y[j]; }
        const float var = red8(sv) * (1.f / 64.f);
        const float rs = rsqrtf(var + 64e-5f);
        float g[8], outv[8];
        unpack8(graw, g);
        float4 l0 = *(const float4*)(lng + chb), l1 = *(const float4*)(lng + chb + 4);
        float4 b0 = *(const float4*)(lnb + chb), b1 = *(const float4*)(lnb + chb + 4);
        float lg[8] = {l0.x, l0.y, l0.z, l0.w, l1.x, l1.y, l1.z, l1.w};
        float lb[8] = {b0.x, b0.y, b0.z, b0.w, b1.x, b1.y, b1.z, b1.w};
#pragma unroll
        for (int j = 0; j < 8; ++j) outv[j] = (y[j] * rs * lg[j] + lb[j] + bon * fv[j]) * g[j];
        if (!(c == 0 && sc == 0 && ss == 0)) *(uint4*)(yrw + o) = pack8(outv);
      }
    }
    if (PASS == 1) {
      float* pl = PL + (size_t)u * 8192;
      float* Pm = pl;
      float* Lm = pl + 4096;
      *(float4*)(Pm + (2 * rp) * 64 + ks * 8) = make_float4(Q0[0], Q0[1], Q0[2], Q0[3]);
      *(float4*)(Pm + (2 * rp) * 64 + ks * 8 + 4) = make_float4(Q0[4], Q0[5], Q0[6], Q0[7]);
      *(float4*)(Pm + (2 * rp + 1) * 64 + ks * 8) = make_float4(Q1[0], Q1[1], Q1[2], Q1[3]);
      *(float4*)(Pm + (2 * rp + 1) * 64 + ks * 8 + 4) = make_float4(Q1[4], Q1[5], Q1[6], Q1[7]);
      *(float4*)(Lm + (2 * rp) * 64 + ks * 8) = make_float4(S0[0], S0[1], S0[2], S0[3]);
      *(float4*)(Lm + (2 * rp) * 64 + ks * 8 + 4) = make_float4(S0[4], S0[5], S0[6], S0[7]);
      *(float4*)(Lm + (2 * rp + 1) * 64 + ks * 8) = make_float4(S1[0], S1[1], S1[2], S1[3]);
      *(float4*)(Lm + (2 * rp + 1) * 64 + ks * 8 + 4) = make_float4(S1[4], S1[5], S1[6], S1[7]);
    }
  }
}

DEV void phase_scanprop(const Params& p, float* smf, int bid, int nb) {
  const int tid = my_tid();
  const float* PL = (const float*)(p.ws + OFF_BIG + B_PL);
  float* SIN = (float*)(p.ws + OFF_BIG + B_SINIT);
  float* sS = smf;
  float* sP = smf + 4096;
  const int i = tid >> 3, k8 = tid & 7;
  for (int bh = bid; bh < 32; bh += nb) {
    float cur[8];
#pragma unroll
    for (int j = 0; j < 8; ++j) cur[j] = 0.f;
    const float* pl0 = PL + (size_t)(bh * 16) * 8192;
    float4 np0 = *(const float4*)(pl0 + tid * 8), np1 = *(const float4*)(pl0 + tid * 8 + 4);
    float4 nl0 = *(const float4*)(pl0 + 4096 + i * 64 + k8 * 8), nl1 = *(const float4*)(pl0 + 4096 + i * 64 + k8 * 8 + 4);
    for (int c = 0; c < 16; ++c) {
      const int u = bh * 16 + c;
      float* so = SIN + (size_t)u * 4096 + i * 64 + k8 * 8;
      *(float4*)so = make_float4(cur[0], cur[1], cur[2], cur[3]);
      *(float4*)(so + 4) = make_float4(cur[4], cur[5], cur[6], cur[7]);
      if (c == 15) break;
      *(float4*)(sS + i * 64 + k8 * 8) = make_float4(cur[0], cur[1], cur[2], cur[3]);
      *(float4*)(sS + i * 64 + k8 * 8 + 4) = make_float4(cur[4], cur[5], cur[6], cur[7]);
      *(float4*)(sP + tid * 8) = np0;
      *(float4*)(sP + tid * 8 + 4) = np1;
      float nw[8] = {nl0.x, nl0.y, nl0.z, nl0.w, nl1.x, nl1.y, nl1.z, nl1.w};
      __syncthreads();
      if (c + 1 < 15) {
        const float* pl = PL + (size_t)(u + 1) * 8192;
        np0 = *(const float4*)(pl + tid * 8); np1 = *(const float4*)(pl + tid * 8 + 4);
        nl0 = *(const float4*)(pl + 4096 + i * 64 + k8 * 8); nl1 = *(const float4*)(pl + 4096 + i * 64 + k8 * 8 + 4);
      }
#pragma unroll 8
      for (int j = 0; j < 64; ++j) {
        const float sij = sS[i * 64 + j];
        float4 p0 = *(const float4*)(sP + j * 64 + k8 * 8), p1 = *(const float4*)(sP + j * 64 + k8 * 8 + 4);
        nw[0] += sij * p0.x; nw[1] += sij * p0.y; nw[2] += sij * p0.z; nw[3] += sij * p0.w;
        nw[4] += sij * p1.x; nw[5] += sij * p1.y; nw[6] += sij * p1.z; nw[7] += sij * p1.w;
      }
#pragma unroll
      for (int j = 0; j < 8; ++j) cur[j] = nw[j];
      __syncthreads();
    }
  }
}

DEV float ret_log2gamma(int h) { return log2f(1.0f - exp2f(-5.0f - (float)h)); }

DEV void stage_rot(const u16* src, size_t ld, const float* rc, const float* rs, int pos0, u16* dst, float sc, float l2g, int rowmode) {
  const int tid = my_tid();
  const int row = tid >> 2, d0 = (tid & 3) * 8;
  float lo[8], hi[8], olo[8], ohi[8];
  unpack8(*(const uint4*)(src + (size_t)row * ld + d0), lo);
  unpack8(*(const uint4*)(src + (size_t)row * ld + d0 + 32), hi);
  const float* cp = rc + (size_t)(pos0 + row) * 32 + d0;
  const float* sp = rs + (size_t)(pos0 + row) * 32 + d0;
  float4 c0 = *(const float4*)cp, c1 = *(const float4*)(cp + 4);
  float4 s0 = *(const float4*)sp, s1 = *(const float4*)(sp + 4);
  float cc[8] = {c0.x, c0.y, c0.z, c0.w, c1.x, c1.y, c1.z, c1.w};
  float sn[8] = {s0.x, s0.y, s0.z, s0.w, s1.x, s1.y, s1.z, s1.w};
  float rsc = sc;
  if (rowmode == 1) rsc *= exp2f((float)(row + 1) * l2g);
  if (rowmode == 2) rsc *= exp2f((float)(127 - row) * l2g);
#pragma unroll
  for (int j = 0; j < 8; ++j) {
    olo[j] = (lo[j] * cc[j] - hi[j] * sn[j]) * rsc;
    ohi[j] = (hi[j] * cc[j] + lo[j] * sn[j]) * rsc;
  }
  *(uint4*)(dst + row * 72 + d0) = pack8(olo);
  *(uint4*)(dst + row * 72 + d0 + 32) = pack8(ohi);
}
DEV void stage_rot_T(const u16* src, size_t ld, const float* rc, const float* rs, int pos0, u16* dst, float sc, float l2g) {
  const int tid = my_tid();
  const int row = tid >> 2, d0 = (tid & 3) * 8;
  float lo[8], hi[8];
  unpack8(*(const uint4*)(src + (size_t)row * ld + d0), lo);
  unpack8(*(const uint4*)(src + (size_t)row * ld + d0 + 32), hi);
  const float* cp = rc + (size_t)(pos0 + row) * 32 + d0;
  const float* sp = rs + (size_t)(pos0 + row) * 32 + d0;
  float4 c0 = *(const float4*)cp, c1 = *(const float4*)(cp + 4);
  float4 s0 = *(const float4*)sp, s1 = *(const float4*)(sp + 4);
  float cc[8] = {c0.x, c0.y, c0.z, c0.w, c1.x, c1.y, c1.z, c1.w};
  float sn[8] = {s0.x, s0.y, s0.z, s0.w, s1.x, s1.y, s1.z, s1.w};
  const float rsc = sc * exp2f((float)(127 - row) * l2g);
#pragma unroll
  for (int j = 0; j < 8; ++j) {
    dst[(d0 + j) * 136 + row] = f2bf((lo[j] * cc[j] - hi[j] * sn[j]) * rsc);
    dst[(d0 + j + 32) * 136 + row] = f2bf((hi[j] * cc[j] + lo[j] * sn[j]) * rsc);
  }
}
DEV void stage_vT(const u16* src, size_t ld, u16* dst) {
  const int tid = my_tid();
  const int row = tid >> 2, d0 = (tid & 3) * 32;
#pragma unroll
  for (int c = 0; c < 4; ++c) {
    uint4 v = *(const uint4*)(src + (size_t)row * ld + d0 + c * 8);
    unsigned w[4] = {v.x, v.y, v.z, v.w};
#pragma unroll
    for (int j = 0; j < 4; ++j) {
      dst[(d0 + c * 8 + 2 * j) * 136 + row] = (u16)(w[j] & 0xffffu);
      dst[(d0 + c * 8 + 2 * j + 1) * 136 + row] = (u16)(w[j] >> 16);
    }
  }
}

DEV void ret_kv_unit(const Params& p, int u, u16* smem) {
  const int tid = my_tid(), lane = tid & 63, wave = tid >> 6;
  const u16* prs = (const u16*)(p.ws + OFF_BIG + B_PRS);
  float* KV = (float*)(p.ws + OFF_BIG + B_KV);
  const float* rc = (const float*)(p.ws + OFF_ROPE);
  const float* rs = rc + SEQ * 32;
  const int n = u & 63, h = (u >> 6) & 3, b = u >> 8;
  const size_t t0 = (size_t)b * SEQ + n * 128;
  const float l2g = ret_log2gamma(h);
  u16* KT = smem;
  u16* VT = smem + 64 * 136;
  stage_rot_T(prs + t0 * 2560 + 256 + h * 64, 2560, rc, rs, n * 128, KT, 0.125f, l2g);
  stage_vT(prs + t0 * 2560 + 512 + h * 128, 2560, VT);
  __syncthreads();
  const int mi = wave >> 1, nj = wave & 1;
  f32x16 acc;
#pragma unroll
  for (int e = 0; e < 16; ++e) acc[e] = 0.f;
#pragma unroll
  for (int ks = 0; ks < 8; ++ks) {
    bf16x8 a = *(const bf16x8*)(VT + (mi * 32 + (lane & 31)) * 136 + ks * 16 + (lane >> 5) * 8);
    bf16x8 bb = *(const bf16x8*)(KT + (nj * 32 + (lane & 31)) * 136 + ks * 16 + (lane >> 5) * 8);
    acc = __builtin_amdgcn_mfma_f32_32x32x16_bf16(a, bb, acc, 0, 0, 0);
  }
  float* kv = KV + (size_t)u * 8192;
#pragma unroll
  for (int e = 0; e < 16; ++e) {
    int dv = mi * 32 + (e & 3) + 8 * (e >> 2) + 4 * (lane >> 5);
    int dk = nj * 32 + (lane & 31);
    kv[dv * 64 + dk] = acc[e];
  }
  __syncthreads();
}

DEV void sgu_unit(const Params& p, int l, int u, u16* smem) {
  const int tid = my_tid(), lane = tid & 63, wave = tid >> 6, wm = wave >> 1, wn = wave & 1;
  const u16* prs = (const u16*)(p.ws + OFF_BIG + B_PRS);
  u16* ysg = (u16*)(p.ws + OFF_BIG + B_YSG);
  const u16* sgw = (const u16*)(p.ws + OFF_W + (size_t)l * LW_BYTES + W_SGW);
  const float* lng = p.in[14] + l * 512;
  const float* lnb = p.in[15] + l * 512;
  const float* sgb = p.in[17] + l * 512;
  const size_t t0 = (size_t)u * 128;
  u16* VT = smem;
  u16* WT = smem + 128 * 136;
  float* st = (float*)(smem + 2 * 128 * 136);
  const int tok = tid >> 2, q = tid & 3;
  const u16* vrow = prs + (t0 + tok) * 2560 + 1536 + 512;
  {
    float s = 0.f, s2 = 0.f;
#pragma unroll 4
    for (int c = 0; c < 16; ++c) {
      float f[8];
      unpack8(*(const uint4*)(vrow + q * 128 + c * 8), f);
#pragma unroll
      for (int j = 0; j < 8; ++j) { float gl = geluf_(f[j]); s += gl; s2 += gl * gl; }
    }
    s = red4(s); s2 = red4(s2);
    const float mean = s * (1.f / 512.f);
    const float var = fmaxf(s2 * (1.f / 512.f) - mean * mean, 0.f);
    if (q == 0) { st[tok] = mean; st[128 + tok] = rsqrtf(var + 1e-6f); }
  }
  __syncthreads();
  const float mean = st[tok], rstd = st[128 + tok];
  for (int g = 0; g < 4; ++g) {
#pragma unroll
    for (int c = 0; c < 4; ++c) {
      const int d = q * 32 + c * 8;
      float f[8];
      unpack8(*(const uint4*)(vrow + g * 128 + d), f);
      float4 g0 = *(const float4*)(lng + g * 128 + d), g1 = *(const float4*)(lng + g * 128 + d + 4);
      float4 b0 = *(const float4*)(lnb + g * 128 + d), b1 = *(const float4*)(lnb + g * 128 + d + 4);
      float gg[8] = {g0.x, g0.y, g0.z, g0.w, g1.x, g1.y, g1.z, g1.w};
      float bb[8] = {b0.x, b0.y, b0.z, b0.w, b1.x, b1.y, b1.z, b1.w};
#pragma unroll
      for (int j = 0; j < 8; ++j) VT[(d + j) * 136 + tok] = f2bf((geluf_(f[j]) - mean) * rstd * gg[j] + bb[j]);
      *(uint4*)(WT + tok * 136 + d) = *(const uint4*)(sgw + (size_t)g * 16384 + tok * 128 + d);
    }
    __syncthreads();
    f32x16 acc[2];
#pragma unroll
    for (int j = 0; j < 2; ++j)
#pragma unroll
      for (int e = 0; e < 16; ++e) acc[j][e] = 0.f;
#pragma unroll
    for (int ks = 0; ks < 8; ++ks) {
      bf16x8 a = *(const bf16x8*)(WT + (wm * 32 + (lane & 31)) * 136 + ks * 16 + (lane >> 5) * 8);
#pragma unroll
      for (int j = 0; j < 2; ++j) {
        bf16x8 bb = *(const bf16x8*)(VT + (wn * 64 + j * 32 + (lane & 31)) * 136 + ks * 16 + (lane >> 5) * 8);
        acc[j] = __builtin_amdgcn_mfma_f32_32x32x16_bf16(a, bb, acc[j], 0, 0, 0);
      }
    }
#pragma unroll
    for (int e = 0; e < 16; ++e) {
      const int i = ACC_ROW(1, 0, e);
      const float bias = sgb[g * 128 + i];
#pragma unroll
      for (int j = 0; j < 2; ++j) {
        const int d = ACC_COL(j);
        const float uu = geluf_(bf2f(prs[(t0 + i) * 2560 + 1536 + g * 128 + d]));
        ysg[(t0 + i) * 512 + g * 128 + d] = f2bf(uu * (acc[j][e] + bias));
      }
    }
    __syncthreads();
  }
}

DEV void phase_retprefix(const Params& p, int bid, int nb) {
  float* KV = (float*)(p.ws + OFF_BIG + B_KV);
  for (int gid = bid * NTHR + my_tid(); gid < 16 * 8192; gid += nb * NTHR) {
    const int bh = gid >> 13, e = gid & 8191;
    const int h = bh & 3;
    const float cd = exp2f(128.f * ret_log2gamma(h));
    float R = 0.f;
    float* ptr = KV + (size_t)bh * 64 * 8192 + e;
    for (int n = 0; n < 64; ++n) {
      float kv = ptr[(size_t)n * 8192];
      ptr[(size_t)n * 8192] = R;
      R = R * cd + kv;
    }
  }
}

DEV void ret_out_unit(const Params& p, int u, u16* smem) {
  const int tid = my_tid(), lane = tid & 63, wave = tid >> 6, wm = wave >> 1, wn = wave & 1;
  const u16* prs = (const u16*)(p.ws + OFF_BIG + B_PRS);
  const float* KV = (const float*)(p.ws + OFF_BIG + B_KV);
  u16* yret = (u16*)(p.ws + OFF_BIG + B_YRET);
  const float* rc = (const float*)(p.ws + OFF_ROPE);
  const float* rs = rc + SEQ * 32;
  const int n = u & 63, h = (u >> 6) & 3, b = u >> 8;
  const size_t t0 = (size_t)b * SEQ + n * 128;
  const float l2g = ret_log2gamma(h);
  u16* Q = smem;
  u16* Kr = Q + 128 * 72;
  u16* VT = Kr + 128 * 72;
  u16* Qd = VT + 128 * 136;
  u16* RT = Qd + 128 * 72;
  u16* SP = RT + 128 * 72;
  float* OT = (float*)smem;
  stage_rot(prs + t0 * 2560 + h * 64, 2560, rc, rs, n * 128, Q, 1.0f, l2g, 0);
  stage_rot(prs + t0 * 2560 + h * 64, 2560, rc, rs, n * 128, Qd, 1.0f, l2g, 1);
  stage_rot(prs + t0 * 2560 + 256 + h * 64, 2560, rc, rs, n * 128, Kr, 0.125f, l2g, 0);
  stage_vT(prs + t0 * 2560 + 512 + h * 128, 2560, VT);
  {
    const int dv = tid >> 2, q = tid & 3;
    const float* src = KV + (size_t)u * 8192 + dv * 64 + q * 16;
    float4 a0 = *(const float4*)src, a1 = *(const float4*)(src + 4), a2 = *(const float4*)(src + 8), a3 = *(const float4*)(src + 12);
    float f0[8] = {a0.x, a0.y, a0.z, a0.w, a1.x, a1.y, a1.z, a1.w};
    float f1[8] = {a2.x, a2.y, a2.z, a2.w, a3.x, a3.y, a3.z, a3.w};
    *(uint4*)(RT + dv * 72 + q * 16) = pack8(f0);
    *(uint4*)(RT + dv * 72 + q * 16 + 8) = pack8(f1);
  }
  __syncthreads();
  f32x16 acc[2];
#pragma unroll
  for (int j = 0; j < 2; ++j)
#pragma unroll
    for (int e = 0; e < 16; ++e) acc[j][e] = 0.f;
#pragma unroll
  for (int ks = 0; ks < 4; ++ks) {
    bf16x8 a = *(const bf16x8*)(Q + (wm * 32 + (lane & 31)) * 72 + ks * 16 + (lane >> 5) * 8);
#pragma unroll
    for (int j = 0; j < 2; ++j) {
      bf16x8 bb = *(const bf16x8*)(Kr + (wn * 64 + j * 32 + (lane & 31)) * 72 + ks * 16 + (lane >> 5) * 8);
      acc[j] = __builtin_amdgcn_mfma_f32_32x32x16_bf16(a, bb, acc[j], 0, 0, 0);
    }
  }
#pragma unroll
  for (int j = 0; j < 2; ++j)
#pragma unroll
    for (int e = 0; e < 16; ++e) {
      const int i = ACC_ROW(1, 0, e), jj = ACC_COL(j);
      const float dcy = (i >= jj) ? exp2f((float)(i - jj) * l2g) : 0.f;
      SP[i * 136 + jj] = f2bf(acc[j][e] * dcy);
    }
  __syncthreads();
#pragma unroll
  for (int j = 0; j < 2; ++j)
#pragma unroll
    for (int e = 0; e < 16; ++e) acc[j][e] = 0.f;
#pragma unroll
  for (int ks = 0; ks < 8; ++ks) {
    bf16x8 a = *(const bf16x8*)(SP + (wm * 32 + (lane & 31)) * 136 + ks * 16 + (lane >> 5) * 8);
#pragma unroll
    for (int j = 0; j < 2; ++j) {
      bf16x8 bb = *(const bf16x8*)(VT + (wn * 64 + j * 32 + (lane & 31)) * 136 + ks * 16 + (lane >> 5) * 8);
      acc[j] = __builtin_amdgcn_mfma_f32_32x32x16_bf16(a, bb, acc[j], 0, 0, 0);
    }
  }
#pragma unroll
  for (int ks = 0; ks < 4; ++ks) {
    bf16x8 a = *(const bf16x8*)(Qd + (wm * 32 + (lane & 31)) * 72 + ks * 16 + (lane >> 5) * 8);
#pragma unroll
    for (int j = 0; j < 2; ++j) {
      bf16x8 bb = *(const bf16x8*)(RT + (wn * 64 + j * 32 + (lane & 31)) * 72 + ks * 16 + (lane >> 5) * 8);
      acc[j] = __builtin_amdgcn_mfma_f32_32x32x16_bf16(a, bb, acc[j], 0, 0, 0);
    }
  }
  __syncthreads();
#pragma unroll
  for (int j = 0; j < 2; ++j)
#pragma unroll
    for (int e = 0; e < 16; ++e) OT[ACC_ROW(1, 0, e) * 132 + ACC_COL(j)] = acc[j][e];
  __syncthreads();
  {
    const int row = tid >> 2, q = tid & 3;
    float o[32];
    float ssq = 0.f;
#pragma unroll
    for (int c = 0; c < 8; ++c) {
      float4 v = *(const float4*)(OT + row * 132 + q * 32 + c * 4);
      o[c * 4] = v.x; o[c * 4 + 1] = v.y; o[c * 4 + 2] = v.z; o[c * 4 + 3] = v.w;
      ssq += v.x * v.x + v.y * v.y + v.z * v.z + v.w * v.w;
    }
    ssq = red4(ssq);
    const float r = rsqrtf(ssq * (1.f / 128.f) + 1e-6f);
    const u16* gp = prs + (t0 + row) * 2560 + 1024 + h * 128 + q * 32;
    u16* op = yret + (t0 + row) * 512 + h * 128 + q * 32;
#pragma unroll
    for (int c = 0; c < 4; ++c) {
      float g[8], ov[8];
      unpack8(*(const uint4*)(gp + c * 8), g);
#pragma unroll
      for (int j = 0; j < 8; ++j) ov[j] = o[c * 8 + j] * r * siluf_(g[j]);
      if (!(n == 0 && row == 0)) *(uint4*)(op + c * 8) = pack8(ov);
    }
  }
  __syncthreads();
}

DEV void phase_merge(const Params& p, int l, const float* rstd, u16* smem, int bid, int nb) {
  const int tid = my_tid(), lane = tid & 63, wave = tid >> 6, wm = wave >> 1, wn = wave & 1;
  const u16* xb = (const u16*)(p.ws + OFF_XB);
  unsigned char* W = p.ws + OFF_W + (size_t)l * LW_BYTES;
  const u16* win = (const u16*)(W + W_IN);
  const u16* wbr = (const u16*)(W + W_BR);
  u16* M = (u16*)(p.ws + OFF_BIG + B_M);
  const int MTL = NTOK / 128, NTL = DM / 128;
  for (int t = vbid(bid, nb); t < MTL * NTL; t += nb) {
    int m, n;
    tile_map(t, MTL, NTL, m, n);
    f32x16 ms[1][2];
#pragma unroll
    for (int j = 0; j < 2; ++j)
#pragma unroll
      for (int e = 0; e < 16; ++e) ms[0][j][e] = 0.f;
    for (int g = 0; g < 3; ++g) {
      const u16* yg = (const u16*)(p.ws + OFF_BIG + (g == 0 ? B_YRW : (g == 1 ? B_YRET : B_YSG)));
      f32x16 ab[1][2], ag[1][2];
#pragma unroll
      for (int j = 0; j < 2; ++j)
#pragma unroll
        for (int e = 0; e < 16; ++e) { ab[0][j][e] = 0.f; ag[0][j][e] = 0.f; }
      gemm_tile<1>(ab, yg, 512, m * 128, -(1 << 30), NTOK - 1, wbr + ((size_t)g * DM + n * 128) * 512, 512, 512, smem);
      gemm_tile<1>(ag, xb, DM, m * 128, -(1 << 30), NTOK - 1, win + ((size_t)(4352 + g * DM + n * 128)) * DM, DM, DM, smem);
#pragma unroll
      for (int e = 0; e < 16; ++e) {
        const float rs = rstd_of(rstd, m * 128 + ACC_ROW(1, 0, e));
#pragma unroll
        for (int j = 0; j < 2; ++j) ms[0][j][e] += sigmoidf_(ag[0][j][e] * rs) * ab[0][j][e];
        if ((e & 3) == 3) __builtin_amdgcn_sched_barrier(0);
      }
    }
#pragma unroll
    for (int e = 0; e < 16; ++e) {
      const size_t row = m * 128 + ACC_ROW(1, 0, e);
#pragma unroll
      for (int j = 0; j < 2; ++j) M[row * DM + n * 128 + ACC_COL(j)] = f2bf(ms[0][j][e]);
    }
  }
}

DEV void phase_resgemm(const u16* A, int K, const u16* wt, const float* xin, float* xout, u16* xbo, float* ssq, u16* smem, int bid, int nb) {
  const int tid = my_tid(), lane = tid & 63, wave = tid >> 6, wm = wave >> 1, wn = wave & 1;
  const int MTL = NTOK / 256, NTL = DM / 256;
  for (int t = vbid(bid, nb); t < MTL * NTL; t += nb) {
    int m, n;
    tile_map(t, MTL, NTL, m, n);
    f32x16 acc[2][4];
    ZERO_BIG(acc);
    gemm_big(acc, A, K, m * 256, -(1 << 30), NTOK - 1, wt + (size_t)n * 256 * K, K, K, smem);
    float* F = (float*)smem;
#pragma unroll
    for (int i = 0; i < 2; ++i) {
#pragma unroll
      for (int e = 0; e < 16; ++e) {
        const int lr = wm * 32 + (e & 3) + 8 * (e >> 2) + 4 * (lane >> 5);
#pragma unroll
        for (int j = 0; j < 4; ++j) F[lr * 260 + BIG_COL(j)] = acc[i][j][e];
      }
      __syncthreads();
#pragma unroll 4
      for (int k = 0; k < 16; ++k) {
        const int c = tid + NTHR * k;
        const int lr = c >> 6, cc = c & 63;
        const size_t row = (size_t)m * 256 + (lr >> 5) * 64 + i * 32 + (lr & 31);
        const size_t o = row * DM + n * 256 + cc * 4;
        const float4 v = *(const float4*)(F + lr * 260 + cc * 4);
        const float4 x = *(const float4*)(xin + o);
        const float4 y = make_float4(x.x + v.x, x.y + v.y, x.z + v.z, x.w + v.w);
        *(float4*)(xout + o) = y;
        if (xbo) {
          *(uint2*)(xbo + o) = make_uint2(pack2(y.x, y.y), pack2(y.z, y.w));
          const float sq = wave_sum(y.x * y.x + y.y * y.y + y.z * y.z + y.w * y.w);
          if (lane == 0) atomicAdd(ssq + row, sq);
        }
      }
      __syncthreads();
    }
  }
}

DEV void phase_ffnup(const Params& p, int l, const float* rstd, u16* smem, int bid, int nb) {
  const int tid = my_tid(), lane = tid & 63, wave = tid >> 6, wm = wave >> 1, wn = wave & 1;
  const u16* xb = (const u16*)(p.ws + OFF_XB);
  const u16* wup = (const u16*)(p.ws + OFF_W + (size_t)l * LW_BYTES + W_UP);
  u16* act = (u16*)(p.ws + OFF_BIG + B_ACT);
  const float* cw = p.in[22] + (size_t)l * 3 * 2 * DFF;
  const float* cb = p.in[23] + (size_t)l * 2 * DFF;
  u16* U = smem;
  const int MPB = 33;
  const int MTL = 4 * MPB, NTL = DFF / 128;
  for (int t = vbid(bid, nb); t < MTL * NTL; t += nb) {
    int m, n;
    tile_map(t, MTL, NTL, m, n);
    const int b = m / MPB, mi = m % MPB;
    const int tokbase = b * SEQ + mi * 254 - 2;
    f32x16 acc[2][4];
    ZERO_BIG(acc);
    gemm_big(acc, xb, DM, tokbase, b * SEQ, NTOK - 1, wup + (size_t)n * 256 * DM, DM, DM, smem);
#pragma unroll
    for (int i = 0; i < 2; ++i)
#pragma unroll
      for (int e = 0; e < 16; ++e) {
        const int r = BIG_ROW(i, e);
        int tk = tokbase + r; tk = tk < 0 ? 0 : (tk > NTOK - 1 ? NTOK - 1 : tk);
        const float rs = rstd_of(rstd, tk);
#pragma unroll
        for (int j = 0; j < 4; ++j) U[r * 264 + BIG_COL(j)] = f2bf(acc[i][j][e] * rs);
      }
    __syncthreads();
    {
      const int c = (tid & 63) * 2, rg = tid >> 6;
      const int gcol = n * 128 + c, vcol = DFF + n * 128 + c;
      float wg0[2], wg1[2], wg2[2], bg[2], wv0[2], wv1[2], wv2[2], bv[2];
#pragma unroll
      for (int q = 0; q < 2; ++q) {
        wg0[q] = cw[gcol + q]; wg1[q] = cw[2 * DFF + gcol + q]; wg2[q] = cw[4 * DFF + gcol + q]; bg[q] = cb[gcol + q];
        wv0[q] = cw[vcol + q]; wv1[q] = cw[2 * DFF + vcol + q]; wv2[q] = cw[4 * DFF + vcol + q]; bv[q] = cb[vcol + q];
      }
      const int r0 = 2 + rg * 32;
      const int rend = (r0 + 32 > 256) ? 256 : r0 + 32;
      unsigned t;
      float g2[2], g1[2], v2[2], v1[2];
      t = *(const unsigned*)(U + (r0 - 2) * 264 + c); g2[0] = __uint_as_float(t << 16); g2[1] = __uint_as_float(t & 0xffff0000u);
      t = *(const unsigned*)(U + (r0 - 1) * 264 + c); g1[0] = __uint_as_float(t << 16); g1[1] = __uint_as_float(t & 0xffff0000u);
      t = *(const unsigned*)(U + (r0 - 2) * 264 + 128 + c); v2[0] = __uint_as_float(t << 16); v2[1] = __uint_as_float(t & 0xffff0000u);
      t = *(const unsigned*)(U + (r0 - 1) * 264 + 128 + c); v1[0] = __uint_as_float(t << 16); v1[1] = __uint_as_float(t & 0xffff0000u);
      const int tend = (b + 1) * SEQ;
      for (int r = r0; r < rend; ++r) {
        const unsigned ug = *(const unsigned*)(U + r * 264 + c), uv = *(const unsigned*)(U + r * 264 + 128 + c);
        const float g0[2] = {__uint_as_float(ug << 16), __uint_as_float(ug & 0xffff0000u)};
        const float v0[2] = {__uint_as_float(uv << 16), __uint_as_float(uv & 0xffff0000u)};
        float o[2];
#pragma unroll
        for (int q = 0; q < 2; ++q) {
          const float cg = bg[q] + wg0[q] * g2[q] + wg1[q] * g1[q] + wg2[q] * g0[q];
          const float cv = bv[q] + wv0[q] * v2[q] + wv1[q] * v1[q] + wv2[q] * v0[q];
          o[q] = siluf_(cg) * cv;
          g2[q] = g1[q]; g1[q] = g0[q]; v2[q] = v1[q]; v1[q] = v0[q];
        }
        const int tk = tokbase + r;
        if (tk < tend) *(unsigned*)(act + (size_t)tk * DFF + n * 128 + c) = pack2(o[0], o[1]);
      }
    }
    __syncthreads();
  }
}

#define PF_COLS 3328
DEV void first_tok_proj(const Params& p, int l, const float* xcur, float* smf, int bid, int nb) {
  float* PF = (float*)(p.ws + OFF_PF);
  const float* w = p.in[2] + (size_t)l * DM * INC;
  const float* g1 = p.in[1] + l * DM;
  const int tid = my_tid(), lane = tid & 63, wave = tid >> 6;
  for (int task = bid; task < 4 * 52; task += nb) {
    const int b = task / 52, c = (task % 52) * 64 + lane;
    const float* xr = xcur + (size_t)b * SEQ * DM;
    float acc = 0.f, ss = 0.f;
    const int k0 = wave * 128;
#pragma unroll 16
    for (int k = k0; k < k0 + 128; ++k) {
      const float xv = xr[k];
      ss += xv * xv;
      acc += xv * g1[k] * w[(size_t)k * INC + c];
    }
    smf[wave * 64 + lane] = acc;
    smf[512 + wave * 64 + lane] = ss;
    __syncthreads();
    if (wave == 0) {
      float ta = 0.f, ts = 0.f;
#pragma unroll
      for (int q = 0; q < 8; ++q) { ta += smf[q * 64 + lane]; ts += smf[512 + q * 64 + lane]; }
      PF[b * PF_COLS + c] = ta * rsqrtf(ts * (1.0f / DM) + 1e-6f);
    }
    __syncthreads();
  }
}
DEV void first_tok_fix(const Params& p, int l, float* smf, int bid, int nb) {
  const int tid = my_tid(), lane = tid & 63;
  const float* PF = (const float*)(p.ws + OFF_PF);
  u16* yrw = (u16*)(p.ws + OFF_BIG + B_YRW);
  u16* yret = (u16*)(p.ws + OFF_BIG + B_YRET);
  const float* mu = p.in[3] + l * 1792;
  for (int task = bid; task < 48; task += nb) {
    const int b = task / 12, hh = task % 12;
    const float* pf = PF + b * PF_COLS;
    const size_t t0 = (size_t)b * SEQ;
    __syncthreads();
    if (hh < 8) {
      const int h = hh;
      if (tid < 64) smf[tid] = pf[1600 + tid] * (1.f - mu[1600 + tid]);
      if (tid < 128) smf[64 + tid] = sigmoidf_(pf[1664 + tid] * (1.f - mu[1664 + tid]));
      __syncthreads();
      if (tid < 64) {
        const int ch = h * 64 + tid;
        const float r = pf[ch] * (1.f - mu[ch]);
        const float k = pf[512 + ch] * (1.f - mu[512 + ch]);
        const float v = pf[1024 + ch] * (1.f - mu[1024 + ch]);
        const float* aup = p.in[7] + (size_t)l * 64 * 512;
        const float* gup = p.in[8] + (size_t)l * 128 * 512;
        float al = p.in[6][l * 512 + ch], g = 0.f;
        for (int j = 0; j < 64; ++j) al += smf[j] * aup[j * 512 + ch];
        for (int j = 0; j < 128; ++j) g += smf[64 + j] * gup[j * 512 + ch];
        const float a = sigmoidf_(al);
        const float kp = k * (1.f + (a - 1.f) * p.in[10][l * 512 + ch]);
        const float s = wave_sum(kp * r);
        const float bon = wave_sum(r * kp * p.in[11][l * 512 + ch]);
        const float y = v * s;
        const float mean = wave_sum(y) * (1.f / 64.f);
        const float d = y - mean;
        const float var = wave_sum(d * d) * (1.f / 64.f);
        const float o = (d * rsqrtf(var + 64e-5f) * p.in[12][l * 512 + ch] + p.in[13][l * 512 + ch] + bon * v) * g;
        yrw[t0 * 512 + ch] = f2bf(o);
      }
    } else {
      const int h = hh - 8;
      float part = 0.f;
      if (tid < 64) part = pf[1792 + h * 64 + tid] * pf[1792 + 256 + h * 64 + tid];
      if (tid < 64) { part = wave_sum(part); if (lane == 0) smf[0] = part * 0.125f; }
      __syncthreads();
      const float s = smf[0];
      float y = 0.f;
      if (tid < 128) y = s * pf[1792 + 512 + h * 128 + tid];
      float q = wave_sum(y * y);
      if (tid < 128 && lane == 0) smf[1 + (tid >> 6)] = q;
      __syncthreads();
      if (tid < 128) {
        const float ms = (smf[1] + smf[2]) * (1.f / 128.f);
        const float g = pf[1792 + 1024 + h * 128 + tid];
        yret[t0 * 512 + h * 128 + tid] = f2bf(y * rsqrtf(ms + 1e-6f) * siluf_(g));
      }
    }
  }
}

namespace pg8 {
#define PG8_LAS __attribute__((address_space(3)))
typedef unsigned short bf16_t;
typedef short bf16x8 __attribute__((ext_vector_type(8)));
typedef float f32x4 __attribute__((ext_vector_type(4)));
typedef unsigned u32x4 __attribute__((ext_vector_type(4)));
constexpr int BM = 256, BK = 64, HALF = 128, HTB = HALF * BK * 2  , STAGE_BYTES = 8 * HTB, NXCD = 8, WGM = 8;

__host__ __device__ __forceinline__ int lds_byte(int r, int c) { const int st = (r >> 4) * 2 + (c >> 5), rr = r & 15, cc = c & 31, ob = rr * 64 + cc * 2; return st * 1024 + (ob ^ (((ob >> 9) & 1) << 5)); }
__host__ __device__ __forceinline__ void stage_rc(int b, int& R, int& C) { const int st = b / 1024, sb = b % 1024, swz = sb ^ (((sb >> 9) & 1) << 5); R = (st >> 1) * 16 + swz / 64; C = (st & 1) * 32 + (swz % 64) / 2; }
__host__ __device__ __forceinline__ int perm32(int rho) { const int n = rho >> 4, i = rho & 15; return 8 * (i >> 2) + 4 * n + (i & 3); }

struct Unit { int pm, pn, arow, slot; };
struct Gemm { const bf16_t* A; const bf16_t* Bt; int M, N, K; };

struct StaticOrder {
    int nM, nN, nwg, G, c;
    __host__ __device__ void init(int M, int N, int G_, int c_) { nM = M / BM; nN = N / BM; nwg = nM * nN; G = G_; c = c_; }
    __host__ __device__ bool next(int i, Unit& u) const {
        const long L = (long)i * G + c; if (L >= nwg) return false;
        int wgid = (int)L; { const int q = nwg / NXCD, r = nwg % NXCD, xcd = wgid % NXCD, off = wgid / NXCD; wgid = (xcd < r ? xcd * (q + 1) : r * (q + 1) + (xcd - r) * q) + off; }
        const int nig = WGM * nN, gid = wgid / nig, fm = gid * WGM, gsz = (nM - fm) < WGM ? (nM - fm) : WGM;
        u.pm = fm + ((wgid % nig) % gsz); u.pn = (wgid % nig) / gsz; u.arow = u.pm * BM; u.slot = i & 1; return true;
    }
    __device__ __forceinline__ void a_ready(const Unit&) const {}
    __device__ __forceinline__ void done(const Unit&) const {}
};

__device__ __forceinline__ unsigned cvt_pk_bf16(float lo, float hi) { unsigned r; asm volatile("v_cvt_pk_bf16_f32 %0, %1, %2" : "=v"(r) : "v"(lo), "v"(hi)); return r; }

template <class Epi, class Sched, bool STAMP = false>
__device__ __forceinline__ void gemm_phase(PG8_LAS unsigned char* lds, const Gemm g, const Sched& S, const Epi& E, unsigned long long* stamps) {
    const int tid = my_tid(), wid = __builtin_amdgcn_readfirstlane(tid >> 6), lane = tid & 63, wr = wid >> 2, wc = wid & 3, fr = lane & 15, fq = lane >> 4;
    const int K = g.K, nt = K / BK;
    int ts_lo = 0, ts_hi = 0, nts = 0; const unsigned long long rt_entry = STAMP ? (unsigned long long)wall_clock64() : 0ull;
#define PG8_STAMP() do { if (STAMP && wid == 0 && nts < 64) { const unsigned long long _c = (unsigned long long)clock64(); \
        ts_lo = (lane == nts) ? (int)(unsigned)_c : ts_lo; ts_hi = (lane == nts) ? (int)(unsigned)(_c >> 32) : ts_hi; ++nts; } } while (0)
    PG8_STAMP();
    unsigned voffA[2], voffB[2];
#pragma unroll
    for (int i = 0; i < 2; ++i) { int R, C; stage_rc(tid * 16 + i * 8192, R, C); const int Rb = Epi::PERM ? ((R & ~31) + perm32(R & 31)) : R;
        voffA[i] = (unsigned)(R * K + C) * 2u; voffB[i] = (unsigned)(Rb * K + C) * 2u; }
    const size_t kstep = (size_t)(BK * 2);
    const size_t hstep = (size_t)HALF * K * 2;
    const size_t tstep = 2 * hstep;
    const unsigned ldsw = (unsigned)wid * 1024u;
    const int aoff = lds_byte(wr * 64 + fr, fq * 8), boff = lds_byte(wc * 32 + fr, fq * 8);
#define PG8_SA(b, h) (((b) * 2 + (h)) * HTB)
#define PG8_SB(b, h) ((4 + (b) * 2 + (h)) * HTB)
#define PG8_STAGE(bufoff, gbase, voff) do { _Pragma("unroll") for (int _i = 0; _i < 2; ++_i) \
        __builtin_amdgcn_global_load_lds((const unsigned*)((const char*)(gbase) + (voff)[_i]), (PG8_LAS unsigned*)(lds + (bufoff) + ldsw + _i * 8192), 16, 0, 0); } while (0)
#define PG8_LDA(dst, b, h) do { _Pragma("unroll") for (int m = 0; m < 4; ++m) _Pragma("unroll") for (int k = 0; k < 2; ++k) dst[m][k] = *(const PG8_LAS bf16x8*)(lds + PG8_SA(b, h) + aoff + m * 2048 + k * 1024); } while (0)
#define PG8_LDB(dst, b, h) do { _Pragma("unroll") for (int n = 0; n < 2; ++n) _Pragma("unroll") for (int k = 0; k < 2; ++k) dst[n][k] = *(const PG8_LAS bf16x8*)(lds + PG8_SB(b, h) + boff + n * 2048 + k * 1024); } while (0)
#define PG8_MMA(ai, bj, At, Bt) do { __builtin_amdgcn_s_setprio(1); _Pragma("unroll") for (int m = 0; m < 4; ++m) _Pragma("unroll") for (int n = 0; n < 2; ++n) _Pragma("unroll") for (int k = 0; k < 2; ++k) \
        acc[ai][bj][m][n] = __builtin_amdgcn_mfma_f32_16x16x32_bf16(Bt[n][k], At[m][k], acc[ai][bj][m][n], 0, 0, 0); __builtin_amdgcn_s_setprio(0); } while (0)
#define PG8_WAIT_V(n) asm volatile("s_waitcnt vmcnt(" #n ")" ::: "memory")
#define PG8_WAIT_L(n) asm volatile("s_waitcnt lgkmcnt(" #n ")" ::: "memory")
#define PG8_BAR __builtin_amdgcn_s_barrier()
#define PG8_SCHED __builtin_amdgcn_sched_barrier(0)
    Unit cur, nxt; int ui = 0;
    if (!S.next(0, cur)) return;
    f32x4 acc[2][2][4][2];
#pragma unroll
    for (int a = 0; a < 2; ++a)
#pragma unroll
        for (int b = 0; b < 2; ++b)
#pragma unroll
            for (int m = 0; m < 4; ++m)
#pragma unroll
                for (int n = 0; n < 2; ++n) acc[a][b][m][n] = (f32x4){0.f, 0.f, 0.f, 0.f};
    bf16x8 At[4][2], B0[2][2], B1[2][2];
    const char* cA = (const char*)g.A + (long)cur.arow * (long)(K * 2); const char* cB = (const char*)g.Bt + (size_t)cur.pn * tstep;
    S.a_ready(cur);
    PG8_STAGE(PG8_SB(0, 0), cB, voffB); PG8_STAGE(PG8_SA(0, 0), cA, voffA); PG8_STAGE(PG8_SB(0, 1), cB + hstep, voffB); PG8_STAGE(PG8_SA(0, 1), cA + hstep, voffA);
    if (wr == 1) PG8_BAR;
    PG8_WAIT_V(4); PG8_BAR;
    PG8_STAGE(PG8_SB(1, 0), cB + kstep, voffB); PG8_STAGE(PG8_SA(1, 0), cA + kstep, voffA); PG8_STAGE(PG8_SB(1, 1), cB + hstep + kstep, voffB);
    PG8_WAIT_V(6); PG8_BAR;
    PG8_STAMP();
    for (;;) {
        const bool has_next = S.next(ui + 1, nxt);
        const char* nA = has_next ? (const char*)g.A + (long)nxt.arow * (long)(K * 2) : cA; const char* nB = has_next ? (const char*)g.Bt + (size_t)nxt.pn * tstep : cB;
        for (int t = 0; t < nt; t += 2) {
            const bool last = (t == nt - 2);
            const char* a1 = cA + (size_t)(t + 1) * kstep;
            const char* a2 = last ? nA : cA + (size_t)(t + 2) * kstep; const char* b2 = last ? nB : cB + (size_t)(t + 2) * kstep;
            const char* a3 = a2 + kstep; const char* b3 = b2 + kstep;
            if (last && has_next) S.a_ready(nxt);
            PG8_LDB(B0, 0, 0); PG8_SCHED; PG8_LDA(At, 0, 0); PG8_STAGE(PG8_SA(1, 1), a1 + hstep, voffA);
            PG8_WAIT_L(8); PG8_BAR; PG8_WAIT_L(0); PG8_MMA(0, 0, At, B0); PG8_BAR; PG8_SCHED;
            PG8_LDB(B1, 0, 1); PG8_STAGE(PG8_SB(0, 0), b2, voffB);
            PG8_BAR; PG8_WAIT_L(0); PG8_MMA(0, 1, At, B1); PG8_BAR;
            PG8_LDA(At, 0, 1); PG8_STAGE(PG8_SA(0, 0), a2, voffA);
            PG8_BAR; PG8_WAIT_L(0); PG8_MMA(1, 0, At, B0); PG8_BAR; PG8_SCHED;
            PG8_STAGE(PG8_SB(0, 1), b2 + hstep, voffB);
            PG8_WAIT_V(6); PG8_BAR; PG8_MMA(1, 1, At, B1); PG8_BAR;
            PG8_LDB(B0, 1, 0); PG8_SCHED; PG8_LDA(At, 1, 0); PG8_STAGE(PG8_SA(0, 1), a2 + hstep, voffA);
            PG8_WAIT_L(8); PG8_BAR; PG8_WAIT_L(0); PG8_MMA(0, 0, At, B0); PG8_BAR; PG8_SCHED;
            PG8_LDB(B1, 1, 1); PG8_STAGE(PG8_SB(1, 0), b3, voffB);
            PG8_BAR; PG8_WAIT_L(0); PG8_MMA(0, 1, At, B1); PG8_BAR;
            PG8_LDA(At, 1, 1); PG8_STAGE(PG8_SA(1, 0), a3, voffA);
            PG8_BAR; PG8_WAIT_L(0); PG8_MMA(1, 0, At, B0); PG8_BAR; PG8_SCHED;
            PG8_STAGE(PG8_SB(1, 1), b3 + hstep, voffB);
            PG8_WAIT_V(6); PG8_BAR; PG8_MMA(1, 1, At, B1); PG8_BAR;
        }
        PG8_STAMP();
        if constexpr (!Epi::AFTER_DRAIN) { E(acc, cur, wr, wc, fr, fq); S.done(cur); }
        PG8_STAMP();
        if (!has_next) break;
#pragma unroll
        for (int a = 0; a < 2; ++a)
#pragma unroll
            for (int b = 0; b < 2; ++b)
#pragma unroll
                for (int m = 0; m < 4; ++m)
#pragma unroll
                    for (int n = 0; n < 2; ++n) acc[a][b][m][n] = (f32x4){0.f, 0.f, 0.f, 0.f};
        cur = nxt; cA = nA; cB = nB; ++ui;
    }
    PG8_WAIT_V(0);
    if (wr == 0) PG8_BAR;
    PG8_BAR;
    if constexpr (Epi::AFTER_DRAIN) { E.fused(acc, cur, wr, wc, fr, fq, lds, wid, lane); S.done(cur); }
    PG8_STAMP();
    if (STAMP && wid == 0) { stamps[lane] = lane < nts ? (((unsigned long long)(unsigned)ts_hi << 32) | (unsigned)ts_lo) : 0ull;
        if (lane == 62) stamps[62] = rt_entry; if (lane == 63) stamps[63] = (unsigned long long)wall_clock64(); }
#undef PG8_STAMP
#undef PG8_SA
#undef PG8_SB
#undef PG8_STAGE
#undef PG8_LDA
#undef PG8_LDB
#undef PG8_MMA
#undef PG8_WAIT_V
#undef PG8_WAIT_L
#undef PG8_BAR
#undef PG8_SCHED
}
}

struct EpiInproj {
  static constexpr bool PERM = true, AFTER_DRAIN = false;
  u16* O; int ldc; const float* ssq;
  __device__ __forceinline__ void operator()(const pg8::f32x4 (&acc)[2][2][4][2], const pg8::Unit& u, int wr, int wc, int fr, int fq) const {
    const int row0 = u.pm * 256 + wr * 64 + fr, col0 = u.pn * 256 + wc * 32 + 8 * fq;
#pragma unroll
    for (int ai = 0; ai < 2; ++ai)
#pragma unroll
      for (int m = 0; m < 4; ++m) {
        const int row = row0 + ai * 128 + m * 16;
        const float rs = ssq ? rsqrtf(ssq[row] * (1.0f / DM) + 1e-6f) : 1.0f;
        u16* rowp = O + (size_t)row * ldc + col0;
#pragma unroll
        for (int bj = 0; bj < 2; ++bj) {
          const pg8::f32x4 v0 = acc[ai][bj][m][0] * rs, v1 = acc[ai][bj][m][1] * rs;
          u32x4 w;
          w.x = pack2(v0[0], v0[1]); w.y = pack2(v0[2], v0[3]); w.z = pack2(v1[0], v1[1]); w.w = pack2(v1[2], v1[3]);
          *(u32x4*)(rowp + bj * 128) = w;
        }
      }
  }
};
struct EpiRes {
  static constexpr bool PERM = false, AFTER_DRAIN = false;
  const float* xin; float* xout; u16* xbo; float* ssq;
  __device__ __forceinline__ void operator()(const pg8::f32x4 (&acc)[2][2][4][2], const pg8::Unit& u, int wr, int wc, int fr, int fq) const {
    const int row0 = u.pm * 256 + wr * 64 + fr, col0 = u.pn * 256 + wc * 32 + 4 * fq;
#pragma unroll
    for (int ai = 0; ai < 2; ++ai)
#pragma unroll
      for (int m = 0; m < 4; ++m) {
        const int row = row0 + ai * 128 + m * 16;
        float sq = 0.f;
#pragma unroll
        for (int bj = 0; bj < 2; ++bj)
#pragma unroll
          for (int n = 0; n < 2; ++n) {
            const size_t o = (size_t)row * DM + col0 + bj * 128 + n * 16;
            const pg8::f32x4 y = *(const pg8::f32x4*)(xin + o) + acc[ai][bj][m][n];
            *(pg8::f32x4*)(xout + o) = y;
            if (xbo) {
              *(uint2*)(xbo + o) = make_uint2(pack2(y[0], y[1]), pack2(y[2], y[3]));
              sq += y[0] * y[0] + y[1] * y[1] + y[2] * y[2] + y[3] * y[3];
            }
          }
        if (xbo) {
          sq += __shfl_xor(sq, 16);
          sq += __shfl_xor(sq, 32);
          if (fq == 0) atomicAdd(ssq + row, sq);
        }
        __builtin_amdgcn_sched_barrier(0);
      }
  }
};
struct EpiGate {
  static constexpr bool PERM = true, AFTER_DRAIN = false;
  u16* Mo; const u16* P; const float* ssq; int first;
  __device__ __forceinline__ void operator()(const pg8::f32x4 (&acc)[2][2][4][2], const pg8::Unit& u, int wr, int wc, int fr, int fq) const {
    const int row0 = u.pm * 256 + wr * 64 + fr, col0 = u.pn * 256 + wc * 32 + 8 * fq;
#pragma unroll
    for (int ai = 0; ai < 2; ++ai)
#pragma unroll
      for (int m = 0; m < 4; ++m) {
        const int row = row0 + ai * 128 + m * 16;
        const float rs = rsqrtf(ssq[row] * (1.0f / DM) + 1e-6f);
#pragma unroll
        for (int bj = 0; bj < 2; ++bj) {
          const size_t o = (size_t)row * DM + col0 + bj * 128;
          float pv[8], mv[8];
          unpack8(*(const uint4*)(P + o), pv);
          if (!first) unpack8(*(const uint4*)(Mo + o), mv);
          else {
#pragma unroll
            for (int j = 0; j < 8; ++j) mv[j] = 0.f;
          }
#pragma unroll
          for (int j = 0; j < 4; ++j) {
            mv[j] += sigmoidf_(acc[ai][bj][m][0][j] * rs) * pv[j];
            mv[4 + j] += sigmoidf_(acc[ai][bj][m][1][j] * rs) * pv[4 + j];
          }
          *(uint4*)(Mo + o) = pack8(mv);
        }
        __builtin_amdgcn_sched_barrier(0);
      }
  }
};
struct FfnOrder : pg8::StaticOrder {
  __device__ bool next(int i, pg8::Unit& u) const {
    if (!pg8::StaticOrder::next(i, u)) return false;
    const int b = u.pm / 33, mi = u.pm % 33;
    u.arow = b * SEQ + mi * 254 - 2;
    return true;
  }
};
struct EpiFfn {
  static constexpr bool PERM = true, AFTER_DRAIN = false;
  const Params* pp; int l; int bid;
  __device__ __forceinline__ void operator()(const pg8::f32x4 (&acc)[2][2][4][2], const pg8::Unit& u, int wr, int wc, int fr, int fq) const {
    const int b = u.pm / 33, mi = u.pm % 33;
    const int tokbase = b * SEQ + mi * 254 - 2, tbeg = b * SEQ, tend = (b + 1) * SEQ;
    asm volatile("" : "+v"(fr), "+v"(fq));
    u16* act = (u16*)(pp->ws + OFF_BIG + B_ACT);
    const float* ssq = (const float*)(pp->ws + OFF_RSTD) + (size_t)(2 * l + 1) * NTOK;
    const float* cw = pp->in[22] + (size_t)l * 3 * 2 * DFF;
    const float* cb = pp->in[23] + (size_t)l * 2 * DFF;
    u16* S = (u16*)(pp->ws + OFF_BIG + 192 * MiB) + (size_t)bid * 131072 + (size_t)u.slot * 65536;
#pragma unroll
    for (int ai = 0; ai < 2; ++ai)
#pragma unroll
      for (int m = 0; m < 4; ++m) {
        const int r = ai * 128 + wr * 64 + m * 16 + fr;
        int tk = tokbase + r; tk = tk < 0 ? 0 : (tk > NTOK - 1 ? NTOK - 1 : tk);
        const float rs = rsqrtf(ssq[tk] * (1.0f / DM) + 1e-6f);
#pragma unroll
        for (int bj = 0; bj < 2; ++bj) {
          const pg8::f32x4 v0 = acc[ai][bj][m][0] * rs, v1 = acc[ai][bj][m][1] * rs;
          u32x4 w;
          w.x = pack2(v0[0], v0[1]); w.y = pack2(v0[2], v0[3]); w.z = pack2(v1[0], v1[1]); w.w = pack2(v1[2], v1[3]);
          *(u32x4*)(S + r * 256 + bj * 128 + wc * 32 + 8 * fq) = w;
        }
      }
    asm volatile("s_waitcnt vmcnt(0)" ::: "memory");
    __builtin_amdgcn_s_barrier();
    __builtin_amdgcn_s_barrier();
    asm volatile("" ::: "memory");
    const int tid = my_tid(), cc = tid & 31, rg = tid >> 5;
    const int gcol = u.pn * 128 + cc * 4, vcol = DFF + gcol;
    float wg[3][4], wv[3][4], bg[4], bv[4];
#pragma unroll
    for (int q = 0; q < 3; ++q) {
      const float4 a0 = *(const float4*)(cw + q * 2 * DFF + gcol);
      const float4 c0 = *(const float4*)(cw + q * 2 * DFF + vcol);
      wg[q][0] = a0.x; wg[q][1] = a0.y; wg[q][2] = a0.z; wg[q][3] = a0.w;
      wv[q][0] = c0.x; wv[q][1] = c0.y; wv[q][2] = c0.z; wv[q][3] = c0.w;
    }
    {
      const float4 a0 = *(const float4*)(cb + gcol);
      const float4 c0 = *(const float4*)(cb + vcol);
      bg[0] = a0.x; bg[1] = a0.y; bg[2] = a0.z; bg[3] = a0.w;
      bv[0] = c0.x; bv[1] = c0.y; bv[2] = c0.z; bv[3] = c0.w;
    }
    uint2 rgt[18], rvl[18];
#pragma unroll
    for (int q = 0; q < 18; ++q) {
      int r = rg * 16 + q - 2; r = r < 0 ? 0 : r;
      rgt[q] = *(const uint2*)(S + r * 256 + cc * 4);
      rvl[q] = *(const uint2*)(S + r * 256 + 128 + cc * 4);
    }
    float g2[4], g1[4], v2[4], v1[4];
#define UNP4(src_, dst_) { dst_[0] = __uint_as_float(src_.x << 16); dst_[1] = __uint_as_float(src_.x & 0xffff0000u); dst_[2] = __uint_as_float(src_.y << 16); dst_[3] = __uint_as_float(src_.y & 0xffff0000u); }
    {
      const bool z0 = (tokbase + rg * 16 - 2) < tbeg, z1 = (tokbase + rg * 16 - 1) < tbeg;
      UNP4(rgt[0], g2); UNP4(rvl[0], v2); UNP4(rgt[1], g1); UNP4(rvl[1], v1);
#pragma unroll
      for (int j = 0; j < 4; ++j) { if (z0) { g2[j] = 0.f; v2[j] = 0.f; } if (z1) { g1[j] = 0.f; v1[j] = 0.f; } }
    }
#pragma unroll
    for (int q = 2; q < 18; ++q) {
      const int r = rg * 16 + q - 2;
      const int tk = tokbase + r;
      float g0[4], v0[4], o[4];
      UNP4(rgt[q], g0); UNP4(rvl[q], v0);
      if (tk < tbeg) {
#pragma unroll
        for (int j = 0; j < 4; ++j) { g0[j] = 0.f; v0[j] = 0.f; }
      }
#pragma unroll
      for (int j = 0; j < 4; ++j) {
        const float cg = bg[j] + wg[0][j] * g2[j] + wg[1][j] * g1[j] + wg[2][j] * g0[j];
        const float cv = bv[j] + wv[0][j] * v2[j] + wv[1][j] * v1[j] + wv[2][j] * v0[j];
        o[j] = siluf_(cg) * cv;
        g2[j] = g1[j]; g1[j] = g0[j]; v2[j] = v1[j]; v1[j] = v0[j];
      }
      if (r >= 2 && tk < tend) *(uint2*)(act + (size_t)tk * DFF + u.pn * 128 + cc * 4) = make_uint2(pack2(o[0], o[1]), pack2(o[2], o[3]));
    }
#undef UNP4
  }
};
template <class Epi>
DEV void pg8_gemm(unsigned char* smraw, const u16* A, const u16* Bt, int M, int N, int K, const Epi& E, int bid, int nb) {
  pg8::Gemm g{A, Bt, M, N, K};
  pg8::StaticOrder S;
  S.init(M, N, nb, bid);
  pg8::gemm_phase<Epi, pg8::StaticOrder, false>((PG8_LAS unsigned char*)smraw, g, S, E, nullptr);
}

#define PPL 17
#define NPHASE (2 + 2 * PPL)
template <int ph>
DEV void run_phase(const Params& p, unsigned char* smraw, int bid, int nb) {
  u16* smem = (u16*)smraw;
  float* smf = (float*)smraw;
  float* xo = p.out;
  u16* xb = (u16*)(p.ws + OFF_XB);
  float* ssq_all = (float*)(p.ws + OFF_RSTD);
  if (ph == 0) { phase_prep(p, smf, bid, nb); return; }
  if (ph == NPHASE - 1) { phase_final(xo, p.in[25], bid, nb); return; }
  const int l = (ph - 1) / PPL, s = (ph - 1) % PPL;
  const float* xcur = (l == 0) ? p.in[0] : xo;
  unsigned char* W = p.ws + OFF_W + (size_t)l * LW_BYTES;
  float* ssq1 = ssq_all + (size_t)(2 * l) * NTOK;
  float* ssq2 = ssq_all + (size_t)(2 * l + 1) * NTOK;
  switch (s) {
    case 0: if (l == 0) phase_norm(xcur, xb, ssq1, bid, nb); break;
    case 1: { EpiInproj E{(u16*)(p.ws + OFF_BIG + B_PRW), 1792, ssq1}; pg8_gemm(smraw, xb, (const u16*)(W + W_IN), NTOK, 1792, DM, E, bid, nb); } break;
    case 2: phase_rwprep(p, l, smem, bid, nb); break;
    case 3: phase_scan<1>(p, l, smf, bid, nb); break;
    case 4: phase_scanprop(p, smf, bid, nb); first_tok_proj(p, l, xcur, smf, nb - 1 - bid, nb); break;
    case 5: phase_scan<3>(p, l, smf, bid, nb); break;
    case 6: { EpiInproj E{(u16*)(p.ws + OFF_BIG + B_PRS), 2560, ssq1}; pg8_gemm(smraw, xb, (const u16*)(W + W_IN) + (size_t)1792 * DM, NTOK, 2560, DM, E, bid, nb); } break;
    case 7:
      for (int u = bid; u < 1024; u += nb) ret_kv_unit(p, u, smem);
      for (int u = bid; u < 256; u += nb) sgu_unit(p, l, u, smem);
      break;
    case 8: phase_retprefix(p, bid, nb); break;
    case 9:
      for (int u = bid; u < 1024; u += nb) ret_out_unit(p, u, smem);
      first_tok_fix(p, l, smf, nb - 1 - bid, nb);
      break;
    case 10: {
      const u16* wbr = (const u16*)(W + W_BR);
      for (int g = 0; g < 3; ++g) {
        const u16* yg = (const u16*)(p.ws + OFF_BIG + (g == 0 ? B_YRW : (g == 1 ? B_YRET : B_YSG)));
        EpiInproj E{(u16*)(p.ws + OFF_BIG + B_P) + (size_t)g * NTOK * DM, DM, nullptr};
        pg8_gemm(smraw, yg, wbr + (size_t)g * DM * 512, NTOK, DM, 512, E, bid, nb);
      }
    } break;
    case 11: case 12: case 13: {
      const int g = s - 11;
      EpiGate E{(u16*)(p.ws + OFF_BIG + B_M), (const u16*)(p.ws + OFF_BIG + B_P) + (size_t)g * NTOK * DM, ssq1, g == 0 ? 1 : 0};
      pg8_gemm(smraw, xb, (const u16*)(W + W_IN) + (size_t)(4352 + g * DM) * DM, NTOK, DM, DM, E, bid, nb);
    } break;
    case 14: { EpiRes E{xcur, xo, xb, ssq2}; pg8_gemm(smraw, (const u16*)(p.ws + OFF_BIG + B_M), (const u16*)(W + W_OUT), NTOK, DM, DM, E, bid, nb); } break;
    case 15: {
      FfnOrder S;
      S.init(132 * 256, 2 * DFF, nb, bid);
      EpiFfn E{&p, l, bid};
      pg8::Gemm g{xb, (const u16*)(W + W_UP), 132 * 256, 2 * DFF, DM};
      pg8::gemm_phase<EpiFfn, FfnOrder, false>((PG8_LAS unsigned char*)smraw, g, S, E, nullptr);
    } break;
    case 16: {
      EpiRes E{xo, xo, (l == 0) ? xb : nullptr, (l == 0) ? ssq_all + (size_t)2 * NTOK : nullptr};
      pg8_gemm(smraw, (const u16*)(p.ws + OFF_BIG + B_ACT), (const u16*)(W + W_DN), NTOK, DM, DFF, E, bid, nb);
    } break;
  }
}
DEV constexpr bool phase_empty(int ph) {
  return ph >= 1 && ph < NPHASE - 1 && ((ph - 1) % PPL == 0 && (ph - 1) / PPL == 1);
}

DEV void gsync(unsigned* ctr, unsigned& target) {
  asm volatile("s_waitcnt vmcnt(0)" ::: "memory");
  __syncthreads();
  if (my_tid() == 0) {
    target += gridDim.x;
    __builtin_amdgcn_fence(__ATOMIC_RELEASE, "agent");
    asm volatile("s_waitcnt vmcnt(0)" ::: "memory");
    __hip_atomic_fetch_add(ctr, 1u, __ATOMIC_RELAXED, __HIP_MEMORY_SCOPE_AGENT);
    while (__hip_atomic_load(ctr, __ATOMIC_RELAXED, __HIP_MEMORY_SCOPE_AGENT) < target) __builtin_amdgcn_s_sleep(2);
    __builtin_amdgcn_fence(__ATOMIC_ACQUIRE, "agent");
    asm volatile("s_waitcnt vmcnt(0)" ::: "memory");
  }
  __syncthreads();
}

#if COOP
template <int PH>
DEV void run_seq(const Params& p, unsigned char* smraw, cg::grid_group& grid, unsigned& target) {
  if constexpr (phase_empty(PH)) {
    run_seq<PH + 1>(p, smraw, grid, target);
  } else {
    int bid_ = blockIdx.x;
    asm volatile("" : "+s"(bid_));
    run_phase<PH>(p, smraw, bid_, gridDim.x);
    if constexpr (PH + 1 < NPHASE) {
      if constexpr (PH == 0) grid.sync();
      else gsync((unsigned*)p.ws, target);
      run_seq<PH + 1>(p, smraw, grid, target);
    }
  }
}
__global__ void __launch_bounds__(NTHR) mega(Params p) {
  __shared__ __align__(16) unsigned char smraw[147456];
  cg::grid_group grid = cg::this_grid();
  unsigned target = 0;
  run_seq<0>(p, smraw, grid, target);
}
#else
template <int PH>
__global__ void __launch_bounds__(NTHR) phk(Params p) {
  __shared__ __align__(16) unsigned char smraw[147456];
  run_phase<PH>(p, smraw, blockIdx.x, gridDim.x);
}
template <int PH>
static void launch_seq(const Params& p, hipStream_t stream) {
  phk<PH><<<256, NTHR, 0, stream>>>(p);
  if constexpr (PH + 1 < NPHASE) launch_seq<PH + 1>(p, stream);
}
#endif

extern "C" void kernel_launch(void* const* d_in, const int* in_sizes, int n_in, void* d_out, int out_size, void* d_ws,
                              size_t ws_size, hipStream_t stream) {
  Params p{};
  for (int i = 0; i < 26; ++i) p.in[i] = (const float*)d_in[i];
  p.out = (float*)d_out;
  p.ws = (unsigned char*)d_ws;
  if (ws_size < WS_NEED) { fprintf(stderr, "workspace too small: %zu < %llu\n", ws_size, (unsigned long long)WS_NEED); return; }
#if COOP
  static int grid_blocks = 0;
  if (!grid_blocks) {
    int dev = 0, cus = 0, per_cu = 0;
    hipGetDevice(&dev);
    hipDeviceGetAttribute(&cus, hipDeviceAttributeMultiprocessorCount, dev);
    hipOccupancyMaxActiveBlocksPerMultiprocessor(&per_cu, mega, NTHR, 0);
    if (per_cu > 1) per_cu = 1;
    grid_blocks = cus * per_cu;
  }
  hipMemsetAsync(d_ws, 0, 256, stream);
  void* args[] = {&p};
  hipError_t e = hipLaunchCooperativeKernel((void*)mega, dim3(grid_blocks), dim3(NTHR), args, 0, stream);
  if (e != hipSuccess) fprintf(stderr, "cooperative launch failed: %s (grid %d)\n", hipGetErrorString(e), grid_blocks);
#else
  launch_seq<0>(p, stream);
#endif
}
```

```cpp
#include <hip/hip_runtime.h>
#include <hip/hip_cooperative_groups.h>
#include <cstdio>
#include <cstdint>
namespace cg = cooperative_groups;

#ifndef COOP
#define COOP 1
#endif

#define DEV __device__ __forceinline__
typedef unsigned short u16;
typedef short bf16x8 __attribute__((ext_vector_type(8)));
typedef float f32x16 __attribute__((ext_vector_type(16)));

#define NTHR 512
#define NTOK 32768
#define SEQ 8192
#define DM 1024
#define INC 7424
#define DFF 2816
#define MiB (1048576ull)

#define OFF_ROPE (64ull * 1024)
#define OFF_RSTD (OFF_ROPE + 2 * MiB)
#define OFF_PF (OFF_RSTD + 640ull * 1024)
#define OFF_W (3 * MiB)
#define LW_BYTES (37 * MiB)
#define W_IN 0ull
#define W_BR 15204352ull
#define W_OUT 18350080ull
#define W_UP 20447232ull
#define W_DN 31981568ull
#define W_RWUP 37748736ull
#define W_RAUP 37814272ull
#define W_RGUP 37879808ull
#define W_SGW 38010880ull
#define OFF_XB (77 * MiB)
#define OFF_BIG (141 * MiB)
#define B_PRW 0ull
#define B_YRW 0ull
#define B_YRET (32 * MiB)
#define B_YSG (64 * MiB)
#define B_OPS (112 * MiB)
#define B_PRS (112 * MiB)
#define B_KV (272 * MiB)
#define B_M 0ull
#define B_P (128 * MiB)
#define B_PL (304 * MiB)
#define B_SINIT (320 * MiB)
#define B_ACT 0ull
#define WS_NEED (OFF_BIG + 328 * MiB)

struct Params {
  const float* in[26];
  float* out;
  unsigned char* ws;
};

DEV int my_tid() {
  int t = __builtin_amdgcn_workitem_id_x();
  asm volatile("" : "+v"(t));
  return t;
}
DEV u16 f2bf(float f) {
  unsigned u = __float_as_uint(f);
  u += 0x7fffu + ((u >> 16) & 1u);
  return (u16)(u >> 16);
}
DEV float bf2f(u16 h) { return __uint_as_float(((unsigned)h) << 16); }
DEV unsigned pack2(float a, float b) { return (unsigned)f2bf(a) | ((unsigned)f2bf(b) << 16); }
DEV void unpack8(uint4 v, float* f) {
  f[0] = __uint_as_float(v.x << 16); f[1] = __uint_as_float(v.x & 0xffff0000u);
  f[2] = __uint_as_float(v.y << 16); f[3] = __uint_as_float(v.y & 0xffff0000u);
  f[4] = __uint_as_float(v.z << 16); f[5] = __uint_as_float(v.z & 0xffff0000u);
  f[6] = __uint_as_float(v.w << 16); f[7] = __uint_as_float(v.w & 0xffff0000u);
}
DEV uint4 pack8(const float* f) {
  return make_uint4(pack2(f[0], f[1]), pack2(f[2], f[3]), pack2(f[4], f[5]), pack2(f[6], f[7]));
}
template <int CTRL>
DEV float dppmov(float x) {
  return __builtin_bit_cast(float, __builtin_amdgcn_update_dpp(0, __builtin_bit_cast(int, x), CTRL, 0xF, 0xF, true));
}
DEV float red4(float x) { x += dppmov<0xB1>(x); x += dppmov<0x4E>(x); return x; }
DEV float red8(float x) { x = red4(x); x += dppmov<0x141>(x); return x; }
DEV float wave_sum(float x) {
  x = red8(x);
  x += dppmov<0x140>(x);
  const int xi = __builtin_bit_cast(int, x);
  return __builtin_bit_cast(float, __builtin_amdgcn_readlane(xi, 0)) + __builtin_bit_cast(float, __builtin_amdgcn_readlane(xi, 16)) +
         __builtin_bit_cast(float, __builtin_amdgcn_readlane(xi, 32)) + __builtin_bit_cast(float, __builtin_amdgcn_readlane(xi, 48));
}
DEV float sigmoidf_(float x) { return 1.f / (1.f + __expf(-x)); }
DEV float siluf_(float x) { return x / (1.f + __expf(-x)); }
DEV float geluf_(float x) { return 0.5f * x * (1.f + erff(x * 0.70710678118654752f)); }

DEV float rstd_of(const float* ssq, int row) { return rsqrtf(ssq[row] * (1.0f / DM) + 1e-6f); }
DEV int vbid(int bid, int nb) { return ((nb & 7) == 0) ? (bid & 7) * (nb >> 3) + (bid >> 3) : bid; }
DEV void tile_map(int t, int MTL, int NTL, int& m, int& n) {
  int per = 8 * NTL;
  int g = t / per;
  int r = t - g * per;
  int gm = MTL - g * 8; gm = gm > 8 ? 8 : gm;
  m = g * 8 + r % gm;
  n = r / gm;
}

typedef unsigned u32x4 __attribute__((ext_vector_type(4)));
template <int NA>
struct GStage { u32x4 a0, a1, a2, a3, b0, b1; };
DEV u32x4 g_ld_a(const u16* A, long lda, int g, int azero_below, int arow_max, int ko) {
  const bool z = g < azero_below;
  g = g < 0 ? 0 : g;
  g = g > arow_max ? arow_max : g;
  u32x4 v = *(const u32x4*)(A + (long)g * lda + ko);
  const u32x4 zero = {0u, 0u, 0u, 0u};
  return z ? zero : v;
}
template <int NA>
DEV void g_load(GStage<NA>& S, const u16* A, long lda, int arow, int azero_below, int arow_max,
                const u16* bp0, const u16* bp1, int ko) {
  S.a0 = g_ld_a(A, lda, arow, azero_below, arow_max, ko);
  S.a1 = g_ld_a(A, lda, arow + 64, azero_below, arow_max, ko);
  if constexpr (NA == 4) {
    S.a2 = g_ld_a(A, lda, arow + 128, azero_below, arow_max, ko);
    S.a3 = g_ld_a(A, lda, arow + 192, azero_below, arow_max, ko);
  }
  S.b0 = *(const u32x4*)(bp0 + ko);
  S.b1 = *(const u32x4*)(bp1 + ko);
}
template <int NA>
DEV void g_store(const GStage<NA>& S, u16* An, u16* Bn, int st_off) {
  *(u32x4*)(An + st_off) = S.a0;
  *(u32x4*)(An + st_off + 64 * 72) = S.a1;
  if constexpr (NA == 4) {
    *(u32x4*)(An + st_off + 128 * 72) = S.a2;
    *(u32x4*)(An + st_off + 192 * 72) = S.a3;
  }
  *(u32x4*)(Bn + st_off) = S.b0;
  *(u32x4*)(Bn + st_off + 64 * 72) = S.b1;
}
template <int MT>
DEV void g_compute(f32x16 (&acc)[MT][2], const u16* Ab, const u16* Bb) {
#pragma unroll
  for (int ks = 0; ks < 4; ++ks) {
    bf16x8 a[MT], b[2];
#pragma unroll
    for (int i = 0; i < MT; ++i) a[i] = *(const bf16x8*)(Ab + i * 32 * 72 + ks * 16);
#pragma unroll
    for (int j = 0; j < 2; ++j) b[j] = *(const bf16x8*)(Bb + j * 32 * 72 + ks * 16);
#pragma unroll
    for (int i = 0; i < MT; ++i)
#pragma unroll
      for (int j = 0; j < 2; ++j) acc[i][j] = __builtin_amdgcn_mfma_f32_32x32x16_bf16(a[i], b[j], acc[i][j], 0, 0, 0);
  }
}
template <int MT>
DEV void gemm_tile(f32x16 (&acc)[MT][2], const u16* A, long lda, int arow0, int azero_below, int arow_max,
                   const u16* B, long ldb, int K, u16* smem) {
  constexpr int TM = 128 * MT;
  constexpr int ASZ = TM * 72, BSZ = 128 * 72;
  constexpr int NA = TM / 64;
  const int tid = my_tid(), lane = tid & 63, wave = tid >> 6, wm = wave >> 1, wn = wave & 1;
  const int crow = tid >> 3, ckc = tid & 7;
  GStage<NA> s0, s1;
  const u16* Ak = A + ckc * 8;
  const int arow = arow0 + crow;
  const u16* bp0 = B + (long)crow * ldb + ckc * 8;
  const u16* bp1 = B + (long)(crow + 64) * ldb + ckc * 8;
  const int nk = K >> 6;
  const int arow_l = (wm * 32 * MT + (lane & 31)) * 72 + (lane >> 5) * 8;
  const int brow_l = (wn * 64 + (lane & 31)) * 72 + (lane >> 5) * 8;
  const int st_off = crow * 72 + ckc * 8;
  g_load<NA>(s0, Ak, lda, arow, azero_below, arow_max, bp0, bp1, 0);
  g_store<NA>(s0, smem, smem + ASZ, st_off);
  g_load<NA>(s1, Ak, lda, arow, azero_below, arow_max, bp0, bp1, 64);
  __syncthreads();
  for (int kt = 0; kt < nk; kt += 2) {
    if (kt + 2 < nk) g_load<NA>(s0, Ak, lda, arow, azero_below, arow_max, bp0, bp1, (kt + 2) * 64);
    g_compute<MT>(acc, smem + arow_l, smem + ASZ + brow_l);
    g_store<NA>(s1, smem + (ASZ + BSZ), smem + (ASZ + BSZ) + ASZ, st_off);
    __syncthreads();
    if (kt + 3 < nk) g_load<NA>(s1, Ak, lda, arow, azero_below, arow_max, bp0, bp1, (kt + 3) * 64);
    g_compute<MT>(acc, smem + (ASZ + BSZ) + arow_l, smem + (ASZ + BSZ) + ASZ + brow_l);
    if (kt + 2 < nk) g_store<NA>(s0, smem, smem + ASZ, st_off);
    __syncthreads();
  }
}
struct GStageB { u32x4 a0, a1, a2, a3, b0, b1, b2, b3; };
DEV const u16* g_rowptr(const u16* A, long lda, int g, int arow_max) {
  g = g < 0 ? 0 : g;
  g = g > arow_max ? arow_max : g;
  return A + (long)g * lda;
}
DEV void gb_load(GStageB& S, const u16* A, long lda, int arow, int arow_max, const u16* Bk, long ldb, int ko) {
  S.a0 = *(const u32x4*)(g_rowptr(A, lda, arow, arow_max) + ko);
  S.a1 = *(const u32x4*)(g_rowptr(A, lda, arow + 64, arow_max) + ko);
  S.a2 = *(const u32x4*)(g_rowptr(A, lda, arow + 128, arow_max) + ko);
  S.a3 = *(const u32x4*)(g_rowptr(A, lda, arow + 192, arow_max) + ko);
  S.b0 = *(const u32x4*)(Bk + ko);
  S.b1 = *(const u32x4*)(Bk + 64 * ldb + ko);
  S.b2 = *(const u32x4*)(Bk + 128 * ldb + ko);
  S.b3 = *(const u32x4*)(Bk + 192 * ldb + ko);
}
DEV void gb_store(const GStageB& S, u16* An, u16* Bn, int st_off, int arow, int azero_below) {
  const u32x4 zero = {0u, 0u, 0u, 0u};
  *(u32x4*)(An + st_off) = (arow < azero_below) ? zero : S.a0;
  *(u32x4*)(An + st_off + 64 * 72) = (arow + 64 < azero_below) ? zero : S.a1;
  *(u32x4*)(An + st_off + 128 * 72) = (arow + 128 < azero_below) ? zero : S.a2;
  *(u32x4*)(An + st_off + 192 * 72) = (arow + 192 < azero_below) ? zero : S.a3;
  *(u32x4*)(Bn + st_off) = S.b0;
  *(u32x4*)(Bn + st_off + 64 * 72) = S.b1;
  *(u32x4*)(Bn + st_off + 128 * 72) = S.b2;
  *(u32x4*)(Bn + st_off + 192 * 72) = S.b3;
}
DEV void gb_compute(f32x16 (&acc)[2][4], const u16* Ab, const u16* Bb) {
#pragma unroll
  for (int ks = 0; ks < 4; ++ks) {
    bf16x8 a[2], b[4];
#pragma unroll
    for (int i = 0; i < 2; ++i) a[i] = *(const bf16x8*)(Ab + i * 32 * 72 + ks * 16);
#pragma unroll
    for (int j = 0; j < 4; ++j) b[j] = *(const bf16x8*)(Bb + j * 32 * 72 + ks * 16);
#pragma unroll
    for (int i = 0; i < 2; ++i)
#pragma unroll
      for (int j = 0; j < 4; ++j) acc[i][j] = __builtin_amdgcn_mfma_f32_32x32x16_bf16(a[i], b[j], acc[i][j], 0, 0, 0);
  }
}
DEV void gemm_big(f32x16 (&acc)[2][4], const u16* A, long lda, int arow0, int azero_below, int arow_max,
                  const u16* B, long ldb, int K, u16* smem) {
  constexpr int ASZ = 256 * 72, BSZ = 256 * 72;
  const int tid = my_tid(), lane = tid & 63, wave = tid >> 6, wm = wave >> 1, wn = wave & 1;
  const int crow = tid >> 3, ckc = tid & 7;
  const u16* Ak = A + ckc * 8;
  const int arow = arow0 + crow;
  const u16* Bk = B + (long)crow * ldb + ckc * 8;
  const int nk = K >> 6;
  const int arow_l = (wm * 64 + (lane & 31)) * 72 + (lane >> 5) * 8;
  const int brow_l = (wn * 128 + (lane & 31)) * 72 + (lane >> 5) * 8;
  const int st_off = crow * 72 + ckc * 8;
  GStageB s;
  gb_load(s, Ak, lda, arow, arow_max, Bk, ldb, 0);
  gb_store(s, smem, smem + ASZ, st_off, arow, azero_below);
  __syncthreads();
  for (int kt = 0; kt < nk; ++kt) {
    const bool more = kt + 1 < nk;
    if (more) gb_load(s, Ak, lda, arow, arow_max, Bk, ldb, (kt + 1) * 64);
    __builtin_amdgcn_sched_barrier(0);
    const u16* cb = smem + (kt & 1) * (ASZ + BSZ);
    gb_compute(acc, cb + arow_l, cb + ASZ + brow_l);
    __builtin_amdgcn_sched_barrier(0);
    if (more) {
      u16* nb_ = smem + ((kt + 1) & 1) * (ASZ + BSZ);
      gb_store(s, nb_, nb_ + ASZ, st_off, arow, azero_below);
    }
    __syncthreads();
  }
}
#define BIG_ROW(i, e) (wm * 64 + (i) * 32 + ((e) & 3) + 8 * ((e) >> 2) + 4 * (lane >> 5))
#define BIG_COL(j) (wn * 128 + (j) * 32 + (lane & 31))
#define ZERO_BIG(acc)                                   \
  _Pragma("unroll") for (int i_ = 0; i_ < 2; ++i_)      \
  _Pragma("unroll") for (int j_ = 0; j_ < 4; ++j_)      \
  _Pragma("unroll") for (int e_ = 0; e_ < 16; ++e_) acc[i_][j_][e_] = 0.f;

#define ACC_ROW(MT_, i, e) (wm * 32 * (MT_) + (i) * 32 + ((e) & 3) + 8 * ((e) >> 2) + 4 * (lane >> 5))
#define ACC_COL(j) (wn * 64 + (j) * 32 + (lane & 31))

DEV void tconv(const float* src, int K, int N, u16* dst, const float* scale, int mode, float* t, int bid, int nb) {
  const int tid = my_tid();
  const int KT = K >> 6, NT = N >> 6;
  for (int tt = bid; tt < KT * NT; tt += nb) {
    const int kt = tt % KT, nt = tt / KT;
    const int k0 = kt * 64, n0 = nt * 64;
    int sn0 = n0;
    if (mode == 1) { int j = n0 >> 8, c = n0 & 255; sn0 = (c < 128) ? (j * 128 + c) : (DFF + j * 128 + c - 128); }
    {
      const int kk = tid >> 6, n = tid & 63;
#pragma unroll
      for (int i = 0; i < 8; ++i) {
        int k = kk + 8 * i;
        float v = src[(long)(k0 + k) * N + sn0 + n];
        if (scale) v *= scale[k0 + k];
        t[k * 65 + n] = v;
      }
    }
    __syncthreads();
    {
      const int n = tid >> 3, k8 = tid & 7;
      float f[8];
#pragma unroll
      for (int j = 0; j < 8; ++j) f[j] = t[(k8 * 8 + j) * 65 + n];
      *(uint4*)(dst + (long)(n0 + n) * K + k0 + k8 * 8) = pack8(f);
    }
    __syncthreads();
  }
}

DEV void phase_prep(const Params& p, float* smf, int bid, int nb) {
  for (int l = 0; l < 2; ++l) {
    unsigned char* W = p.ws + OFF_W + (size_t)l * LW_BYTES;
    tconv(p.in[2] + (size_t)l * DM * INC, DM, INC, (u16*)(W + W_IN), p.in[1] + l * DM, 0, smf, bid, nb);
    for (int g = 0; g < 3; ++g)
      tconv(p.in[18] + (size_t)(l * 3 + g) * 512 * DM, 512, DM, (u16*)(W + W_BR) + (size_t)g * DM * 512, nullptr, 0, smf, bid, nb);
    tconv(p.in[19] + (size_t)l * DM * DM, DM, DM, (u16*)(W + W_OUT), nullptr, 0, smf, bid, nb);
    tconv(p.in[21] + (size_t)l * DM * 2 * DFF, DM, 2 * DFF, (u16*)(W + W_UP), p.in[20] + l * DM, 1, smf, bid, nb);
    tconv(p.in[24] + (size_t)l * DFF * DM, DFF, DM, (u16*)(W + W_DN), nullptr, 0, smf, bid, nb);
    tconv(p.in[5] + (size_t)l * 64 * 512, 64, 512, (u16*)(W + W_RWUP), nullptr, 0, smf, bid, nb);
    tconv(p.in[7] + (size_t)l * 64 * 512, 64, 512, (u16*)(W + W_RAUP), nullptr, 0, smf, bid, nb);
    tconv(p.in[8] + (size_t)l * 128 * 512, 128, 512, (u16*)(W + W_RGUP), nullptr, 0, smf, bid, nb);
    const float* sw = p.in[16] + (size_t)l * 4 * 128 * 128;
    u16* sd = (u16*)(W + W_SGW);
    for (int idx = bid * NTHR + my_tid(); idx < 4 * 128 * 128; idx += nb * NTHR) {
      int i = (idx >> 7) & 127, j = idx & 127;
      sd[idx] = f2bf(j <= i ? sw[idx] : 0.f);
    }
  }
  {
    float* sq = (float*)(p.ws + OFF_RSTD) + NTOK;
    for (int idx = bid * NTHR + my_tid(); idx < 3 * NTOK; idx += nb * NTHR) sq[idx] = 0.f;
  }
  float* rc = (float*)(p.ws + OFF_ROPE);
  float* rs = rc + SEQ * 32;
  for (int idx = bid * NTHR + my_tid(); idx < SEQ * 32; idx += nb * NTHR) {
    int pos = idx >> 5, d = idx & 31;
    float lin = (d == 31) ? 1.0f : (float)d * (1.0f / 31.0f);
    float invf = 1.0f / powf(10000.0f, lin);
    float ang = (float)pos * invf;
    double rev = (double)ang * 0.15915494309189533577;
    float fr = (float)(rev - floor(rev));
    rc[idx] = __builtin_amdgcn_cosf(fr);
    rs[idx] = __builtin_amdgcn_sinf(fr);
  }
}

DEV void phase_norm(const float* x, u16* xb, float* rstd, int bid, int nb) {
  const int lane = my_tid() & 63, wave = my_tid() >> 6;
  for (int row = bid * 8 + wave; row < NTOK; row += nb * 8) {
    const float4* xr = (const float4*)(x + (size_t)row * DM);
    float4 v[4];
    float ss = 0.f;
#pragma unroll
    for (int i = 0; i < 4; ++i) {
      v[i] = xr[lane + 64 * i];
      ss += v[i].x * v[i].x + v[i].y * v[i].y + v[i].z * v[i].z + v[i].w * v[i].w;
    }
    ss = wave_sum(ss);
    if (lane == 0) rstd[row] = ss;
    uint2* o = (uint2*)(xb + (size_t)row * DM);
#pragma unroll
    for (int i = 0; i < 4; ++i) o[lane + 64 * i] = make_uint2(pack2(v[i].x, v[i].y), pack2(v[i].z, v[i].w));
  }
}
DEV void phase_final(float* x, const float* g, int bid, int nb) {
  const int lane = my_tid() & 63, wave = my_tid() >> 6;
  for (int row = bid * 8 + wave; row < NTOK; row += nb * 8) {
    float4* xr = (float4*)(x + (size_t)row * DM);
    const float4* gr = (const float4*)g;
    float4 v[4];
    float ss = 0.f;
#pragma unroll
    for (int i = 0; i < 4; ++i) {
      v[i] = xr[lane + 64 * i];
      ss += v[i].x * v[i].x + v[i].y * v[i].y + v[i].z * v[i].z + v[i].w * v[i].w;
    }
    ss = wave_sum(ss);
    float r = rsqrtf(ss * (1.0f / DM) + 1e-6f);
#pragma unroll
    for (int i = 0; i < 4; ++i) {
      float4 gg = gr[lane + 64 * i];
      xr[lane + 64 * i] = make_float4(v[i].x * r * gg.x, v[i].y * r * gg.y, v[i].z * r * gg.z, v[i].w * r * gg.w);
    }
  }
}

DEV void phase_inproj(const u16* xb, const float* rstd, const u16* wt, int N, u16* out, u16* smem, int bid, int nb) {
  const int tid = my_tid(), lane = tid & 63, wave = tid >> 6, wm = wave >> 1, wn = wave & 1;
  const int MTL = NTOK / 256, NTL = N / 256;
  for (int t = vbid(bid, nb); t < MTL * NTL; t += nb) {
    int m, n;
    tile_map(t, MTL, NTL, m, n);
    f32x16 acc[2][4];
    ZERO_BIG(acc);
    gemm_big(acc, xb, DM, m * 256, -(1 << 30), NTOK - 1, wt + (size_t)n * 256 * DM, DM, DM, smem);
#pragma unroll
    for (int i = 0; i < 2; ++i)
#pragma unroll
      for (int e = 0; e < 16; ++e) {
        const int r = BIG_ROW(i, e);
        const float rs = rstd_of(rstd, m * 256 + r);
#pragma unroll
        for (int j = 0; j < 4; ++j) smem[r * 264 + BIG_COL(j)] = f2bf(acc[i][j][e] * rs);
      }
    __syncthreads();
#pragma unroll 4
    for (int k = 0; k < 16; ++k) {
      const int c = tid + NTHR * k;
      const int r = c >> 5, cc = c & 31;
      *(uint4*)(out + (size_t)(m * 256 + r) * N + n * 256 + cc * 8) = *(const uint4*)(smem + r * 264 + cc * 8);
    }
    __syncthreads();
  }
}

#define OPS_STRIDE ((size_t)NTOK * 512)
template <int WHICH>
DEV void rwprep_gemm(const u16* T, u16* OS, const u16* wsrc, const float* w0, const float* a0, u16* ops, int t0, int nbk) {
  const int tid = my_tid(), lane = tid & 63, wave = tid >> 6, wm = wave >> 1, wn = wave & 1;
  constexpr int kd = (WHICH == 2) ? 128 : 64;
  constexpr int aoff = (WHICH == 0) ? 0 : (WHICH == 1 ? 64 : 128);
  constexpr int arr = (WHICH == 0) ? 4 : (WHICH == 1 ? 3 : 5);
  const int arow = (wm * 32 + (lane & 31)) * 264 + (lane >> 5) * 8;
  const int bn = nbk * 128 + wn * 64 + (lane & 31);
  bf16x8 bfr[kd / 16][2];
#pragma unroll
  for (int ks = 0; ks < kd / 16; ++ks)
#pragma unroll
    for (int j = 0; j < 2; ++j) bfr[ks][j] = *(const bf16x8*)(wsrc + (size_t)(bn + j * 32) * kd + ks * 16 + (lane >> 5) * 8);
  f32x16 ac[2];
#pragma unroll
  for (int j = 0; j < 2; ++j)
#pragma unroll
    for (int e = 0; e < 16; ++e) ac[j][e] = 0.f;
#pragma unroll
  for (int ks = 0; ks < kd / 16; ++ks) {
    const bf16x8 a1 = *(const bf16x8*)(T + arow + aoff + ks * 16);
#pragma unroll
    for (int j = 0; j < 2; ++j) ac[j] = __builtin_amdgcn_mfma_f32_32x32x16_bf16(a1, bfr[ks][j], ac[j], 0, 0, 0);
  }
#pragma unroll
  for (int j = 0; j < 2; ++j) {
    const int cl = ACC_COL(j);
    const int ch = nbk * 128 + cl;
    const float w0c = w0[ch], a0c = a0[ch];
#pragma unroll
    for (int e = 0; e < 16; ++e) {
      float val;
      if (WHICH == 0) {
        const float z = -(w0c + ac[j][e]);
        const float sp = fmaxf(z, 0.f) + log1pf(__expf(-fabsf(z)));
        val = __expf(-sp - 0.5f);
      } else if (WHICH == 1) {
        val = sigmoidf_(a0c + ac[j][e]);
      } else {
        val = ac[j][e];
      }
      OS[ACC_ROW(1, 0, e) * 136 + cl] = f2bf(val);
    }
  }
  __syncthreads();
#pragma unroll
  for (int k = 0; k < 4; ++k) {
    const int c = tid + NTHR * k;
    const int r = c >> 4, cc = c & 15;
    *(uint4*)(ops + (size_t)arr * OPS_STRIDE + (size_t)(t0 + r) * 512 + nbk * 128 + cc * 8) = *(const uint4*)(OS + r * 136 + cc * 8);
  }
  __syncthreads();
}

DEV void phase_rwprep(const Params& p, int l, u16* smem, int bid, int nb) {
  const int tid = my_tid(), lane = tid & 63, wave = tid >> 6, wm = wave >> 1, wn = wave & 1;
  const u16* prw = (const u16*)(p.ws + OFF_BIG + B_PRW);
  u16* ops = (u16*)(p.ws + OFF_BIG + B_OPS);
  unsigned char* W = p.ws + OFF_W + (size_t)l * LW_BYTES;
  const u16* wup = (const u16*)(W + W_RWUP);
  const u16* aup = (const u16*)(W + W_RAUP);
  const u16* gup = (const u16*)(W + W_RGUP);
  const float* mu = p.in[3] + l * 1792;
  const float* w0 = p.in[4] + l * 512;
  const float* a0 = p.in[6] + l * 512;
  u16* T = smem;
  for (int tile = bid; tile < NTOK / 128; tile += nb) {
    const int t0 = tile * 128;
    for (int c0 = tid; c0 < 128 * 224; c0 += NTHR * 8) {
      u32x4 cu[8], pv[8];
#pragma unroll
      for (int q = 0; q < 8; ++q) {
        const int c = c0 + NTHR * q;
        const int tok = c / 224, ch = (c % 224) * 8;
        const int t = t0 + tok;
        cu[q] = *(const u32x4*)(prw + (size_t)t * 1792 + ch);
        const int tp = ((t & (SEQ - 1)) != 0) ? t - 1 : t;
        pv[q] = *(const u32x4*)(prw + (size_t)tp * 1792 + ch);
      }
#pragma unroll
      for (int q = 0; q < 8; ++q) {
        const int c = c0 + NTHR * q;
        const int tok = c / 224, ch = (c % 224) * 8;
        const int t = t0 + tok;
        float cur[8], prv[8], o[8];
        unpack8(make_uint4(cu[q].x, cu[q].y, cu[q].z, cu[q].w), cur);
        unpack8(make_uint4(pv[q].x, pv[q].y, pv[q].z, pv[q].w), prv);
        if ((t & (SEQ - 1)) == 0) {
#pragma unroll
          for (int j = 0; j < 8; ++j) prv[j] = 0.f;
        }
        float4 m0 = *(const float4*)(mu + ch), m1 = *(const float4*)(mu + ch + 4);
        float mm[8] = {m0.x, m0.y, m0.z, m0.w, m1.x, m1.y, m1.z, m1.w};
#pragma unroll
        for (int j = 0; j < 8; ++j) o[j] = cur[j] + mm[j] * (prv[j] - cur[j]);
        if (ch < 1536) {
          int arr = ch >> 9;
          *(uint4*)(ops + arr * OPS_STRIDE + (size_t)t * 512 + (ch & 511)) = pack8(o);
        } else {
          int cc = ch - 1536;
          if (cc < 64) {
#pragma unroll
            for (int j = 0; j < 8; ++j) o[j] = tanhf(o[j]);
          } else if (cc >= 128) {
#pragma unroll
            for (int j = 0; j < 8; ++j) o[j] = sigmoidf_(o[j]);
          }
          *(uint4*)(T + tok * 264 + cc) = pack8(o);
        }
      }
    }
    __syncthreads();
    u16* OS = smem + 128 * 264;
    for (int nbk = 0; nbk < 4; ++nbk) {
      rwprep_gemm<0>(T, OS, wup, w0, a0, ops, t0, nbk);
      rwprep_gemm<1>(T, OS, aup, w0, a0, ops, t0, nbk);
      rwprep_gemm<2>(T, OS, gup, w0, a0, ops, t0, nbk);
    }
    __syncthreads();
  }
}

#define TS 32
struct ScanStage {
  float* W; float* KK; float* BB; float* KP; float* RR; float* VV; float* YY;
};
template <int PASS>
DEV void phase_scan(const Params& p, int l, float* smf, int bid, int nb) {
  const int tid = my_tid();
  const int half = tid >> 8, tu = tid & 255;
  const u16* ops = (const u16*)(p.ws + OFF_BIG + B_OPS);
  float* PL = (float*)(p.ws + OFF_BIG + B_PL);
  const float* SIN = (const float*)(p.ws + OFF_BIG + B_SINIT);
  u16* yrw = (u16*)(p.ws + OFF_BIG + B_YRW);
  const float* k_k = p.in[9] + l * 512;
  const float* k_a = p.in[10] + l * 512;
  const float* r_k = p.in[11] + l * 512;
  const float* lng = p.in[12] + l * 512;
  const float* lnb = p.in[13] + l * 512;
  float* base = smf + half * (7 * TS * 64);
  float* sW = base; float* sKK = base + TS * 64; float* sB = base + 2 * TS * 64; float* sKP = base + 3 * TS * 64;
  float* sR = base + 4 * TS * 64; float* sV = base + 5 * TS * 64; float* sY = base + 6 * TS * 64;
  const int ss = tu >> 3, c8 = tu & 7;
  const int ks = tu & 7, rp = tu >> 3;
  for (int u2 = bid; u2 < 256; u2 += nb) {
    const int u = u2 * 2 + half;
    const int bh = u >> 4, c = u & 15;
    const int b = bh >> 3, h = bh & 7;
    const int tok0 = b * SEQ + c * 512;
    const int chb = h * 64 + c8 * 8;
    float S0[8], S1[8], Q0[8], Q1[8];
    if (PASS == 1) {
#pragma unroll
      for (int j = 0; j < 8; ++j) {
        S0[j] = 0.f; S1[j] = 0.f;
        Q0[j] = (ks * 8 + j == 2 * rp) ? 1.f : 0.f;
        Q1[j] = (ks * 8 + j == 2 * rp + 1) ? 1.f : 0.f;
      }
    } else {
      const float* si = SIN + (size_t)u * 4096;
      float4 x0 = *(const float4*)(si + (2 * rp) * 64 + ks * 8), x1 = *(const float4*)(si + (2 * rp) * 64 + ks * 8 + 4);
      float4 y0 = *(const float4*)(si + (2 * rp + 1) * 64 + ks * 8), y1 = *(const float4*)(si + (2 * rp + 1) * 64 + ks * 8 + 4);
      S0[0] = x0.x; S0[1] = x0.y; S0[2] = x0.z; S0[3] = x0.w; S0[4] = x1.x; S0[5] = x1.y; S0[6] = x1.z; S0[7] = x1.w;
      S1[0] = y0.x; S1[1] = y0.y; S1[2] = y0.z; S1[3] = y0.w; S1[4] = y1.x; S1[5] = y1.y; S1[6] = y1.z; S1[7] = y1.w;
#pragma unroll
      for (int j = 0; j < 8; ++j) { Q0[j] = 0.f; Q1[j] = 0.f; }
    }
    float kkc[8], kac[8], rkc[8];
    {
      float4 q0 = *(const float4*)(k_k + chb), q1 = *(const float4*)(k_k + chb + 4);
      kkc[0] = q0.x; kkc[1] = q0.y; kkc[2] = q0.z; kkc[3] = q0.w; kkc[4] = q1.x; kkc[5] = q1.y; kkc[6] = q1.z; kkc[7] = q1.w;
      q0 = *(const float4*)(k_a + chb); q1 = *(const float4*)(k_a + chb + 4);
      kac[0] = q0.x; kac[1] = q0.y; kac[2] = q0.z; kac[3] = q0.w; kac[4] = q1.x; kac[5] = q1.y; kac[6] = q1.z; kac[7] = q1.w;
      q0 = *(const float4*)(r_k + chb); q1 = *(const float4*)(r_k + chb + 4);
      rkc[0] = q0.x; rkc[1] = q0.y; rkc[2] = q0.z; rkc[3] = q0.w; rkc[4] = q1.x; rkc[5] = q1.y; rkc[6] = q1.z; rkc[7] = q1.w;
    }
    uint4 pr_r, pr_k, pr_v, pr_a, pr_e, pr_g = make_uint4(0, 0, 0, 0);
    {
      const size_t o0 = (size_t)(tok0 + ss) * 512 + chb;
      pr_r = *(const uint4*)(ops + 0 * OPS_STRIDE + o0);
      pr_k = *(const uint4*)(ops + 1 * OPS_STRIDE + o0);
      pr_v = *(const uint4*)(ops + 2 * OPS_STRIDE + o0);
      pr_a = *(const uint4*)(ops + 3 * OPS_STRIDE + o0);
      pr_e = *(const uint4*)(ops + 4 * OPS_STRIDE + o0);
      if (PASS == 3) pr_g = *(const uint4*)(ops + 5 * OPS_STRIDE + o0);
    }
    for (int sc = 0; sc < 512 / TS; ++sc) {
      const size_t o = (size_t)(tok0 + sc * TS + ss) * 512 + chb;
      float fr[8], fk[8], fv[8], fa[8], fe[8];
      unpack8(pr_r, fr);
      unpack8(pr_k, fk);
      unpack8(pr_v, fv);
      unpack8(pr_a, fa);
      unpack8(pr_e, fe);
      const uint4 graw = pr_g;
      if (sc + 1 < 512 / TS) {
        const size_t o1 = o + (size_t)TS * 512;
        pr_r = *(const uint4*)(ops + 0 * OPS_STRIDE + o1);
        pr_k = *(const uint4*)(ops + 1 * OPS_STRIDE + o1);
        pr_v = *(const uint4*)(ops + 2 * OPS_STRIDE + o1);
        pr_a = *(const uint4*)(ops + 3 * OPS_STRIDE + o1);
        pr_e = *(const uint4*)(ops + 4 * OPS_STRIDE + o1);
        if (PASS == 3) pr_g = *(const uint4*)(ops + 5 * OPS_STRIDE + o1);
      }
      float kk[8], kp[8], ssq = 0.f, bon = 0.f;
#pragma unroll
      for (int j = 0; j < 8; ++j) {
        kk[j] = fk[j] * kkc[j];
        ssq += kk[j] * kk[j];
        kp[j] = fk[j] * (1.f + (fa[j] - 1.f) * kac[j]);
        bon += fr[j] * kp[j] * rkc[j];
      }
      ssq = red8(ssq);
      bon = red8(bon);
      const float inv = 1.f / fmaxf(sqrtf(ssq), 1e-12f);
      float fw[8], fb[8];
#pragma unroll
      for (int j = 0; j < 8; ++j) {
        kk[j] *= inv;
        fb[j] = fa[j] * kk[j];
        fw[j] = __expf(-fe[j]);
      }
      {
        const int so = ss * 64 + c8 * 8;
        *(float4*)(sW + so) = make_float4(fw[0], fw[1], fw[2], fw[3]); *(float4*)(sW + so + 4) = make_float4(fw[4], fw[5], fw[6], fw[7]);
        *(float4*)(sKK + so) = make_float4(kk[0], kk[1], kk[2], kk[3]); *(float4*)(sKK + so + 4) = make_float4(kk[4], kk[5], kk[6], kk[7]);
        *(float4*)(sB + so) = make_float4(fb[0], fb[1], fb[2], fb[3]); *(float4*)(sB + so + 4) = make_float4(fb[4], fb[5], fb[6], fb[7]);
        *(float4*)(sKP + so) = make_float4(kp[0], kp[1], kp[2], kp[3]); *(float4*)(sKP + so + 4) = make_float4(kp[4], kp[5], kp[6], kp[7]);
        *(float4*)(sV + so) = make_float4(fv[0], fv[1], fv[2], fv[3]); *(float4*)(sV + so + 4) = make_float4(fv[4], fv[5], fv[6], fv[7]);
        if (PASS == 3) {
          *(float4*)(sR + so) = make_float4(fr[0], fr[1], fr[2], fr[3]); *(float4*)(sR + so + 4) = make_float4(fr[4], fr[5], fr[6], fr[7]);
        }
      }
      __syncthreads();
#pragma unroll 2
      for (int s = 0; s < TS; ++s) {
        const int so = s * 64 + ks * 8;
        float4 t0 = *(const float4*)(sW + so), t1 = *(const float4*)(sW + so + 4);
        float w[8] = {t0.x, t0.y, t0.z, t0.w, t1.x, t1.y, t1.z, t1.w};
        t0 = *(const float4*)(sKK + so); t1 = *(const float4*)(sKK + so + 4);
        float kq[8] = {t0.x, t0.y, t0.z, t0.w, t1.x, t1.y, t1.z, t1.w};
        t0 = *(const float4*)(sB + so); t1 = *(const float4*)(sB + so + 4);
        float bq[8] = {t0.x, t0.y, t0.z, t0.w, t1.x, t1.y, t1.z, t1.w};
        t0 = *(const float4*)(sKP + so); t1 = *(const float4*)(sKP + so + 4);
        float kpq[8] = {t0.x, t0.y, t0.z, t0.w, t1.x, t1.y, t1.z, t1.w};
        const float2 vv = *(const float2*)(sV + s * 64 + 2 * rp);
        float sa0 = 0.f, sa1 = 0.f;
#pragma unroll
        for (int j = 0; j < 8; ++j) { sa0 += S0[j] * kq[j]; sa1 += S1[j] * kq[j]; }
        sa0 = red8(sa0); sa1 = red8(sa1);
#pragma unroll
        for (int j = 0; j < 8; ++j) {
          S0[j] = S0[j] * w[j] - sa0 * bq[j] + vv.x * kpq[j];
          S1[j] = S1[j] * w[j] - sa1 * bq[j] + vv.y * kpq[j];
        }
        if (PASS == 1) {
          float pa0 = 0.f, pa1 = 0.f;
#pragma unroll
          for (int j = 0; j < 8; ++j) { pa0 += Q0[j] * kq[j]; pa1 += Q1[j] * kq[j]; }
          pa0 = red8(pa0); pa1 = red8(pa1);
#pragma unroll
          for (int j = 0; j < 8; ++j) {
            Q0[j] = Q0[j] * w[j] - pa0 * bq[j];
            Q1[j] = Q1[j] * w[j] - pa1 * bq[j];
          }
        } else {
          t0 = *(const float4*)(sR + so); t1 = *(const float4*)(sR + so + 4);
          float rq[8] = {t0.x, t0.y, t0.z, t0.w, t1.x, t1.y, t1.z, t1.w};
          float y0 = 0.f, y1 = 0.f;
#pragma unroll
          for (int j = 0; j < 8; ++j) { y0 += S0[j] * rq[j]; y1 += S1[j] * rq[j]; }
          y0 = red8(y0); y1 = red8(y1);
          if (ks == 0) *(float2*)(sY + s * 64 + 2 * rp) = make_float2(y0, y1);
        }
      }
      __syncthreads();
      if (PASS == 3) {
        const int so = ss * 64 + c8 * 8;
        float4 y0 = *(const float4*)(sY + so), y1 = *(const float4*)(sY + so + 4);
        float y[8] = {y0.x, y0.y, y0.z, y0.w, y1.x, y1.y, y1.z, y1.w};
        float sm = 0.f;
#pragma unroll
        for (int j = 0; j < 8; ++j) sm += y[j];
        const float mean = red8(sm) * (1.f / 64.f);
        float sv = 0.f;
#pragma unroll
        for (int j = 0; j < 8; ++j) { y[j] -= mean; sv += y[j] * y[j]; }
        const float var = red8(sv) * (1.f / 64.f);
        const float rs = rsqrtf(var + 64e-5f);
        float g[8], outv[8];
        unpack8(graw, g);
        float4 l0 = *(const float4*)(lng + chb), l1 = *(const float4*)(lng + chb + 4);
        float4 b0 = *(const float4*)(lnb + chb), b1 = *(const float4*)(lnb + chb + 4);
        float lg[8] = {l0.x, l0.y, l0.z, l0.w, l1.x, l1.y, l1.z, l1.w};
        float lb[8] = {b0.x, b0.y, b0.z, b0.w, b1.x, b1.y, b1.z, b1.w};
#pragma unroll
        for (int j = 0; j < 8; ++j) outv[j] = (y[j] * rs * lg[j] + lb[j] + bon * fv[j]) * g[j];
        if (!(c == 0 && sc == 0 && ss == 0)) *(uint4*)(yrw + o) = pack8(outv);
      }
    }
    if (PASS == 1) {
      float* pl = PL + (size_t)u * 8192;
      float* Pm = pl;
      float* Lm = pl + 4096;
      *(float4*)(Pm + (2 * rp) * 64 + ks * 8) = make_float4(Q0[0], Q0[1], Q0[2], Q0[3]);
      *(float4*)(Pm + (2 * rp) * 64 + ks * 8 + 4) = make_float4(Q0[4], Q0[5], Q0[6], Q0[7]);
      *(float4*)(Pm + (2 * rp + 1) * 64 + ks * 8) = make_float4(Q1[0], Q1[1], Q1[2], Q1[3]);
      *(float4*)(Pm + (2 * rp + 1) * 64 + ks * 8 + 4) = make_float4(Q1[4], Q1[5], Q1[6], Q1[7]);
      *(float4*)(Lm + (2 * rp) * 64 + ks * 8) = make_float4(S0[0], S0[1], S0[2], S0[3]);
      *(float4*)(Lm + (2 * rp) * 64 + ks * 8 + 4) = make_float4(S0[4], S0[5], S0[6], S0[7]);
      *(float4*)(Lm + (2 * rp + 1) * 64 + ks * 8) = make_float4(S1[0], S1[1], S1[2], S1[3]);
      *(float4*)(Lm + (2 * rp + 1) * 64 + ks * 8 + 4) = make_float4(S1[4], S1[5], S1[6], S1[7]);
    }
  }
}

DEV void phase_scanprop(const Params& p, float* smf, int bid, int nb) {
  const int tid = my_tid();
  const float* PL = (const float*)(p.ws + OFF_BIG + B_PL);
  float* SIN = (float*)(p.ws + OFF_BIG + B_SINIT);
  float* sS = smf;
  float* sP = smf + 4096;
  const int i = tid >> 3, k8 = tid & 7;
  for (int bh = bid; bh < 32; bh += nb) {
    float cur[8];
#pragma unroll
    for (int j = 0; j < 8; ++j) cur[j] = 0.f;
    const float* pl0 = PL + (size_t)(bh * 16) * 8192;
    float4 np0 = *(const float4*)(pl0 + tid * 8), np1 = *(const float4*)(pl0 + tid * 8 + 4);
    float4 nl0 = *(const float4*)(pl0 + 4096 + i * 64 + k8 * 8), nl1 = *(const float4*)(pl0 + 4096 + i * 64 + k8 * 8 + 4);
    for (int c = 0; c < 16; ++c) {
      const int u = bh * 16 + c;
      float* so = SIN + (size_t)u * 4096 + i * 64 + k8 * 8;
      *(float4*)so = make_float4(cur[0], cur[1], cur[2], cur[3]);
      *(float4*)(so + 4) = make_float4(cur[4], cur[5], cur[6], cur[7]);
      if (c == 15) break;
      *(float4*)(sS + i * 64 + k8 * 8) = make_float4(cur[0], cur[1], cur[2], cur[3]);
      *(float4*)(sS + i * 64 + k8 * 8 + 4) = make_float4(cur[4], cur[5], cur[6], cur[7]);
      *(float4*)(sP + tid * 8) = np0;
      *(float4*)(sP + tid * 8 + 4) = np1;
      float nw[8] = {nl0.x, nl0.y, nl0.z, nl0.w, nl1.x, nl1.y, nl1.z, nl1.w};
      __syncthreads();
      if (c + 1 < 15) {
        const float* pl = PL + (size_t)(u + 1) * 8192;
        np0 = *(const float4*)(pl + tid * 8); np1 = *(const float4*)(pl + tid * 8 + 4);
        nl0 = *(const float4*)(pl + 4096 + i * 64 + k8 * 8); nl1 = *(const float4*)(pl + 4096 + i * 64 + k8 * 8 + 4);
      }
#pragma unroll 8
      for (int j = 0; j < 64; ++j) {
        const float sij = sS[i * 64 + j];
        float4 p0 = *(const float4*)(sP + j * 64 + k8 * 8), p1 = *(const float4*)(sP + j * 64 + k8 * 8 + 4);
        nw[0] += sij * p0.x; nw[1] += sij * p0.y; nw[2] += sij * p0.z; nw[3] += sij * p0.w;
        nw[4] += sij * p1.x; nw[5] += sij * p1.y; nw[6] += sij * p1.z; nw[7] += sij * p1.w;
      }
#pragma unroll
      for (int j = 0; j < 8; ++j) cur[j] = nw[j];
      __syncthreads();
    }
  }
}

DEV float ret_log2gamma(int h) { return log2f(1.0f - exp2f(-5.0f - (float)h)); }

DEV void stage_rot(const u16* src, size_t ld, const float* rc, const float* rs, int pos0, u16* dst, float sc, float l2g, int rowmode) {
  const int tid = my_tid();
  const int row = tid >> 2, d0 = (tid & 3) * 8;
  float lo[8], hi[8], olo[8], ohi[8];
  unpack8(*(const uint4*)(src + (size_t)row * ld + d0), lo);
  unpack8(*(const uint4*)(src + (size_t)row * ld + d0 + 32), hi);
  const float* cp = rc + (size_t)(pos0 + row) * 32 + d0;
  const float* sp = rs + (size_t)(pos0 + row) * 32 + d0;
  float4 c0 = *(const float4*)cp, c1 = *(const float4*)(cp + 4);
  float4 s0 = *(const float4*)sp, s1 = *(const float4*)(sp + 4);
  float cc[8] = {c0.x, c0.y, c0.z, c0.w, c1.x, c1.y, c1.z, c1.w};
  float sn[8] = {s0.x, s0.y, s0.z, s0.w, s1.x, s1.y, s1.z, s1.w};
  float rsc = sc;
  if (rowmode == 1) rsc *= exp2f((float)(row + 1) * l2g);
  if (rowmode == 2) rsc *= exp2f((float)(127 - row) * l2g);
#pragma unroll
  for (int j = 0; j < 8; ++j) {
    olo[j] = (lo[j] * cc[j] - hi[j] * sn[j]) * rsc;
    ohi[j] = (hi[j] * cc[j] + lo[j] * sn[j]) * rsc;
  }
  *(uint4*)(dst + row * 72 + d0) = pack8(olo);
  *(uint4*)(dst + row * 72 + d0 + 32) = pack8(ohi);
}
DEV void stage_rot_T(const u16* src, size_t ld, const float* rc, const float* rs, int pos0, u16* dst, float sc, float l2g) {
  const int tid = my_tid();
  const int row = tid >> 2, d0 = (tid & 3) * 8;
  float lo[8], hi[8];
  unpack8(*(const uint4*)(src + (size_t)row * ld + d0), lo);
  unpack8(*(const uint4*)(src + (size_t)row * ld + d0 + 32), hi);
  const float* cp = rc + (size_t)(pos0 + row) * 32 + d0;
  const float* sp = rs + (size_t)(pos0 + row) * 32 + d0;
  float4 c0 = *(const float4*)cp, c1 = *(const float4*)(cp + 4);
  float4 s0 = *(const float4*)sp, s1 = *(const float4*)(sp + 4);
  float cc[8] = {c0.x, c0.y, c0.z, c0.w, c1.x, c1.y, c1.z, c1.w};
  float sn[8] = {s0.x, s0.y, s0.z, s0.w, s1.x, s1.y, s1.z, s1.w};
  const float rsc = sc * exp2f((float)(127 - row) * l2g);
#pragma unroll
  for (int j = 0; j < 8; ++j) {
    dst[(d0 + j) * 136 + row] = f2bf((lo[j] * cc[j] - hi[j] * sn[j]) * rsc);
    dst[(d0 + j + 32) * 136 + row] = f2bf((hi[j] * cc[j] + lo[j] * sn[j]) * rsc);
  }
}
DEV void stage_vT(const u16* src, size_t ld, u16* dst) {
  const int tid = my_tid();
  const int row = tid >> 2, d0 = (tid & 3) * 32;
#pragma unroll
  for (int c = 0; c < 4; ++c) {
    uint4 v = *(const uint4*)(src + (size_t)row * ld + d0 + c * 8);
    unsigned w[4] = {v.x, v.y, v.z, v.w};
#pragma unroll
    for (int j = 0; j < 4; ++j) {
      dst[(d0 + c * 8 + 2 * j) * 136 + row] = (u16)(w[j] & 0xffffu);
      dst[(d0 + c * 8 + 2 * j + 1) * 136 + row] = (u16)(w[j] >> 16);
    }
  }
}

DEV void ret_kv_unit(const Params& p, int u, u16* smem) {
  const int tid = my_tid(), lane = tid & 63, wave = tid >> 6;
  const u16* prs = (const u16*)(p.ws + OFF_BIG + B_PRS);
  float* KV = (float*)(p.ws + OFF_BIG + B_KV);
  const float* rc = (const float*)(p.ws + OFF_ROPE);
  const float* rs = rc + SEQ * 32;
  const int n = u & 63, h = (u >> 6) & 3, b = u >> 8;
  const size_t t0 = (size_t)b * SEQ + n * 128;
  const float l2g = ret_log2gamma(h);
  u16* KT = smem;
  u16* VT = smem + 64 * 136;
  stage_rot_T(prs + t0 * 2560 + 256 + h * 64, 2560, rc, rs, n * 128, KT, 0.125f, l2g);
  stage_vT(prs + t0 * 2560 + 512 + h * 128, 2560, VT);
  __syncthreads();
  const int mi = wave >> 1, nj = wave & 1;
  f32x16 acc;
#pragma unroll
  for (int e = 0; e < 16; ++e) acc[e] = 0.f;
#pragma unroll
  for (int ks = 0; ks < 8; ++ks) {
    bf16x8 a = *(const bf16x8*)(VT + (mi * 32 + (lane & 31)) * 136 + ks * 16 + (lane >> 5) * 8);
    bf16x8 bb = *(const bf16x8*)(KT + (nj * 32 + (lane & 31)) * 136 + ks * 16 + (lane >> 5) * 8);
    acc = __builtin_amdgcn_mfma_f32_32x32x16_bf16(a, bb, acc, 0, 0, 0);
  }
  float* kv = KV + (size_t)u * 8192;
#pragma unroll
  for (int e = 0; e < 16; ++e) {
    int dv = mi * 32 + (e & 3) + 8 * (e >> 2) + 4 * (lane >> 5);
    int dk = nj * 32 + (lane & 31);
    kv[dv * 64 + dk] = acc[e];
  }
  __syncthreads();
}

DEV void sgu_unit(const Params& p, int l, int u, u16* smem) {
  const int tid = my_tid(), lane = tid & 63, wave = tid >> 6, wm = wave >> 1, wn = wave & 1;
  const u16* prs = (const u16*)(p.ws + OFF_BIG + B_PRS);
  u16* ysg = (u16*)(p.ws + OFF_BIG + B_YSG);
  const u16* sgw = (const u16*)(p.ws + OFF_W + (size_t)l * LW_BYTES + W_SGW);
  const float* lng = p.in[14] + l * 512;
  const float* lnb = p.in[15] + l * 512;
  const float* sgb = p.in[17] + l * 512;
  const size_t t0 = (size_t)u * 128;
  u16* VT = smem;
  u16* WT = smem + 128 * 136;
  float* st = (float*)(smem + 2 * 128 * 136);
  const int tok = tid >> 2, q = tid & 3;
  const u16* vrow = prs + (t0 + tok) * 2560 + 1536 + 512;
  {
    float s = 0.f, s2 = 0.f;
#pragma unroll 4
    for (int c = 0; c < 16; ++c) {
      float f[8];
      unpack8(*(const uint4*)(vrow + q * 128 + c * 8), f);
#pragma unroll
      for (int j = 0; j < 8; ++j) { float gl = geluf_(f[j]); s += gl; s2 += gl * gl; }
    }
    s = red4(s); s2 = red4(s2);
    const float mean = s * (1.f / 512.f);
    const float var = fmaxf(s2 * (1.f / 512.f) - mean * mean, 0.f);
    if (q == 0) { st[tok] = mean; st[128 + tok] = rsqrtf(var + 1e-6f); }
  }
  __syncthreads();
  const float mean = st[tok], rstd = st[128 + tok];
  for (int g = 0; g < 4; ++g) {
#pragma unroll
    for (int c = 0; c < 4; ++c) {
      const int d = q * 32 + c * 8;
      float f[8];
      unpack8(*(const uint4*)(vrow + g * 128 + d), f);
      float4 g0 = *(const float4*)(lng + g * 128 + d), g1 = *(const float4*)(lng + g * 128 + d + 4);
      float4 b0 = *(const float4*)(lnb + g * 128 + d), b1 = *(const float4*)(lnb + g * 128 + d + 4);
      float gg[8] = {g0.x, g0.y, g0.z, g0.w, g1.x, g1.y, g1.z, g1.w};
      float bb[8] = {b0.x, b0.y, b0.z, b0.w, b1.x, b1.y, b1.z, b1.w};
#pragma unroll
      for (int j = 0; j < 8; ++j) VT[(d + j) * 136 + tok] = f2bf((geluf_(f[j]) - mean) * rstd * gg[j] + bb[j]);
      *(uint4*)(WT + tok * 136 + d) = *(const uint4*)(sgw + (size_t)g * 16384 + tok * 128 + d);
    }
    __syncthreads();
    f32x16 acc[2];
#pragma unroll
    for (int j = 0; j < 2; ++j)
#pragma unroll
      for (int e = 0; e < 16; ++e) acc[j][e] = 0.f;
#pragma unroll
    for (int ks = 0; ks < 8; ++ks) {
      bf16x8 a = *(const bf16x8*)(WT + (wm * 32 + (lane & 31)) * 136 + ks * 16 + (lane >> 5) * 8);
#pragma unroll
      for (int j = 0; j < 2; ++j) {
        bf16x8 bb = *(const bf16x8*)(VT + (wn * 64 + j * 32 + (lane & 31)) * 136 + ks * 16 + (lane >> 5) * 8);
        acc[j] = __builtin_amdgcn_mfma_f32_32x32x16_bf16(a, bb, acc[j], 0, 0, 0);
      }
    }
#pragma unroll
    for (int e = 0; e < 16; ++e) {
      const int i = ACC_ROW(1, 0, e);
      const float bias = sgb[g * 128 + i];
#pragma unroll
      for (int j = 0; j < 2; ++j) {
        const int d = ACC_COL(j);
        const float uu = geluf_(bf2f(prs[(t0 + i) * 2560 + 1536 + g * 128 + d]));
        ysg[(t0 + i) * 512 + g * 128 + d] = f2bf(uu * (acc[j][e] + bias));
      }
    }
    __syncthreads();
  }
}

DEV void phase_retprefix(const Params& p, int bid, int nb) {
  float* KV = (float*)(p.ws + OFF_BIG + B_KV);
  for (int gid = bid * NTHR + my_tid(); gid < 16 * 8192; gid += nb * NTHR) {
    const int bh = gid >> 13, e = gid & 8191;
    const int h = bh & 3;
    const float cd = exp2f(128.f * ret_log2gamma(h));
    float R = 0.f;
    float* ptr = KV + (size_t)bh * 64 * 8192 + e;
    for (int n = 0; n < 64; ++n) {
      float kv = ptr[(size_t)n * 8192];
      ptr[(size_t)n * 8192] = R;
      R = R * cd + kv;
    }
  }
}

DEV void ret_out_unit(const Params& p, int u, u16* smem) {
  const int tid = my_tid(), lane = tid & 63, wave = tid >> 6, wm = wave >> 1, wn = wave & 1;
  const u16* prs = (const u16*)(p.ws + OFF_BIG + B_PRS);
  const float* KV = (const float*)(p.ws + OFF_BIG + B_KV);
  u16* yret = (u16*)(p.ws + OFF_BIG + B_YRET);
  const float* rc = (const float*)(p.ws + OFF_ROPE);
  const float* rs = rc + SEQ * 32;
  const int n = u & 63, h = (u >> 6) & 3, b = u >> 8;
  const size_t t0 = (size_t)b * SEQ + n * 128;
  const float l2g = ret_log2gamma(h);
  u16* Q = smem;
  u16* Kr = Q + 128 * 72;
  u16* VT = Kr + 128 * 72;
  u16* Qd = VT + 128 * 136;
  u16* RT = Qd + 128 * 72;
  u16* SP = RT + 128 * 72;
  float* OT = (float*)smem;
  stage_rot(prs + t0 * 2560 + h * 64, 2560, rc, rs, n * 128, Q, 1.0f, l2g, 0);
  stage_rot(prs + t0 * 2560 + h * 64, 2560, rc, rs, n * 128, Qd, 1.0f, l2g, 1);
  stage_rot(prs + t0 * 2560 + 256 + h * 64, 2560, rc, rs, n * 128, Kr, 0.125f, l2g, 0);
  stage_vT(prs + t0 * 2560 + 512 + h * 128, 2560, VT);
  {
    const int dv = tid >> 2, q = tid & 3;
    const float* src = KV + (size_t)u * 8192 + dv * 64 + q * 16;
    float4 a0 = *(const float4*)src, a1 = *(const float4*)(src + 4), a2 = *(const float4*)(src + 8), a3 = *(const float4*)(src + 12);
    float f0[8] = {a0.x, a0.y, a0.z, a0.w, a1.x, a1.y, a1.z, a1.w};
    float f1[8] = {a2.x, a2.y, a2.z, a2.w, a3.x, a3.y, a3.z, a3.w};
    *(uint4*)(RT + dv * 72 + q * 16) = pack8(f0);
    *(uint4*)(RT + dv * 72 + q * 16 + 8) = pack8(f1);
  }
  __syncthreads();
  f32x16 acc[2];
#pragma unroll
  for (int j = 0; j < 2; ++j)
#pragma unroll
    for (int e = 0; e < 16; ++e) acc[j][e] = 0.f;
#pragma unroll
  for (int ks = 0; ks < 4; ++ks) {
    bf16x8 a = *(const bf16x8*)(Q + (wm * 32 + (lane & 31)) * 72 + ks * 16 + (lane >> 5) * 8);
#pragma unroll
    for (int j = 0; j < 2; ++j) {
      bf16x8 bb = *(const bf16x8*)(Kr + (wn * 64 + j * 32 + (lane & 31)) * 72 + ks * 16 + (lane >> 5) * 8);
      acc[j] = __builtin_amdgcn_mfma_f32_32x32x16_bf16(a, bb, acc[j], 0, 0, 0);
    }
  }
#pragma unroll
  for (int j = 0; j < 2; ++j)
#pragma unroll
    for (int e = 0; e < 16; ++e) {
      const int i = ACC_ROW(1, 0, e), jj = ACC_COL(j);
      const float dcy = (i >= jj) ? exp2f((float)(i - jj) * l2g) : 0.f;
      SP[i * 136 + jj] = f2bf(acc[j][e] * dcy);
    }
  __syncthreads();
#pragma unroll
  for (int j = 0; j < 2; ++j)
#pragma unroll
    for (int e = 0; e < 16; ++e) acc[j][e] = 0.f;
#pragma unroll
  for (int ks = 0; ks < 8; ++ks) {
    bf16x8 a = *(const bf16x8*)(SP + (wm * 32 + (lane & 31)) * 136 + ks * 16 + (lane >> 5) * 8);
#pragma unroll
    for (int j = 0; j < 2; ++j) {
      bf16x8 bb = *(const bf16x8*)(VT + (wn * 64 + j * 32 + (lane & 31)) * 136 + ks * 16 + (lane >> 5) * 8);
      acc[j] = __builtin_amdgcn_mfma_f32_32x32x16_bf16(a, bb, acc[j], 0, 0, 0);
    }
  }
#pragma unroll
  for (int ks = 0; ks < 4; ++ks) {
    bf16x8 a = *(const bf16x8*)(Qd + (wm * 32 + (lane & 31)) * 72 + ks * 16 + (lane >> 5) * 8);
#pragma unroll
    for (int j = 0; j < 2; ++j) {
      bf16x8 bb = *(const bf16x8*)(RT + (wn * 64 + j * 32 + (lane & 31)) * 72 + ks * 16 + (lane >> 5) * 8);
      acc[j] = __builtin_amdgcn_mfma_f32_32x32x16_bf16(a, bb, acc[j], 0, 0, 0);
    }
  }
  __syncthreads();
#pragma unroll
  for (int j = 0; j < 2; ++j)
#pragma unroll
    for (int e = 0; e < 16; ++e) OT[ACC_ROW(1, 0, e) * 132 + ACC_COL(j)] = acc[j][e];
  __syncthreads();
  {
    const int row = tid >> 2, q = tid & 3;
    float o[32];
    float ssq = 0.f;
#pragma unroll
    for (int c = 0; c < 8; ++c) {
      float4 v = *(const float4*)(OT + row * 132 + q * 32 + c * 4);
      o[c * 4] = v.x; o[c * 4 + 1] = v.y; o[c * 4 + 2] = v.z; o[c * 4 + 3] = v.w;
      ssq += v.x * v.x + v.y * v.y + v.z * v.z + v.w * v.w;
    }
    ssq = red4(ssq);
    const float r = rsqrtf(ssq * (1.f / 128.f) + 1e-6f);
    const u16* gp = prs + (t0 + row) * 2560 + 1024 + h * 128 + q * 32;
    u16* op = yret + (t0 + row) * 512 + h * 128 + q * 32;
#pragma unroll
    for (int c = 0; c < 4; ++c) {
      float g[8], ov[8];
      unpack8(*(const uint4*)(gp + c * 8), g);
#pragma unroll
      for (int j = 0; j < 8; ++j) ov[j] = o[c * 8 + j] * r * siluf_(g[j]);
      if (!(n == 0 && row == 0)) *(uint4*)(op + c * 8) = pack8(ov);
    }
  }
  __syncthreads();
}

DEV void phase_merge(const Params& p, int l, const float* rstd, u16* smem, int bid, int nb) {
  const int tid = my_tid(), lane = tid & 63, wave = tid >> 6, wm = wave >> 1, wn = wave & 1;
  const u16* xb = (const u16*)(p.ws + OFF_XB);
  unsigned char* W = p.ws + OFF_W + (size_t)l * LW_BYTES;
  const u16* win = (const u16*)(W + W_IN);
  const u16* wbr = (const u16*)(W + W_BR);
  u16* M = (u16*)(p.ws + OFF_BIG + B_M);
  const int MTL = NTOK / 128, NTL = DM / 128;
  for (int t = vbid(bid, nb); t < MTL * NTL; t += nb) {
    int m, n;
    tile_map(t, MTL, NTL, m, n);
    f32x16 ms[1][2];
#pragma unroll
    for (int j = 0; j < 2; ++j)
#pragma unroll
      for (int e = 0; e < 16; ++e) ms[0][j][e] = 0.f;
    for (int g = 0; g < 3; ++g) {
      const u16* yg = (const u16*)(p.ws + OFF_BIG + (g == 0 ? B_YRW : (g == 1 ? B_YRET : B_YSG)));
      f32x16 ab[1][2], ag[1][2];
#pragma unroll
      for (int j = 0; j < 2; ++j)
#pragma unroll
        for (int e = 0; e < 16; ++e) { ab[0][j][e] = 0.f; ag[0][j][e] = 0.f; }
      gemm_tile<1>(ab, yg, 512, m * 128, -(1 << 30), NTOK - 1, wbr + ((size_t)g * DM + n * 128) * 512, 512, 512, smem);
      gemm_tile<1>(ag, xb, DM, m * 128, -(1 << 30), NTOK - 1, win + ((size_t)(4352 + g * DM + n * 128)) * DM, DM, DM, smem);
#pragma unroll
      for (int e = 0; e < 16; ++e) {
        const float rs = rstd_of(rstd, m * 128 + ACC_ROW(1, 0, e));
#pragma unroll
        for (int j = 0; j < 2; ++j) ms[0][j][e] += sigmoidf_(ag[0][j][e] * rs) * ab[0][j][e];
        if ((e & 3) == 3) __builtin_amdgcn_sched_barrier(0);
      }
    }
#pragma unroll
    for (int e = 0; e < 16; ++e) {
      const size_t row = m * 128 + ACC_ROW(1, 0, e);
#pragma unroll
      for (int j = 0; j < 2; ++j) M[row * DM + n * 128 + ACC_COL(j)] = f2bf(ms[0][j][e]);
    }
  }
}

DEV void phase_resgemm(const u16* A, int K, const u16* wt, const float* xin, float* xout, u16* xbo, float* ssq, u16* smem, int bid, int nb) {
  const int tid = my_tid(), lane = tid & 63, wave = tid >> 6, wm = wave >> 1, wn = wave & 1;
  const int MTL = NTOK / 256, NTL = DM / 256;
  for (int t = vbid(bid, nb); t < MTL * NTL; t += nb) {
    int m, n;
    tile_map(t, MTL, NTL, m, n);
    f32x16 acc[2][4];
    ZERO_BIG(acc);
    gemm_big(acc, A, K, m * 256, -(1 << 30), NTOK - 1, wt + (size_t)n * 256 * K, K, K, smem);
    float* F = (float*)smem;
#pragma unroll
    for (int i = 0; i < 2; ++i) {
#pragma unroll
      for (int e = 0; e < 16; ++e) {
        const int lr = wm * 32 + (e & 3) + 8 * (e >> 2) + 4 * (lane >> 5);
#pragma unroll
        for (int j = 0; j < 4; ++j) F[lr * 260 + BIG_COL(j)] = acc[i][j][e];
      }
      __syncthreads();
#pragma unroll 4
      for (int k = 0; k < 16; ++k) {
        const int c = tid + NTHR * k;
        const int lr = c >> 6, cc = c & 63;
        const size_t row = (size_t)m * 256 + (lr >> 5) * 64 + i * 32 + (lr & 31);
        const size_t o = row * DM + n * 256 + cc * 4;
        const float4 v = *(const float4*)(F + lr * 260 + cc * 4);
        const float4 x = *(const float4*)(xin + o);
        const float4 y = make_float4(x.x + v.x, x.y + v.y, x.z + v.z, x.w + v.w);
        *(float4*)(xout + o) = y;
        if (xbo) {
          *(uint2*)(xbo + o) = make_uint2(pack2(y.x, y.y), pack2(y.z, y.w));
          const float sq = wave_sum(y.x * y.x + y.y * y.y + y.z * y.z + y.w * y.w);
          if (lane == 0) atomicAdd(ssq + row, sq);
        }
      }
      __syncthreads();
    }
  }
}

DEV void phase_ffnup(const Params& p, int l, const float* rstd, u16* smem, int bid, int nb) {
  const int tid = my_tid(), lane = tid & 63, wave = tid >> 6, wm = wave >> 1, wn = wave & 1;
  const u16* xb = (const u16*)(p.ws + OFF_XB);
  const u16* wup = (const u16*)(p.ws + OFF_W + (size_t)l * LW_BYTES + W_UP);
  u16* act = (u16*)(p.ws + OFF_BIG + B_ACT);
  const float* cw = p.in[22] + (size_t)l * 3 * 2 * DFF;
  const float* cb = p.in[23] + (size_t)l * 2 * DFF;
  u16* U = smem;
  const int MPB = 33;
  const int MTL = 4 * MPB, NTL = DFF / 128;
  for (int t = vbid(bid, nb); t < MTL * NTL; t += nb) {
    int m, n;
    tile_map(t, MTL, NTL, m, n);
    const int b = m / MPB, mi = m % MPB;
    const int tokbase = b * SEQ + mi * 254 - 2;
    f32x16 acc[2][4];
    ZERO_BIG(acc);
    gemm_big(acc, xb, DM, tokbase, b * SEQ, NTOK - 1, wup + (size_t)n * 256 * DM, DM, DM, smem);
#pragma unroll
    for (int i = 0; i < 2; ++i)
#pragma unroll
      for (int e = 0; e < 16; ++e) {
        const int r = BIG_ROW(i, e);
        int tk = tokbase + r; tk = tk < 0 ? 0 : (tk > NTOK - 1 ? NTOK - 1 : tk);
        const float rs = rstd_of(rstd, tk);
#pragma unroll
        for (int j = 0; j < 4; ++j) U[r * 264 + BIG_COL(j)] = f2bf(acc[i][j][e] * rs);
      }
    __syncthreads();
    {
      const int c = (tid & 63) * 2, rg = tid >> 6;
      const int gcol = n * 128 + c, vcol = DFF + n * 128 + c;
      float wg0[2], wg1[2], wg2[2], bg[2], wv0[2], wv1[2], wv2[2], bv[2];
#pragma unroll
      for (int q = 0; q < 2; ++q) {
        wg0[q] = cw[gcol + q]; wg1[q] = cw[2 * DFF + gcol + q]; wg2[q] = cw[4 * DFF + gcol + q]; bg[q] = cb[gcol + q];
        wv0[q] = cw[vcol + q]; wv1[q] = cw[2 * DFF + vcol + q]; wv2[q] = cw[4 * DFF + vcol + q]; bv[q] = cb[vcol + q];
      }
      const int r0 = 2 + rg * 32;
      const int rend = (r0 + 32 > 256) ? 256 : r0 + 32;
      unsigned t;
      float g2[2], g1[2], v2[2], v1[2];
      t = *(const unsigned*)(U + (r0 - 2) * 264 + c); g2[0] = __uint_as_float(t << 16); g2[1] = __uint_as_float(t & 0xffff0000u);
      t = *(const unsigned*)(U + (r0 - 1) * 264 + c); g1[0] = __uint_as_float(t << 16); g1[1] = __uint_as_float(t & 0xffff0000u);
      t = *(const unsigned*)(U + (r0 - 2) * 264 + 128 + c); v2[0] = __uint_as_float(t << 16); v2[1] = __uint_as_float(t & 0xffff0000u);
      t = *(const unsigned*)(U + (r0 - 1) * 264 + 128 + c); v1[0] = __uint_as_float(t << 16); v1[1] = __uint_as_float(t & 0xffff0000u);
      const int tend = (b + 1) * SEQ;
      for (int r = r0; r < rend; ++r) {
        const unsigned ug = *(const unsigned*)(U + r * 264 + c), uv = *(const unsigned*)(U + r * 264 + 128 + c);
        const float g0[2] = {__uint_as_float(ug << 16), __uint_as_float(ug & 0xffff0000u)};
        const float v0[2] = {__uint_as_float(uv << 16), __uint_as_float(uv & 0xffff0000u)};
        float o[2];
#pragma unroll
        for (int q = 0; q < 2; ++q) {
          const float cg = bg[q] + wg0[q] * g2[q] + wg1[q] * g1[q] + wg2[q] * g0[q];
          const float cv = bv[q] + wv0[q] * v2[q] + wv1[q] * v1[q] + wv2[q] * v0[q];
          o[q] = siluf_(cg) * cv;
          g2[q] = g1[q]; g1[q] = g0[q]; v2[q] = v1[q]; v1[q] = v0[q];
        }
        const int tk = tokbase + r;
        if (tk < tend) *(unsigned*)(act + (size_t)tk * DFF + n * 128 + c) = pack2(o[0], o[1]);
      }
    }
    __syncthreads();
  }
}

#define PF_COLS 3328
DEV void first_tok_proj(const Params& p, int l, const float* xcur, float* smf, int bid, int nb) {
  float* PF = (float*)(p.ws + OFF_PF);
  const float* w = p.in[2] + (size_t)l * DM * INC;
  const float* g1 = p.in[1] + l * DM;
  const int tid = my_tid(), lane = tid & 63, wave = tid >> 6;
  for (int task = bid; task < 4 * 52; task += nb) {
    const int b = task / 52, c = (task % 52) * 64 + lane;
    const float* xr = xcur + (size_t)b * SEQ * DM;
    float acc = 0.f, ss = 0.f;
    const int k0 = wave * 128;
#pragma unroll 16
    for (int k = k0; k < k0 + 128; ++k) {
      const float xv = xr[k];
      ss += xv * xv;
      acc += xv * g1[k] * w[(size_t)k * INC + c];
    }
    smf[wave * 64 + lane] = acc;
    smf[512 + wave * 64 + lane] = ss;
    __syncthreads();
    if (wave == 0) {
      float ta = 0.f, ts = 0.f;
#pragma unroll
      for (int q = 0; q < 8; ++q) { ta += smf[q * 64 + lane]; ts += smf[512 + q * 64 + lane]; }
      PF[b * PF_COLS + c] = ta * rsqrtf(ts * (1.0f / DM) + 1e-6f);
    }
    __syncthreads();
  }
}
DEV void first_tok_fix(const Params& p, int l, float* smf, int bid, int nb) {
  const int tid = my_tid(), lane = tid & 63;
  const float* PF = (const float*)(p.ws + OFF_PF);
  u16* yrw = (u16*)(p.ws + OFF_BIG + B_YRW);
  u16* yret = (u16*)(p.ws + OFF_BIG + B_YRET);
  const float* mu = p.in[3] + l * 1792;
  for (int task = bid; task < 48; task += nb) {
    const int b = task / 12, hh = task % 12;
    const float* pf = PF + b * PF_COLS;
    const size_t t0 = (size_t)b * SEQ;
    __syncthreads();
    if (hh < 8) {
      const int h = hh;
      if (tid < 64) smf[tid] = pf[1600 + tid] * (1.f - mu[1600 + tid]);
      if (tid < 128) smf[64 + tid] = sigmoidf_(pf[1664 + tid] * (1.f - mu[1664 + tid]));
      __syncthreads();
      if (tid < 64) {
        const int ch = h * 64 + tid;
        const float r = pf[ch] * (1.f - mu[ch]);
        const float k = pf[512 + ch] * (1.f - mu[512 + ch]);
        const float v = pf[1024 + ch] * (1.f - mu[1024 + ch]);
        const float* aup = p.in[7] + (size_t)l * 64 * 512;
        const float* gup = p.in[8] + (size_t)l * 128 * 512;
        float al = p.in[6][l * 512 + ch], g = 0.f;
        for (int j = 0; j < 64; ++j) al += smf[j] * aup[j * 512 + ch];
        for (int j = 0; j < 128; ++j) g += smf[64 + j] * gup[j * 512 + ch];
        const float a = sigmoidf_(al);
        const float kp = k * (1.f + (a - 1.f) * p.in[10][l * 512 + ch]);
        const float s = wave_sum(kp * r);
        const float bon = wave_sum(r * kp * p.in[11][l * 512 + ch]);
        const float y = v * s;
        const float mean = wave_sum(y) * (1.f / 64.f);
        const float d = y - mean;
        const float var = wave_sum(d * d) * (1.f / 64.f);
        const float o = (d * rsqrtf(var + 64e-5f) * p.in[12][l * 512 + ch] + p.in[13][l * 512 + ch] + bon * v) * g;
        yrw[t0 * 512 + ch] = f2bf(o);
      }
    } else {
      const int h = hh - 8;
      float part = 0.f;
      if (tid < 64) part = pf[1792 + h * 64 + tid] * pf[1792 + 256 + h * 64 + tid];
      if (tid < 64) { part = wave_sum(part); if (lane == 0) smf[0] = part * 0.125f; }
      __syncthreads();
      const float s = smf[0];
      float y = 0.f;
      if (tid < 128) y = s * pf[1792 + 512 + h * 128 + tid];
      float q = wave_sum(y * y);
      if (tid < 128 && lane == 0) smf[1 + (tid >> 6)] = q;
      __syncthreads();
      if (tid < 128) {
        const float ms = (smf[1] + smf[2]) * (1.f / 128.f);
        const float g = pf[1792 + 1024 + h * 128 + tid];
        yret[t0 * 512 + h * 128 + tid] = f2bf(y * rsqrtf(ms + 1e-6f) * siluf_(g));
      }
    }
  }
}

namespace pg8 {
#define PG8_LAS __attribute__((address_space(3)))
typedef unsigned short bf16_t;
typedef short bf16x8 __attribute__((ext_vector_type(8)));
typedef float f32x4 __attribute__((ext_vector_type(4)));
typedef unsigned u32x4 __attribute__((ext_vector_type(4)));
constexpr int BM = 256, BK = 64, HALF = 128, HTB = HALF * BK * 2  , STAGE_BYTES = 8 * HTB, NXCD = 8, WGM = 8;

__host__ __device__ __forceinline__ int lds_byte(int r, int c) { const int st = (r >> 4) * 2 + (c >> 5), rr = r & 15, cc = c & 31, ob = rr * 64 + cc * 2; return st * 1024 + (ob ^ (((ob >> 9) & 1) << 5)); }
__host__ __device__ __forceinline__ void stage_rc(int b, int& R, int& C) { const int st = b / 1024, sb = b % 1024, swz = sb ^ (((sb >> 9) & 1) << 5); R = (st >> 1) * 16 + swz / 64; C = (st & 1) * 32 + (swz % 64) / 2; }
__host__ __device__ __forceinline__ int perm32(int rho) { const int n = rho >> 4, i = rho & 15; return 8 * (i >> 2) + 4 * n + (i & 3); }

struct Unit { int pm, pn, arow, slot; };
struct Gemm { const bf16_t* A; const bf16_t* Bt; int M, N, K; };

struct StaticOrder {
    int nM, nN, nwg, G, c;
    __host__ __device__ void init(int M, int N, int G_, int c_) { nM = M / BM; nN = N / BM; nwg = nM * nN; G = G_; c = c_; }
    __host__ __device__ bool next(int i, Unit& u) const {
        const long L = (long)i * G + c; if (L >= nwg) return false;
        int wgid = (int)L; { const int q = nwg / NXCD, r = nwg % NXCD, xcd = wgid % NXCD, off = wgid / NXCD; wgid = (xcd < r ? xcd * (q + 1) : r * (q + 1) + (xcd - r) * q) + off; }
        const int nig = WGM * nN, gid = wgid / nig, fm = gid * WGM, gsz = (nM - fm) < WGM ? (nM - fm) : WGM;
        u.pm = fm + ((wgid % nig) % gsz); u.pn = (wgid % nig) / gsz; u.arow = u.pm * BM; u.slot = i & 1; return true;
    }
    __device__ __forceinline__ void a_ready(const Unit&) const {}
    __device__ __forceinline__ void done(const Unit&) const {}
};

__device__ __forceinline__ unsigned cvt_pk_bf16(float lo, float hi) { unsigned r; asm volatile("v_cvt_pk_bf16_f32 %0, %1, %2" : "=v"(r) : "v"(lo), "v"(hi)); return r; }

template <class Epi, class Sched, bool STAMP = false>
__device__ __forceinline__ void gemm_phase(PG8_LAS unsigned char* lds, const Gemm g, const Sched& S, const Epi& E, unsigned long long* stamps) {
    const int tid = my_tid(), wid = __builtin_amdgcn_readfirstlane(tid >> 6), lane = tid & 63, wr = wid >> 2, wc = wid & 3, fr = lane & 15, fq = lane >> 4;
    const int K = g.K, nt = K / BK;
    int ts_lo = 0, ts_hi = 0, nts = 0; const unsigned long long rt_entry = STAMP ? (unsigned long long)wall_clock64() : 0ull;
#define PG8_STAMP() do { if (STAMP && wid == 0 && nts < 64) { const unsigned long long _c = (unsigned long long)clock64(); \
        ts_lo = (lane == nts) ? (int)(unsigned)_c : ts_lo; ts_hi = (lane == nts) ? (int)(unsigned)(_c >> 32) : ts_hi; ++nts; } } while (0)
    PG8_STAMP();
    unsigned voffA[2], voffB[2];
#pragma unroll
    for (int i = 0; i < 2; ++i) { int R, C; stage_rc(tid * 16 + i * 8192, R, C); const int Rb = Epi::PERM ? ((R & ~31) + perm32(R & 31)) : R;
        voffA[i] = (unsigned)(R * K + C) * 2u; voffB[i] = (unsigned)(Rb * K + C) * 2u; }
    const size_t kstep = (size_t)(BK * 2);
    const size_t hstep = (size_t)HALF * K * 2;
    const size_t tstep = 2 * hstep;
    const unsigned ldsw = (unsigned)wid * 1024u;
    const int aoff = lds_byte(wr * 64 + fr, fq * 8), boff = lds_byte(wc * 32 + fr, fq * 8);
#define PG8_SA(b, h) (((b) * 2 + (h)) * HTB)
#define PG8_SB(b, h) ((4 + (b) * 2 + (h)) * HTB)
#define PG8_STAGE(bufoff, gbase, voff) do { _Pragma("unroll") for (int _i = 0; _i < 2; ++_i) \
        __builtin_amdgcn_global_load_lds((const unsigned*)((const char*)(gbase) + (voff)[_i]), (PG8_LAS unsigned*)(lds + (bufoff) + ldsw + _i * 8192), 16, 0, 0); } while (0)
#define PG8_LDA(dst, b, h) do { _Pragma("unroll") for (int m = 0; m < 4; ++m) _Pragma("unroll") for (int k = 0; k < 2; ++k) dst[m][k] = *(const PG8_LAS bf16x8*)(lds + PG8_SA(b, h) + aoff + m * 2048 + k * 1024); } while (0)
#define PG8_LDB(dst, b, h) do { _Pragma("unroll") for (int n = 0; n < 2; ++n) _Pragma("unroll") for (int k = 0; k < 2; ++k) dst[n][k] = *(const PG8_LAS bf16x8*)(lds + PG8_SB(b, h) + boff + n * 2048 + k * 1024); } while (0)
#define PG8_MMA(ai, bj, At, Bt) do { __builtin_amdgcn_s_setprio(1); _Pragma("unroll") for (int m = 0; m < 4; ++m) _Pragma("unroll") for (int n = 0; n < 2; ++n) _Pragma("unroll") for (int k = 0; k < 2; ++k) \
        acc[ai][bj][m][n] = __builtin_amdgcn_mfma_f32_16x16x32_bf16(Bt[n][k], At[m][k], acc[ai][bj][m][n], 0, 0, 0); __builtin_amdgcn_s_setprio(0); } while (0)
#define PG8_WAIT_V(n) asm volatile("s_waitcnt vmcnt(" #n ")" ::: "memory")
#define PG8_WAIT_L(n) asm volatile("s_waitcnt lgkmcnt(" #n ")" ::: "memory")
#define PG8_BAR __builtin_amdgcn_s_barrier()
#define PG8_SCHED __builtin_amdgcn_sched_barrier(0)
    Unit cur, nxt; int ui = 0;
    if (!S.next(0, cur)) return;
    f32x4 acc[2][2][4][2];
#pragma unroll
    for (int a = 0; a < 2; ++a)
#pragma unroll
        for (int b = 0; b < 2; ++b)
#pragma unroll
            for (int m = 0; m < 4; ++m)
#pragma unroll
                for (int n = 0; n < 2; ++n) acc[a][b][m][n] = (f32x4){0.f, 0.f, 0.f, 0.f};
    bf16x8 At[4][2], B0[2][2], B1[2][2];
    const char* cA = (const char*)g.A + (long)cur.arow * (long)(K * 2); const char* cB = (const char*)g.Bt + (size_t)cur.pn * tstep;
    S.a_ready(cur);
    PG8_STAGE(PG8_SB(0, 0), cB, voffB); PG8_STAGE(PG8_SA(0, 0), cA, voffA); PG8_STAGE(PG8_SB(0, 1), cB + hstep, voffB); PG8_STAGE(PG8_SA(0, 1), cA + hstep, voffA);
    if (wr == 1) PG8_BAR;
    PG8_WAIT_V(4); PG8_BAR;
    PG8_STAGE(PG8_SB(1, 0), cB + kstep, voffB); PG8_STAGE(PG8_SA(1, 0), cA + kstep, voffA); PG8_STAGE(PG8_SB(1, 1), cB + hstep + kstep, voffB);
    PG8_WAIT_V(6); PG8_BAR;
    PG8_STAMP();
    for (;;) {
        const bool has_next = S.next(ui + 1, nxt);
        const char* nA = has_next ? (const char*)g.A + (long)nxt.arow * (long)(K * 2) : cA; const char* nB = has_next ? (const char*)g.Bt + (size_t)nxt.pn * tstep : cB;
        for (int t = 0; t < nt; t += 2) {
            const bool last = (t == nt - 2);
            const char* a1 = cA + (size_t)(t + 1) * kstep;
            const char* a2 = last ? nA : cA + (size_t)(t + 2) * kstep; const char* b2 = last ? nB : cB + (size_t)(t + 2) * kstep;
            const char* a3 = a2 + kstep; const char* b3 = b2 + kstep;
            if (last && has_next) S.a_ready(nxt);
            PG8_LDB(B0, 0, 0); PG8_SCHED; PG8_LDA(At, 0, 0); PG8_STAGE(PG8_SA(1, 1), a1 + hstep, voffA);
            PG8_WAIT_L(8); PG8_BAR; PG8_WAIT_L(0); PG8_MMA(0, 0, At, B0); PG8_BAR; PG8_SCHED;
            PG8_LDB(B1, 0, 1); PG8_STAGE(PG8_SB(0, 0), b2, voffB);
            PG8_BAR; PG8_WAIT_L(0); PG8_MMA(0, 1, At, B1); PG8_BAR;
            PG8_LDA(At, 0, 1); PG8_STAGE(PG8_SA(0, 0), a2, voffA);
            PG8_BAR; PG8_WAIT_L(0); PG8_MMA(1, 0, At, B0); PG8_BAR; PG8_SCHED;
            PG8_STAGE(PG8_SB(0, 1), b2 + hstep, voffB);
            PG8_WAIT_V(6); PG8_BAR; PG8_MMA(1, 1, At, B1); PG8_BAR;
            PG8_LDB(B0, 1, 0); PG8_SCHED; PG8_LDA(At, 1, 0); PG8_STAGE(PG8_SA(0, 1), a2 + hstep, voffA);
            PG8_WAIT_L(8); PG8_BAR; PG8_WAIT_L(0); PG8_MMA(0, 0, At, B0); PG8_BAR; PG8_SCHED;
            PG8_LDB(B1, 1, 1); PG8_STAGE(PG8_SB(1, 0), b3, voffB);
            PG8_BAR; PG8_WAIT_L(0); PG8_MMA(0, 1, At, B1); PG8_BAR;
            PG8_LDA(At, 1, 1); PG8_STAGE(PG8_SA(1, 0), a3, voffA);
            PG8_BAR; PG8_WAIT_L(0); PG8_MMA(1, 0, At, B0); PG8_BAR; PG8_SCHED;
            PG8_STAGE(PG8_SB(1, 1), b3 + hstep, voffB);
            PG8_WAIT_V(6); PG8_BAR; PG8_MMA(1, 1, At, B1); PG8_BAR;
        }
        PG8_STAMP();
        if constexpr (!Epi::AFTER_DRAIN) { E(acc, cur, wr, wc, fr, fq); S.done(cur); }
        PG8_STAMP();
        if (!has_next) break;
#pragma unroll
        for (int a = 0; a < 2; ++a)
#pragma unroll
            for (int b = 0; b < 2; ++b)
#pragma unroll
                for (int m = 0; m < 4; ++m)
#pragma unroll
                    for (int n = 0; n < 2; ++n) acc[a][b][m][n] = (f32x4){0.f, 0.f, 0.f, 0.f};
        cur = nxt; cA = nA; cB = nB; ++ui;
    }
    PG8_WAIT_V(0);
    if (wr == 0) PG8_BAR;
    PG8_BAR;
    if constexpr (Epi::AFTER_DRAIN) { E.fused(acc, cur, wr, wc, fr, fq, lds, wid, lane); S.done(cur); }
    PG8_STAMP();
    if (STAMP && wid == 0) { stamps[lane] = lane < nts ? (((unsigned long long)(unsigned)ts_hi << 32) | (unsigned)ts_lo) : 0ull;
        if (lane == 62) stamps[62] = rt_entry; if (lane == 63) stamps[63] = (unsigned long long)wall_clock64(); }
#undef PG8_STAMP
#undef PG8_SA
#undef PG8_SB
#undef PG8_STAGE
#undef PG8_LDA
#undef PG8_LDB
#undef PG8_MMA
#undef PG8_WAIT_V
#undef PG8_WAIT_L
#undef PG8_BAR
#undef PG8_SCHED
}
}

struct EpiInproj {
  static constexpr bool PERM = true, AFTER_DRAIN = false;
  u16* O; int ldc; const float* ssq;
  __device__ __forceinline__ void operator()(const pg8::f32x4 (&acc)[2][2][4][2], const pg8::Unit& u, int wr, int wc, int fr, int fq) const {
    const int row0 = u.pm * 256 + wr * 64 + fr, col0 = u.pn * 256 + wc * 32 + 8 * fq;
#pragma unroll
    for (int ai = 0; ai < 2; ++ai)
#pragma unroll
      for (int m = 0; m < 4; ++m) {
        const int row = row0 + ai * 128 + m * 16;
        const float rs = ssq ? rsqrtf(ssq[row] * (1.0f / DM) + 1e-6f) : 1.0f;
        u16* rowp = O + (size_t)row * ldc + col0;
#pragma unroll
        for (int bj = 0; bj < 2; ++bj) {
          const pg8::f32x4 v0 = acc[ai][bj][m][0] * rs, v1 = acc[ai][bj][m][1] * rs;
          u32x4 w;
          w.x = pack2(v0[0], v0[1]); w.y = pack2(v0[2], v0[3]); w.z = pack2(v1[0], v1[1]); w.w = pack2(v1[2], v1[3]);
          *(u32x4*)(rowp + bj * 128) = w;
        }
      }
  }
};
struct EpiRes {
  static constexpr bool PERM = false, AFTER_DRAIN = false;
  const float* xin; float* xout; u16* xbo; float* ssq;
  __device__ __forceinline__ void operator()(const pg8::f32x4 (&acc)[2][2][4][2], const pg8::Unit& u, int wr, int wc, int fr, int fq) const {
    const int row0 = u.pm * 256 + wr * 64 + fr, col0 = u.pn * 256 + wc * 32 + 4 * fq;
#pragma unroll
    for (int ai = 0; ai < 2; ++ai)
#pragma unroll
      for (int m = 0; m < 4; ++m) {
        const int row = row0 + ai * 128 + m * 16;
        float sq = 0.f;
#pragma unroll
        for (int bj = 0; bj < 2; ++bj)
#pragma unroll
          for (int n = 0; n < 2; ++n) {
            const size_t o = (size_t)row * DM + col0 + bj * 128 + n * 16;
            const pg8::f32x4 y = *(const pg8::f32x4*)(xin + o) + acc[ai][bj][m][n];
            *(pg8::f32x4*)(xout + o) = y;
            if (xbo) {
              *(uint2*)(xbo + o) = make_uint2(pack2(y[0], y[1]), pack2(y[2], y[3]));
              sq += y[0] * y[0] + y[1] * y[1] + y[2] * y[2] + y[3] * y[3];
            }
          }
        if (xbo) {
          sq += __shfl_xor(sq, 16);
          sq += __shfl_xor(sq, 32);
          if (fq == 0) atomicAdd(ssq + row, sq);
        }
        __builtin_amdgcn_sched_barrier(0);
      }
  }
};
struct EpiGate {
  static constexpr bool PERM = true, AFTER_DRAIN = false;
  u16* Mo; const u16* P; const float* ssq; int first;
  __device__ __forceinline__ void operator()(const pg8::f32x4 (&acc)[2][2][4][2], const pg8::Unit& u, int wr, int wc, int fr, int fq) const {
    const int row0 = u.pm * 256 + wr * 64 + fr, col0 = u.pn * 256 + wc * 32 + 8 * fq;
#pragma unroll
    for (int ai = 0; ai < 2; ++ai)
#pragma unroll
      for (int m = 0; m < 4; ++m) {
        const int row = row0 + ai * 128 + m * 16;
        const float rs = rsqrtf(ssq[row] * (1.0f / DM) + 1e-6f);
#pragma unroll
        for (int bj = 0; bj < 2; ++bj) {
          const size_t o = (size_t)row * DM + col0 + bj * 128;
          float pv[8], mv[8];
          unpack8(*(const uint4*)(P + o), pv);
          if (!first) unpack8(*(const uint4*)(Mo + o), mv);
          else {
#pragma unroll
            for (int j = 0; j < 8; ++j) mv[j] = 0.f;
          }
#pragma unroll
          for (int j = 0; j < 4; ++j) {
            mv[j] += sigmoidf_(acc[ai][bj][m][0][j] * rs) * pv[j];
            mv[4 + j] += sigmoidf_(acc[ai][bj][m][1][j] * rs) * pv[4 + j];
          }
          *(uint4*)(Mo + o) = pack8(mv);
        }
        __builtin_amdgcn_sched_barrier(0);
      }
  }
};
struct FfnOrder : pg8::StaticOrder {
  __device__ bool next(int i, pg8::Unit& u) const {
    if (!pg8::StaticOrder::next(i, u)) return false;
    const int b = u.pm / 33, mi = u.pm % 33;
    u.arow = b * SEQ + mi * 254 - 2;
    return true;
  }
};
struct EpiFfn {
  static constexpr bool PERM = true, AFTER_DRAIN = false;
  const Params* pp; int l; int bid;
  __device__ __forceinline__ void operator()(const pg8::f32x4 (&acc)[2][2][4][2], const pg8::Unit& u, int wr, int wc, int fr, int fq) const {
    const int b = u.pm / 33, mi = u.pm % 33;
    const int tokbase = b * SEQ + mi * 254 - 2, tbeg = b * SEQ, tend = (b + 1) * SEQ;
    asm volatile("" : "+v"(fr), "+v"(fq));
    u16* act = (u16*)(pp->ws + OFF_BIG + B_ACT);
    const float* ssq = (const float*)(pp->ws + OFF_RSTD) + (size_t)(2 * l + 1) * NTOK;
    const float* cw = pp->in[22] + (size_t)l * 3 * 2 * DFF;
    const float* cb = pp->in[23] + (size_t)l * 2 * DFF;
    u16* S = (u16*)(pp->ws + OFF_BIG + 192 * MiB) + (size_t)bid * 131072 + (size_t)u.slot * 65536;
#pragma unroll
    for (int ai = 0; ai < 2; ++ai)
#pragma unroll
      for (int m = 0; m < 4; ++m) {
        const int r = ai * 128 + wr * 64 + m * 16 + fr;
        int tk = tokbase + r; tk = tk < 0 ? 0 : (tk > NTOK - 1 ? NTOK - 1 : tk);
        const float rs = rsqrtf(ssq[tk] * (1.0f / DM) + 1e-6f);
#pragma unroll
        for (int bj = 0; bj < 2; ++bj) {
          const pg8::f32x4 v0 = acc[ai][bj][m][0] * rs, v1 = acc[ai][bj][m][1] * rs;
          u32x4 w;
          w.x = pack2(v0[0], v0[1]); w.y = pack2(v0[2], v0[3]); w.z = pack2(v1[0], v1[1]); w.w = pack2(v1[2], v1[3]);
          *(u32x4*)(S + r * 256 + bj * 128 + wc * 32 + 8 * fq) = w;
        }
      }
    asm volatile("s_waitcnt vmcnt(0)" ::: "memory");
    __builtin_amdgcn_s_barrier();
    __builtin_amdgcn_s_barrier();
    asm volatile("" ::: "memory");
    const int tid = my_tid(), cc = tid & 31, rg = tid >> 5;
    const int gcol = u.pn * 128 + cc * 4, vcol = DFF + gcol;
    float wg[3][4], wv[3][4], bg[4], bv[4];
#pragma unroll
    for (int q = 0; q < 3; ++q) {
      const float4 a0 = *(const float4*)(cw + q * 2 * DFF + gcol);
      const float4 c0 = *(const float4*)(cw + q * 2 * DFF + vcol);
      wg[q][0] = a0.x; wg[q][1] = a0.y; wg[q][2] = a0.z; wg[q][3] = a0.w;
      wv[q][0] = c0.x; wv[q][1] = c0.y; wv[q][2] = c0.z; wv[q][3] = c0.w;
    }
    {
      const float4 a0 = *(const float4*)(cb + gcol);
      const float4 c0 = *(const float4*)(cb + vcol);
      bg[0] = a0.x; bg[1] = a0.y; bg[2] = a0.z; bg[3] = a0.w;
      bv[0] = c0.x; bv[1] = c0.y; bv[2] = c0.z; bv[3] = c0.w;
    }
    uint2 rgt[18], rvl[18];
#pragma unroll
    for (int q = 0; q < 18; ++q) {
      int r = rg * 16 + q - 2; r = r < 0 ? 0 : r;
      rgt[q] = *(const uint2*)(S + r * 256 + cc * 4);
      rvl[q] = *(const uint2*)(S + r * 256 + 128 + cc * 4);
    }
    float g2[4], g1[4], v2[4], v1[4];
#define UNP4(src_, dst_) { dst_[0] = __uint_as_float(src_.x << 16); dst_[1] = __uint_as_float(src_.x & 0xffff0000u); dst_[2] = __uint_as_float(src_.y << 16); dst_[3] = __uint_as_float(src_.y & 0xffff0000u); }
    {
      const bool z0 = (tokbase + rg * 16 - 2) < tbeg, z1 = (tokbase + rg * 16 - 1) < tbeg;
      UNP4(rgt[0], g2); UNP4(rvl[0], v2); UNP4(rgt[1], g1); UNP4(rvl[1], v1);
#pragma unroll
      for (int j = 0; j < 4; ++j) { if (z0) { g2[j] = 0.f; v2[j] = 0.f; } if (z1) { g1[j] = 0.f; v1[j] = 0.f; } }
    }
#pragma unroll
    for (int q = 2; q < 18; ++q) {
      const int r = rg * 16 + q - 2;
      const int tk = tokbase + r;
      float g0[4], v0[4], o[4];
      UNP4(rgt[q], g0); UNP4(rvl[q], v0);
      if (tk < tbeg) {
#pragma unroll
        for (int j = 0; j < 4; ++j) { g0[j] = 0.f; v0[j] = 0.f; }
      }
#pragma unroll
      for (int j = 0; j < 4; ++j) {
        const float cg = bg[j] + wg[0][j] * g2[j] + wg[1][j] * g1[j] + wg[2][j] * g0[j];
        const float cv = bv[j] + wv[0][j] * v2[j] + wv[1][j] * v1[j] + wv[2][j] * v0[j];
        o[j] = siluf_(cg) * cv;
        g2[j] = g1[j]; g1[j] = g0[j]; v2[j] = v1[j]; v1[j] = v0[j];
      }
      if (r >= 2 && tk < tend) *(uint2*)(act + (size_t)tk * DFF + u.pn * 128 + cc * 4) = make_uint2(pack2(o[0], o[1]), pack2(o[2], o[3]));
    }
#undef UNP4
  }
};
template <class Epi>
DEV void pg8_gemm(unsigned char* smraw, const u16* A, const u16* Bt, int M, int N, int K, const Epi& E, int bid, int nb) {
  pg8::Gemm g{A, Bt, M, N, K};
  pg8::StaticOrder S;
  S.init(M, N, nb, bid);
  pg8::gemm_phase<Epi, pg8::StaticOrder, false>((PG8_LAS unsigned char*)smraw, g, S, E, nullptr);
}

#define PPL 17
#define NPHASE (2 + 2 * PPL)
template <int ph>
DEV void run_phase(const Params& p, unsigned char* smraw, int bid, int nb) {
  u16* smem = (u16*)smraw;
  float* smf = (float*)smraw;
  float* xo = p.out;
  u16* xb = (u16*)(p.ws + OFF_XB);
  float* ssq_all = (float*)(p.ws + OFF_RSTD);
  if (ph == 0) { phase_prep(p, smf, bid, nb); return; }
  if (ph == NPHASE - 1) { phase_final(xo, p.in[25], bid, nb); return; }
  const int l = (ph - 1) / PPL, s = (ph - 1) % PPL;
  const float* xcur = (l == 0) ? p.in[0] : xo;
  unsigned char* W = p.ws + OFF_W + (size_t)l * LW_BYTES;
  float* ssq1 = ssq_all + (size_t)(2 * l) * NTOK;
  float* ssq2 = ssq_all + (size_t)(2 * l + 1) * NTOK;
  switch (s) {
    case 0: if (l == 0) phase_norm(xcur, xb, ssq1, bid, nb); break;
    case 1: { EpiInproj E{(u16*)(p.ws + OFF_BIG + B_PRW), 1792, ssq1}; pg8_gemm(smraw, xb, (const u16*)(W + W_IN), NTOK, 1792, DM, E, bid, nb); } break;
    case 2: phase_rwprep(p, l, smem, bid, nb); break;
    case 3: phase_scan<1>(p, l, smf, bid, nb); break;
    case 4: phase_scanprop(p, smf, bid, nb); first_tok_proj(p, l, xcur, smf, nb - 1 - bid, nb); break;
    case 5: phase_scan<3>(p, l, smf, bid, nb); break;
    case 6: { EpiInproj E{(u16*)(p.ws + OFF_BIG + B_PRS), 2560, ssq1}; pg8_gemm(smraw, xb, (const u16*)(W + W_IN) + (size_t)1792 * DM, NTOK, 2560, DM, E, bid, nb); } break;
    case 7:
      for (int u = bid; u < 1024; u += nb) ret_kv_unit(p, u, smem);
      for (int u = bid; u < 256; u += nb) sgu_unit(p, l, u, smem);
      break;
    case 8: phase_retprefix(p, bid, nb); break;
    case 9:
      for (int u = bid; u < 1024; u += nb) ret_out_unit(p, u, smem);
      first_tok_fix(p, l, smf, nb - 1 - bid, nb);
      break;
    case 10: {
      const u16* wbr = (const u16*)(W + W_BR);
      for (int g = 0; g < 3; ++g) {
        const u16* yg = (const u16*)(p.ws + OFF_BIG + (g == 0 ? B_YRW : (g == 1 ? B_YRET : B_YSG)));
        EpiInproj E{(u16*)(p.ws + OFF_BIG + B_P) + (size_t)g * NTOK * DM, DM, nullptr};
        pg8_gemm(smraw, yg, wbr + (size_t)g * DM * 512, NTOK, DM, 512, E, bid, nb);
      }
    } break;
    case 11: case 12: case 13: {
      const int g = s - 11;
      EpiGate E{(u16*)(p.ws + OFF_BIG + B_M), (const u16*)(p.ws + OFF_BIG + B_P) + (size_t)g * NTOK * DM, ssq1, g == 0 ? 1 : 0};
      pg8_gemm(smraw, xb, (const u16*)(W + W_IN) + (size_t)(4352 + g * DM) * DM, NTOK, DM, DM, E, bid, nb);
    } break;
    case 14: { EpiRes E{xcur, xo, xb, ssq2}; pg8_gemm(smraw, (const u16*)(p.ws + OFF_BIG + B_M), (const u16*)(W + W_OUT), NTOK, DM, DM, E, bid, nb); } break;
    case 15: {
      FfnOrder S;
      S.init(132 * 256, 2 * DFF, nb, bid);
      EpiFfn E{&p, l, bid};
      pg8::Gemm g{xb, (const u16*)(W + W_UP), 132 * 256, 2 * DFF, DM};
      pg8::gemm_phase<EpiFfn, FfnOrder, false>((PG8_LAS unsigned char*)smraw, g, S, E, nullptr);
    } break;
    case 16: {
      EpiRes E{xo, xo, (l == 0) ? xb : nullptr, (l == 0) ? ssq_all + (size_t)2 * NTOK : nullptr};
      pg8_gemm(smraw, (const u16*)(p.ws + OFF_BIG + B_ACT), (const u16*)(W + W_DN), NTOK, DM, DFF, E, bid, nb);
    } break;
  }
}
DEV constexpr bool phase_empty(int ph) {
  return ph >= 1 && ph < NPHASE - 1 && ((ph - 1) % PPL == 0 && (ph - 1) / PPL == 1);
}

#define XB_TMO      128
#define XB_XCNT(j)  (256  + 64 * (j))
#define XB_XSUB(j)  (1280 + 64 * (j))
#define XB_XGEN(j)  (2304 + 64 * (j))
#define XB_TOP      3328
#define XB_TOPGEN   3392
#define XCD_BAR_WORDS 3456
#define XB_SPIN_CAP (1u << 18)
#define LAS __attribute__((address_space(3)))

__device__ __forceinline__ unsigned xb_ld(unsigned* p)              { return __hip_atomic_load(p, __ATOMIC_RELAXED, __HIP_MEMORY_SCOPE_AGENT); }
__device__ __forceinline__ unsigned xb_add(unsigned* p, unsigned v) { return __hip_atomic_fetch_add(p, v, __ATOMIC_RELAXED, __HIP_MEMORY_SCOPE_AGENT); }
__device__ __forceinline__ unsigned xb_xcc_id() { return (unsigned)__builtin_amdgcn_s_getreg((3 << 11) | 20) & 0xFu; }
#define XB_SPIN(cond, bar) do { unsigned _sp = 0; while (cond) { __builtin_amdgcn_s_sleep(1); \
    if ((++_sp & 255u) == 0u) { if (xb_ld(&(bar)[XB_TMO])) break; if (_sp > XB_SPIN_CAP) { atomicAdd(&(bar)[XB_TMO], 1u); break; } } } } while (0)

struct XcdBarrier {
    unsigned* bar; unsigned x;
    volatile LAS unsigned* st;
};

__device__ __forceinline__ XcdBarrier xcd_barrier_post(unsigned* bar, volatile LAS unsigned* st) {
    XcdBarrier b; b.bar = bar; b.x = xb_xcc_id(); b.st = st;
    if (my_tid() == 0) (void)xb_add(&bar[XB_XCNT(b.x)], 1u);
    return b;
}
__device__ __forceinline__ void xcd_barrier_complete(unsigned* bar, unsigned x, unsigned& nloc, unsigned& nx) {
    const unsigned G = gridDim.x * gridDim.y * gridDim.z;
    unsigned sum, cnt, mine, sp = 0u;
    for (;;) {
        sum = 0u; cnt = 0u; mine = 0u;
#pragma unroll
        for (unsigned j = 0; j < 16; ++j) { const unsigned c = xb_ld(&bar[XB_XCNT(j)]); sum += c; cnt += (c > 0u) ? 1u : 0u; mine = (j == x) ? c : mine; }
        if (sum == G) break;
        __builtin_amdgcn_s_sleep(1);
        if ((++sp & 255u) == 0u) { if (xb_ld(&bar[XB_TMO])) break; if (sp > XB_SPIN_CAP) { atomicAdd(&bar[XB_TMO], 1u); break; } }
    }
    nloc = mine > 0u ? mine : 1u; nx = cnt > 0u ? cnt : 1u;
}

__device__ __forceinline__ void xcd_barrier(const XcdBarrier& b) {
    asm volatile("s_waitcnt vmcnt(0)" ::: "memory");
    __syncthreads();
    if (my_tid() == 0) {
        unsigned* bar = b.bar;
        __builtin_amdgcn_s_waitcnt(0);
        unsigned nloc = b.st[0], nx = b.st[1];
        if (nloc == 0u) { xcd_barrier_complete(bar, b.x, nloc, nx); b.st[0] = nloc; b.st[1] = nx; }
        const unsigned old = xb_add(&bar[XB_XSUB(b.x)], 1u);
        const unsigned gen = old / nloc;
        if (old + 1u == (gen + 1u) * nloc) {
            __builtin_amdgcn_fence(__ATOMIC_RELEASE, "agent");
            asm volatile("s_waitcnt vmcnt(0)" ::: "memory");
            const unsigned og = xb_add(&bar[XB_TOP], 1u);
            const unsigned tg = og / nx;
            if (og + 1u == (tg + 1u) * nx) xb_add(&bar[XB_TOPGEN], 1u);
            else XB_SPIN(xb_ld(&bar[XB_TOPGEN]) == tg, bar);
            __builtin_amdgcn_fence(__ATOMIC_ACQUIRE, "agent");
            xb_add(&bar[XB_XGEN(b.x)], 1u);
            asm volatile("s_waitcnt vmcnt(0)" ::: "memory");
        } else {
            XB_SPIN(xb_ld(&bar[XB_XGEN(b.x)]) == gen, bar);
            __builtin_amdgcn_fence(__ATOMIC_ACQUIRE, "agent");
            asm volatile("s_waitcnt vmcnt(0)" ::: "memory");
        }
    }
    __syncthreads();
}


DEV void gsync(unsigned* ctr, unsigned& target) {
  asm volatile("s_waitcnt vmcnt(0)" ::: "memory");
  __syncthreads();
  if (my_tid() == 0) {
    target += gridDim.x;
    __builtin_amdgcn_fence(__ATOMIC_RELEASE, "agent");
    asm volatile("s_waitcnt vmcnt(0)" ::: "memory");
    __hip_atomic_fetch_add(ctr, 1u, __ATOMIC_RELAXED, __HIP_MEMORY_SCOPE_AGENT);
    while (__hip_atomic_load(ctr, __ATOMIC_RELAXED, __HIP_MEMORY_SCOPE_AGENT) < target) __builtin_amdgcn_s_sleep(2);
    __builtin_amdgcn_fence(__ATOMIC_ACQUIRE, "agent");
    asm volatile("s_waitcnt vmcnt(0)" ::: "memory");
  }
  __syncthreads();
}

#if COOP
template <int PH>
DEV void run_seq(const Params& p, unsigned char* smraw, cg::grid_group& grid, const XcdBarrier& xb) {
  if constexpr (phase_empty(PH)) {
    run_seq<PH + 1>(p, smraw, grid, xb);
  } else {
    int bid_ = blockIdx.x;
    asm volatile("" : "+s"(bid_));
    run_phase<PH>(p, smraw, bid_, gridDim.x);
    if constexpr (PH + 1 < NPHASE) {
      if constexpr (PH == 0) grid.sync();
      else xcd_barrier(xb);
      run_seq<PH + 1>(p, smraw, grid, xb);
    }
  }
}
__global__ void __launch_bounds__(NTHR) mega(Params p) {
  __shared__ __align__(16) unsigned char smraw[147456];
  cg::grid_group grid = cg::this_grid();
  __shared__ uint4 xb_words;
  if (my_tid() == 0) xb_words = make_uint4(0u, 0u, 0u, 0u);
  __syncthreads();
  XcdBarrier xb = xcd_barrier_post((unsigned*)p.ws, (volatile LAS unsigned*)&xb_words);
  run_seq<0>(p, smraw, grid, xb);
}
#else
template <int PH>
__global__ void __launch_bounds__(NTHR) phk(Params p) {
  __shared__ __align__(16) unsigned char smraw[147456];
  run_phase<PH>(p, smraw, blockIdx.x, gridDim.x);
}
template <int PH>
static void launch_seq(const Params& p, hipStream_t stream) {
  phk<PH><<<256, NTHR, 0, stream>>>(p);
  if constexpr (PH + 1 < NPHASE) launch_seq<PH + 1>(p, stream);
}
#endif

extern "C" void kernel_launch(void* const* d_in, const int* in_sizes, int n_in, void* d_out, int out_size, void* d_ws,
                              size_t ws_size, hipStream_t stream) {
  Params p{};
  for (int i = 0; i < 26; ++i) p.in[i] = (const float*)d_in[i];
  p.out = (float*)d_out;
  p.ws = (unsigned char*)d_ws;
  if (ws_size < WS_NEED) { fprintf(stderr, "workspace too small: %zu < %llu\n", ws_size, (unsigned long long)WS_NEED); return; }
#if COOP
  static int grid_blocks = 0;
  if (!grid_blocks) {
    int dev = 0, cus = 0, per_cu = 0;
    hipGetDevice(&dev);
    hipDeviceGetAttribute(&cus, hipDeviceAttributeMultiprocessorCount, dev);
    hipOccupancyMaxActiveBlocksPerMultiprocessor(&per_cu, mega, NTHR, 0);
    if (per_cu > 1) per_cu = 1;
    grid_blocks = cus * per_cu;
  }
  hipMemsetAsync(d_ws, 0, 16384, stream);
  void* args[] = {&p};
  hipError_t e = hipLaunchCooperativeKernel((void*)mega, dim3(grid_blocks), dim3(NTHR), args, 0, stream);
  if (e != hipSuccess) fprintf(stderr, "cooperative launch failed: %s (grid %d)\n", hipGetErrorString(e), grid_blocks);
#else
  launch_seq<0>(p, stream);
#endif
}
```

```cpp
#include <hip/hip_runtime.h>
#include <hip/hip_cooperative_groups.h>
#include <cstdio>
#include <cstdint>
namespace cg = cooperative_groups;

#ifndef COOP
#define COOP 1
#endif

#define DEV __device__ __forceinline__
typedef unsigned short u16;
typedef short bf16x8 __attribute__((ext_vector_type(8)));
typedef float f32x16 __attribute__((ext_vector_type(16)));

#define NTHR 512
#define NTOK 32768
#define SEQ 8192
#define DM 1024
#define INC 7424
#define DFF 2816
#define MiB (1048576ull)

#define OFF_ROPE (64ull * 1024)
#define OFF_RSTD (OFF_ROPE + 2 * MiB)
#define OFF_PF (OFF_RSTD + 640ull * 1024)
#define OFF_W (3 * MiB)
#define LW_BYTES (37 * MiB)
#define W_IN 0ull
#define W_BR 15204352ull
#define W_OUT 18350080ull
#define W_UP 20447232ull
#define W_DN 31981568ull
#define W_RWUP 37748736ull
#define W_RAUP 37814272ull
#define W_RGUP 37879808ull
#define W_SGW 38010880ull
#define OFF_XB (77 * MiB)
#define OFF_BIG (141 * MiB)
#define B_PRW 0ull
#define B_YRW 0ull
#define B_YRET (32 * MiB)
#define B_YSG (64 * MiB)
#define B_OPS (112 * MiB)
#define B_PRS (112 * MiB)
#define B_KV (272 * MiB)
#define B_M 0ull
#define B_P (128 * MiB)
#define B_PL (304 * MiB)
#define B_SINIT (320 * MiB)
#define B_ACT 0ull
#define WS_NEED (OFF_BIG + 328 * MiB)

struct Params {
  const float* in[26];
  float* out;
  unsigned char* ws;
};

DEV int my_tid() {
  int t = __builtin_amdgcn_workitem_id_x();
  asm volatile("" : "+v"(t));
  return t;
}
DEV u16 f2bf(float f) {
  unsigned u = __float_as_uint(f);
  u += 0x7fffu + ((u >> 16) & 1u);
  return (u16)(u >> 16);
}
DEV float bf2f(u16 h) { return __uint_as_float(((unsigned)h) << 16); }
DEV unsigned pack2(float a, float b) { return (unsigned)f2bf(a) | ((unsigned)f2bf(b) << 16); }
DEV void unpack8(uint4 v, float* f) {
  f[0] = __uint_as_float(v.x << 16); f[1] = __uint_as_float(v.x & 0xffff0000u);
  f[2] = __uint_as_float(v.y << 16); f[3] = __uint_as_float(v.y & 0xffff0000u);
  f[4] = __uint_as_float(v.z << 16); f[5] = __uint_as_float(v.z & 0xffff0000u);
  f[6] = __uint_as_float(v.w << 16); f[7] = __uint_as_float(v.w & 0xffff0000u);
}
DEV uint4 pack8(const float* f) {
  return make_uint4(pack2(f[0], f[1]), pack2(f[2], f[3]), pack2(f[4], f[5]), pack2(f[6], f[7]));
}
template <int CTRL>
DEV float dppmov(float x) {
  return __builtin_bit_cast(float, __builtin_amdgcn_update_dpp(0, __builtin_bit_cast(int, x), CTRL, 0xF, 0xF, true));
}
DEV float red4(float x) { x += dppmov<0xB1>(x); x += dppmov<0x4E>(x); return x; }
DEV float red8(float x) { x = red4(x); x += dppmov<0x141>(x); return x; }
DEV float wave_sum(float x) {
  x = red8(x);
  x += dppmov<0x140>(x);
  const int xi = __builtin_bit_cast(int, x);
  return __builtin_bit_cast(float, __builtin_amdgcn_readlane(xi, 0)) + __builtin_bit_cast(float, __builtin_amdgcn_readlane(xi, 16)) +
         __builtin_bit_cast(float, __builtin_amdgcn_readlane(xi, 32)) + __builtin_bit_cast(float, __builtin_amdgcn_readlane(xi, 48));
}
DEV float sigmoidf_(float x) { return 1.f / (1.f + __expf(-x)); }
DEV float siluf_(float x) { return x / (1.f + __expf(-x)); }
DEV float geluf_(float x) { return 0.5f * x * (1.f + erff(x * 0.70710678118654752f)); }

DEV float rstd_of(const float* ssq, int row) { return rsqrtf(ssq[row] * (1.0f / DM) + 1e-6f); }
DEV int vbid(int bid, int nb) { return ((nb & 7) == 0) ? (bid & 7) * (nb >> 3) + (bid >> 3) : bid; }
DEV void tile_map(int t, int MTL, int NTL, int& m, int& n) {
  int per = 8 * NTL;
  int g = t / per;
  int r = t - g * per;
  int gm = MTL - g * 8; gm = gm > 8 ? 8 : gm;
  m = g * 8 + r % gm;
  n = r / gm;
}

typedef unsigned u32x4 __attribute__((ext_vector_type(4)));
template <int NA>
struct GStage { u32x4 a0, a1, a2, a3, b0, b1; };
DEV u32x4 g_ld_a(const u16* A, long lda, int g, int azero_below, int arow_max, int ko) {
  const bool z = g < azero_below;
  g = g < 0 ? 0 : g;
  g = g > arow_max ? arow_max : g;
  u32x4 v = *(const u32x4*)(A + (long)g * lda + ko);
  const u32x4 zero = {0u, 0u, 0u, 0u};
  return z ? zero : v;
}
template <int NA>
DEV void g_load(GStage<NA>& S, const u16* A, long lda, int arow, int azero_below, int arow_max,
                const u16* bp0, const u16* bp1, int ko) {
  S.a0 = g_ld_a(A, lda, arow, azero_below, arow_max, ko);
  S.a1 = g_ld_a(A, lda, arow + 64, azero_below, arow_max, ko);
  if constexpr (NA == 4) {
    S.a2 = g_ld_a(A, lda, arow + 128, azero_below, arow_max, ko);
    S.a3 = g_ld_a(A, lda, arow + 192, azero_below, arow_max, ko);
  }
  S.b0 = *(const u32x4*)(bp0 + ko);
  S.b1 = *(const u32x4*)(bp1 + ko);
}
template <int NA>
DEV void g_store(const GStage<NA>& S, u16* An, u16* Bn, int st_off) {
  *(u32x4*)(An + st_off) = S.a0;
  *(u32x4*)(An + st_off + 64 * 72) = S.a1;
  if constexpr (NA == 4) {
    *(u32x4*)(An + st_off + 128 * 72) = S.a2;
    *(u32x4*)(An + st_off + 192 * 72) = S.a3;
  }
  *(u32x4*)(Bn + st_off) = S.b0;
  *(u32x4*)(Bn + st_off + 64 * 72) = S.b1;
}
template <int MT>
DEV void g_compute(f32x16 (&acc)[MT][2], const u16* Ab, const u16* Bb) {
#pragma unroll
  for (int ks = 0; ks < 4; ++ks) {
    bf16x8 a[MT], b[2];
#pragma unroll
    for (int i = 0; i < MT; ++i) a[i] = *(const bf16x8*)(Ab + i * 32 * 72 + ks * 16);
#pragma unroll
    for (int j = 0; j < 2; ++j) b[j] = *(const bf16x8*)(Bb + j * 32 * 72 + ks * 16);
#pragma unroll
    for (int i = 0; i < MT; ++i)
#pragma unroll
      for (int j = 0; j < 2; ++j) acc[i][j] = __builtin_amdgcn_mfma_f32_32x32x16_bf16(a[i], b[j], acc[i][j], 0, 0, 0);
  }
}
template <int MT>
DEV void gemm_tile(f32x16 (&acc)[MT][2], const u16* A, long lda, int arow0, int azero_below, int arow_max,
                   const u16* B, long ldb, int K, u16* smem) {
  constexpr int TM = 128 * MT;
  constexpr int ASZ = TM * 72, BSZ = 128 * 72;
  constexpr int NA = TM / 64;
  const int tid = my_tid(), lane = tid & 63, wave = tid >> 6, wm = wave >> 1, wn = wave & 1;
  const int crow = tid >> 3, ckc = tid & 7;
  GStage<NA> s0, s1;
  const u16* Ak = A + ckc * 8;
  const int arow = arow0 + crow;
  const u16* bp0 = B + (long)crow * ldb + ckc * 8;
  const u16* bp1 = B + (long)(crow + 64) * ldb + ckc * 8;
  const int nk = K >> 6;
  const int arow_l = (wm * 32 * MT + (lane & 31)) * 72 + (lane >> 5) * 8;
  const int brow_l = (wn * 64 + (lane & 31)) * 72 + (lane >> 5) * 8;
  const int st_off = crow * 72 + ckc * 8;
  g_load<NA>(s0, Ak, lda, arow, azero_below, arow_max, bp0, bp1, 0);
  g_store<NA>(s0, smem, smem + ASZ, st_off);
  g_load<NA>(s1, Ak, lda, arow, azero_below, arow_max, bp0, bp1, 64);
  __syncthreads();
  for (int kt = 0; kt < nk; kt += 2) {
    if (kt + 2 < nk) g_load<NA>(s0, Ak, lda, arow, azero_below, arow_max, bp0, bp1, (kt + 2) * 64);
    g_compute<MT>(acc, smem + arow_l, smem + ASZ + brow_l);
    g_store<NA>(s1, smem + (ASZ + BSZ), smem + (ASZ + BSZ) + ASZ, st_off);
    __syncthreads();
    if (kt + 3 < nk) g_load<NA>(s1, Ak, lda, arow, azero_below, arow_max, bp0, bp1, (kt + 3) * 64);
    g_compute<MT>(acc, smem + (ASZ + BSZ) + arow_l, smem + (ASZ + BSZ) + ASZ + brow_l);
    if (kt + 2 < nk) g_store<NA>(s0, smem, smem + ASZ, st_off);
    __syncthreads();
  }
}
struct GStageB { u32x4 a0, a1, a2, a3, b0, b1, b2, b3; };
DEV const u16* g_rowptr(const u16* A, long lda, int g, int arow_max) {
  g = g < 0 ? 0 : g;
  g = g > arow_max ? arow_max : g;
  return A + (long)g * lda;
}
DEV void gb_load(GStageB& S, const u16* A, long lda, int arow, int arow_max, const u16* Bk, long ldb, int ko) {
  S.a0 = *(const u32x4*)(g_rowptr(A, lda, arow, arow_max) + ko);
  S.a1 = *(const u32x4*)(g_rowptr(A, lda, arow + 64, arow_max) + ko);
  S.a2 = *(const u32x4*)(g_rowptr(A, lda, arow + 128, arow_max) + ko);
  S.a3 = *(const u32x4*)(g_rowptr(A, lda, arow + 192, arow_max) + ko);
  S.b0 = *(const u32x4*)(Bk + ko);
  S.b1 = *(const u32x4*)(Bk + 64 * ldb + ko);
  S.b2 = *(const u32x4*)(Bk + 128 * ldb + ko);
  S.b3 = *(const u32x4*)(Bk + 192 * ldb + ko);
}
DEV void gb_store(const GStageB& S, u16* An, u16* Bn, int st_off, int arow, int azero_below) {
  const u32x4 zero = {0u, 0u, 0u, 0u};
  *(u32x4*)(An + st_off) = (arow < azero_below) ? zero : S.a0;
  *(u32x4*)(An + st_off + 64 * 72) = (arow + 64 < azero_below) ? zero : S.a1;
  *(u32x4*)(An + st_off + 128 * 72) = (arow + 128 < azero_below) ? zero : S.a2;
  *(u32x4*)(An + st_off + 192 * 72) = (arow + 192 < azero_below) ? zero : S.a3;
  *(u32x4*)(Bn + st_off) = S.b0;
  *(u32x4*)(Bn + st_off + 64 * 72) = S.b1;
  *(u32x4*)(Bn + st_off + 128 * 72) = S.b2;
  *(u32x4*)(Bn + st_off + 192 * 72) = S.b3;
}
DEV void gb_compute(f32x16 (&acc)[2][4], const u16* Ab, const u16* Bb) {
#pragma unroll
  for (int ks = 0; ks < 4; ++ks) {
    bf16x8 a[2], b[4];
#pragma unroll
    for (int i = 0; i < 2; ++i) a[i] = *(const bf16x8*)(Ab + i * 32 * 72 + ks * 16);
#pragma unroll
    for (int j = 0; j < 4; ++j) b[j] = *(const bf16x8*)(Bb + j * 32 * 72 + ks * 16);
#pragma unroll
    for (int i = 0; i < 2; ++i)
#pragma unroll
      for (int j = 0; j < 4; ++j) acc[i][j] = __builtin_amdgcn_mfma_f32_32x32x16_bf16(a[i], b[j], acc[i][j], 0, 0, 0);
  }
}
DEV void gemm_big(f32x16 (&acc)[2][4], const u16* A, long lda, int arow0, int azero_below, int arow_max,
                  const u16* B, long ldb, int K, u16* smem) {
  constexpr int ASZ = 256 * 72, BSZ = 256 * 72;
  const int tid = my_tid(), lane = tid & 63, wave = tid >> 6, wm = wave >> 1, wn = wave & 1;
  const int crow = tid >> 3, ckc = tid & 7;
  const u16* Ak = A + ckc * 8;
  const int arow = arow0 + crow;
  const u16* Bk = B + (long)crow * ldb + ckc * 8;
  const int nk = K >> 6;
  const int arow_l = (wm * 64 + (lane & 31)) * 72 + (lane >> 5) * 8;
  const int brow_l = (wn * 128 + (lane & 31)) * 72 + (lane >> 5) * 8;
  const int st_off = crow * 72 + ckc * 8;
  GStageB s;
  gb_load(s, Ak, lda, arow, arow_max, Bk, ldb, 0);
  gb_store(s, smem, smem + ASZ, st_off, arow, azero_below);
  __syncthreads();
  for (int kt = 0; kt < nk; ++kt) {
    const bool more = kt + 1 < nk;
    if (more) gb_load(s, Ak, lda, arow, arow_max, Bk, ldb, (kt + 1) * 64);
    __builtin_amdgcn_sched_barrier(0);
    const u16* cb = smem + (kt & 1) * (ASZ + BSZ);
    gb_compute(acc, cb + arow_l, cb + ASZ + brow_l);
    __builtin_amdgcn_sched_barrier(0);
    if (more) {
      u16* nb_ = smem + ((kt + 1) & 1) * (ASZ + BSZ);
      gb_store(s, nb_, nb_ + ASZ, st_off, arow, azero_below);
    }
    __syncthreads();
  }
}
#define BIG_ROW(i, e) (wm * 64 + (i) * 32 + ((e) & 3) + 8 * ((e) >> 2) + 4 * (lane >> 5))
#define BIG_COL(j) (wn * 128 + (j) * 32 + (lane & 31))
#define ZERO_BIG(acc)                                   \
  _Pragma("unroll") for (int i_ = 0; i_ < 2; ++i_)      \
  _Pragma("unroll") for (int j_ = 0; j_ < 4; ++j_)      \
  _Pragma("unroll") for (int e_ = 0; e_ < 16; ++e_) acc[i_][j_][e_] = 0.f;

#define ACC_ROW(MT_, i, e) (wm * 32 * (MT_) + (i) * 32 + ((e) & 3) + 8 * ((e) >> 2) + 4 * (lane >> 5))
#define ACC_COL(j) (wn * 64 + (j) * 32 + (lane & 31))

DEV void tconv(const float* src, int K, int N, u16* dst, const float* scale, int mode, float* t, int bid, int nb) {
  const int tid = my_tid();
  const int KT = K >> 6, NT = N >> 6;
  for (int tt = bid; tt < KT * NT; tt += nb) {
    const int kt = tt % KT, nt = tt / KT;
    const int k0 = kt * 64, n0 = nt * 64;
    int sn0 = n0;
    if (mode == 1) { int j = n0 >> 8, c = n0 & 255; sn0 = (c < 128) ? (j * 128 + c) : (DFF + j * 128 + c - 128); }
    {
      const int kk = tid >> 6, n = tid & 63;
#pragma unroll
      for (int i = 0; i < 8; ++i) {
        int k = kk + 8 * i;
        float v = src[(long)(k0 + k) * N + sn0 + n];
        if (scale) v *= scale[k0 + k];
        t[k * 65 + n] = v;
      }
    }
    __syncthreads();
    {
      const int n = tid >> 3, k8 = tid & 7;
      float f[8];
#pragma unroll
      for (int j = 0; j < 8; ++j) f[j] = t[(k8 * 8 + j) * 65 + n];
      *(uint4*)(dst + (long)(n0 + n) * K + k0 + k8 * 8) = pack8(f);
    }
    __syncthreads();
  }
}

DEV void phase_prep(const Params& p, float* smf, int bid, int nb) {
  for (int l = 0; l < 2; ++l) {
    unsigned char* W = p.ws + OFF_W + (size_t)l * LW_BYTES;
    tconv(p.in[2] + (size_t)l * DM * INC, DM, INC, (u16*)(W + W_IN), p.in[1] + l * DM, 0, smf, bid, nb);
    for (int g = 0; g < 3; ++g)
      tconv(p.in[18] + (size_t)(l * 3 + g) * 512 * DM, 512, DM, (u16*)(W + W_BR) + (size_t)g * DM * 512, nullptr, 0, smf, bid, nb);
    tconv(p.in[19] + (size_t)l * DM * DM, DM, DM, (u16*)(W + W_OUT), nullptr, 0, smf, bid, nb);
    tconv(p.in[21] + (size_t)l * DM * 2 * DFF, DM, 2 * DFF, (u16*)(W + W_UP), p.in[20] + l * DM, 1, smf, bid, nb);
    tconv(p.in[24] + (size_t)l * DFF * DM, DFF, DM, (u16*)(W + W_DN), nullptr, 0, smf, bid, nb);
    tconv(p.in[5] + (size_t)l * 64 * 512, 64, 512, (u16*)(W + W_RWUP), nullptr, 0, smf, bid, nb);
    tconv(p.in[7] + (size_t)l * 64 * 512, 64, 512, (u16*)(W + W_RAUP), nullptr, 0, smf, bid, nb);
    tconv(p.in[8] + (size_t)l * 128 * 512, 128, 512, (u16*)(W + W_RGUP), nullptr, 0, smf, bid, nb);
    const float* sw = p.in[16] + (size_t)l * 4 * 128 * 128;
    u16* sd = (u16*)(W + W_SGW);
    for (int idx = bid * NTHR + my_tid(); idx < 4 * 128 * 128; idx += nb * NTHR) {
      int i = (idx >> 7) & 127, j = idx & 127;
      sd[idx] = f2bf(j <= i ? sw[idx] : 0.f);
    }
  }
  {
    float* sq = (float*)(p.ws + OFF_RSTD) + NTOK;
    for (int idx = bid * NTHR + my_tid(); idx < 3 * NTOK; idx += nb * NTHR) sq[idx] = 0.f;
  }
  float* rc = (float*)(p.ws + OFF_ROPE);
  float* rs = rc + SEQ * 32;
  for (int idx = bid * NTHR + my_tid(); idx < SEQ * 32; idx += nb * NTHR) {
    int pos = idx >> 5, d = idx & 31;
    float lin = (d == 31) ? 1.0f : (float)d * (1.0f / 31.0f);
    float invf = 1.0f / powf(10000.0f, lin);
    float ang = (float)pos * invf;
    double rev = (double)ang * 0.15915494309189533577;
    float fr = (float)(rev - floor(rev));
    rc[idx] = __builtin_amdgcn_cosf(fr);
    rs[idx] = __builtin_amdgcn_sinf(fr);
  }
}

DEV void phase_norm(const float* x, u16* xb, float* rstd, int bid, int nb) {
  const int lane = my_tid() & 63, wave = my_tid() >> 6;
  for (int row = bid * 8 + wave; row < NTOK; row += nb * 8) {
    const float4* xr = (const float4*)(x + (size_t)row * DM);
    float4 v[4];
    float ss = 0.f;
#pragma unroll
    for (int i = 0; i < 4; ++i) {
      v[i] = xr[lane + 64 * i];
      ss += v[i].x * v[i].x + v[i].y * v[i].y + v[i].z * v[i].z + v[i].w * v[i].w;
    }
    ss = wave_sum(ss);
    if (lane == 0) rstd[row] = ss;
    uint2* o = (uint2*)(xb + (size_t)row * DM);
#pragma unroll
    for (int i = 0; i < 4; ++i) o[lane + 64 * i] = make_uint2(pack2(v[i].x, v[i].y), pack2(v[i].z, v[i].w));
  }
}
DEV void phase_final(float* x, const float* g, int bid, int nb) {
  const int lane = my_tid() & 63, wave = my_tid() >> 6;
  for (int row = bid * 8 + wave; row < NTOK; row += nb * 8) {
    float4* xr = (float4*)(x + (size_t)row * DM);
    const float4* gr = (const float4*)g;
    float4 v[4];
    float ss = 0.f;
#pragma unroll
    for (int i = 0; i < 4; ++i) {
      v[i] = xr[lane + 64 * i];
      ss += v[i].x * v[i].x + v[i].y * v[i].y + v[i].z * v[i].z + v[i].w * v[i].w;
    }
    ss = wave_sum(ss);
    float r = rsqrtf(ss * (1.0f / DM) + 1e-6f);
#pragma unroll
    for (int i = 0; i < 4; ++i) {
      float4 gg = gr[lane + 64 * i];
      xr[lane + 64 * i] = make_float4(v[i].x * r * gg.x, v[i].y * r * gg.y, v[i].z * r * gg.z, v[i].w * r * gg.w);
    }
  }
}

DEV void phase_inproj(const u16* xb, const float* rstd, const u16* wt, int N, u16* out, u16* smem, int bid, int nb) {
  const int tid = my_tid(), lane = tid & 63, wave = tid >> 6, wm = wave >> 1, wn = wave & 1;
  const int MTL = NTOK / 256, NTL = N / 256;
  for (int t = vbid(bid, nb); t < MTL * NTL; t += nb) {
    int m, n;
    tile_map(t, MTL, NTL, m, n);
    f32x16 acc[2][4];
    ZERO_BIG(acc);
    gemm_big(acc, xb, DM, m * 256, -(1 << 30), NTOK - 1, wt + (size_t)n * 256 * DM, DM, DM, smem);
#pragma unroll
    for (int i = 0; i < 2; ++i)
#pragma unroll
      for (int e = 0; e < 16; ++e) {
        const int r = BIG_ROW(i, e);
        const float rs = rstd_of(rstd, m * 256 + r);
#pragma unroll
        for (int j = 0; j < 4; ++j) smem[r * 264 + BIG_COL(j)] = f2bf(acc[i][j][e] * rs);
      }
    __syncthreads();
#pragma unroll 4
    for (int k = 0; k < 16; ++k) {
      const int c = tid + NTHR * k;
      const int r = c >> 5, cc = c & 31;
      *(uint4*)(out + (size_t)(m * 256 + r) * N + n * 256 + cc * 8) = *(const uint4*)(smem + r * 264 + cc * 8);
    }
    __syncthreads();
  }
}

#define OPS_STRIDE ((size_t)NTOK * 512)
template <int WHICH>
DEV void rwprep_gemm(const u16* T, u16* OS, const u16* wsrc, const float* w0, const float* a0, u16* ops, int t0, int nbk) {
  const int tid = my_tid(), lane = tid & 63, wave = tid >> 6, wm = wave >> 1, wn = wave & 1;
  constexpr int kd = (WHICH == 2) ? 128 : 64;
  constexpr int aoff = (WHICH == 0) ? 0 : (WHICH == 1 ? 64 : 128);
  constexpr int arr = (WHICH == 0) ? 4 : (WHICH == 1 ? 3 : 5);
  const int arow = (wm * 32 + (lane & 31)) * 264 + (lane >> 5) * 8;
  const int bn = nbk * 128 + wn * 64 + (lane & 31);
  bf16x8 bfr[kd / 16][2];
#pragma unroll
  for (int ks = 0; ks < kd / 16; ++ks)
#pragma unroll
    for (int j = 0; j < 2; ++j) bfr[ks][j] = *(const bf16x8*)(wsrc + (size_t)(bn + j * 32) * kd + ks * 16 + (lane >> 5) * 8);
  f32x16 ac[2];
#pragma unroll
  for (int j = 0; j < 2; ++j)
#pragma unroll
    for (int e = 0; e < 16; ++e) ac[j][e] = 0.f;
#pragma unroll
  for (int ks = 0; ks < kd / 16; ++ks) {
    const bf16x8 a1 = *(const bf16x8*)(T + arow + aoff + ks * 16);
#pragma unroll
    for (int j = 0; j < 2; ++j) ac[j] = __builtin_amdgcn_mfma_f32_32x32x16_bf16(a1, bfr[ks][j], ac[j], 0, 0, 0);
  }
#pragma unroll
  for (int j = 0; j < 2; ++j) {
    const int cl = ACC_COL(j);
    const int ch = nbk * 128 + cl;
    const float w0c = w0[ch], a0c = a0[ch];
#pragma unroll
    for (int e = 0; e < 16; ++e) {
      float val;
      if (WHICH == 0) {
        const float z = -(w0c + ac[j][e]);
        const float sp = fmaxf(z, 0.f) + log1pf(__expf(-fabsf(z)));
        val = __expf(-sp - 0.5f);
      } else if (WHICH == 1) {
        val = sigmoidf_(a0c + ac[j][e]);
      } else {
        val = ac[j][e];
      }
      OS[ACC_ROW(1, 0, e) * 136 + cl] = f2bf(val);
    }
  }
  __syncthreads();
#pragma unroll
  for (int k = 0; k < 4; ++k) {
    const int c = tid + NTHR * k;
    const int r = c >> 4, cc = c & 15;
    *(uint4*)(ops + (size_t)arr * OPS_STRIDE + (size_t)(t0 + r) * 512 + nbk * 128 + cc * 8) = *(const uint4*)(OS + r * 136 + cc * 8);
  }
  __syncthreads();
}

DEV void phase_rwprep(const Params& p, int l, u16* smem, int bid, int nb) {
  const int tid = my_tid(), lane = tid & 63, wave = tid >> 6, wm = wave >> 1, wn = wave & 1;
  const u16* prw = (const u16*)(p.ws + OFF_BIG + B_PRW);
  u16* ops = (u16*)(p.ws + OFF_BIG + B_OPS);
  unsigned char* W = p.ws + OFF_W + (size_t)l * LW_BYTES;
  const u16* wup = (const u16*)(W + W_RWUP);
  const u16* aup = (const u16*)(W + W_RAUP);
  const u16* gup = (const u16*)(W + W_RGUP);
  const float* mu = p.in[3] + l * 1792;
  const float* w0 = p.in[4] + l * 512;
  const float* a0 = p.in[6] + l * 512;
  u16* T = smem;
  for (int tile = bid; tile < NTOK / 128; tile += nb) {
    const int t0 = tile * 128;
    for (int c0 = tid; c0 < 128 * 224; c0 += NTHR * 8) {
      u32x4 cu[8], pv[8];
#pragma unroll
      for (int q = 0; q < 8; ++q) {
        const int c = c0 + NTHR * q;
        const int tok = c / 224, ch = (c % 224) * 8;
        const int t = t0 + tok;
        cu[q] = *(const u32x4*)(prw + (size_t)t * 1792 + ch);
        const int tp = ((t & (SEQ - 1)) != 0) ? t - 1 : t;
        pv[q] = *(const u32x4*)(prw + (size_t)tp * 1792 + ch);
      }
#pragma unroll
      for (int q = 0; q < 8; ++q) {
        const int c = c0 + NTHR * q;
        const int tok = c / 224, ch = (c % 224) * 8;
        const int t = t0 + tok;
        float cur[8], prv[8], o[8];
        unpack8(make_uint4(cu[q].x, cu[q].y, cu[q].z, cu[q].w), cur);
        unpack8(make_uint4(pv[q].x, pv[q].y, pv[q].z, pv[q].w), prv);
        if ((t & (SEQ - 1)) == 0) {
#pragma unroll
          for (int j = 0; j < 8; ++j) prv[j] = 0.f;
        }
        float4 m0 = *(const float4*)(mu + ch), m1 = *(const float4*)(mu + ch + 4);
        float mm[8] = {m0.x, m0.y, m0.z, m0.w, m1.x, m1.y, m1.z, m1.w};
#pragma unroll
        for (int j = 0; j < 8; ++j) o[j] = cur[j] + mm[j] * (prv[j] - cur[j]);
        if (ch < 1536) {
          int arr = ch >> 9;
          *(uint4*)(ops + arr * OPS_STRIDE + (size_t)t * 512 + (ch & 511)) = pack8(o);
        } else {
          int cc = ch - 1536;
          if (cc < 64) {
#pragma unroll
            for (int j = 0; j < 8; ++j) o[j] = tanhf(o[j]);
          } else if (cc >= 128) {
#pragma unroll
            for (int j = 0; j < 8; ++j) o[j] = sigmoidf_(o[j]);
          }
          *(uint4*)(T + tok * 264 + cc) = pack8(o);
        }
      }
    }
    __syncthreads();
    u16* OS = smem + 128 * 264;
    for (int nbk = 0; nbk < 4; ++nbk) {
      rwprep_gemm<0>(T, OS, wup, w0, a0, ops, t0, nbk);
      rwprep_gemm<1>(T, OS, aup, w0, a0, ops, t0, nbk);
      rwprep_gemm<2>(T, OS, gup, w0, a0, ops, t0, nbk);
    }
    __syncthreads();
  }
}

#define TS 32
struct ScanStage {
  float* W; float* KK; float* BB; float* KP; float* RR; float* VV; float* YY;
};
template <int PASS>
DEV void phase_scan(const Params& p, int l, float* smf, int bid, int nb) {
  const int tid = my_tid();
  const int half = tid >> 8, tu = tid & 255;
  const u16* ops = (const u16*)(p.ws + OFF_BIG + B_OPS);
  float* PL = (float*)(p.ws + OFF_BIG + B_PL);
  const float* SIN = (const float*)(p.ws + OFF_BIG + B_SINIT);
  u16* yrw = (u16*)(p.ws + OFF_BIG + B_YRW);
  const float* k_k = p.in[9] + l * 512;
  const float* k_a = p.in[10] + l * 512;
  const float* r_k = p.in[11] + l * 512;
  const float* lng = p.in[12] + l * 512;
  const float* lnb = p.in[13] + l * 512;
  float* base = smf + half * (7 * TS * 64);
  float* sW = base; float* sKK = base + TS * 64; float* sB = base + 2 * TS * 64; float* sKP = base + 3 * TS * 64;
  float* sR = base + 4 * TS * 64; float* sV = base + 5 * TS * 64; float* sY = base + 6 * TS * 64;
  const int ss = tu >> 3, c8 = tu & 7;
  const int ks = tu & 7, rp = tu >> 3;
  for (int u2 = bid; u2 < 256; u2 += nb) {
    const int u = u2 * 2 + half;
    const int bh = u >> 4, c = u & 15;
    const int b = bh >> 3, h = bh & 7;
    const int tok0 = b * SEQ + c * 512;
    const int chb = h * 64 + c8 * 8;
    float S0[8], S1[8], Q0[8], Q1[8];
    if (PASS == 1) {
#pragma unroll
      for (int j = 0; j < 8; ++j) {
        S0[j] = 0.f; S1[j] = 0.f;
        Q0[j] = (ks * 8 + j == 2 * rp) ? 1.f : 0.f;
        Q1[j] = (ks * 8 + j == 2 * rp + 1) ? 1.f : 0.f;
      }
    } else {
      const float* si = SIN + (size_t)u * 4096;
      float4 x0 = *(const float4*)(si + (2 * rp) * 64 + ks * 8), x1 = *(const float4*)(si + (2 * rp) * 64 + ks * 8 + 4);
      float4 y0 = *(const float4*)(si + (2 * rp + 1) * 64 + ks * 8), y1 = *(const float4*)(si + (2 * rp + 1) * 64 + ks * 8 + 4);
      S0[0] = x0.x; S0[1] = x0.y; S0[2] = x0.z; S0[3] = x0.w; S0[4] = x1.x; S0[5] = x1.y; S0[6] = x1.z; S0[7] = x1.w;
      S1[0] = y0.x; S1[1] = y0.y; S1[2] = y0.z; S1[3] = y0.w; S1[4] = y1.x; S1[5] = y1.y; S1[6] = y1.z; S1[7] = y1.w;
#pragma unroll
      for (int j = 0; j < 8; ++j) { Q0[j] = 0.f; Q1[j] = 0.f; }
    }
    float kkc[8], kac[8], rkc[8];
    {
      float4 q0 = *(const float4*)(k_k + chb), q1 = *(const float4*)(k_k + chb + 4);
      kkc[0] = q0.x; kkc[1] = q0.y; kkc[2] = q0.z; kkc[3] = q0.w; kkc[4] = q1.x; kkc[5] = q1.y; kkc[6] = q1.z; kkc[7] = q1.w;
      q0 = *(const float4*)(k_a + chb); q1 = *(const float4*)(k_a + chb + 4);
      kac[0] = q0.x; kac[1] = q0.y; kac[2] = q0.z; kac[3] = q0.w; kac[4] = q1.x; kac[5] = q1.y; kac[6] = q1.z; kac[7] = q1.w;
      q0 = *(const float4*)(r_k + chb); q1 = *(const float4*)(r_k + chb + 4);
      rkc[0] = q0.x; rkc[1] = q0.y; rkc[2] = q0.z; rkc[3] = q0.w; rkc[4] = q1.x; rkc[5] = q1.y; rkc[6] = q1.z; rkc[7] = q1.w;
    }
    uint4 pr_r, pr_k, pr_v, pr_a, pr_e, pr_g = make_uint4(0, 0, 0, 0);
    {
      const size_t o0 = (size_t)(tok0 + ss) * 512 + chb;
      pr_r = *(const uint4*)(ops + 0 * OPS_STRIDE + o0);
      pr_k = *(const uint4*)(ops + 1 * OPS_STRIDE + o0);
      pr_v = *(const uint4*)(ops + 2 * OPS_STRIDE + o0);
      pr_a = *(const uint4*)(ops + 3 * OPS_STRIDE + o0);
      pr_e = *(const uint4*)(ops + 4 * OPS_STRIDE + o0);
      if (PASS == 3) pr_g = *(const uint4*)(ops + 5 * OPS_STRIDE + o0);
    }
    for (int sc = 0; sc < 512 / TS; ++sc) {
      const size_t o = (size_t)(tok0 + sc * TS + ss) * 512 + chb;
      float fr[8], fk[8], fv[8], fa[8], fe[8];
      unpack8(pr_r, fr);
      unpack8(pr_k, fk);
      unpack8(pr_v, fv);
      unpack8(pr_a, fa);
      unpack8(pr_e, fe);
      const uint4 graw = pr_g;
      if (sc + 1 < 512 / TS) {
        const size_t o1 = o + (size_t)TS * 512;
        pr_r = *(const uint4*)(ops + 0 * OPS_STRIDE + o1);
        pr_k = *(const uint4*)(ops + 1 * OPS_STRIDE + o1);
        pr_v = *(const uint4*)(ops + 2 * OPS_STRIDE + o1);
        pr_a = *(const uint4*)(ops + 3 * OPS_STRIDE + o1);
        pr_e = *(const uint4*)(ops + 4 * OPS_STRIDE + o1);
        if (PASS == 3) pr_g = *(const uint4*)(ops + 5 * OPS_STRIDE + o1);
      }
      float kk[8], kp[8], ssq = 0.f, bon = 0.f;
#pragma unroll
      for (int j = 0; j < 8; ++j) {
        kk[j] = fk[j] * kkc[j];
        ssq += kk[j] * kk[j];
        kp[j] = fk[j] * (1.f + (fa[j] - 1.f) * kac[j]);
        bon += fr[j] * kp[j] * rkc[j];
      }
      ssq = red8(ssq);
      bon = red8(bon);
      const float inv = 1.f / fmaxf(sqrtf(ssq), 1e-12f);
      float fw[8], fb[8];
#pragma unroll
      for (int j = 0; j < 8; ++j) {
        kk[j] *= inv;
        fb[j] = fa[j] * kk[j];
        fw[j] = __expf(-fe[j]);
      }
      {
        const int so = ss * 64 + c8 * 8;
        *(float4*)(sW + so) = make_float4(fw[0], fw[1], fw[2], fw[3]); *(float4*)(sW + so + 4) = make_float4(fw[4], fw[5], fw[6], fw[7]);
        *(float4*)(sKK + so) = make_float4(kk[0], kk[1], kk[2], kk[3]); *(float4*)(sKK + so + 4) = make_float4(kk[4], kk[5], kk[6], kk[7]);
        *(float4*)(sB + so) = make_float4(fb[0], fb[1], fb[2], fb[3]); *(float4*)(sB + so + 4) = make_float4(fb[4], fb[5], fb[6], fb[7]);
        *(float4*)(sKP + so) = make_float4(kp[0], kp[1], kp[2], kp[3]); *(float4*)(sKP + so + 4) = make_float4(kp[4], kp[5], kp[6], kp[7]);
        *(float4*)(sV + so) = make_float4(fv[0], fv[1], fv[2], fv[3]); *(float4*)(sV + so + 4) = make_float4(fv[4], fv[5], fv[6], fv[7]);
        if (PASS == 3) {
          *(float4*)(sR + so) = make_float4(fr[0], fr[1], fr[2], fr[3]); *(float4*)(sR + so + 4) = make_float4(fr[4], fr[5], fr[6], fr[7]);
        }
      }
      __syncthreads();
#pragma unroll 2
      for (int s = 0; s < TS; ++s) {
        const int so = s * 64 + ks * 8;
        float4 t0 = *(const float4*)(sW + so), t1 = *(const float4*)(sW + so + 4);
        float w[8] = {t0.x, t0.y, t0.z, t0.w, t1.x, t1.y, t1.z, t1.w};
        t0 = *(const float4*)(sKK + so); t1 = *(const float4*)(sKK + so + 4);
        float kq[8] = {t0.x, t0.y, t0.z, t0.w, t1.x, t1.y, t1.z, t1.w};
        t0 = *(const float4*)(sB + so); t1 = *(const float4*)(sB + so + 4);
        float bq[8] = {t0.x, t0.y, t0.z, t0.w, t1.x, t1.y, t1.z, t1.w};
        t0 = *(const float4*)(sKP + so); t1 = *(const float4*)(sKP + so + 4);
        float kpq[8] = {t0.x, t0.y, t0.z, t0.w, t1.x, t1.y, t1.z, t1.w};
        const float2 vv = *(const float2*)(sV + s * 64 + 2 * rp);
        float sa0 = 0.f, sa1 = 0.f;
#pragma unroll
        for (int j = 0; j < 8; ++j) { sa0 += S0[j] * kq[j]; sa1 += S1[j] * kq[j]; }
        sa0 = red8(sa0); sa1 = red8(sa1);
#pragma unroll
        for (int j = 0; j < 8; ++j) {
          S0[j] = S0[j] * w[j] - sa0 * bq[j] + vv.x * kpq[j];
          S1[j] = S1[j] * w[j] - sa1 * bq[j] + vv.y * kpq[j];
        }
        if (PASS == 1) {
          float pa0 = 0.f, pa1 = 0.f;
#pragma unroll
          for (int j = 0; j < 8; ++j) { pa0 += Q0[j] * kq[j]; pa1 += Q1[j] * kq[j]; }
          pa0 = red8(pa0); pa1 = red8(pa1);
#pragma unroll
          for (int j = 0; j < 8; ++j) {
            Q0[j] = Q0[j] * w[j] - pa0 * bq[j];
            Q1[j] = Q1[j] * w[j] - pa1 * bq[j];
          }
        } else {
          t0 = *(const float4*)(sR + so); t1 = *(const float4*)(sR + so + 4);
          float rq[8] = {t0.x, t0.y, t0.z, t0.w, t1.x, t1.y, t1.z, t1.w};
          float y0 = 0.f, y1 = 0.f;
#pragma unroll
          for (int j = 0; j < 8; ++j) { y0 += S0[j] * rq[j]; y1 += S1[j] * rq[j]; }
          y0 = red8(y0); y1 = red8(y1);
          if (ks == 0) *(float2*)(sY + s * 64 + 2 * rp) = make_float2(y0, y1);
        }
      }
      __syncthreads();
      if (PASS == 3) {
        const int so = ss * 64 + c8 * 8;
        float4 y0 = *(const float4*)(sY + so), y1 = *(const float4*)(sY + so + 4);
        float y[8] = {y0.x, y0.y, y0.z, y0.w, y1.x, y1.y, y1.z, y1.w};
        float sm = 0.f;
#pragma unroll
        for (int j = 0; j < 8; ++j) sm += y[j];
        const float mean = red8(sm) * (1.f / 64.f);
        float sv = 0.f;
#pragma unroll
        for (int j = 0; j < 8; ++j) { y[j] -= mean; sv += y[j] * y[j]; }
        const float var = red8(sv) * (1.f / 64.f);
        const float rs = rsqrtf(var + 64e-5f);
        float g[8], outv[8];
        unpack8(graw, g);
        float4 l0 = *(const float4*)(lng + chb), l1 = *(const float4*)(lng + chb + 4);
        float4 b0 = *(const float4*)(lnb + chb), b1 = *(const float4*)(lnb + chb + 4);
        float lg[8] = {l0.x, l0.y, l0.z, l0.w, l1.x, l1.y, l1.z, l1.w};
        float lb[8] = {b0.x, b0.y, b0.z, b0.w, b1.x, b1.y, b1.z, b1.w};
#pragma unroll
        for (int j = 0; j < 8; ++j) outv[j] = (y[j] * rs * lg[j] + lb[j] + bon * fv[j]) * g[j];
        if (!(c == 0 && sc == 0 && ss == 0)) *(uint4*)(yrw + o) = pack8(outv);
      }
    }
    if (PASS == 1) {
      float* pl = PL + (size_t)u * 8192;
      float* Pm = pl;
      float* Lm = pl + 4096;
      *(float4*)(Pm + (2 * rp) * 64 + ks * 8) = make_float4(Q0[0], Q0[1], Q0[2], Q0[3]);
      *(float4*)(Pm + (2 * rp) * 64 + ks * 8 + 4) = make_float4(Q0[4], Q0[5], Q0[6], Q0[7]);
      *(float4*)(Pm + (2 * rp + 1) * 64 + ks * 8) = make_float4(Q1[0], Q1[1], Q1[2], Q1[3]);
      *(float4*)(Pm + (2 * rp + 1) * 64 + ks * 8 + 4) = make_float4(Q1[4], Q1[5], Q1[6], Q1[7]);
      *(float4*)(Lm + (2 * rp) * 64 + ks * 8) = make_float4(S0[0], S0[1], S0[2], S0[3]);
      *(float4*)(Lm + (2 * rp) * 64 + ks * 8 + 4) = make_float4(S0[4], S0[5], S0[6], S0[7]);
      *(float4*)(Lm + (2 * rp + 1) * 64 + ks * 8) = make_float4(S1[0], S1[1], S1[2], S1[3]);
      *(float4*)(Lm + (2 * rp + 1) * 64 + ks * 8 + 4) = make_float4(S1[4], S1[5], S1[6], S1[7]);
    }
  }
}

DEV void phase_scanprop(const Params& p, float* smf, int bid, int nb) {
  const int tid = my_tid();
  const float* PL = (const float*)(p.ws + OFF_BIG + B_PL);
  float* SIN = (float*)(p.ws + OFF_BIG + B_SINIT);
  float* sS = smf;
  float* sP = smf + 4096;
  const int i = tid >> 3, k8 = tid & 7;
  for (int bh = bid; bh < 32; bh += nb) {
    float cur[8];
#pragma unroll
    for (int j = 0; j < 8; ++j) cur[j] = 0.f;
    const float* pl0 = PL + (size_t)(bh * 16) * 8192;
    float4 np0 = *(const float4*)(pl0 + tid * 8), np1 = *(const float4*)(pl0 + tid * 8 + 4);
    float4 nl0 = *(const float4*)(pl0 + 4096 + i * 64 + k8 * 8), nl1 = *(const float4*)(pl0 + 4096 + i * 64 + k8 * 8 + 4);
    for (int c = 0; c < 16; ++c) {
      const int u = bh * 16 + c;
      float* so = SIN + (size_t)u * 4096 + i * 64 + k8 * 8;
      *(float4*)so = make_float4(cur[0], cur[1], cur[2], cur[3]);
      *(float4*)(so + 4) = make_float4(cur[4], cur[5], cur[6], cur[7]);
      if (c == 15) break;
      *(float4*)(sS + i * 64 + k8 * 8) = make_float4(cur[0], cur[1], cur[2], cur[3]);
      *(float4*)(sS + i * 64 + k8 * 8 + 4) = make_float4(cur[4], cur[5], cur[6], cur[7]);
      *(float4*)(sP + tid * 8) = np0;
      *(float4*)(sP + tid * 8 + 4) = np1;
      float nw[8] = {nl0.x, nl0.y, nl0.z, nl0.w, nl1.x, nl1.y, nl1.z, nl1.w};
      __syncthreads();
      if (c + 1 < 15) {
        const float* pl = PL + (size_t)(u + 1) * 8192;
        np0 = *(const float4*)(pl + tid * 8); np1 = *(const float4*)(pl + tid * 8 + 4);
        nl0 = *(const float4*)(pl + 4096 + i * 64 + k8 * 8); nl1 = *(const float4*)(pl + 4096 + i * 64 + k8 * 8 + 4);
      }
#pragma unroll 8
      for (int j = 0; j < 64; ++j) {
        const float sij = sS[i * 64 + j];
        float4 p0 = *(const float4*)(sP + j * 64 + k8 * 8), p1 = *(const float4*)(sP + j * 64 + k8 * 8 + 4);
        nw[0] += sij * p0.x; nw[1] += sij * p0.y; nw[2] += sij * p0.z; nw[3] += sij * p0.w;
        nw[4] += sij * p1.x; nw[5] += sij * p1.y; nw[6] += sij * p1.z; nw[7] += sij * p1.w;
      }
#pragma unroll
      for (int j = 0; j < 8; ++j) cur[j] = nw[j];
      __syncthreads();
    }
  }
}

DEV float ret_log2gamma(int h) { return log2f(1.0f - exp2f(-5.0f - (float)h)); }

DEV void stage_rot(const u16* src, size_t ld, const float* rc, const float* rs, int pos0, u16* dst, float sc, float l2g, int rowmode) {
  const int tid = my_tid();
  const int row = tid >> 2, d0 = (tid & 3) * 8;
  float lo[8], hi[8], olo[8], ohi[8];
  unpack8(*(const uint4*)(src + (size_t)row * ld + d0), lo);
  unpack8(*(const uint4*)(src + (size_t)row * ld + d0 + 32), hi);
  const float* cp = rc + (size_t)(pos0 + row) * 32 + d0;
  const float* sp = rs + (size_t)(pos0 + row) * 32 + d0;
  float4 c0 = *(const float4*)cp, c1 = *(const float4*)(cp + 4);
  float4 s0 = *(const float4*)sp, s1 = *(const float4*)(sp + 4);
  float cc[8] = {c0.x, c0.y, c0.z, c0.w, c1.x, c1.y, c1.z, c1.w};
  float sn[8] = {s0.x, s0.y, s0.z, s0.w, s1.x, s1.y, s1.z, s1.w};
  float rsc = sc;
  if (rowmode == 1) rsc *= exp2f((float)(row + 1) * l2g);
  if (rowmode == 2) rsc *= exp2f((float)(127 - row) * l2g);
#pragma unroll
  for (int j = 0; j < 8; ++j) {
    olo[j] = (lo[j] * cc[j] - hi[j] * sn[j]) * rsc;
    ohi[j] = (hi[j] * cc[j] + lo[j] * sn[j]) * rsc;
  }
  *(uint4*)(dst + row * 72 + d0) = pack8(olo);
  *(uint4*)(dst + row * 72 + d0 + 32) = pack8(ohi);
}
DEV void stage_rot_T(const u16* src, size_t ld, const float* rc, const float* rs, int pos0, u16* dst, float sc, float l2g) {
  const int tid = my_tid();
  const int row = tid >> 2, d0 = (tid & 3) * 8;
  float lo[8], hi[8];
  unpack8(*(const uint4*)(src + (size_t)row * ld + d0), lo);
  unpack8(*(const uint4*)(src + (size_t)row * ld + d0 + 32), hi);
  const float* cp = rc + (size_t)(pos0 + row) * 32 + d0;
  const float* sp = rs + (size_t)(pos0 + row) * 32 + d0;
  float4 c0 = *(const float4*)cp, c1 = *(const float4*)(cp + 4);
  float4 s0 = *(const float4*)sp, s1 = *(const float4*)(sp + 4);
  float cc[8] = {c0.x, c0.y, c0.z, c0.w, c1.x, c1.y, c1.z, c1.w};
  float sn[8] = {s0.x, s0.y, s0.z, s0.w, s1.x, s1.y, s1.z, s1.w};
  const float rsc = sc * exp2f((float)(127 - row) * l2g);
#pragma unroll
  for (int j = 0; j < 8; ++j) {
    dst[(d0 + j) * 136 + row] = f2bf((lo[j] * cc[j] - hi[j] * sn[j]) * rsc);
    dst[(d0 + j + 32) * 136 + row] = f2bf((hi[j] * cc[j] + lo[j] * sn[j]) * rsc);
  }
}
DEV void stage_vT(const u16* src, size_t ld, u16* dst) {
  const int tid = my_tid();
  const int row = tid >> 2, d0 = (tid & 3) * 32;
#pragma unroll
  for (int c = 0; c < 4; ++c) {
    uint4 v = *(const uint4*)(src + (size_t)row * ld + d0 + c * 8);
    unsigned w[4] = {v.x, v.y, v.z, v.w};
#pragma unroll
    for (int j = 0; j < 4; ++j) {
      dst[(d0 + c * 8 + 2 * j) * 136 + row] = (u16)(w[j] & 0xffffu);
      dst[(d0 + c * 8 + 2 * j + 1) * 136 + row] = (u16)(w[j] >> 16);
    }
  }
}

DEV void ret_kv_unit(const Params& p, int u, u16* smem) {
  const int tid = my_tid(), lane = tid & 63, wave = tid >> 6;
  const u16* prs = (const u16*)(p.ws + OFF_BIG + B_PRS);
  float* KV = (float*)(p.ws + OFF_BIG + B_KV);
  const float* rc = (const float*)(p.ws + OFF_ROPE);
  const float* rs = rc + SEQ * 32;
  const int n = u & 63, h = (u >> 6) & 3, b = u >> 8;
  const size_t t0 = (size_t)b * SEQ + n * 128;
  const float l2g = ret_log2gamma(h);
  u16* KT = smem;
  u16* VT = smem + 64 * 136;
  stage_rot_T(prs + t0 * 2560 + 256 + h * 64, 2560, rc, rs, n * 128, KT, 0.125f, l2g);
  stage_vT(prs + t0 * 2560 + 512 + h * 128, 2560, VT);
  __syncthreads();
  const int mi = wave >> 1, nj = wave & 1;
  f32x16 acc;
#pragma unroll
  for (int e = 0; e < 16; ++e) acc[e] = 0.f;
#pragma unroll
  for (int ks = 0; ks < 8; ++ks) {
    bf16x8 a = *(const bf16x8*)(VT + (mi * 32 + (lane & 31)) * 136 + ks * 16 + (lane >> 5) * 8);
    bf16x8 bb = *(const bf16x8*)(KT + (nj * 32 + (lane & 31)) * 136 + ks * 16 + (lane >> 5) * 8);
    acc = __builtin_amdgcn_mfma_f32_32x32x16_bf16(a, bb, acc, 0, 0, 0);
  }
  float* kv = KV + (size_t)u * 8192;
#pragma unroll
  for (int e = 0; e < 16; ++e) {
    int dv = mi * 32 + (e & 3) + 8 * (e >> 2) + 4 * (lane >> 5);
    int dk = nj * 32 + (lane & 31);
    kv[dv * 64 + dk] = acc[e];
  }
  __syncthreads();
}

DEV void sgu_unit(const Params& p, int l, int u, u16* smem) {
  const int tid = my_tid(), lane = tid & 63, wave = tid >> 6, wm = wave >> 1, wn = wave & 1;
  const u16* prs = (const u16*)(p.ws + OFF_BIG + B_PRS);
  u16* ysg = (u16*)(p.ws + OFF_BIG + B_YSG);
  const u16* sgw = (const u16*)(p.ws + OFF_W + (size_t)l * LW_BYTES + W_SGW);
  const float* lng = p.in[14] + l * 512;
  const float* lnb = p.in[15] + l * 512;
  const float* sgb = p.in[17] + l * 512;
  const size_t t0 = (size_t)u * 128;
  u16* VT = smem;
  u16* WT = smem + 128 * 136;
  float* st = (float*)(smem + 2 * 128 * 136);
  const int tok = tid >> 2, q = tid & 3;
  const u16* vrow = prs + (t0 + tok) * 2560 + 1536 + 512;
  {
    float s = 0.f, s2 = 0.f;
#pragma unroll 4
    for (int c = 0; c < 16; ++c) {
      float f[8];
      unpack8(*(const uint4*)(vrow + q * 128 + c * 8), f);
#pragma unroll
      for (int j = 0; j < 8; ++j) { float gl = geluf_(f[j]); s += gl; s2 += gl * gl; }
    }
    s = red4(s); s2 = red4(s2);
    const float mean = s * (1.f / 512.f);
    const float var = fmaxf(s2 * (1.f / 512.f) - mean * mean, 0.f);
    if (q == 0) { st[tok] = mean; st[128 + tok] = rsqrtf(var + 1e-6f); }
  }
  __syncthreads();
  const float mean = st[tok], rstd = st[128 + tok];
  for (int g = 0; g < 4; ++g) {
#pragma unroll
    for (int c = 0; c < 4; ++c) {
      const int d = q * 32 + c * 8;
      float f[8];
      unpack8(*(const uint4*)(vrow + g * 128 + d), f);
      float4 g0 = *(const float4*)(lng + g * 128 + d), g1 = *(const float4*)(lng + g * 128 + d + 4);
      float4 b0 = *(const float4*)(lnb + g * 128 + d), b1 = *(const float4*)(lnb + g * 128 + d + 4);
      float gg[8] = {g0.x, g0.y, g0.z, g0.w, g1.x, g1.y, g1.z, g1.w};
      float bb[8] = {b0.x, b0.y, b0.z, b0.w, b1.x, b1.y, b1.z, b1.w};
#pragma unroll
      for (int j = 0; j < 8; ++j) VT[(d + j) * 136 + tok] = f2bf((geluf_(f[j]) - mean) * rstd * gg[j] + bb[j]);
      *(uint4*)(WT + tok * 136 + d) = *(const uint4*)(sgw + (size_t)g * 16384 + tok * 128 + d);
    }
    __syncthreads();
    f32x16 acc[2];
#pragma unroll
    for (int j = 0; j < 2; ++j)
#pragma unroll
      for (int e = 0; e < 16; ++e) acc[j][e] = 0.f;
#pragma unroll
    for (int ks = 0; ks < 8; ++ks) {
      bf16x8 a = *(const bf16x8*)(WT + (wm * 32 + (lane & 31)) * 136 + ks * 16 + (lane >> 5) * 8);
#pragma unroll
      for (int j = 0; j < 2; ++j) {
        bf16x8 bb = *(const bf16x8*)(VT + (wn * 64 + j * 32 + (lane & 31)) * 136 + ks * 16 + (lane >> 5) * 8);
        acc[j] = __builtin_amdgcn_mfma_f32_32x32x16_bf16(a, bb, acc[j], 0, 0, 0);
      }
    }
#pragma unroll
    for (int e = 0; e < 16; ++e) {
      const int i = ACC_ROW(1, 0, e);
      const float bias = sgb[g * 128 + i];
#pragma unroll
      for (int j = 0; j < 2; ++j) {
        const int d = ACC_COL(j);
        const float uu = geluf_(bf2f(prs[(t0 + i) * 2560 + 1536 + g * 128 + d]));
        ysg[(t0 + i) * 512 + g * 128 + d] = f2bf(uu * (acc[j][e] + bias));
      }
    }
    __syncthreads();
  }
}

DEV void phase_retprefix(const Params& p, int bid, int nb) {
  float* KV = (float*)(p.ws + OFF_BIG + B_KV);
  for (int gid = bid * NTHR + my_tid(); gid < 16 * 8192; gid += nb * NTHR) {
    const int bh = gid >> 13, e = gid & 8191;
    const int h = bh & 3;
    const float cd = exp2f(128.f * ret_log2gamma(h));
    float R = 0.f;
    float* ptr = KV + (size_t)bh * 64 * 8192 + e;
    for (int n = 0; n < 64; ++n) {
      float kv = ptr[(size_t)n * 8192];
      ptr[(size_t)n * 8192] = R;
      R = R * cd + kv;
    }
  }
}

DEV void ret_out_unit(const Params& p, int u, u16* smem) {
  const int tid = my_tid(), lane = tid & 63, wave = tid >> 6, wm = wave >> 1, wn = wave & 1;
  const u16* prs = (const u16*)(p.ws + OFF_BIG + B_PRS);
  const float* KV = (const float*)(p.ws + OFF_BIG + B_KV);
  u16* yret = (u16*)(p.ws + OFF_BIG + B_YRET);
  const float* rc = (const float*)(p.ws + OFF_ROPE);
  const float* rs = rc + SEQ * 32;
  const int n = u & 63, h = (u >> 6) & 3, b = u >> 8;
  const size_t t0 = (size_t)b * SEQ + n * 128;
  const float l2g = ret_log2gamma(h);
  u16* Q = smem;
  u16* Kr = Q + 128 * 72;
  u16* VT = Kr + 128 * 72;
  u16* Qd = VT + 128 * 136;
  u16* RT = Qd + 128 * 72;
  u16* SP = RT + 128 * 72;
  float* OT = (float*)smem;
  stage_rot(prs + t0 * 2560 + h * 64, 2560, rc, rs, n * 128, Q, 1.0f, l2g, 0);
  stage_rot(prs + t0 * 2560 + h * 64, 2560, rc, rs, n * 128, Qd, 1.0f, l2g, 1);
  stage_rot(prs + t0 * 2560 + 256 + h * 64, 2560, rc, rs, n * 128, Kr, 0.125f, l2g, 0);
  stage_vT(prs + t0 * 2560 + 512 + h * 128, 2560, VT);
  {
    const int dv = tid >> 2, q = tid & 3;
    const float* src = KV + (size_t)u * 8192 + dv * 64 + q * 16;
    float4 a0 = *(const float4*)src, a1 = *(const float4*)(src + 4), a2 = *(const float4*)(src + 8), a3 = *(const float4*)(src + 12);
    float f0[8] = {a0.x, a0.y, a0.z, a0.w, a1.x, a1.y, a1.z, a1.w};
    float f1[8] = {a2.x, a2.y, a2.z, a2.w, a3.x, a3.y, a3.z, a3.w};
    *(uint4*)(RT + dv * 72 + q * 16) = pack8(f0);
    *(uint4*)(RT + dv * 72 + q * 16 + 8) = pack8(f1);
  }
  __syncthreads();
  f32x16 acc[2];
#pragma unroll
  for (int j = 0; j < 2; ++j)
#pragma unroll
    for (int e = 0; e < 16; ++e) acc[j][e] = 0.f;
#pragma unroll
  for (int ks = 0; ks < 4; ++ks) {
    bf16x8 a = *(const bf16x8*)(Q + (wm * 32 + (lane & 31)) * 72 + ks * 16 + (lane >> 5) * 8);
#pragma unroll
    for (int j = 0; j < 2; ++j) {
      bf16x8 bb = *(const bf16x8*)(Kr + (wn * 64 + j * 32 + (lane & 31)) * 72 + ks * 16 + (lane >> 5) * 8);
      acc[j] = __builtin_amdgcn_mfma_f32_32x32x16_bf16(a, bb, acc[j], 0, 0, 0);
    }
  }
#pragma unroll
  for (int j = 0; j < 2; ++j)
#pragma unroll
    for (int e = 0; e < 16; ++e) {
      const int i = ACC_ROW(1, 0, e), jj = ACC_COL(j);
      const float dcy = (i >= jj) ? exp2f((float)(i - jj) * l2g) : 0.f;
      SP[i * 136 + jj] = f2bf(acc[j][e] * dcy);
    }
  __syncthreads();
#pragma unroll
  for (int j = 0; j < 2; ++j)
#pragma unroll
    for (int e = 0; e < 16; ++e) acc[j][e] = 0.f;
#pragma unroll
  for (int ks = 0; ks < 8; ++ks) {
    bf16x8 a = *(const bf16x8*)(SP + (wm * 32 + (lane & 31)) * 136 + ks * 16 + (lane >> 5) * 8);
#pragma unroll
    for (int j = 0; j < 2; ++j) {
      bf16x8 bb = *(const bf16x8*)(VT + (wn * 64 + j * 32 + (lane & 31)) * 136 + ks * 16 + (lane >> 5) * 8);
      acc[j] = __builtin_amdgcn_mfma_f32_32x32x16_bf16(a, bb, acc[j], 0, 0, 0);
    }
  }
#pragma unroll
  for (int ks = 0; ks < 4; ++ks) {
    bf16x8 a = *(const bf16x8*)(Qd + (wm * 32 + (lane & 31)) * 72 + ks * 16 + (lane >> 5) * 8);
#pragma unroll
    for (int j = 0; j < 2; ++j) {
      bf16x8 bb = *(const bf16x8*)(RT + (wn * 64 + j * 32 + (lane & 31)) * 72 + ks * 16 + (lane >> 5) * 8);
      acc[j] = __builtin_amdgcn_mfma_f32_32x32x16_bf16(a, bb, acc[j], 0, 0, 0);
    }
  }
  __syncthreads();
#pragma unroll
  for (int j = 0; j < 2; ++j)
#pragma unroll
    for (int e = 0; e < 16; ++e) OT[ACC_ROW(1, 0, e) * 132 + ACC_COL(j)] = acc[j][e];
  __syncthreads();
  {
    const int row = tid >> 2, q = tid & 3;
    float o[32];
    float ssq = 0.f;
#pragma unroll
    for (int c = 0; c < 8; ++c) {
      float4 v = *(const float4*)(OT + row * 132 + q * 32 + c * 4);
      o[c * 4] = v.x; o[c * 4 + 1] = v.y; o[c * 4 + 2] = v.z; o[c * 4 + 3] = v.w;
      ssq += v.x * v.x + v.y * v.y + v.z * v.z + v.w * v.w;
    }
    ssq = red4(ssq);
    const float r = rsqrtf(ssq * (1.f / 128.f) + 1e-6f);
    const u16* gp = prs + (t0 + row) * 2560 + 1024 + h * 128 + q * 32;
    u16* op = yret + (t0 + row) * 512 + h * 128 + q * 32;
#pragma unroll
    for (int c = 0; c < 4; ++c) {
      float g[8], ov[8];
      unpack8(*(const uint4*)(gp + c * 8), g);
#pragma unroll
      for (int j = 0; j < 8; ++j) ov[j] = o[c * 8 + j] * r * siluf_(g[j]);
      if (!(n == 0 && row == 0)) *(uint4*)(op + c * 8) = pack8(ov);
    }
  }
  __syncthreads();
}

DEV void phase_merge(const Params& p, int l, const float* rstd, u16* smem, int bid, int nb) {
  const int tid = my_tid(), lane = tid & 63, wave = tid >> 6, wm = wave >> 1, wn = wave & 1;
  const u16* xb = (const u16*)(p.ws + OFF_XB);
  unsigned char* W = p.ws + OFF_W + (size_t)l * LW_BYTES;
  const u16* win = (const u16*)(W + W_IN);
  const u16* wbr = (const u16*)(W + W_BR);
  u16* M = (u16*)(p.ws + OFF_BIG + B_M);
  const int MTL = NTOK / 128, NTL = DM / 128;
  for (int t = vbid(bid, nb); t < MTL * NTL; t += nb) {
    int m, n;
    tile_map(t, MTL, NTL, m, n);
    f32x16 ms[1][2];
#pragma unroll
    for (int j = 0; j < 2; ++j)
#pragma unroll
      for (int e = 0; e < 16; ++e) ms[0][j][e] = 0.f;
    for (int g = 0; g < 3; ++g) {
      const u16* yg = (const u16*)(p.ws + OFF_BIG + (g == 0 ? B_YRW : (g == 1 ? B_YRET : B_YSG)));
      f32x16 ab[1][2], ag[1][2];
#pragma unroll
      for (int j = 0; j < 2; ++j)
#pragma unroll
        for (int e = 0; e < 16; ++e) { ab[0][j][e] = 0.f; ag[0][j][e] = 0.f; }
      gemm_tile<1>(ab, yg, 512, m * 128, -(1 << 30), NTOK - 1, wbr + ((size_t)g * DM + n * 128) * 512, 512, 512, smem);
      gemm_tile<1>(ag, xb, DM, m * 128, -(1 << 30), NTOK - 1, win + ((size_t)(4352 + g * DM + n * 128)) * DM, DM, DM, smem);
#pragma unroll
      for (int e = 0; e < 16; ++e) {
        const float rs = rstd_of(rstd, m * 128 + ACC_ROW(1, 0, e));
#pragma unroll
        for (int j = 0; j < 2; ++j) ms[0][j][e] += sigmoidf_(ag[0][j][e] * rs) * ab[0][j][e];
        if ((e & 3) == 3) __builtin_amdgcn_sched_barrier(0);
      }
    }
#pragma unroll
    for (int e = 0; e < 16; ++e) {
      const size_t row = m * 128 + ACC_ROW(1, 0, e);
#pragma unroll
      for (int j = 0; j < 2; ++j) M[row * DM + n * 128 + ACC_COL(j)] = f2bf(ms[0][j][e]);
    }
  }
}

DEV void phase_resgemm(const u16* A, int K, const u16* wt, const float* xin, float* xout, u16* xbo, float* ssq, u16* smem, int bid, int nb) {
  const int tid = my_tid(), lane = tid & 63, wave = tid >> 6, wm = wave >> 1, wn = wave & 1;
  const int MTL = NTOK / 256, NTL = DM / 256;
  for (int t = vbid(bid, nb); t < MTL * NTL; t += nb) {
    int m, n;
    tile_map(t, MTL, NTL, m, n);
    f32x16 acc[2][4];
    ZERO_BIG(acc);
    gemm_big(acc, A, K, m * 256, -(1 << 30), NTOK - 1, wt + (size_t)n * 256 * K, K, K, smem);
    float* F = (float*)smem;
#pragma unroll
    for (int i = 0; i < 2; ++i) {
#pragma unroll
      for (int e = 0; e < 16; ++e) {
        const int lr = wm * 32 + (e & 3) + 8 * (e >> 2) + 4 * (lane >> 5);
#pragma unroll
        for (int j = 0; j < 4; ++j) F[lr * 260 + BIG_COL(j)] = acc[i][j][e];
      }
      __syncthreads();
#pragma unroll 4
      for (int k = 0; k < 16; ++k) {
        const int c = tid + NTHR * k;
        const int lr = c >> 6, cc = c & 63;
        const size_t row = (size_t)m * 256 + (lr >> 5) * 64 + i * 32 + (lr & 31);
        const size_t o = row * DM + n * 256 + cc * 4;
        const float4 v = *(const float4*)(F + lr * 260 + cc * 4);
        const float4 x = *(const float4*)(xin + o);
        const float4 y = make_float4(x.x + v.x, x.y + v.y, x.z + v.z, x.w + v.w);
        *(float4*)(xout + o) = y;
        if (xbo) {
          *(uint2*)(xbo + o) = make_uint2(pack2(y.x, y.y), pack2(y.z, y.w));
          const float sq = wave_sum(y.x * y.x + y.y * y.y + y.z * y.z + y.w * y.w);
          if (lane == 0) atomicAdd(ssq + row, sq);
        }
      }
      __syncthreads();
    }
  }
}

DEV void phase_ffnup(const Params& p, int l, const float* rstd, u16* smem, int bid, int nb) {
  const int tid = my_tid(), lane = tid & 63, wave = tid >> 6, wm = wave >> 1, wn = wave & 1;
  const u16* xb = (const u16*)(p.ws + OFF_XB);
  const u16* wup = (const u16*)(p.ws + OFF_W + (size_t)l * LW_BYTES + W_UP);
  u16* act = (u16*)(p.ws + OFF_BIG + B_ACT);
  const float* cw = p.in[22] + (size_t)l * 3 * 2 * DFF;
  const float* cb = p.in[23] + (size_t)l * 2 * DFF;
  u16* U = smem;
  const int MPB = 33;
  const int MTL = 4 * MPB, NTL = DFF / 128;
  for (int t = vbid(bid, nb); t < MTL * NTL; t += nb) {
    int m, n;
    tile_map(t, MTL, NTL, m, n);
    const int b = m / MPB, mi = m % MPB;
    const int tokbase = b * SEQ + mi * 254 - 2;
    f32x16 acc[2][4];
    ZERO_BIG(acc);
    gemm_big(acc, xb, DM, tokbase, b * SEQ, NTOK - 1, wup + (size_t)n * 256 * DM, DM, DM, smem);
#pragma unroll
    for (int i = 0; i < 2; ++i)
#pragma unroll
      for (int e = 0; e < 16; ++e) {
        const int r = BIG_ROW(i, e);
        int tk = tokbase + r; tk = tk < 0 ? 0 : (tk > NTOK - 1 ? NTOK - 1 : tk);
        const float rs = rstd_of(rstd, tk);
#pragma unroll
        for (int j = 0; j < 4; ++j) U[r * 264 + BIG_COL(j)] = f2bf(acc[i][j][e] * rs);
      }
    __syncthreads();
    {
      const int c = (tid & 63) * 2, rg = tid >> 6;
      const int gcol = n * 128 + c, vcol = DFF + n * 128 + c;
      float wg0[2], wg1[2], wg2[2], bg[2], wv0[2], wv1[2], wv2[2], bv[2];
#pragma unroll
      for (int q = 0; q < 2; ++q) {
        wg0[q] = cw[gcol + q]; wg1[q] = cw[2 * DFF + gcol + q]; wg2[q] = cw[4 * DFF + gcol + q]; bg[q] = cb[gcol + q];
        wv0[q] = cw[vcol + q]; wv1[q] = cw[2 * DFF + vcol + q]; wv2[q] = cw[4 * DFF + vcol + q]; bv[q] = cb[vcol + q];
      }
      const int r0 = 2 + rg * 32;
      const int rend = (r0 + 32 > 256) ? 256 : r0 + 32;
      unsigned t;
      float g2[2], g1[2], v2[2], v1[2];
      t = *(const unsigned*)(U + (r0 - 2) * 264 + c); g2[0] = __uint_as_float(t << 16); g2[1] = __uint_as_float(t & 0xffff0000u);
      t = *(const unsigned*)(U + (r0 - 1) * 264 + c); g1[0] = __uint_as_float(t << 16); g1[1] = __uint_as_float(t & 0xffff0000u);
      t = *(const unsigned*)(U + (r0 - 2) * 264 + 128 + c); v2[0] = __uint_as_float(t << 16); v2[1] = __uint_as_float(t & 0xffff0000u);
      t = *(const unsigned*)(U + (r0 - 1) * 264 + 128 + c); v1[0] = __uint_as_float(t << 16); v1[1] = __uint_as_float(t & 0xffff0000u);
      const int tend = (b + 1) * SEQ;
      for (int r = r0; r < rend; ++r) {
        const unsigned ug = *(const unsigned*)(U + r * 264 + c), uv = *(const unsigned*)(U + r * 264 + 128 + c);
        const float g0[2] = {__uint_as_float(ug << 16), __uint_as_float(ug & 0xffff0000u)};
        const float v0[2] = {__uint_as_float(uv << 16), __uint_as_float(uv & 0xffff0000u)};
        float o[2];
#pragma unroll
        for (int q = 0; q < 2; ++q) {
          const float cg = bg[q] + wg0[q] * g2[q] + wg1[q] * g1[q] + wg2[q] * g0[q];
          const float cv = bv[q] + wv0[q] * v2[q] + wv1[q] * v1[q] + wv2[q] * v0[q];
          o[q] = siluf_(cg) * cv;
          g2[q] = g1[q]; g1[q] = g0[q]; v2[q] = v1[q]; v1[q] = v0[q];
        }
        const int tk = tokbase + r;
        if (tk < tend) *(unsigned*)(act + (size_t)tk * DFF + n * 128 + c) = pack2(o[0], o[1]);
      }
    }
    __syncthreads();
  }
}

#define PF_COLS 3328
DEV void first_tok_proj(const Params& p, int l, const float* xcur, float* smf, int bid, int nb) {
  float* PF = (float*)(p.ws + OFF_PF);
  const float* w = p.in[2] + (size_t)l * DM * INC;
  const float* g1 = p.in[1] + l * DM;
  const int tid = my_tid(), lane = tid & 63, wave = tid >> 6;
  for (int task = bid; task < 4 * 52; task += nb) {
    const int b = task / 52, c = (task % 52) * 64 + lane;
    const float* xr = xcur + (size_t)b * SEQ * DM;
    float acc = 0.f, ss = 0.f;
    const int k0 = wave * 128;
#pragma unroll 16
    for (int k = k0; k < k0 + 128; ++k) {
      const float xv = xr[k];
      ss += xv * xv;
      acc += xv * g1[k] * w[(size_t)k * INC + c];
    }
    smf[wave * 64 + lane] = acc;
    smf[512 + wave * 64 + lane] = ss;
    __syncthreads();
    if (wave == 0) {
      float ta = 0.f, ts = 0.f;
#pragma unroll
      for (int q = 0; q < 8; ++q) { ta += smf[q * 64 + lane]; ts += smf[512 + q * 64 + lane]; }
      PF[b * PF_COLS + c] = ta * rsqrtf(ts * (1.0f / DM) + 1e-6f);
    }
    __syncthreads();
  }
}
DEV void first_tok_fix(const Params& p, int l, float* smf, int bid, int nb) {
  const int tid = my_tid(), lane = tid & 63;
  const float* PF = (const float*)(p.ws + OFF_PF);
  u16* yrw = (u16*)(p.ws + OFF_BIG + B_YRW);
  u16* yret = (u16*)(p.ws + OFF_BIG + B_YRET);
  const float* mu = p.in[3] + l * 1792;
  for (int task = bid; task < 48; task += nb) {
    const int b = task / 12, hh = task % 12;
    const float* pf = PF + b * PF_COLS;
    const size_t t0 = (size_t)b * SEQ;
    __syncthreads();
    if (hh < 8) {
      const int h = hh;
      if (tid < 64) smf[tid] = pf[1600 + tid] * (1.f - mu[1600 + tid]);
      if (tid < 128) smf[64 + tid] = sigmoidf_(pf[1664 + tid] * (1.f - mu[1664 + tid]));
      __syncthreads();
      if (tid < 64) {
        const int ch = h * 64 + tid;
        const float r = pf[ch] * (1.f - mu[ch]);
        const float k = pf[512 + ch] * (1.f - mu[512 + ch]);
        const float v = pf[1024 + ch] * (1.f - mu[1024 + ch]);
        const float* aup = p.in[7] + (size_t)l * 64 * 512;
        const float* gup = p.in[8] + (size_t)l * 128 * 512;
        float al = p.in[6][l * 512 + ch], g = 0.f;
        for (int j = 0; j < 64; ++j) al += smf[j] * aup[j * 512 + ch];
        for (int j = 0; j < 128; ++j) g += smf[64 + j] * gup[j * 512 + ch];
        const float a = sigmoidf_(al);
        const float kp = k * (1.f + (a - 1.f) * p.in[10][l * 512 + ch]);
        const float s = wave_sum(kp * r);
        const float bon = wave_sum(r * kp * p.in[11][l * 512 + ch]);
        const float y = v * s;
        const float mean = wave_sum(y) * (1.f / 64.f);
        const float d = y - mean;
        const float var = wave_sum(d * d) * (1.f / 64.f);
        const float o = (d * rsqrtf(var + 64e-5f) * p.in[12][l * 512 + ch] + p.in[13][l * 512 + ch] + bon * v) * g;
        yrw[t0 * 512 + ch] = f2bf(o);
      }
    } else {
      const int h = hh - 8;
      float part = 0.f;
      if (tid < 64) part = pf[1792 + h * 64 + tid] * pf[1792 + 256 + h * 64 + tid];
      if (tid < 64) { part = wave_sum(part); if (lane == 0) smf[0] = part * 0.125f; }
      __syncthreads();
      const float s = smf[0];
      float y = 0.f;
      if (tid < 128) y = s * pf[1792 + 512 + h * 128 + tid];
      float q = wave_sum(y * y);
      if (tid < 128 && lane == 0) smf[1 + (tid >> 6)] = q;
      __syncthreads();
      if (tid < 128) {
        const float ms = (smf[1] + smf[2]) * (1.f / 128.f);
        const float g = pf[1792 + 1024 + h * 128 + tid];
        yret[t0 * 512 + h * 128 + tid] = f2bf(y * rsqrtf(ms + 1e-6f) * siluf_(g));
      }
    }
  }
}

namespace pg8 {
#define PG8_LAS __attribute__((address_space(3)))
typedef unsigned short bf16_t;
typedef short bf16x8 __attribute__((ext_vector_type(8)));
typedef float f32x4 __attribute__((ext_vector_type(4)));
typedef unsigned u32x4 __attribute__((ext_vector_type(4)));
constexpr int BM = 256, BK = 64, HALF = 128, HTB = HALF * BK * 2  , STAGE_BYTES = 8 * HTB, NXCD = 8, WGM = 8;

__host__ __device__ __forceinline__ int lds_byte(int r, int c) { const int st = (r >> 4) * 2 + (c >> 5), rr = r & 15, cc = c & 31, ob = rr * 64 + cc * 2; return st * 1024 + (ob ^ (((ob >> 9) & 1) << 5)); }
__host__ __device__ __forceinline__ void stage_rc(int b, int& R, int& C) { const int st = b / 1024, sb = b % 1024, swz = sb ^ (((sb >> 9) & 1) << 5); R = (st >> 1) * 16 + swz / 64; C = (st & 1) * 32 + (swz % 64) / 2; }
__host__ __device__ __forceinline__ int perm32(int rho) { const int n = rho >> 4, i = rho & 15; return 8 * (i >> 2) + 4 * n + (i & 3); }

struct Unit { int pm, pn, arow, slot; };
struct Gemm { const bf16_t* A; const bf16_t* Bt; int M, N, K; };

struct StaticOrder {
    int nM, nN, nwg, G, c;
    __host__ __device__ void init(int M, int N, int G_, int c_) { nM = M / BM; nN = N / BM; nwg = nM * nN; G = G_; c = c_; }
    __host__ __device__ bool next(int i, Unit& u) const {
        const long L = (long)i * G + c; if (L >= nwg) return false;
        int wgid = (int)L; { const int q = nwg / NXCD, r = nwg % NXCD, xcd = wgid % NXCD, off = wgid / NXCD; wgid = (xcd < r ? xcd * (q + 1) : r * (q + 1) + (xcd - r) * q) + off; }
        const int nig = WGM * nN, gid = wgid / nig, fm = gid * WGM, gsz = (nM - fm) < WGM ? (nM - fm) : WGM;
        u.pm = fm + ((wgid % nig) % gsz); u.pn = (wgid % nig) / gsz; u.arow = u.pm * BM; u.slot = i & 1; return true;
    }
    __device__ __forceinline__ void a_ready(const Unit&) const {}
    __device__ __forceinline__ void done(const Unit&) const {}
};

__device__ __forceinline__ unsigned cvt_pk_bf16(float lo, float hi) { unsigned r; asm volatile("v_cvt_pk_bf16_f32 %0, %1, %2" : "=v"(r) : "v"(lo), "v"(hi)); return r; }

template <class Epi, class Sched, bool STAMP = false>
__device__ __forceinline__ void gemm_phase(PG8_LAS unsigned char* lds, const Gemm g, const Sched& S, const Epi& E, unsigned long long* stamps) {
    const int tid = my_tid(), wid = __builtin_amdgcn_readfirstlane(tid >> 6), lane = tid & 63, wr = wid >> 2, wc = wid & 3, fr = lane & 15, fq = lane >> 4;
    const int K = g.K, nt = K / BK;
    int ts_lo = 0, ts_hi = 0, nts = 0; const unsigned long long rt_entry = STAMP ? (unsigned long long)wall_clock64() : 0ull;
#define PG8_STAMP() do { if (STAMP && wid == 0 && nts < 64) { const unsigned long long _c = (unsigned long long)clock64(); \
        ts_lo = (lane == nts) ? (int)(unsigned)_c : ts_lo; ts_hi = (lane == nts) ? (int)(unsigned)(_c >> 32) : ts_hi; ++nts; } } while (0)
    PG8_STAMP();
    unsigned voffA[2], voffB[2];
#pragma unroll
    for (int i = 0; i < 2; ++i) { int R, C; stage_rc(tid * 16 + i * 8192, R, C); const int Rb = Epi::PERM ? ((R & ~31) + perm32(R & 31)) : R;
        voffA[i] = (unsigned)(R * K + C) * 2u; voffB[i] = (unsigned)(Rb * K + C) * 2u; }
    const size_t kstep = (size_t)(BK * 2);
    const size_t hstep = (size_t)HALF * K * 2;
    const size_t tstep = 2 * hstep;
    const unsigned ldsw = (unsigned)wid * 1024u;
    const int aoff = lds_byte(wr * 64 + fr, fq * 8), boff = lds_byte(wc * 32 + fr, fq * 8);
#define PG8_SA(b, h) (((b) * 2 + (h)) * HTB)
#define PG8_SB(b, h) ((4 + (b) * 2 + (h)) * HTB)
#define PG8_STAGE(bufoff, gbase, voff) do { _Pragma("unroll") for (int _i = 0; _i < 2; ++_i) \
        __builtin_amdgcn_global_load_lds((const unsigned*)((const char*)(gbase) + (voff)[_i]), (PG8_LAS unsigned*)(lds + (bufoff) + ldsw + _i * 8192), 16, 0, 0); } while (0)
#define PG8_LDA(dst, b, h) do { _Pragma("unroll") for (int m = 0; m < 4; ++m) _Pragma("unroll") for (int k = 0; k < 2; ++k) dst[m][k] = *(const PG8_LAS bf16x8*)(lds + PG8_SA(b, h) + aoff + m * 2048 + k * 1024); } while (0)
#define PG8_LDB(dst, b, h) do { _Pragma("unroll") for (int n = 0; n < 2; ++n) _Pragma("unroll") for (int k = 0; k < 2; ++k) dst[n][k] = *(const PG8_LAS bf16x8*)(lds + PG8_SB(b, h) + boff + n * 2048 + k * 1024); } while (0)
#define PG8_MMA(ai, bj, At, Bt) do { __builtin_amdgcn_s_setprio(1); _Pragma("unroll") for (int m = 0; m < 4; ++m) _Pragma("unroll") for (int n = 0; n < 2; ++n) _Pragma("unroll") for (int k = 0; k < 2; ++k) \
        acc[ai][bj][m][n] = __builtin_amdgcn_mfma_f32_16x16x32_bf16(Bt[n][k], At[m][k], acc[ai][bj][m][n], 0, 0, 0); __builtin_amdgcn_s_setprio(0); } while (0)
#define PG8_WAIT_V(n) asm volatile("s_waitcnt vmcnt(" #n ")" ::: "memory")
#define PG8_WAIT_L(n) asm volatile("s_waitcnt lgkmcnt(" #n ")" ::: "memory")
#define PG8_BAR __builtin_amdgcn_s_barrier()
#define PG8_SCHED __builtin_amdgcn_sched_barrier(0)
    Unit cur, nxt; int ui = 0;
    if (!S.next(0, cur)) return;
    f32x4 acc[2][2][4][2];
#pragma unroll
    for (int a = 0; a < 2; ++a)
#pragma unroll
        for (int b = 0; b < 2; ++b)
#pragma unroll
            for (int m = 0; m < 4; ++m)
#pragma unroll
                for (int n = 0; n < 2; ++n) acc[a][b][m][n] = (f32x4){0.f, 0.f, 0.f, 0.f};
    bf16x8 At[4][2], B0[2][2], B1[2][2];
    const char* cA = (const char*)g.A + (long)cur.arow * (long)(K * 2); const char* cB = (const char*)g.Bt + (size_t)cur.pn * tstep;
    S.a_ready(cur);
    PG8_STAGE(PG8_SB(0, 0), cB, voffB); PG8_STAGE(PG8_SA(0, 0), cA, voffA); PG8_STAGE(PG8_SB(0, 1), cB + hstep, voffB); PG8_STAGE(PG8_SA(0, 1), cA + hstep, voffA);
    if (wr == 1) PG8_BAR;
    PG8_WAIT_V(4); PG8_BAR;
    PG8_STAGE(PG8_SB(1, 0), cB + kstep, voffB); PG8_STAGE(PG8_SA(1, 0), cA + kstep, voffA); PG8_STAGE(PG8_SB(1, 1), cB + hstep + kstep, voffB);
    PG8_WAIT_V(6); PG8_BAR;
    PG8_STAMP();
    for (;;) {
        const bool has_next = S.next(ui + 1, nxt);
        const char* nA = has_next ? (const char*)g.A + (long)nxt.arow * (long)(K * 2) : cA; const char* nB = has_next ? (const char*)g.Bt + (size_t)nxt.pn * tstep : cB;
        for (int t = 0; t < nt; t += 2) {
            const bool last = (t == nt - 2);
            const char* a1 = cA + (size_t)(t + 1) * kstep;
            const char* a2 = last ? nA : cA + (size_t)(t + 2) * kstep; const char* b2 = last ? nB : cB + (size_t)(t + 2) * kstep;
            const char* a3 = a2 + kstep; const char* b3 = b2 + kstep;
            if (last && has_next) S.a_ready(nxt);
            PG8_LDB(B0, 0, 0); PG8_SCHED; PG8_LDA(At, 0, 0); PG8_STAGE(PG8_SA(1, 1), a1 + hstep, voffA);
            PG8_WAIT_L(8); PG8_BAR; PG8_WAIT_L(0); PG8_MMA(0, 0, At, B0); PG8_BAR; PG8_SCHED;
            PG8_LDB(B1, 0, 1); PG8_STAGE(PG8_SB(0, 0), b2, voffB);
            PG8_BAR; PG8_WAIT_L(0); PG8_MMA(0, 1, At, B1); PG8_BAR;
            PG8_LDA(At, 0, 1); PG8_STAGE(PG8_SA(0, 0), a2, voffA);
            PG8_BAR; PG8_WAIT_L(0); PG8_MMA(1, 0, At, B0); PG8_BAR; PG8_SCHED;
            PG8_STAGE(PG8_SB(0, 1), b2 + hstep, voffB);
            PG8_WAIT_V(6); PG8_BAR; PG8_MMA(1, 1, At, B1); PG8_BAR;
            PG8_LDB(B0, 1, 0); PG8_SCHED; PG8_LDA(At, 1, 0); PG8_STAGE(PG8_SA(0, 1), a2 + hstep, voffA);
            PG8_WAIT_L(8); PG8_BAR; PG8_WAIT_L(0); PG8_MMA(0, 0, At, B0); PG8_BAR; PG8_SCHED;
            PG8_LDB(B1, 1, 1); PG8_STAGE(PG8_SB(1, 0), b3, voffB);
            PG8_BAR; PG8_WAIT_L(0); PG8_MMA(0, 1, At, B1); PG8_BAR;
            PG8_LDA(At, 1, 1); PG8_STAGE(PG8_SA(1, 0), a3, voffA);
            PG8_BAR; PG8_WAIT_L(0); PG8_MMA(1, 0, At, B0); PG8_BAR; PG8_SCHED;
            PG8_STAGE(PG8_SB(1, 1), b3 + hstep, voffB);
            PG8_WAIT_V(6); PG8_BAR; PG8_MMA(1, 1, At, B1); PG8_BAR;
        }
        PG8_STAMP();
        if constexpr (!Epi::AFTER_DRAIN) { E(acc, cur, wr, wc, fr, fq); S.done(cur); }
        PG8_STAMP();
        if (!has_next) break;
#pragma unroll
        for (int a = 0; a < 2; ++a)
#pragma unroll
            for (int b = 0; b < 2; ++b)
#pragma unroll
                for (int m = 0; m < 4; ++m)
#pragma unroll
                    for (int n = 0; n < 2; ++n) acc[a][b][m][n] = (f32x4){0.f, 0.f, 0.f, 0.f};
        cur = nxt; cA = nA; cB = nB; ++ui;
    }
    PG8_WAIT_V(0);
    if (wr == 0) PG8_BAR;
    PG8_BAR;
    if constexpr (Epi::AFTER_DRAIN) { E.fused(acc, cur, wr, wc, fr, fq, lds, wid, lane); S.done(cur); }
    PG8_STAMP();
    if (STAMP && wid == 0) { stamps[lane] = lane < nts ? (((unsigned long long)(unsigned)ts_hi << 32) | (unsigned)ts_lo) : 0ull;
        if (lane == 62) stamps[62] = rt_entry; if (lane == 63) stamps[63] = (unsigned long long)wall_clock64(); }
#undef PG8_STAMP
#undef PG8_SA
#undef PG8_SB
#undef PG8_STAGE
#undef PG8_LDA
#undef PG8_LDB
#undef PG8_MMA
#undef PG8_WAIT_V
#undef PG8_WAIT_L
#undef PG8_BAR
#undef PG8_SCHED
}
}

struct EpiInproj {
  static constexpr bool PERM = true, AFTER_DRAIN = false;
  u16* O; int ldc; const float* ssq;
  __device__ __forceinline__ void operator()(const pg8::f32x4 (&acc)[2][2][4][2], const pg8::Unit& u, int wr, int wc, int fr, int fq) const {
    const int row0 = u.pm * 256 + wr * 64 + fr, col0 = u.pn * 256 + wc * 32 + 8 * fq;
#pragma unroll
    for (int ai = 0; ai < 2; ++ai)
#pragma unroll
      for (int m = 0; m < 4; ++m) {
        const int row = row0 + ai * 128 + m * 16;
        const float rs = ssq ? rsqrtf(ssq[row] * (1.0f / DM) + 1e-6f) : 1.0f;
        u16* rowp = O + (size_t)row * ldc + col0;
#pragma unroll
        for (int bj = 0; bj < 2; ++bj) {
          const pg8::f32x4 v0 = acc[ai][bj][m][0] * rs, v1 = acc[ai][bj][m][1] * rs;
          u32x4 w;
          w.x = pack2(v0[0], v0[1]); w.y = pack2(v0[2], v0[3]); w.z = pack2(v1[0], v1[1]); w.w = pack2(v1[2], v1[3]);
          *(u32x4*)(rowp + bj * 128) = w;
        }
      }
  }
};
struct EpiRes {
  static constexpr bool PERM = false, AFTER_DRAIN = false;
  const float* xin; float* xout; u16* xbo; float* ssq;
  __device__ __forceinline__ void operator()(const pg8::f32x4 (&acc)[2][2][4][2], const pg8::Unit& u, int wr, int wc, int fr, int fq) const {
    const int row0 = u.pm * 256 + wr * 64 + fr, col0 = u.pn * 256 + wc * 32 + 4 * fq;
#pragma unroll
    for (int ai = 0; ai < 2; ++ai)
#pragma unroll
      for (int m = 0; m < 4; ++m) {
        const int row = row0 + ai * 128 + m * 16;
        float sq = 0.f;
#pragma unroll
        for (int bj = 0; bj < 2; ++bj)
#pragma unroll
          for (int n = 0; n < 2; ++n) {
            const size_t o = (size_t)row * DM + col0 + bj * 128 + n * 16;
            const pg8::f32x4 y = *(const pg8::f32x4*)(xin + o) + acc[ai][bj][m][n];
            *(pg8::f32x4*)(xout + o) = y;
            if (xbo) {
              *(uint2*)(xbo + o) = make_uint2(pack2(y[0], y[1]), pack2(y[2], y[3]));
              sq += y[0] * y[0] + y[1] * y[1] + y[2] * y[2] + y[3] * y[3];
            }
          }
        if (xbo) {
          sq += __shfl_xor(sq, 16);
          sq += __shfl_xor(sq, 32);
          if (fq == 0) atomicAdd(ssq + row, sq);
        }
        __builtin_amdgcn_sched_barrier(0);
      }
  }
};
struct TriOrder : pg8::StaticOrder {
  int a_rows_per_g;
  __device__ bool next(int i, pg8::Unit& u) const {
    const int g = i % 3;
    if (!pg8::StaticOrder::next(i / 3, u)) return false;
    u.arow = g * a_rows_per_g + u.pm * 256;
    u.pn += 4 * g;
    u.slot = i & 1;
    return true;
  }
};
struct EpiP {
  static constexpr bool PERM = true, AFTER_DRAIN = false;
  u16* O;
  __device__ __forceinline__ void operator()(const pg8::f32x4 (&acc)[2][2][4][2], const pg8::Unit& u, int wr, int wc, int fr, int fq) const {
    const int g = u.pn >> 2, ct = u.pn & 3;
    const int row0 = u.pm * 256 + wr * 64 + fr, col0 = ct * 256 + wc * 32 + 8 * fq;
    u16* base = O + (size_t)g * NTOK * DM;
#pragma unroll
    for (int ai = 0; ai < 2; ++ai)
#pragma unroll
      for (int m = 0; m < 4; ++m) {
        u16* rowp = base + (size_t)(row0 + ai * 128 + m * 16) * DM + col0;
#pragma unroll
        for (int bj = 0; bj < 2; ++bj) {
          const pg8::f32x4 v0 = acc[ai][bj][m][0], v1 = acc[ai][bj][m][1];
          u32x4 w;
          w.x = pack2(v0[0], v0[1]); w.y = pack2(v0[2], v0[3]); w.z = pack2(v1[0], v1[1]); w.w = pack2(v1[2], v1[3]);
          *(u32x4*)(rowp + bj * 128) = w;
        }
      }
  }
};
struct EpiGate {
  static constexpr bool PERM = true, AFTER_DRAIN = false;
  u16* Mo; const u16* Pall; const float* ssq;
  __device__ __forceinline__ void operator()(const pg8::f32x4 (&acc)[2][2][4][2], const pg8::Unit& u, int wr, int wc, int fr, int fq) const {
    const int g = u.pn >> 2, first = (g == 0);
    const u16* P = Pall + (size_t)g * NTOK * DM;
    const int row0 = u.pm * 256 + wr * 64 + fr, col0 = (u.pn & 3) * 256 + wc * 32 + 8 * fq;
#pragma unroll
    for (int ai = 0; ai < 2; ++ai)
#pragma unroll
      for (int m = 0; m < 4; ++m) {
        const int row = row0 + ai * 128 + m * 16;
        const float rs = rsqrtf(ssq[row] * (1.0f / DM) + 1e-6f);
#pragma unroll
        for (int bj = 0; bj < 2; ++bj) {
          const size_t o = (size_t)row * DM + col0 + bj * 128;
          float pv[8], mv[8];
          unpack8(*(const uint4*)(P + o), pv);
          if (!first) unpack8(*(const uint4*)(Mo + o), mv);
          else {
#pragma unroll
            for (int j = 0; j < 8; ++j) mv[j] = 0.f;
          }
#pragma unroll
          for (int j = 0; j < 4; ++j) {
            mv[j] += sigmoidf_(acc[ai][bj][m][0][j] * rs) * pv[j];
            mv[4 + j] += sigmoidf_(acc[ai][bj][m][1][j] * rs) * pv[4 + j];
          }
          *(uint4*)(Mo + o) = pack8(mv);
        }
        __builtin_amdgcn_sched_barrier(0);
      }
  }
};
struct FfnOrder : pg8::StaticOrder {
  __device__ bool next(int i, pg8::Unit& u) const {
    if (!pg8::StaticOrder::next(i, u)) return false;
    const int b = u.pm / 33, mi = u.pm % 33;
    u.arow = b * SEQ + mi * 254 - 2;
    return true;
  }
};
struct EpiFfn {
  static constexpr bool PERM = true, AFTER_DRAIN = false;
  const Params* pp; int l; int bid;
  __device__ __forceinline__ void operator()(const pg8::f32x4 (&acc)[2][2][4][2], const pg8::Unit& u, int wr, int wc, int fr, int fq) const {
    const int b = u.pm / 33, mi = u.pm % 33;
    const int tokbase = b * SEQ + mi * 254 - 2, tbeg = b * SEQ, tend = (b + 1) * SEQ;
    asm volatile("" : "+v"(fr), "+v"(fq));
    u16* act = (u16*)(pp->ws + OFF_BIG + B_ACT);
    const float* ssq = (const float*)(pp->ws + OFF_RSTD) + (size_t)(2 * l + 1) * NTOK;
    const float* cw = pp->in[22] + (size_t)l * 3 * 2 * DFF;
    const float* cb = pp->in[23] + (size_t)l * 2 * DFF;
    u16* S = (u16*)(pp->ws + OFF_BIG + 192 * MiB) + (size_t)bid * 131072 + (size_t)u.slot * 65536;
#pragma unroll
    for (int ai = 0; ai < 2; ++ai)
#pragma unroll
      for (int m = 0; m < 4; ++m) {
        const int r = ai * 128 + wr * 64 + m * 16 + fr;
        int tk = tokbase + r; tk = tk < 0 ? 0 : (tk > NTOK - 1 ? NTOK - 1 : tk);
        const float rs = rsqrtf(ssq[tk] * (1.0f / DM) + 1e-6f);
#pragma unroll
        for (int bj = 0; bj < 2; ++bj) {
          const pg8::f32x4 v0 = acc[ai][bj][m][0] * rs, v1 = acc[ai][bj][m][1] * rs;
          u32x4 w;
          w.x = pack2(v0[0], v0[1]); w.y = pack2(v0[2], v0[3]); w.z = pack2(v1[0], v1[1]); w.w = pack2(v1[2], v1[3]);
          *(u32x4*)(S + r * 256 + bj * 128 + wc * 32 + 8 * fq) = w;
        }
      }
    asm volatile("s_waitcnt vmcnt(0)" ::: "memory");
    __builtin_amdgcn_s_barrier();
    __builtin_amdgcn_s_barrier();
    asm volatile("" ::: "memory");
    const int tid = my_tid(), cc = tid & 31, rg = tid >> 5;
    const int gcol = u.pn * 128 + cc * 4, vcol = DFF + gcol;
    float wg[3][4], wv[3][4], bg[4], bv[4];
#pragma unroll
    for (int q = 0; q < 3; ++q) {
      const float4 a0 = *(const float4*)(cw + q * 2 * DFF + gcol);
      const float4 c0 = *(const float4*)(cw + q * 2 * DFF + vcol);
      wg[q][0] = a0.x; wg[q][1] = a0.y; wg[q][2] = a0.z; wg[q][3] = a0.w;
      wv[q][0] = c0.x; wv[q][1] = c0.y; wv[q][2] = c0.z; wv[q][3] = c0.w;
    }
    {
      const float4 a0 = *(const float4*)(cb + gcol);
      const float4 c0 = *(const float4*)(cb + vcol);
      bg[0] = a0.x; bg[1] = a0.y; bg[2] = a0.z; bg[3] = a0.w;
      bv[0] = c0.x; bv[1] = c0.y; bv[2] = c0.z; bv[3] = c0.w;
    }
    uint2 rgt[18], rvl[18];
#pragma unroll
    for (int q = 0; q < 18; ++q) {
      int r = rg * 16 + q - 2; r = r < 0 ? 0 : r;
      rgt[q] = *(const uint2*)(S + r * 256 + cc * 4);
      rvl[q] = *(const uint2*)(S + r * 256 + 128 + cc * 4);
    }
    float g2[4], g1[4], v2[4], v1[4];
#define UNP4(src_, dst_) { dst_[0] = __uint_as_float(src_.x << 16); dst_[1] = __uint_as_float(src_.x & 0xffff0000u); dst_[2] = __uint_as_float(src_.y << 16); dst_[3] = __uint_as_float(src_.y & 0xffff0000u); }
    {
      const bool z0 = (tokbase + rg * 16 - 2) < tbeg, z1 = (tokbase + rg * 16 - 1) < tbeg;
      UNP4(rgt[0], g2); UNP4(rvl[0], v2); UNP4(rgt[1], g1); UNP4(rvl[1], v1);
#pragma unroll
      for (int j = 0; j < 4; ++j) { if (z0) { g2[j] = 0.f; v2[j] = 0.f; } if (z1) { g1[j] = 0.f; v1[j] = 0.f; } }
    }
#pragma unroll
    for (int q = 2; q < 18; ++q) {
      const int r = rg * 16 + q - 2;
      const int tk = tokbase + r;
      float g0[4], v0[4], o[4];
      UNP4(rgt[q], g0); UNP4(rvl[q], v0);
      if (tk < tbeg) {
#pragma unroll
        for (int j = 0; j < 4; ++j) { g0[j] = 0.f; v0[j] = 0.f; }
      }
#pragma unroll
      for (int j = 0; j < 4; ++j) {
        const float cg = bg[j] + wg[0][j] * g2[j] + wg[1][j] * g1[j] + wg[2][j] * g0[j];
        const float cv = bv[j] + wv[0][j] * v2[j] + wv[1][j] * v1[j] + wv[2][j] * v0[j];
        o[j] = siluf_(cg) * cv;
        g2[j] = g1[j]; g1[j] = g0[j]; v2[j] = v1[j]; v1[j] = v0[j];
      }
      if (r >= 2 && tk < tend) *(uint2*)(act + (size_t)tk * DFF + u.pn * 128 + cc * 4) = make_uint2(pack2(o[0], o[1]), pack2(o[2], o[3]));
    }
#undef UNP4
  }
};
template <class Epi>
DEV void pg8_gemm(unsigned char* smraw, const u16* A, const u16* Bt, int M, int N, int K, const Epi& E, int bid, int nb) {
  pg8::Gemm g{A, Bt, M, N, K};
  pg8::StaticOrder S;
  S.init(M, N, nb, bid);
  pg8::gemm_phase<Epi, pg8::StaticOrder, false>((PG8_LAS unsigned char*)smraw, g, S, E, nullptr);
}

#define PPL 15
#define NPHASE (2 + 2 * PPL)
template <int ph>
DEV void run_phase(const Params& p, unsigned char* smraw, int bid, int nb) {
  u16* smem = (u16*)smraw;
  float* smf = (float*)smraw;
  float* xo = p.out;
  u16* xb = (u16*)(p.ws + OFF_XB);
  float* ssq_all = (float*)(p.ws + OFF_RSTD);
  if (ph == 0) { phase_prep(p, smf, bid, nb); return; }
  if (ph == NPHASE - 1) { phase_final(xo, p.in[25], bid, nb); return; }
  const int l = (ph - 1) / PPL, s = (ph - 1) % PPL;
  const float* xcur = (l == 0) ? p.in[0] : xo;
  unsigned char* W = p.ws + OFF_W + (size_t)l * LW_BYTES;
  float* ssq1 = ssq_all + (size_t)(2 * l) * NTOK;
  float* ssq2 = ssq_all + (size_t)(2 * l + 1) * NTOK;
  switch (s) {
    case 0: if (l == 0) phase_norm(xcur, xb, ssq1, bid, nb); break;
    case 1: { EpiInproj E{(u16*)(p.ws + OFF_BIG + B_PRW), 1792, ssq1}; pg8_gemm(smraw, xb, (const u16*)(W + W_IN), NTOK, 1792, DM, E, bid, nb); } break;
    case 2: phase_rwprep(p, l, smem, bid, nb); break;
    case 3: phase_scan<1>(p, l, smf, bid, nb); break;
    case 4: phase_scanprop(p, smf, bid, nb); first_tok_proj(p, l, xcur, smf, nb - 1 - bid, nb); break;
    case 5: phase_scan<3>(p, l, smf, bid, nb); break;
    case 6: { EpiInproj E{(u16*)(p.ws + OFF_BIG + B_PRS), 2560, ssq1}; pg8_gemm(smraw, xb, (const u16*)(W + W_IN) + (size_t)1792 * DM, NTOK, 2560, DM, E, bid, nb); } break;
    case 7:
      for (int u = bid; u < 1024; u += nb) ret_kv_unit(p, u, smem);
      for (int u = bid; u < 256; u += nb) sgu_unit(p, l, u, smem);
      break;
    case 8: phase_retprefix(p, bid, nb); break;
    case 9:
      for (int u = bid; u < 1024; u += nb) ret_out_unit(p, u, smem);
      first_tok_fix(p, l, smf, nb - 1 - bid, nb);
      break;
    case 10: {
      TriOrder S; S.init(NTOK, DM, nb, bid); S.a_rows_per_g = NTOK;
      EpiP E{(u16*)(p.ws + OFF_BIG + B_P)};
      pg8::Gemm g{(const u16*)(p.ws + OFF_BIG + B_YRW), (const u16*)(W + W_BR), NTOK, DM, 512};
      pg8::gemm_phase<EpiP, TriOrder, false>((PG8_LAS unsigned char*)smraw, g, S, E, nullptr);
    } break;
    case 11: {
      TriOrder S; S.init(NTOK, DM, nb, bid); S.a_rows_per_g = 0;
      EpiGate E{(u16*)(p.ws + OFF_BIG + B_M), (const u16*)(p.ws + OFF_BIG + B_P), ssq1};
      pg8::Gemm g{xb, (const u16*)(W + W_IN) + (size_t)4352 * DM, NTOK, DM, DM};
      pg8::gemm_phase<EpiGate, TriOrder, false>((PG8_LAS unsigned char*)smraw, g, S, E, nullptr);
    } break;
    case 12: { EpiRes E{xcur, xo, xb, ssq2}; pg8_gemm(smraw, (const u16*)(p.ws + OFF_BIG + B_M), (const u16*)(W + W_OUT), NTOK, DM, DM, E, bid, nb); } break;
    case 13: {
      FfnOrder S;
      S.init(132 * 256, 2 * DFF, nb, bid);
      EpiFfn E{&p, l, bid};
      pg8::Gemm g{xb, (const u16*)(W + W_UP), 132 * 256, 2 * DFF, DM};
      pg8::gemm_phase<EpiFfn, FfnOrder, false>((PG8_LAS unsigned char*)smraw, g, S, E, nullptr);
    } break;
    case 14: {
      EpiRes E{xo, xo, (l == 0) ? xb : nullptr, (l == 0) ? ssq_all + (size_t)2 * NTOK : nullptr};
      pg8_gemm(smraw, (const u16*)(p.ws + OFF_BIG + B_ACT), (const u16*)(W + W_DN), NTOK, DM, DFF, E, bid, nb);
    } break;
  }
}
DEV constexpr bool phase_empty(int ph) {
  return ph >= 1 && ph < NPHASE - 1 && ((ph - 1) % PPL == 0 && (ph - 1) / PPL == 1);
}

#define XB_TMO      128
#define XB_XCNT(j)  (256  + 64 * (j))
#define XB_XSUB(j)  (1280 + 64 * (j))
#define XB_XGEN(j)  (2304 + 64 * (j))
#define XB_TOP      3328
#define XB_TOPGEN   3392
#define XCD_BAR_WORDS 3456
#define XB_SPIN_CAP (1u << 18)
#define LAS __attribute__((address_space(3)))

__device__ __forceinline__ unsigned xb_ld(unsigned* p)              { return __hip_atomic_load(p, __ATOMIC_RELAXED, __HIP_MEMORY_SCOPE_AGENT); }
__device__ __forceinline__ unsigned xb_add(unsigned* p, unsigned v) { return __hip_atomic_fetch_add(p, v, __ATOMIC_RELAXED, __HIP_MEMORY_SCOPE_AGENT); }
__device__ __forceinline__ unsigned xb_xcc_id() { return (unsigned)__builtin_amdgcn_s_getreg((3 << 11) | 20) & 0xFu; }
#define XB_SPIN(cond, bar) do { unsigned _sp = 0; while (cond) { __builtin_amdgcn_s_sleep(1); \
    if ((++_sp & 255u) == 0u) { if (xb_ld(&(bar)[XB_TMO])) break; if (_sp > XB_SPIN_CAP) { atomicAdd(&(bar)[XB_TMO], 1u); break; } } } } while (0)

struct XcdBarrier {
    unsigned* bar; unsigned x;
    volatile LAS unsigned* st;
};

__device__ __forceinline__ XcdBarrier xcd_barrier_post(unsigned* bar, volatile LAS unsigned* st) {
    XcdBarrier b; b.bar = bar; b.x = xb_xcc_id(); b.st = st;
    if (my_tid() == 0) (void)xb_add(&bar[XB_XCNT(b.x)], 1u);
    return b;
}
__device__ __forceinline__ void xcd_barrier_complete(unsigned* bar, unsigned x, unsigned& nloc, unsigned& nx) {
    const unsigned G = gridDim.x * gridDim.y * gridDim.z;
    unsigned sum, cnt, mine, sp = 0u;
    for (;;) {
        sum = 0u; cnt = 0u; mine = 0u;
#pragma unroll
        for (unsigned j = 0; j < 16; ++j) { const unsigned c = xb_ld(&bar[XB_XCNT(j)]); sum += c; cnt += (c > 0u) ? 1u : 0u; mine = (j == x) ? c : mine; }
        if (sum == G) break;
        __builtin_amdgcn_s_sleep(1);
        if ((++sp & 255u) == 0u) { if (xb_ld(&bar[XB_TMO])) break; if (sp > XB_SPIN_CAP) { atomicAdd(&bar[XB_TMO], 1u); break; } }
    }
    nloc = mine > 0u ? mine : 1u; nx = cnt > 0u ? cnt : 1u;
}

__device__ __forceinline__ void xcd_barrier(const XcdBarrier& b) {
    asm volatile("s_waitcnt vmcnt(0)" ::: "memory");
    __syncthreads();
    if (my_tid() == 0) {
        unsigned* bar = b.bar;
        __builtin_amdgcn_s_waitcnt(0);
        unsigned nloc = b.st[0], nx = b.st[1];
        if (nloc == 0u) { xcd_barrier_complete(bar, b.x, nloc, nx); b.st[0] = nloc; b.st[1] = nx; }
        const unsigned old = xb_add(&bar[XB_XSUB(b.x)], 1u);
        const unsigned gen = old / nloc;
        if (old + 1u == (gen + 1u) * nloc) {
            __builtin_amdgcn_fence(__ATOMIC_RELEASE, "agent");
            asm volatile("s_waitcnt vmcnt(0)" ::: "memory");
            const unsigned og = xb_add(&bar[XB_TOP], 1u);
            const unsigned tg = og / nx;
            if (og + 1u == (tg + 1u) * nx) xb_add(&bar[XB_TOPGEN], 1u);
            else XB_SPIN(xb_ld(&bar[XB_TOPGEN]) == tg, bar);
            __builtin_amdgcn_fence(__ATOMIC_ACQUIRE, "agent");
            xb_add(&bar[XB_XGEN(b.x)], 1u);
            asm volatile("s_waitcnt vmcnt(0)" ::: "memory");
        } else {
            XB_SPIN(xb_ld(&bar[XB_XGEN(b.x)]) == gen, bar);
            __builtin_amdgcn_fence(__ATOMIC_ACQUIRE, "agent");
            asm volatile("s_waitcnt vmcnt(0)" ::: "memory");
        }
    }
    __syncthreads();
}


DEV void gsync(unsigned* ctr, unsigned& target) {
  asm volatile("s_waitcnt vmcnt(0)" ::: "memory");
  __syncthreads();
  if (my_tid() == 0) {
    target += gridDim.x;
    __builtin_amdgcn_fence(__ATOMIC_RELEASE, "agent");
    asm volatile("s_waitcnt vmcnt(0)" ::: "memory");
    __hip_atomic_fetch_add(ctr, 1u, __ATOMIC_RELAXED, __HIP_MEMORY_SCOPE_AGENT);
    while (__hip_atomic_load(ctr, __ATOMIC_RELAXED, __HIP_MEMORY_SCOPE_AGENT) < target) __builtin_amdgcn_s_sleep(2);
    __builtin_amdgcn_fence(__ATOMIC_ACQUIRE, "agent");
    asm volatile("s_waitcnt vmcnt(0)" ::: "memory");
  }
  __syncthreads();
}

#if COOP
template <int PH>
DEV void run_seq(const Params& p, unsigned char* smraw, cg::grid_group& grid, const XcdBarrier& xb) {
  if constexpr (phase_empty(PH)) {
    run_seq<PH + 1>(p, smraw, grid, xb);
  } else {
    int bid_ = blockIdx.x;
    asm volatile("" : "+s"(bid_));
    run_phase<PH>(p, smraw, bid_, gridDim.x);
    if constexpr (PH + 1 < NPHASE) {
      if constexpr (PH == 0) grid.sync();
      else xcd_barrier(xb);
      run_seq<PH + 1>(p, smraw, grid, xb);
    }
  }
}
__global__ void __launch_bounds__(NTHR) mega(Params p) {
  __shared__ __align__(16) unsigned char smraw[147456];
  cg::grid_group grid = cg::this_grid();
  __shared__ uint4 xb_words;
  if (my_tid() == 0) xb_words = make_uint4(0u, 0u, 0u, 0u);
  __syncthreads();
  XcdBarrier xb = xcd_barrier_post((unsigned*)p.ws, (volatile LAS unsigned*)&xb_words);
  run_seq<0>(p, smraw, grid, xb);
}
#else
template <int PH>
__global__ void __launch_bounds__(NTHR) phk(Params p) {
  __shared__ __align__(16) unsigned char smraw[147456];
  run_phase<PH>(p, smraw, blockIdx.x, gridDim.x);
}
template <int PH>
static void launch_seq(const Params& p, hipStream_t stream) {
  phk<PH><<<256, NTHR, 0, stream>>>(p);
  if constexpr (PH + 1 < NPHASE) launch_seq<PH + 1>(p, stream);
}
#endif

extern "C" void kernel_launch(void* const* d_in, const int* in_sizes, int n_in, void* d_out, int out_size, void* d_ws,
                              size_t ws_size, hipStream_t stream) {
  Params p{};
  for (int i = 0; i < 26; ++i) p.in[i] = (const float*)d_in[i];
  p.out = (float*)d_out;
  p.ws = (unsigned char*)d_ws;
  if (ws_size < WS_NEED) { fprintf(stderr, "workspace too small: %zu < %llu\n", ws_size, (unsigned long long)WS_NEED); return; }
#if COOP
  static int grid_blocks = 0;
  if (!grid_blocks) {
    int dev = 0, cus = 0, per_cu = 0;
    hipGetDevice(&dev);
    hipDeviceGetAttribute(&cus, hipDeviceAttributeMultiprocessorCount, dev);
    hipOccupancyMaxActiveBlocksPerMultiprocessor(&per_cu, mega, NTHR, 0);
    if (per_cu > 1) per_cu = 1;
    grid_blocks = cus * per_cu;
  }
  hipMemsetAsync(d_ws, 0, 16384, stream);
  void* args[] = {&p};
  hipError_t e = hipLaunchCooperativeKernel((void*)mega, dim3(grid_blocks), dim3(NTHR), args, 0, stream);
  if (e != hipSuccess) fprintf(stderr, "cooperative launch failed: %s (grid %d)\n", hipGetErrorString(e), grid_blocks);
#else
  launch_seq<0>(p, stream);
#endif
}
```

```cpp
#include <hip/hip_runtime.h>
#include <hip/hip_cooperative_groups.h>
#include <cstdio>
#include <cstdint>
namespace cg = cooperative_groups;

#ifndef COOP
#define COOP 1
#endif

#define DEV __device__ __forceinline__
typedef unsigned short u16;
typedef short bf16x8 __attribute__((ext_vector_type(8)));
typedef float f32x16 __attribute__((ext_vector_type(16)));

#define NTHR 512
#define NTOK 32768
#define SEQ 8192
#define DM 1024
#define INC 7424
#define DFF 2816
#define MiB (1048576ull)

#define OFF_ROPE (64ull * 1024)
#define OFF_RSTD (OFF_ROPE + 2 * MiB)
#define OFF_PF (OFF_RSTD + 640ull * 1024)
#define OFF_W (3 * MiB)
#define LW_BYTES (37 * MiB)
#define W_IN 0ull
#define W_BR 15204352ull
#define W_OUT 18350080ull
#define W_UP 20447232ull
#define W_DN 31981568ull
#define W_RWUP 37748736ull
#define W_RAUP 37814272ull
#define W_RGUP 37879808ull
#define W_SGW 38010880ull
#define OFF_XB (77 * MiB)
#define OFF_BIG (141 * MiB)
#define B_PRW 0ull
#define B_YRW 0ull
#define B_YRET (32 * MiB)
#define B_YSG (64 * MiB)
#define B_OPS (112 * MiB)
#define B_PRS (112 * MiB)
#define B_KV (272 * MiB)
#define B_M 0ull
#define B_P (128 * MiB)
#define B_PL (304 * MiB)
#define B_SINIT (320 * MiB)
#define B_ACT 0ull
#define WS_NEED (OFF_BIG + 328 * MiB)

struct Params {
  const float* in[26];
  float* out;
  unsigned char* ws;
};

DEV int my_tid() {
  int t = __builtin_amdgcn_workitem_id_x();
  asm volatile("" : "+v"(t));
  return t;
}
DEV u16 f2bf(float f) {
  unsigned u = __float_as_uint(f);
  u += 0x7fffu + ((u >> 16) & 1u);
  return (u16)(u >> 16);
}
DEV float bf2f(u16 h) { return __uint_as_float(((unsigned)h) << 16); }
DEV unsigned pack2(float a, float b) { return (unsigned)f2bf(a) | ((unsigned)f2bf(b) << 16); }
DEV void unpack8(uint4 v, float* f) {
  f[0] = __uint_as_float(v.x << 16); f[1] = __uint_as_float(v.x & 0xffff0000u);
  f[2] = __uint_as_float(v.y << 16); f[3] = __uint_as_float(v.y & 0xffff0000u);
  f[4] = __uint_as_float(v.z << 16); f[5] = __uint_as_float(v.z & 0xffff0000u);
  f[6] = __uint_as_float(v.w << 16); f[7] = __uint_as_float(v.w & 0xffff0000u);
}
DEV uint4 pack8(const float* f) {
  return make_uint4(pack2(f[0], f[1]), pack2(f[2], f[3]), pack2(f[4], f[5]), pack2(f[6], f[7]));
}
template <int CTRL>
DEV float dppmov(float x) {
  return __builtin_bit_cast(float, __builtin_amdgcn_update_dpp(0, __builtin_bit_cast(int, x), CTRL, 0xF, 0xF, true));
}
DEV float red4(float x) { x += dppmov<0xB1>(x); x += dppmov<0x4E>(x); return x; }
DEV float red8(float x) { x = red4(x); x += dppmov<0x141>(x); return x; }
DEV float wave_sum(float x) {
  x = red8(x);
  x += dppmov<0x140>(x);
  const int xi = __builtin_bit_cast(int, x);
  return __builtin_bit_cast(float, __builtin_amdgcn_readlane(xi, 0)) + __builtin_bit_cast(float, __builtin_amdgcn_readlane(xi, 16)) +
         __builtin_bit_cast(float, __builtin_amdgcn_readlane(xi, 32)) + __builtin_bit_cast(float, __builtin_amdgcn_readlane(xi, 48));
}
DEV float sigmoidf_(float x) { return 1.f / (1.f + __expf(-x)); }
DEV float siluf_(float x) { return x / (1.f + __expf(-x)); }
DEV float geluf_(float x) { return 0.5f * x * (1.f + erff(x * 0.70710678118654752f)); }

DEV float rstd_of(const float* ssq, int row) { return rsqrtf(ssq[row] * (1.0f / DM) + 1e-6f); }
DEV int vbid(int bid, int nb) { return ((nb & 7) == 0) ? (bid & 7) * (nb >> 3) + (bid >> 3) : bid; }
DEV void tile_map(int t, int MTL, int NTL, int& m, int& n) {
  int per = 8 * NTL;
  int g = t / per;
  int r = t - g * per;
  int gm = MTL - g * 8; gm = gm > 8 ? 8 : gm;
  m = g * 8 + r % gm;
  n = r / gm;
}

typedef unsigned u32x4 __attribute__((ext_vector_type(4)));
template <int NA>
struct GStage { u32x4 a0, a1, a2, a3, b0, b1; };
DEV u32x4 g_ld_a(const u16* A, long lda, int g, int azero_below, int arow_max, int ko) {
  const bool z = g < azero_below;
  g = g < 0 ? 0 : g;
  g = g > arow_max ? arow_max : g;
  u32x4 v = *(const u32x4*)(A + (long)g * lda + ko);
  const u32x4 zero = {0u, 0u, 0u, 0u};
  return z ? zero : v;
}
template <int NA>
DEV void g_load(GStage<NA>& S, const u16* A, long lda, int arow, int azero_below, int arow_max,
                const u16* bp0, const u16* bp1, int ko) {
  S.a0 = g_ld_a(A, lda, arow, azero_below, arow_max, ko);
  S.a1 = g_ld_a(A, lda, arow + 64, azero_below, arow_max, ko);
  if constexpr (NA == 4) {
    S.a2 = g_ld_a(A, lda, arow + 128, azero_below, arow_max, ko);
    S.a3 = g_ld_a(A, lda, arow + 192, azero_below, arow_max, ko);
  }
  S.b0 = *(const u32x4*)(bp0 + ko);
  S.b1 = *(const u32x4*)(bp1 + ko);
}
template <int NA>
DEV void g_store(const GStage<NA>& S, u16* An, u16* Bn, int st_off) {
  *(u32x4*)(An + st_off) = S.a0;
  *(u32x4*)(An + st_off + 64 * 72) = S.a1;
  if constexpr (NA == 4) {
    *(u32x4*)(An + st_off + 128 * 72) = S.a2;
    *(u32x4*)(An + st_off + 192 * 72) = S.a3;
  }
  *(u32x4*)(Bn + st_off) = S.b0;
  *(u32x4*)(Bn + st_off + 64 * 72) = S.b1;
}
template <int MT>
DEV void g_compute(f32x16 (&acc)[MT][2], const u16* Ab, const u16* Bb) {
#pragma unroll
  for (int ks = 0; ks < 4; ++ks) {
    bf16x8 a[MT], b[2];
#pragma unroll
    for (int i = 0; i < MT; ++i) a[i] = *(const bf16x8*)(Ab + i * 32 * 72 + ks * 16);
#pragma unroll
    for (int j = 0; j < 2; ++j) b[j] = *(const bf16x8*)(Bb + j * 32 * 72 + ks * 16);
#pragma unroll
    for (int i = 0; i < MT; ++i)
#pragma unroll
      for (int j = 0; j < 2; ++j) acc[i][j] = __builtin_amdgcn_mfma_f32_32x32x16_bf16(a[i], b[j], acc[i][j], 0, 0, 0);
  }
}
template <int MT>
DEV void gemm_tile(f32x16 (&acc)[MT][2], const u16* A, long lda, int arow0, int azero_below, int arow_max,
                   const u16* B, long ldb, int K, u16* smem) {
  constexpr int TM = 128 * MT;
  constexpr int ASZ = TM * 72, BSZ = 128 * 72;
  constexpr int NA = TM / 64;
  const int tid = my_tid(), lane = tid & 63, wave = tid >> 6, wm = wave >> 1, wn = wave & 1;
  const int crow = tid >> 3, ckc = tid & 7;
  GStage<NA> s0, s1;
  const u16* Ak = A + ckc * 8;
  const int arow = arow0 + crow;
  const u16* bp0 = B + (long)crow * ldb + ckc * 8;
  const u16* bp1 = B + (long)(crow + 64) * ldb + ckc * 8;
  const int nk = K >> 6;
  const int arow_l = (wm * 32 * MT + (lane & 31)) * 72 + (lane >> 5) * 8;
  const int brow_l = (wn * 64 + (lane & 31)) * 72 + (lane >> 5) * 8;
  const int st_off = crow * 72 + ckc * 8;
  g_load<NA>(s0, Ak, lda, arow, azero_below, arow_max, bp0, bp1, 0);
  g_store<NA>(s0, smem, smem + ASZ, st_off);
  g_load<NA>(s1, Ak, lda, arow, azero_below, arow_max, bp0, bp1, 64);
  __syncthreads();
  for (int kt = 0; kt < nk; kt += 2) {
    if (kt + 2 < nk) g_load<NA>(s0, Ak, lda, arow, azero_below, arow_max, bp0, bp1, (kt + 2) * 64);
    g_compute<MT>(acc, smem + arow_l, smem + ASZ + brow_l);
    g_store<NA>(s1, smem + (ASZ + BSZ), smem + (ASZ + BSZ) + ASZ, st_off);
    __syncthreads();
    if (kt + 3 < nk) g_load<NA>(s1, Ak, lda, arow, azero_below, arow_max, bp0, bp1, (kt + 3) * 64);
    g_compute<MT>(acc, smem + (ASZ + BSZ) + arow_l, smem + (ASZ + BSZ) + ASZ + brow_l);
    if (kt + 2 < nk) g_store<NA>(s0, smem, smem + ASZ, st_off);
    __syncthreads();
  }
}
struct GStageB { u32x4 a0, a1, a2, a3, b0, b1, b2, b3; };
DEV const u16* g_rowptr(const u16* A, long lda, int g, int arow_max) {
  g = g < 0 ? 0 : g;
  g = g > arow_max ? arow_max : g;
  return A + (long)g * lda;
}
DEV void gb_load(GStageB& S, const u16* A, long lda, int arow, int arow_max, const u16* Bk, long ldb, int ko) {
  S.a0 = *(const u32x4*)(g_rowptr(A, lda, arow, arow_max) + ko);
  S.a1 = *(const u32x4*)(g_rowptr(A, lda, arow + 64, arow_max) + ko);
  S.a2 = *(const u32x4*)(g_rowptr(A, lda, arow + 128, arow_max) + ko);
  S.a3 = *(const u32x4*)(g_rowptr(A, lda, arow + 192, arow_max) + ko);
  S.b0 = *(const u32x4*)(Bk + ko);
  S.b1 = *(const u32x4*)(Bk + 64 * ldb + ko);
  S.b2 = *(const u32x4*)(Bk + 128 * ldb + ko);
  S.b3 = *(const u32x4*)(Bk + 192 * ldb + ko);
}
DEV void gb_store(const GStageB& S, u16* An, u16* Bn, int st_off, int arow, int azero_below) {
  const u32x4 zero = {0u, 0u, 0u, 0u};
  *(u32x4*)(An + st_off) = (arow < azero_below) ? zero : S.a0;
  *(u32x4*)(An + st_off + 64 * 72) = (arow + 64 < azero_below) ? zero : S.a1;
  *(u32x4*)(An + st_off + 128 * 72) = (arow + 128 < azero_below) ? zero : S.a2;
  *(u32x4*)(An + st_off + 192 * 72) = (arow + 192 < azero_below) ? zero : S.a3;
  *(u32x4*)(Bn + st_off) = S.b0;
  *(u32x4*)(Bn + st_off + 64 * 72) = S.b1;
  *(u32x4*)(Bn + st_off + 128 * 72) = S.b2;
  *(u32x4*)(Bn + st_off + 192 * 72) = S.b3;
}
DEV void gb_compute(f32x16 (&acc)[2][4], const u16* Ab, const u16* Bb) {
#pragma unroll
  for (int ks = 0; ks < 4; ++ks) {
    bf16x8 a[2], b[4];
#pragma unroll
    for (int i = 0; i < 2; ++i) a[i] = *(const bf16x8*)(Ab + i * 32 * 72 + ks * 16);
#pragma unroll
    for (int j = 0; j < 4; ++j) b[j] = *(const bf16x8*)(Bb + j * 32 * 72 + ks * 16);
#pragma unroll
    for (int i = 0; i < 2; ++i)
#pragma unroll
      for (int j = 0; j < 4; ++j) acc[i][j] = __builtin_amdgcn_mfma_f32_32x32x16_bf16(a[i], b[j], acc[i][j], 0, 0, 0);
  }
}
DEV void gemm_big(f32x16 (&acc)[2][4], const u16* A, long lda, int arow0, int azero_below, int arow_max,
                  const u16* B, long ldb, int K, u16* smem) {
  constexpr int ASZ = 256 * 72, BSZ = 256 * 72;
  const int tid = my_tid(), lane = tid & 63, wave = tid >> 6, wm = wave >> 1, wn = wave & 1;
  const int crow = tid >> 3, ckc = tid & 7;
  const u16* Ak = A + ckc * 8;
  const int arow = arow0 + crow;
  const u16* Bk = B + (long)crow * ldb + ckc * 8;
  const int nk = K >> 6;
  const int arow_l = (wm * 64 + (lane & 31)) * 72 + (lane >> 5) * 8;
  const int brow_l = (wn * 128 + (lane & 31)) * 72 + (lane >> 5) * 8;
  const int st_off = crow * 72 + ckc * 8;
  GStageB s;
  gb_load(s, Ak, lda, arow, arow_max, Bk, ldb, 0);
  gb_store(s, smem, smem + ASZ, st_off, arow, azero_below);
  __syncthreads();
  for (int kt = 0; kt < nk; ++kt) {
    const bool more = kt + 1 < nk;
    if (more) gb_load(s, Ak, lda, arow, arow_max, Bk, ldb, (kt + 1) * 64);
    __builtin_amdgcn_sched_barrier(0);
    const u16* cb = smem + (kt & 1) * (ASZ + BSZ);
    gb_compute(acc, cb + arow_l, cb + ASZ + brow_l);
    __builtin_amdgcn_sched_barrier(0);
    if (more) {
      u16* nb_ = smem + ((kt + 1) & 1) * (ASZ + BSZ);
      gb_store(s, nb_, nb_ + ASZ, st_off, arow, azero_below);
    }
    __syncthreads();
  }
}
#define BIG_ROW(i, e) (wm * 64 + (i) * 32 + ((e) & 3) + 8 * ((e) >> 2) + 4 * (lane >> 5))
#define BIG_COL(j) (wn * 128 + (j) * 32 + (lane & 31))
#define ZERO_BIG(acc)                                   \
  _Pragma("unroll") for (int i_ = 0; i_ < 2; ++i_)      \
  _Pragma("unroll") for (int j_ = 0; j_ < 4; ++j_)      \
  _Pragma("unroll") for (int e_ = 0; e_ < 16; ++e_) acc[i_][j_][e_] = 0.f;

#define ACC_ROW(MT_, i, e) (wm * 32 * (MT_) + (i) * 32 + ((e) & 3) + 8 * ((e) >> 2) + 4 * (lane >> 5))
#define ACC_COL(j) (wn * 64 + (j) * 32 + (lane & 31))

DEV void tconv(const float* src, int K, int N, u16* dst, const float* scale, int mode, float* t, int bid, int nb) {
  const int tid = my_tid();
  const int KT = K >> 6, NT = N >> 6;
  for (int tt = bid; tt < KT * NT; tt += nb) {
    const int kt = tt % KT, nt = tt / KT;
    const int k0 = kt * 64, n0 = nt * 64;
    int sn0 = n0;
    if (mode == 1) { int j = n0 >> 8, c = n0 & 255; sn0 = (c < 128) ? (j * 128 + c) : (DFF + j * 128 + c - 128); }
    {
      const int kk = tid >> 6, n = tid & 63;
#pragma unroll
      for (int i = 0; i < 8; ++i) {
        int k = kk + 8 * i;
        float v = src[(long)(k0 + k) * N + sn0 + n];
        if (scale) v *= scale[k0 + k];
        t[k * 65 + n] = v;
      }
    }
    __syncthreads();
    {
      const int n = tid >> 3, k8 = tid & 7;
      float f[8];
#pragma unroll
      for (int j = 0; j < 8; ++j) f[j] = t[(k8 * 8 + j) * 65 + n];
      *(uint4*)(dst + (long)(n0 + n) * K + k0 + k8 * 8) = pack8(f);
    }
    __syncthreads();
  }
}

DEV void phase_prep(const Params& p, float* smf, int bid, int nb) {
  for (int l = 0; l < 2; ++l) {
    unsigned char* W = p.ws + OFF_W + (size_t)l * LW_BYTES;
    tconv(p.in[2] + (size_t)l * DM * INC, DM, INC, (u16*)(W + W_IN), p.in[1] + l * DM, 0, smf, bid, nb);
    for (int g = 0; g < 3; ++g)
      tconv(p.in[18] + (size_t)(l * 3 + g) * 512 * DM, 512, DM, (u16*)(W + W_BR) + (size_t)g * DM * 512, nullptr, 0, smf, bid, nb);
    tconv(p.in[19] + (size_t)l * DM * DM, DM, DM, (u16*)(W + W_OUT), nullptr, 0, smf, bid, nb);
    tconv(p.in[21] + (size_t)l * DM * 2 * DFF, DM, 2 * DFF, (u16*)(W + W_UP), p.in[20] + l * DM, 1, smf, bid, nb);
    tconv(p.in[24] + (size_t)l * DFF * DM, DFF, DM, (u16*)(W + W_DN), nullptr, 0, smf, bid, nb);
    tconv(p.in[5] + (size_t)l * 64 * 512, 64, 512, (u16*)(W + W_RWUP), nullptr, 0, smf, bid, nb);
    tconv(p.in[7] + (size_t)l * 64 * 512, 64, 512, (u16*)(W + W_RAUP), nullptr, 0, smf, bid, nb);
    tconv(p.in[8] + (size_t)l * 128 * 512, 128, 512, (u16*)(W + W_RGUP), nullptr, 0, smf, bid, nb);
    const float* sw = p.in[16] + (size_t)l * 4 * 128 * 128;
    u16* sd = (u16*)(W + W_SGW);
    for (int idx = bid * NTHR + my_tid(); idx < 4 * 128 * 128; idx += nb * NTHR) {
      int i = (idx >> 7) & 127, j = idx & 127;
      sd[idx] = f2bf(j <= i ? sw[idx] : 0.f);
    }
  }
  {
    float* sq = (float*)(p.ws + OFF_RSTD) + NTOK;
    for (int idx = bid * NTHR + my_tid(); idx < 3 * NTOK; idx += nb * NTHR) sq[idx] = 0.f;
  }
  float* rc = (float*)(p.ws + OFF_ROPE);
  float* rs = rc + SEQ * 32;
  for (int idx = bid * NTHR + my_tid(); idx < SEQ * 32; idx += nb * NTHR) {
    int pos = idx >> 5, d = idx & 31;
    float lin = (d == 31) ? 1.0f : (float)d * (1.0f / 31.0f);
    float invf = 1.0f / powf(10000.0f, lin);
    float ang = (float)pos * invf;
    double rev = (double)ang * 0.15915494309189533577;
    float fr = (float)(rev - floor(rev));
    rc[idx] = __builtin_amdgcn_cosf(fr);
    rs[idx] = __builtin_amdgcn_sinf(fr);
  }
}

DEV void phase_norm(const float* x, u16* xb, float* rstd, int bid, int nb) {
  const int lane = my_tid() & 63, wave = my_tid() >> 6;
  for (int row = bid * 8 + wave; row < NTOK; row += nb * 8) {
    const float4* xr = (const float4*)(x + (size_t)row * DM);
    float4 v[4];
    float ss = 0.f;
#pragma unroll
    for (int i = 0; i < 4; ++i) {
      v[i] = xr[lane + 64 * i];
      ss += v[i].x * v[i].x + v[i].y * v[i].y + v[i].z * v[i].z + v[i].w * v[i].w;
    }
    ss = wave_sum(ss);
    if (lane == 0) rstd[row] = ss;
    uint2* o = (uint2*)(xb + (size_t)row * DM);
#pragma unroll
    for (int i = 0; i < 4; ++i) o[lane + 64 * i] = make_uint2(pack2(v[i].x, v[i].y), pack2(v[i].z, v[i].w));
  }
}
DEV void phase_final(float* x, const float* g, int bid, int nb) {
  const int lane = my_tid() & 63, wave = my_tid() >> 6;
  for (int row = bid * 8 + wave; row < NTOK; row += nb * 8) {
    float4* xr = (float4*)(x + (size_t)row * DM);
    const float4* gr = (const float4*)g;
    float4 v[4];
    float ss = 0.f;
#pragma unroll
    for (int i = 0; i < 4; ++i) {
      v[i] = xr[lane + 64 * i];
      ss += v[i].x * v[i].x + v[i].y * v[i].y + v[i].z * v[i].z + v[i].w * v[i].w;
    }
    ss = wave_sum(ss);
    float r = rsqrtf(ss * (1.0f / DM) + 1e-6f);
#pragma unroll
    for (int i = 0; i < 4; ++i) {
      float4 gg = gr[lane + 64 * i];
      xr[lane + 64 * i] = make_float4(v[i].x * r * gg.x, v[i].y * r * gg.y, v[i].z * r * gg.z, v[i].w * r * gg.w);
    }
  }
}

DEV void phase_inproj(const u16* xb, const float* rstd, const u16* wt, int N, u16* out, u16* smem, int bid, int nb) {
  const int tid = my_tid(), lane = tid & 63, wave = tid >> 6, wm = wave >> 1, wn = wave & 1;
  const int MTL = NTOK / 256, NTL = N / 256;
  for (int t = vbid(bid, nb); t < MTL * NTL; t += nb) {
    int m, n;
    tile_map(t, MTL, NTL, m, n);
    f32x16 acc[2][4];
    ZERO_BIG(acc);
    gemm_big(acc, xb, DM, m * 256, -(1 << 30), NTOK - 1, wt + (size_t)n * 256 * DM, DM, DM, smem);
#pragma unroll
    for (int i = 0; i < 2; ++i)
#pragma unroll
      for (int e = 0; e < 16; ++e) {
        const int r = BIG_ROW(i, e);
        const float rs = rstd_of(rstd, m * 256 + r);
#pragma unroll
        for (int j = 0; j < 4; ++j) smem[r * 264 + BIG_COL(j)] = f2bf(acc[i][j][e] * rs);
      }
    __syncthreads();
#pragma unroll 4
    for (int k = 0; k < 16; ++k) {
      const int c = tid + NTHR * k;
      const int r = c >> 5, cc = c & 31;
      *(uint4*)(out + (size_t)(m * 256 + r) * N + n * 256 + cc * 8) = *(const uint4*)(smem + r * 264 + cc * 8);
    }
    __syncthreads();
  }
}

#define OPS_STRIDE ((size_t)NTOK * 512)
template <int WHICH>
DEV void rwprep_gemm(const u16* T, u16* OS, const u16* wsrc, const float* w0, const float* a0, u16* ops, int t0, int nbk) {
  const int tid = my_tid(), lane = tid & 63, wave = tid >> 6, wm = wave >> 1, wn = wave & 1;
  constexpr int kd = (WHICH == 2) ? 128 : 64;
  constexpr int aoff = (WHICH == 0) ? 0 : (WHICH == 1 ? 64 : 128);
  constexpr int arr = (WHICH == 0) ? 4 : (WHICH == 1 ? 3 : 5);
  const int arow = (wm * 32 + (lane & 31)) * 264 + (lane >> 5) * 8;
  const int bn = nbk * 128 + wn * 64 + (lane & 31);
  bf16x8 bfr[kd / 16][2];
#pragma unroll
  for (int ks = 0; ks < kd / 16; ++ks)
#pragma unroll
    for (int j = 0; j < 2; ++j) bfr[ks][j] = *(const bf16x8*)(wsrc + (size_t)(bn + j * 32) * kd + ks * 16 + (lane >> 5) * 8);
  f32x16 ac[2];
#pragma unroll
  for (int j = 0; j < 2; ++j)
#pragma unroll
    for (int e = 0; e < 16; ++e) ac[j][e] = 0.f;
#pragma unroll
  for (int ks = 0; ks < kd / 16; ++ks) {
    const bf16x8 a1 = *(const bf16x8*)(T + arow + aoff + ks * 16);
#pragma unroll
    for (int j = 0; j < 2; ++j) ac[j] = __builtin_amdgcn_mfma_f32_32x32x16_bf16(a1, bfr[ks][j], ac[j], 0, 0, 0);
  }
#pragma unroll
  for (int j = 0; j < 2; ++j) {
    const int cl = ACC_COL(j);
    const int ch = nbk * 128 + cl;
    const float w0c = w0[ch], a0c = a0[ch];
#pragma unroll
    for (int e = 0; e < 16; ++e) {
      float val;
      if (WHICH == 0) {
        const float z = -(w0c + ac[j][e]);
        const float sp = fmaxf(z, 0.f) + log1pf(__expf(-fabsf(z)));
        val = __expf(-sp - 0.5f);
      } else if (WHICH == 1) {
        val = sigmoidf_(a0c + ac[j][e]);
      } else {
        val = ac[j][e];
      }
      OS[ACC_ROW(1, 0, e) * 136 + cl] = f2bf(val);
    }
  }
  __syncthreads();
#pragma unroll
  for (int k = 0; k < 4; ++k) {
    const int c = tid + NTHR * k;
    const int r = c >> 4, cc = c & 15;
    *(uint4*)(ops + (size_t)arr * OPS_STRIDE + (size_t)(t0 + r) * 512 + nbk * 128 + cc * 8) = *(const uint4*)(OS + r * 136 + cc * 8);
  }
  __syncthreads();
}

DEV void phase_rwprep(const Params& p, int l, u16* smem, int bid, int nb) {
  const int tid = my_tid(), lane = tid & 63, wave = tid >> 6, wm = wave >> 1, wn = wave & 1;
  const u16* prw = (const u16*)(p.ws + OFF_BIG + B_PRW);
  u16* ops = (u16*)(p.ws + OFF_BIG + B_OPS);
  unsigned char* W = p.ws + OFF_W + (size_t)l * LW_BYTES;
  const u16* wup = (const u16*)(W + W_RWUP);
  const u16* aup = (const u16*)(W + W_RAUP);
  const u16* gup = (const u16*)(W + W_RGUP);
  const float* mu = p.in[3] + l * 1792;
  const float* w0 = p.in[4] + l * 512;
  const float* a0 = p.in[6] + l * 512;
  u16* T = smem;
  for (int tile = bid; tile < NTOK / 128; tile += nb) {
    const int t0 = tile * 128;
    for (int c0 = tid; c0 < 128 * 224; c0 += NTHR * 8) {
      u32x4 cu[8], pv[8];
#pragma unroll
      for (int q = 0; q < 8; ++q) {
        const int c = c0 + NTHR * q;
        const int tok = c / 224, ch = (c % 224) * 8;
        const int t = t0 + tok;
        cu[q] = *(const u32x4*)(prw + (size_t)t * 1792 + ch);
        const int tp = ((t & (SEQ - 1)) != 0) ? t - 1 : t;
        pv[q] = *(const u32x4*)(prw + (size_t)tp * 1792 + ch);
      }
#pragma unroll
      for (int q = 0; q < 8; ++q) {
        const int c = c0 + NTHR * q;
        const int tok = c / 224, ch = (c % 224) * 8;
        const int t = t0 + tok;
        float cur[8], prv[8], o[8];
        unpack8(make_uint4(cu[q].x, cu[q].y, cu[q].z, cu[q].w), cur);
        unpack8(make_uint4(pv[q].x, pv[q].y, pv[q].z, pv[q].w), prv);
        if ((t & (SEQ - 1)) == 0) {
#pragma unroll
          for (int j = 0; j < 8; ++j) prv[j] = 0.f;
        }
        float4 m0 = *(const float4*)(mu + ch), m1 = *(const float4*)(mu + ch + 4);
        float mm[8] = {m0.x, m0.y, m0.z, m0.w, m1.x, m1.y, m1.z, m1.w};
#pragma unroll
        for (int j = 0; j < 8; ++j) o[j] = cur[j] + mm[j] * (prv[j] - cur[j]);
        if (ch < 1536) {
          int arr = ch >> 9;
          *(uint4*)(ops + arr * OPS_STRIDE + (size_t)t * 512 + (ch & 511)) = pack8(o);
        } else {
          int cc = ch - 1536;
          if (cc < 64) {
#pragma unroll
            for (int j = 0; j < 8; ++j) o[j] = tanhf(o[j]);
          } else if (cc >= 128) {
#pragma unroll
            for (int j = 0; j < 8; ++j) o[j] = sigmoidf_(o[j]);
          }
          *(uint4*)(T + tok * 264 + cc) = pack8(o);
        }
      }
    }
    __syncthreads();
    u16* OS = smem + 128 * 264;
    for (int nbk = 0; nbk < 4; ++nbk) {
      rwprep_gemm<0>(T, OS, wup, w0, a0, ops, t0, nbk);
      rwprep_gemm<1>(T, OS, aup, w0, a0, ops, t0, nbk);
      rwprep_gemm<2>(T, OS, gup, w0, a0, ops, t0, nbk);
    }
    __syncthreads();
  }
}

#define TS 32
struct ScanStage {
  float* W; float* KK; float* BB; float* KP; float* RR; float* VV; float* YY;
};
template <int PASS>
DEV void phase_scan(const Params& p, int l, float* smf, int bid, int nb) {
  const int tid = my_tid();
  const int half = tid >> 8, tu = tid & 255;
  const u16* ops = (const u16*)(p.ws + OFF_BIG + B_OPS);
  float* PL = (float*)(p.ws + OFF_BIG + B_PL);
  const float* SIN = (const float*)(p.ws + OFF_BIG + B_SINIT);
  u16* yrw = (u16*)(p.ws + OFF_BIG + B_YRW);
  const float* k_k = p.in[9] + l * 512;
  const float* k_a = p.in[10] + l * 512;
  const float* r_k = p.in[11] + l * 512;
  const float* lng = p.in[12] + l * 512;
  const float* lnb = p.in[13] + l * 512;
  float* base = smf + half * (7 * TS * 64);
  float* sW = base; float* sKK = base + TS * 64; float* sB = base + 2 * TS * 64; float* sKP = base + 3 * TS * 64;
  float* sR = base + 4 * TS * 64; float* sV = base + 5 * TS * 64; float* sY = base + 6 * TS * 64;
  const int ss = tu >> 3, c8 = tu & 7;
  const int ks = tu & 7, rp = tu >> 3;
  for (int u2 = bid; u2 < 256; u2 += nb) {
    const int u = u2 * 2 + half;
    const int bh = u >> 4, c = u & 15;
    const int b = bh >> 3, h = bh & 7;
    const int tok0 = b * SEQ + c * 512;
    const int chb = h * 64 + c8 * 8;
    float S0[8], S1[8], Q0[8], Q1[8];
    if (PASS == 1) {
#pragma unroll
      for (int j = 0; j < 8; ++j) {
        S0[j] = 0.f; S1[j] = 0.f;
        Q0[j] = (ks * 8 + j == 2 * rp) ? 1.f : 0.f;
        Q1[j] = (ks * 8 + j == 2 * rp + 1) ? 1.f : 0.f;
      }
    } else {
      const float* si = SIN + (size_t)u * 4096;
      float4 x0 = *(const float4*)(si + (2 * rp) * 64 + ks * 8), x1 = *(const float4*)(si + (2 * rp) * 64 + ks * 8 + 4);
      float4 y0 = *(const float4*)(si + (2 * rp + 1) * 64 + ks * 8), y1 = *(const float4*)(si + (2 * rp + 1) * 64 + ks * 8 + 4);
      S0[0] = x0.x; S0[1] = x0.y; S0[2] = x0.z; S0[3] = x0.w; S0[4] = x1.x; S0[5] = x1.y; S0[6] = x1.z; S0[7] = x1.w;
      S1[0] = y0.x; S1[1] = y0.y; S1[2] = y0.z; S1[3] = y0.w; S1[4] = y1.x; S1[5] = y1.y; S1[6] = y1.z; S1[7] = y1.w;
#pragma unroll
      for (int j = 0; j < 8; ++j) { Q0[j] = 0.f; Q1[j] = 0.f; }
    }
    float kkc[8], kac[8], rkc[8];
    {
      float4 q0 = *(const float4*)(k_k + chb), q1 = *(const float4*)(k_k + chb + 4);
      kkc[0] = q0.x; kkc[1] = q0.y; kkc[2] = q0.z; kkc[3] = q0.w; kkc[4] = q1.x; kkc[5] = q1.y; kkc[6] = q1.z; kkc[7] = q1.w;
      q0 = *(const float4*)(k_a + chb); q1 = *(const float4*)(k_a + chb + 4);
      kac[0] = q0.x; kac[1] = q0.y; kac[2] = q0.z; kac[3] = q0.w; kac[4] = q1.x; kac[5] = q1.y; kac[6] = q1.z; kac[7] = q1.w;
      q0 = *(const float4*)(r_k + chb); q1 = *(const float4*)(r_k + chb + 4);
      rkc[0] = q0.x; rkc[1] = q0.y; rkc[2] = q0.z; rkc[3] = q0.w; rkc[4] = q1.x; rkc[5] = q1.y; rkc[6] = q1.z; rkc[7] = q1.w;
    }
    uint4 pr_r, pr_k, pr_v, pr_a, pr_e, pr_g = make_uint4(0, 0, 0, 0);
    {
      const size_t o0 = (size_t)(tok0 + ss) * 512 + chb;
      pr_r = *(const uint4*)(ops + 0 * OPS_STRIDE + o0);
      pr_k = *(const uint4*)(ops + 1 * OPS_STRIDE + o0);
      pr_v = *(const uint4*)(ops + 2 * OPS_STRIDE + o0);
      pr_a = *(const uint4*)(ops + 3 * OPS_STRIDE + o0);
      pr_e = *(const uint4*)(ops + 4 * OPS_STRIDE + o0);
      if (PASS == 3) pr_g = *(const uint4*)(ops + 5 * OPS_STRIDE + o0);
    }
    for (int sc = 0; sc < 512 / TS; ++sc) {
      const size_t o = (size_t)(tok0 + sc * TS + ss) * 512 + chb;
      float fr[8], fk[8], fv[8], fa[8], fe[8];
      unpack8(pr_r, fr);
      unpack8(pr_k, fk);
      unpack8(pr_v, fv);
      unpack8(pr_a, fa);
      unpack8(pr_e, fe);
      const uint4 graw = pr_g;
      if (sc + 1 < 512 / TS) {
        const size_t o1 = o + (size_t)TS * 512;
        pr_r = *(const uint4*)(ops + 0 * OPS_STRIDE + o1);
        pr_k = *(const uint4*)(ops + 1 * OPS_STRIDE + o1);
        pr_v = *(const uint4*)(ops + 2 * OPS_STRIDE + o1);
        pr_a = *(const uint4*)(ops + 3 * OPS_STRIDE + o1);
        pr_e = *(const uint4*)(ops + 4 * OPS_STRIDE + o1);
        if (PASS == 3) pr_g = *(const uint4*)(ops + 5 * OPS_STRIDE + o1);
      }
      float kk[8], kp[8], ssq = 0.f, bon = 0.f;
#pragma unroll
      for (int j = 0; j < 8; ++j) {
        kk[j] = fk[j] * kkc[j];
        ssq += kk[j] * kk[j];
        kp[j] = fk[j] * (1.f + (fa[j] - 1.f) * kac[j]);
        bon += fr[j] * kp[j] * rkc[j];
      }
      ssq = red8(ssq);
      bon = red8(bon);
      const float inv = 1.f / fmaxf(sqrtf(ssq), 1e-12f);
      float fw[8], fb[8];
#pragma unroll
      for (int j = 0; j < 8; ++j) {
        kk[j] *= inv;
        fb[j] = fa[j] * kk[j];
        fw[j] = __expf(-fe[j]);
      }
      {
        const int so = ss * 64 + c8 * 8;
        *(float4*)(sW + so) = make_float4(fw[0], fw[1], fw[2], fw[3]); *(float4*)(sW + so + 4) = make_float4(fw[4], fw[5], fw[6], fw[7]);
        *(float4*)(sKK + so) = make_float4(kk[0], kk[1], kk[2], kk[3]); *(float4*)(sKK + so + 4) = make_float4(kk[4], kk[5], kk[6], kk[7]);
        *(float4*)(sB + so) = make_float4(fb[0], fb[1], fb[2], fb[3]); *(float4*)(sB + so + 4) = make_float4(fb[4], fb[5], fb[6], fb[7]);
        *(float4*)(sKP + so) = make_float4(kp[0], kp[1], kp[2], kp[3]); *(float4*)(sKP + so + 4) = make_float4(kp[4], kp[5], kp[6], kp[7]);
        *(float4*)(sV + so) = make_float4(fv[0], fv[1], fv[2], fv[3]); *(float4*)(sV + so + 4) = make_float4(fv[4], fv[5], fv[6], fv[7]);
        if (PASS == 3) {
          *(float4*)(sR + so) = make_float4(fr[0], fr[1], fr[2], fr[3]); *(float4*)(sR + so + 4) = make_float4(fr[4], fr[5], fr[6], fr[7]);
        }
      }
      __syncthreads();
      typedef float f2 __attribute__((ext_vector_type(2)));
      f2 SP[8], QP[8];
#pragma unroll
      for (int j = 0; j < 8; ++j) { SP[j] = (f2){S0[j], S1[j]}; QP[j] = (f2){Q0[j], Q1[j]}; }
#pragma unroll 2
      for (int s = 0; s < TS; ++s) {
        const int so = s * 64 + ks * 8;
        float4 t0 = *(const float4*)(sW + so), t1 = *(const float4*)(sW + so + 4);
        const float w[8] = {t0.x, t0.y, t0.z, t0.w, t1.x, t1.y, t1.z, t1.w};
        t0 = *(const float4*)(sKK + so); t1 = *(const float4*)(sKK + so + 4);
        const float kq[8] = {t0.x, t0.y, t0.z, t0.w, t1.x, t1.y, t1.z, t1.w};
        t0 = *(const float4*)(sB + so); t1 = *(const float4*)(sB + so + 4);
        const float bq[8] = {t0.x, t0.y, t0.z, t0.w, t1.x, t1.y, t1.z, t1.w};
        t0 = *(const float4*)(sKP + so); t1 = *(const float4*)(sKP + so + 4);
        const float kpq[8] = {t0.x, t0.y, t0.z, t0.w, t1.x, t1.y, t1.z, t1.w};
        const float2 vraw = *(const float2*)(sV + s * 64 + 2 * rp);
        const f2 vv = (f2){vraw.x, vraw.y};
        f2 sa = SP[0] * kq[0];
#pragma unroll
        for (int j = 1; j < 8; ++j) sa = SP[j] * kq[j] + sa;
        sa = (f2){red8(sa.x), red8(sa.y)};
#pragma unroll
        for (int j = 0; j < 8; ++j) SP[j] = SP[j] * w[j] + (vv * kpq[j] - sa * bq[j]);
        if (PASS == 1) {
          f2 pa = QP[0] * kq[0];
#pragma unroll
          for (int j = 1; j < 8; ++j) pa = QP[j] * kq[j] + pa;
          pa = (f2){red8(pa.x), red8(pa.y)};
#pragma unroll
          for (int j = 0; j < 8; ++j) QP[j] = QP[j] * w[j] - pa * bq[j];
        } else {
          t0 = *(const float4*)(sR + so); t1 = *(const float4*)(sR + so + 4);
          const float rq[8] = {t0.x, t0.y, t0.z, t0.w, t1.x, t1.y, t1.z, t1.w};
          f2 y = SP[0] * rq[0];
#pragma unroll
          for (int j = 1; j < 8; ++j) y = SP[j] * rq[j] + y;
          const float y0 = red8(y.x), y1 = red8(y.y);
          if (ks == 0) *(float2*)(sY + s * 64 + 2 * rp) = make_float2(y0, y1);
        }
      }
#pragma unroll
      for (int j = 0; j < 8; ++j) { S0[j] = SP[j].x; S1[j] = SP[j].y; Q0[j] = QP[j].x; Q1[j] = QP[j].y; }
      __syncthreads();
      if (PASS == 3) {
        const int so = ss * 64 + c8 * 8;
        float4 y0 = *(const float4*)(sY + so), y1 = *(const float4*)(sY + so + 4);
        float y[8] = {y0.x, y0.y, y0.z, y0.w, y1.x, y1.y, y1.z, y1.w};
        float sm = 0.f;
#pragma unroll
        for (int j = 0; j < 8; ++j) sm += y[j];
        const float mean = red8(sm) * (1.f / 64.f);
        float sv = 0.f;
#pragma unroll
        for (int j = 0; j < 8; ++j) { y[j] -= mean; sv += y[j] * y[j]; }
        const float var = red8(sv) * (1.f / 64.f);
        const float rs = rsqrtf(var + 64e-5f);
        float g[8], outv[8];
        unpack8(graw, g);
        float4 l0 = *(const float4*)(lng + chb), l1 = *(const float4*)(lng + chb + 4);
        float4 b0 = *(const float4*)(lnb + chb), b1 = *(const float4*)(lnb + chb + 4);
        float lg[8] = {l0.x, l0.y, l0.z, l0.w, l1.x, l1.y, l1.z, l1.w};
        float lb[8] = {b0.x, b0.y, b0.z, b0.w, b1.x, b1.y, b1.z, b1.w};
#pragma unroll
        for (int j = 0; j < 8; ++j) outv[j] = (y[j] * rs * lg[j] + lb[j] + bon * fv[j]) * g[j];
        if (!(c == 0 && sc == 0 && ss == 0)) *(uint4*)(yrw + o) = pack8(outv);
      }
    }
    if (PASS == 1) {
      float* pl = PL + (size_t)u * 8192;
      float* Pm = pl;
      float* Lm = pl + 4096;
      *(float4*)(Pm + (2 * rp) * 64 + ks * 8) = make_float4(Q0[0], Q0[1], Q0[2], Q0[3]);
      *(float4*)(Pm + (2 * rp) * 64 + ks * 8 + 4) = make_float4(Q0[4], Q0[5], Q0[6], Q0[7]);
      *(float4*)(Pm + (2 * rp + 1) * 64 + ks * 8) = make_float4(Q1[0], Q1[1], Q1[2], Q1[3]);
      *(float4*)(Pm + (2 * rp + 1) * 64 + ks * 8 + 4) = make_float4(Q1[4], Q1[5], Q1[6], Q1[7]);
      *(float4*)(Lm + (2 * rp) * 64 + ks * 8) = make_float4(S0[0], S0[1], S0[2], S0[3]);
      *(float4*)(Lm + (2 * rp) * 64 + ks * 8 + 4) = make_float4(S0[4], S0[5], S0[6], S0[7]);
      *(float4*)(Lm + (2 * rp + 1) * 64 + ks * 8) = make_float4(S1[0], S1[1], S1[2], S1[3]);
      *(float4*)(Lm + (2 * rp + 1) * 64 + ks * 8 + 4) = make_float4(S1[4], S1[5], S1[6], S1[7]);
    }
  }
}

DEV void phase_scanprop(const Params& p, float* smf, int bid, int nb) {
  const int tid = my_tid();
  const float* PL = (const float*)(p.ws + OFF_BIG + B_PL);
  float* SIN = (float*)(p.ws + OFF_BIG + B_SINIT);
  float* sS = smf;
  float* sP = smf + 4096;
  const int i = tid >> 3, k8 = tid & 7;
  for (int bh = bid; bh < 32; bh += nb) {
    float cur[8];
#pragma unroll
    for (int j = 0; j < 8; ++j) cur[j] = 0.f;
    const float* pl0 = PL + (size_t)(bh * 16) * 8192;
    float4 np0 = *(const float4*)(pl0 + tid * 8), np1 = *(const float4*)(pl0 + tid * 8 + 4);
    float4 nl0 = *(const float4*)(pl0 + 4096 + i * 64 + k8 * 8), nl1 = *(const float4*)(pl0 + 4096 + i * 64 + k8 * 8 + 4);
    for (int c = 0; c < 16; ++c) {
      const int u = bh * 16 + c;
      float* so = SIN + (size_t)u * 4096 + i * 64 + k8 * 8;
      *(float4*)so = make_float4(cur[0], cur[1], cur[2], cur[3]);
      *(float4*)(so + 4) = make_float4(cur[4], cur[5], cur[6], cur[7]);
      if (c == 15) break;
      *(float4*)(sS + i * 64 + k8 * 8) = make_float4(cur[0], cur[1], cur[2], cur[3]);
      *(float4*)(sS + i * 64 + k8 * 8 + 4) = make_float4(cur[4], cur[5], cur[6], cur[7]);
      *(float4*)(sP + tid * 8) = np0;
      *(float4*)(sP + tid * 8 + 4) = np1;
      float nw[8] = {nl0.x, nl0.y, nl0.z, nl0.w, nl1.x, nl1.y, nl1.z, nl1.w};
      __syncthreads();
      if (c + 1 < 15) {
        const float* pl = PL + (size_t)(u + 1) * 8192;
        np0 = *(const float4*)(pl + tid * 8); np1 = *(const float4*)(pl + tid * 8 + 4);
        nl0 = *(const float4*)(pl + 4096 + i * 64 + k8 * 8); nl1 = *(const float4*)(pl + 4096 + i * 64 + k8 * 8 + 4);
      }
#pragma unroll 8
      for (int j = 0; j < 64; ++j) {
        const float sij = sS[i * 64 + j];
        float4 p0 = *(const float4*)(sP + j * 64 + k8 * 8), p1 = *(const float4*)(sP + j * 64 + k8 * 8 + 4);
        nw[0] += sij * p0.x; nw[1] += sij * p0.y; nw[2] += sij * p0.z; nw[3] += sij * p0.w;
        nw[4] += sij * p1.x; nw[5] += sij * p1.y; nw[6] += sij * p1.z; nw[7] += sij * p1.w;
      }
#pragma unroll
      for (int j = 0; j < 8; ++j) cur[j] = nw[j];
      __syncthreads();
    }
  }
}

DEV float ret_log2gamma(int h) { return log2f(1.0f - exp2f(-5.0f - (float)h)); }

DEV void stage_rot(const u16* src, size_t ld, const float* rc, const float* rs, int pos0, u16* dst, float sc, float l2g, int rowmode) {
  const int tid = my_tid();
  const int row = tid >> 2, d0 = (tid & 3) * 8;
  float lo[8], hi[8], olo[8], ohi[8];
  unpack8(*(const uint4*)(src + (size_t)row * ld + d0), lo);
  unpack8(*(const uint4*)(src + (size_t)row * ld + d0 + 32), hi);
  const float* cp = rc + (size_t)(pos0 + row) * 32 + d0;
  const float* sp = rs + (size_t)(pos0 + row) * 32 + d0;
  float4 c0 = *(const float4*)cp, c1 = *(const float4*)(cp + 4);
  float4 s0 = *(const float4*)sp, s1 = *(const float4*)(sp + 4);
  float cc[8] = {c0.x, c0.y, c0.z, c0.w, c1.x, c1.y, c1.z, c1.w};
  float sn[8] = {s0.x, s0.y, s0.z, s0.w, s1.x, s1.y, s1.z, s1.w};
  float rsc = sc;
  if (rowmode == 1) rsc *= exp2f((float)(row + 1) * l2g);
  if (rowmode == 2) rsc *= exp2f((float)(127 - row) * l2g);
#pragma unroll
  for (int j = 0; j < 8; ++j) {
    olo[j] = (lo[j] * cc[j] - hi[j] * sn[j]) * rsc;
    ohi[j] = (hi[j] * cc[j] + lo[j] * sn[j]) * rsc;
  }
  *(uint4*)(dst + row * 72 + d0) = pack8(olo);
  *(uint4*)(dst + row * 72 + d0 + 32) = pack8(ohi);
}
DEV void stage_rot_T(const u16* src, size_t ld, const float* rc, const float* rs, int pos0, u16* dst, float sc, float l2g) {
  const int tid = my_tid();
  const int row = tid >> 2, d0 = (tid & 3) * 8;
  float lo[8], hi[8];
  unpack8(*(const uint4*)(src + (size_t)row * ld + d0), lo);
  unpack8(*(const uint4*)(src + (size_t)row * ld + d0 + 32), hi);
  const float* cp = rc + (size_t)(pos0 + row) * 32 + d0;
  const float* sp = rs + (size_t)(pos0 + row) * 32 + d0;
  float4 c0 = *(const float4*)cp, c1 = *(const float4*)(cp + 4);
  float4 s0 = *(const float4*)sp, s1 = *(const float4*)(sp + 4);
  float cc[8] = {c0.x, c0.y, c0.z, c0.w, c1.x, c1.y, c1.z, c1.w};
  float sn[8] = {s0.x, s0.y, s0.z, s0.w, s1.x, s1.y, s1.z, s1.w};
  const float rsc = sc * exp2f((float)(127 - row) * l2g);
#pragma unroll
  for (int j = 0; j < 8; ++j) {
    dst[(d0 + j) * 136 + row] = f2bf((lo[j] * cc[j] - hi[j] * sn[j]) * rsc);
    dst[(d0 + j + 32) * 136 + row] = f2bf((hi[j] * cc[j] + lo[j] * sn[j]) * rsc);
  }
}
DEV void stage_vT(const u16* src, size_t ld, u16* dst) {
  const int tid = my_tid();
  const int row = tid >> 2, d0 = (tid & 3) * 32;
#pragma unroll
  for (int c = 0; c < 4; ++c) {
    uint4 v = *(const uint4*)(src + (size_t)row * ld + d0 + c * 8);
    unsigned w[4] = {v.x, v.y, v.z, v.w};
#pragma unroll
    for (int j = 0; j < 4; ++j) {
      dst[(d0 + c * 8 + 2 * j) * 136 + row] = (u16)(w[j] & 0xffffu);
      dst[(d0 + c * 8 + 2 * j + 1) * 136 + row] = (u16)(w[j] >> 16);
    }
  }
}

DEV void ret_kv_unit(const Params& p, int u, u16* smem) {
  const int tid = my_tid(), lane = tid & 63, wave = tid >> 6;
  const u16* prs = (const u16*)(p.ws + OFF_BIG + B_PRS);
  float* KV = (float*)(p.ws + OFF_BIG + B_KV);
  const float* rc = (const float*)(p.ws + OFF_ROPE);
  const float* rs = rc + SEQ * 32;
  const int n = u & 63, h = (u >> 6) & 3, b = u >> 8;
  const size_t t0 = (size_t)b * SEQ + n * 128;
  const float l2g = ret_log2gamma(h);
  u16* KT = smem;
  u16* VT = smem + 64 * 136;
  stage_rot_T(prs + t0 * 2560 + 256 + h * 64, 2560, rc, rs, n * 128, KT, 0.125f, l2g);
  stage_vT(prs + t0 * 2560 + 512 + h * 128, 2560, VT);
  __syncthreads();
  const int mi = wave >> 1, nj = wave & 1;
  f32x16 acc;
#pragma unroll
  for (int e = 0; e < 16; ++e) acc[e] = 0.f;
#pragma unroll
  for (int ks = 0; ks < 8; ++ks) {
    bf16x8 a = *(const bf16x8*)(VT + (mi * 32 + (lane & 31)) * 136 + ks * 16 + (lane >> 5) * 8);
    bf16x8 bb = *(const bf16x8*)(KT + (nj * 32 + (lane & 31)) * 136 + ks * 16 + (lane >> 5) * 8);
    acc = __builtin_amdgcn_mfma_f32_32x32x16_bf16(a, bb, acc, 0, 0, 0);
  }
  float* kv = KV + (size_t)u * 8192;
#pragma unroll
  for (int e = 0; e < 16; ++e) {
    int dv = mi * 32 + (e & 3) + 8 * (e >> 2) + 4 * (lane >> 5);
    int dk = nj * 32 + (lane & 31);
    kv[dv * 64 + dk] = acc[e];
  }
  __syncthreads();
}

DEV void sgu_unit(const Params& p, int l, int u, u16* smem) {
  const int tid = my_tid(), lane = tid & 63, wave = tid >> 6, wm = wave >> 1, wn = wave & 1;
  const u16* prs = (const u16*)(p.ws + OFF_BIG + B_PRS);
  u16* ysg = (u16*)(p.ws + OFF_BIG + B_YSG);
  const u16* sgw = (const u16*)(p.ws + OFF_W + (size_t)l * LW_BYTES + W_SGW);
  const float* lng = p.in[14] + l * 512;
  const float* lnb = p.in[15] + l * 512;
  const float* sgb = p.in[17] + l * 512;
  const size_t t0 = (size_t)u * 128;
  u16* VT = smem;
  u16* WT = smem + 128 * 136;
  float* st = (float*)(smem + 2 * 128 * 136);
  const int tok = tid >> 2, q = tid & 3;
  const u16* vrow = prs + (t0 + tok) * 2560 + 1536 + 512;
  {
    float s = 0.f, s2 = 0.f;
#pragma unroll 4
    for (int c = 0; c < 16; ++c) {
      float f[8];
      unpack8(*(const uint4*)(vrow + q * 128 + c * 8), f);
#pragma unroll
      for (int j = 0; j < 8; ++j) { float gl = geluf_(f[j]); s += gl; s2 += gl * gl; }
    }
    s = red4(s); s2 = red4(s2);
    const float mean = s * (1.f / 512.f);
    const float var = fmaxf(s2 * (1.f / 512.f) - mean * mean, 0.f);
    if (q == 0) { st[tok] = mean; st[128 + tok] = rsqrtf(var + 1e-6f); }
  }
  __syncthreads();
  const float mean = st[tok], rstd = st[128 + tok];
  for (int g = 0; g < 4; ++g) {
#pragma unroll
    for (int c = 0; c < 4; ++c) {
      const int d = q * 32 + c * 8;
      float f[8];
      unpack8(*(const uint4*)(vrow + g * 128 + d), f);
      float4 g0 = *(const float4*)(lng + g * 128 + d), g1 = *(const float4*)(lng + g * 128 + d + 4);
      float4 b0 = *(const float4*)(lnb + g * 128 + d), b1 = *(const float4*)(lnb + g * 128 + d + 4);
      float gg[8] = {g0.x, g0.y, g0.z, g0.w, g1.x, g1.y, g1.z, g1.w};
      float bb[8] = {b0.x, b0.y, b0.z, b0.w, b1.x, b1.y, b1.z, b1.w};
#pragma unroll
      for (int j = 0; j < 8; ++j) VT[(d + j) * 136 + tok] = f2bf((geluf_(f[j]) - mean) * rstd * gg[j] + bb[j]);
      *(uint4*)(WT + tok * 136 + d) = *(const uint4*)(sgw + (size_t)g * 16384 + tok * 128 + d);
    }
    __syncthreads();
    f32x16 acc[2];
#pragma unroll
    for (int j = 0; j < 2; ++j)
#pragma unroll
      for (int e = 0; e < 16; ++e) acc[j][e] = 0.f;
#pragma unroll
    for (int ks = 0; ks < 8; ++ks) {
      bf16x8 a = *(const bf16x8*)(WT + (wm * 32 + (lane & 31)) * 136 + ks * 16 + (lane >> 5) * 8);
#pragma unroll
      for (int j = 0; j < 2; ++j) {
        bf16x8 bb = *(const bf16x8*)(VT + (wn * 64 + j * 32 + (lane & 31)) * 136 + ks * 16 + (lane >> 5) * 8);
        acc[j] = __builtin_amdgcn_mfma_f32_32x32x16_bf16(a, bb, acc[j], 0, 0, 0);
      }
    }
#pragma unroll
    for (int e = 0; e < 16; ++e) {
      const int i = ACC_ROW(1, 0, e);
      const float bias = sgb[g * 128 + i];
#pragma unroll
      for (int j = 0; j < 2; ++j) {
        const int d = ACC_COL(j);
        const float uu = geluf_(bf2f(prs[(t0 + i) * 2560 + 1536 + g * 128 + d]));
        ysg[(t0 + i) * 512 + g * 128 + d] = f2bf(uu * (acc[j][e] + bias));
      }
    }
    __syncthreads();
  }
}

DEV void phase_retprefix(const Params& p, int bid, int nb) {
  float* KV = (float*)(p.ws + OFF_BIG + B_KV);
  for (int gid = bid * NTHR + my_tid(); gid < 16 * 8192; gid += nb * NTHR) {
    const int bh = gid >> 13, e = gid & 8191;
    const int h = bh & 3;
    const float cd = exp2f(128.f * ret_log2gamma(h));
    float R = 0.f;
    float* ptr = KV + (size_t)bh * 64 * 8192 + e;
    for (int n = 0; n < 64; ++n) {
      float kv = ptr[(size_t)n * 8192];
      ptr[(size_t)n * 8192] = R;
      R = R * cd + kv;
    }
  }
}

DEV void ret_out_unit(const Params& p, int u, u16* smem) {
  const int tid = my_tid(), lane = tid & 63, wave = tid >> 6, wm = wave >> 1, wn = wave & 1;
  const u16* prs = (const u16*)(p.ws + OFF_BIG + B_PRS);
  const float* KV = (const float*)(p.ws + OFF_BIG + B_KV);
  u16* yret = (u16*)(p.ws + OFF_BIG + B_YRET);
  const float* rc = (const float*)(p.ws + OFF_ROPE);
  const float* rs = rc + SEQ * 32;
  const int n = u & 63, h = (u >> 6) & 3, b = u >> 8;
  const size_t t0 = (size_t)b * SEQ + n * 128;
  const float l2g = ret_log2gamma(h);
  u16* Q = smem;
  u16* Kr = Q + 128 * 72;
  u16* VT = Kr + 128 * 72;
  u16* Qd = VT + 128 * 136;
  u16* RT = Qd + 128 * 72;
  u16* SP = RT + 128 * 72;
  float* OT = (float*)smem;
  stage_rot(prs + t0 * 2560 + h * 64, 2560, rc, rs, n * 128, Q, 1.0f, l2g, 0);
  stage_rot(prs + t0 * 2560 + h * 64, 2560, rc, rs, n * 128, Qd, 1.0f, l2g, 1);
  stage_rot(prs + t0 * 2560 + 256 + h * 64, 2560, rc, rs, n * 128, Kr, 0.125f, l2g, 0);
  stage_vT(prs + t0 * 2560 + 512 + h * 128, 2560, VT);
  {
    const int dv = tid >> 2, q = tid & 3;
    const float* src = KV + (size_t)u * 8192 + dv * 64 + q * 16;
    float4 a0 = *(const float4*)src, a1 = *(const float4*)(src + 4), a2 = *(const float4*)(src + 8), a3 = *(const float4*)(src + 12);
    float f0[8] = {a0.x, a0.y, a0.z, a0.w, a1.x, a1.y, a1.z, a1.w};
    float f1[8] = {a2.x, a2.y, a2.z, a2.w, a3.x, a3.y, a3.z, a3.w};
    *(uint4*)(RT + dv * 72 + q * 16) = pack8(f0);
    *(uint4*)(RT + dv * 72 + q * 16 + 8) = pack8(f1);
  }
  __syncthreads();
  f32x16 acc[2];
#pragma unroll
  for (int j = 0; j < 2; ++j)
#pragma unroll
    for (int e = 0; e < 16; ++e) acc[j][e] = 0.f;
#pragma unroll
  for (int ks = 0; ks < 4; ++ks) {
    bf16x8 a = *(const bf16x8*)(Q + (wm * 32 + (lane & 31)) * 72 + ks * 16 + (lane >> 5) * 8);
#pragma unroll
    for (int j = 0; j < 2; ++j) {
      bf16x8 bb = *(const bf16x8*)(Kr + (wn * 64 + j * 32 + (lane & 31)) * 72 + ks * 16 + (lane >> 5) * 8);
      acc[j] = __builtin_amdgcn_mfma_f32_32x32x16_bf16(a, bb, acc[j], 0, 0, 0);
    }
  }
#pragma unroll
  for (int j = 0; j < 2; ++j)
#pragma unroll
    for (int e = 0; e < 16; ++e) {
      const int i = ACC_ROW(1, 0, e), jj = ACC_COL(j);
      const float dcy = (i >= jj) ? exp2f((float)(i - jj) * l2g) : 0.f;
      SP[i * 136 + jj] = f2bf(acc[j][e] * dcy);
    }
  __syncthreads();
#pragma unroll
  for (int j = 0; j < 2; ++j)
#pragma unroll
    for (int e = 0; e < 16; ++e) acc[j][e] = 0.f;
#pragma unroll
  for (int ks = 0; ks < 8; ++ks) {
    bf16x8 a = *(const bf16x8*)(SP + (wm * 32 + (lane & 31)) * 136 + ks * 16 + (lane >> 5) * 8);
#pragma unroll
    for (int j = 0; j < 2; ++j) {
      bf16x8 bb = *(const bf16x8*)(VT + (wn * 64 + j * 32 + (lane & 31)) * 136 + ks * 16 + (lane >> 5) * 8);
      acc[j] = __builtin_amdgcn_mfma_f32_32x32x16_bf16(a, bb, acc[j], 0, 0, 0);
    }
  }
#pragma unroll
  for (int ks = 0; ks < 4; ++ks) {
    bf16x8 a = *(const bf16x8*)(Qd + (wm * 32 + (lane & 31)) * 72 + ks * 16 + (lane >> 5) * 8);
#pragma unroll
    for (int j = 0; j < 2; ++j) {
      bf16x8 bb = *(const bf16x8*)(RT + (wn * 64 + j * 32 + (lane & 31)) * 72 + ks * 16 + (lane >> 5) * 8);
      acc[j] = __builtin_amdgcn_mfma_f32_32x32x16_bf16(a, bb, acc[j], 0, 0, 0);
    }
  }
  __syncthreads();
#pragma unroll
  for (int j = 0; j < 2; ++j)
#pragma unroll
    for (int e = 0; e < 16; ++e) OT[ACC_ROW(1, 0, e) * 132 + ACC_COL(j)] = acc[j][e];
  __syncthreads();
  {
    const int row = tid >> 2, q = tid & 3;
    float o[32];
    float ssq = 0.f;
#pragma unroll
    for (int c = 0; c < 8; ++c) {
      float4 v = *(const float4*)(OT + row * 132 + q * 32 + c * 4);
      o[c * 4] = v.x; o[c * 4 + 1] = v.y; o[c * 4 + 2] = v.z; o[c * 4 + 3] = v.w;
      ssq += v.x * v.x + v.y * v.y + v.z * v.z + v.w * v.w;
    }
    ssq = red4(ssq);
    const float r = rsqrtf(ssq * (1.f / 128.f) + 1e-6f);
    const u16* gp = prs + (t0 + row) * 2560 + 1024 + h * 128 + q * 32;
    u16* op = yret + (t0 + row) * 512 + h * 128 + q * 32;
#pragma unroll
    for (int c = 0; c < 4; ++c) {
      float g[8], ov[8];
      unpack8(*(const uint4*)(gp + c * 8), g);
#pragma unroll
      for (int j = 0; j < 8; ++j) ov[j] = o[c * 8 + j] * r * siluf_(g[j]);
      if (!(n == 0 && row == 0)) *(uint4*)(op + c * 8) = pack8(ov);
    }
  }
  __syncthreads();
}

DEV void phase_merge(const Params& p, int l, const float* rstd, u16* smem, int bid, int nb) {
  const int tid = my_tid(), lane = tid & 63, wave = tid >> 6, wm = wave >> 1, wn = wave & 1;
  const u16* xb = (const u16*)(p.ws + OFF_XB);
  unsigned char* W = p.ws + OFF_W + (size_t)l * LW_BYTES;
  const u16* win = (const u16*)(W + W_IN);
  const u16* wbr = (const u16*)(W + W_BR);
  u16* M = (u16*)(p.ws + OFF_BIG + B_M);
  const int MTL = NTOK / 128, NTL = DM / 128;
  for (int t = vbid(bid, nb); t < MTL * NTL; t += nb) {
    int m, n;
    tile_map(t, MTL, NTL, m, n);
    f32x16 ms[1][2];
#pragma unroll
    for (int j = 0; j < 2; ++j)
#pragma unroll
      for (int e = 0; e < 16; ++e) ms[0][j][e] = 0.f;
    for (int g = 0; g < 3; ++g) {
      const u16* yg = (const u16*)(p.ws + OFF_BIG + (g == 0 ? B_YRW : (g == 1 ? B_YRET : B_YSG)));
      f32x16 ab[1][2], ag[1][2];
#pragma unroll
      for (int j = 0; j < 2; ++j)
#pragma unroll
        for (int e = 0; e < 16; ++e) { ab[0][j][e] = 0.f; ag[0][j][e] = 0.f; }
      gemm_tile<1>(ab, yg, 512, m * 128, -(1 << 30), NTOK - 1, wbr + ((size_t)g * DM + n * 128) * 512, 512, 512, smem);
      gemm_tile<1>(ag, xb, DM, m * 128, -(1 << 30), NTOK - 1, win + ((size_t)(4352 + g * DM + n * 128)) * DM, DM, DM, smem);
#pragma unroll
      for (int e = 0; e < 16; ++e) {
        const float rs = rstd_of(rstd, m * 128 + ACC_ROW(1, 0, e));
#pragma unroll
        for (int j = 0; j < 2; ++j) ms[0][j][e] += sigmoidf_(ag[0][j][e] * rs) * ab[0][j][e];
        if ((e & 3) == 3) __builtin_amdgcn_sched_barrier(0);
      }
    }
#pragma unroll
    for (int e = 0; e < 16; ++e) {
      const size_t row = m * 128 + ACC_ROW(1, 0, e);
#pragma unroll
      for (int j = 0; j < 2; ++j) M[row * DM + n * 128 + ACC_COL(j)] = f2bf(ms[0][j][e]);
    }
  }
}

DEV void phase_resgemm(const u16* A, int K, const u16* wt, const float* xin, float* xout, u16* xbo, float* ssq, u16* smem, int bid, int nb) {
  const int tid = my_tid(), lane = tid & 63, wave = tid >> 6, wm = wave >> 1, wn = wave & 1;
  const int MTL = NTOK / 256, NTL = DM / 256;
  for (int t = vbid(bid, nb); t < MTL * NTL; t += nb) {
    int m, n;
    tile_map(t, MTL, NTL, m, n);
    f32x16 acc[2][4];
    ZERO_BIG(acc);
    gemm_big(acc, A, K, m * 256, -(1 << 30), NTOK - 1, wt + (size_t)n * 256 * K, K, K, smem);
    float* F = (float*)smem;
#pragma unroll
    for (int i = 0; i < 2; ++i) {
#pragma unroll
      for (int e = 0; e < 16; ++e) {
        const int lr = wm * 32 + (e & 3) + 8 * (e >> 2) + 4 * (lane >> 5);
#pragma unroll
        for (int j = 0; j < 4; ++j) F[lr * 260 + BIG_COL(j)] = acc[i][j][e];
      }
      __syncthreads();
#pragma unroll 4
      for (int k = 0; k < 16; ++k) {
        const int c = tid + NTHR * k;
        const int lr = c >> 6, cc = c & 63;
        const size_t row = (size_t)m * 256 + (lr >> 5) * 64 + i * 32 + (lr & 31);
        const size_t o = row * DM + n * 256 + cc * 4;
        const float4 v = *(const float4*)(F + lr * 260 + cc * 4);
        const float4 x = *(const float4*)(xin + o);
        const float4 y = make_float4(x.x + v.x, x.y + v.y, x.z + v.z, x.w + v.w);
        *(float4*)(xout + o) = y;
        if (xbo) {
          *(uint2*)(xbo + o) = make_uint2(pack2(y.x, y.y), pack2(y.z, y.w));
          const float sq = wave_sum(y.x * y.x + y.y * y.y + y.z * y.z + y.w * y.w);
          if (lane == 0) atomicAdd(ssq + row, sq);
        }
      }
      __syncthreads();
    }
  }
}

DEV void phase_ffnup(const Params& p, int l, const float* rstd, u16* smem, int bid, int nb) {
  const int tid = my_tid(), lane = tid & 63, wave = tid >> 6, wm = wave >> 1, wn = wave & 1;
  const u16* xb = (const u16*)(p.ws + OFF_XB);
  const u16* wup = (const u16*)(p.ws + OFF_W + (size_t)l * LW_BYTES + W_UP);
  u16* act = (u16*)(p.ws + OFF_BIG + B_ACT);
  const float* cw = p.in[22] + (size_t)l * 3 * 2 * DFF;
  const float* cb = p.in[23] + (size_t)l * 2 * DFF;
  u16* U = smem;
  const int MPB = 33;
  const int MTL = 4 * MPB, NTL = DFF / 128;
  for (int t = vbid(bid, nb); t < MTL * NTL; t += nb) {
    int m, n;
    tile_map(t, MTL, NTL, m, n);
    const int b = m / MPB, mi = m % MPB;
    const int tokbase = b * SEQ + mi * 254 - 2;
    f32x16 acc[2][4];
    ZERO_BIG(acc);
    gemm_big(acc, xb, DM, tokbase, b * SEQ, NTOK - 1, wup + (size_t)n * 256 * DM, DM, DM, smem);
#pragma unroll
    for (int i = 0; i < 2; ++i)
#pragma unroll
      for (int e = 0; e < 16; ++e) {
        const int r = BIG_ROW(i, e);
        int tk = tokbase + r; tk = tk < 0 ? 0 : (tk > NTOK - 1 ? NTOK - 1 : tk);
        const float rs = rstd_of(rstd, tk);
#pragma unroll
        for (int j = 0; j < 4; ++j) U[r * 264 + BIG_COL(j)] = f2bf(acc[i][j][e] * rs);
      }
    __syncthreads();
    {
      const int c = (tid & 63) * 2, rg = tid >> 6;
      const int gcol = n * 128 + c, vcol = DFF + n * 128 + c;
      float wg0[2], wg1[2], wg2[2], bg[2], wv0[2], wv1[2], wv2[2], bv[2];
#pragma unroll
      for (int q = 0; q < 2; ++q) {
        wg0[q] = cw[gcol + q]; wg1[q] = cw[2 * DFF + gcol + q]; wg2[q] = cw[4 * DFF + gcol + q]; bg[q] = cb[gcol + q];
        wv0[q] = cw[vcol + q]; wv1[q] = cw[2 * DFF + vcol + q]; wv2[q] = cw[4 * DFF + vcol + q]; bv[q] = cb[vcol + q];
      }
      const int r0 = 2 + rg * 32;
      const int rend = (r0 + 32 > 256) ? 256 : r0 + 32;
      unsigned t;
      float g2[2], g1[2], v2[2], v1[2];
      t = *(const unsigned*)(U + (r0 - 2) * 264 + c); g2[0] = __uint_as_float(t << 16); g2[1] = __uint_as_float(t & 0xffff0000u);
      t = *(const unsigned*)(U + (r0 - 1) * 264 + c); g1[0] = __uint_as_float(t << 16); g1[1] = __uint_as_float(t & 0xffff0000u);
      t = *(const unsigned*)(U + (r0 - 2) * 264 + 128 + c); v2[0] = __uint_as_float(t << 16); v2[1] = __uint_as_float(t & 0xffff0000u);
      t = *(const unsigned*)(U + (r0 - 1) * 264 + 128 + c); v1[0] = __uint_as_float(t << 16); v1[1] = __uint_as_float(t & 0xffff0000u);
      const int tend = (b + 1) * SEQ;
      for (int r = r0; r < rend; ++r) {
        const unsigned ug = *(const unsigned*)(U + r * 264 + c), uv = *(const unsigned*)(U + r * 264 + 128 + c);
        const float g0[2] = {__uint_as_float(ug << 16), __uint_as_float(ug & 0xffff0000u)};
        const float v0[2] = {__uint_as_float(uv << 16), __uint_as_float(uv & 0xffff0000u)};
        float o[2];
#pragma unroll
        for (int q = 0; q < 2; ++q) {
          const float cg = bg[q] + wg0[q] * g2[q] + wg1[q] * g1[q] + wg2[q] * g0[q];
          const float cv = bv[q] + wv0[q] * v2[q] + wv1[q] * v1[q] + wv2[q] * v0[q];
          o[q] = siluf_(cg) * cv;
          g2[q] = g1[q]; g1[q] = g0[q]; v2[q] = v1[q]; v1[q] = v0[q];
        }
        const int tk = tokbase + r;
        if (tk < tend) *(unsigned*)(act + (size_t)tk * DFF + n * 128 + c) = pack2(o[0], o[1]);
      }
    }
    __syncthreads();
  }
}

#define PF_COLS 3328
DEV void first_tok_proj(const Params& p, int l, const float* xcur, float* smf, int bid, int nb) {
  float* PF = (float*)(p.ws + OFF_PF);
  const float* w = p.in[2] + (size_t)l * DM * INC;
  const float* g1 = p.in[1] + l * DM;
  const int tid = my_tid(), lane = tid & 63, wave = tid >> 6;
  for (int task = bid; task < 4 * 52; task += nb) {
    const int b = task / 52, c = (task % 52) * 64 + lane;
    const float* xr = xcur + (size_t)b * SEQ * DM;
    float acc = 0.f, ss = 0.f;
    const int k0 = wave * 128;
#pragma unroll 16
    for (int k = k0; k < k0 + 128; ++k) {
      const float xv = xr[k];
      ss += xv * xv;
      acc += xv * g1[k] * w[(size_t)k * INC + c];
    }
    smf[wave * 64 + lane] = acc;
    smf[512 + wave * 64 + lane] = ss;
    __syncthreads();
    if (wave == 0) {
      float ta = 0.f, ts = 0.f;
#pragma unroll
      for (int q = 0; q < 8; ++q) { ta += smf[q * 64 + lane]; ts += smf[512 + q * 64 + lane]; }
      PF[b * PF_COLS + c] = ta * rsqrtf(ts * (1.0f / DM) + 1e-6f);
    }
    __syncthreads();
  }
}
DEV void first_tok_fix(const Params& p, int l, float* smf, int bid, int nb) {
  const int tid = my_tid(), lane = tid & 63;
  const float* PF = (const float*)(p.ws + OFF_PF);
  u16* yrw = (u16*)(p.ws + OFF_BIG + B_YRW);
  u16* yret = (u16*)(p.ws + OFF_BIG + B_YRET);
  const float* mu = p.in[3] + l * 1792;
  for (int task = bid; task < 48; task += nb) {
    const int b = task / 12, hh = task % 12;
    const float* pf = PF + b * PF_COLS;
    const size_t t0 = (size_t)b * SEQ;
    __syncthreads();
    if (hh < 8) {
      const int h = hh;
      if (tid < 64) smf[tid] = pf[1600 + tid] * (1.f - mu[1600 + tid]);
      if (tid < 128) smf[64 + tid] = sigmoidf_(pf[1664 + tid] * (1.f - mu[1664 + tid]));
      __syncthreads();
      if (tid < 64) {
        const int ch = h * 64 + tid;
        const float r = pf[ch] * (1.f - mu[ch]);
        const float k = pf[512 + ch] * (1.f - mu[512 + ch]);
        const float v = pf[1024 + ch] * (1.f - mu[1024 + ch]);
        const float* aup = p.in[7] + (size_t)l * 64 * 512;
        const float* gup = p.in[8] + (size_t)l * 128 * 512;
        float al = p.in[6][l * 512 + ch], g = 0.f;
        for (int j = 0; j < 64; ++j) al += smf[j] * aup[j * 512 + ch];
        for (int j = 0; j < 128; ++j) g += smf[64 + j] * gup[j * 512 + ch];
        const float a = sigmoidf_(al);
        const float kp = k * (1.f + (a - 1.f) * p.in[10][l * 512 + ch]);
        const float s = wave_sum(kp * r);
        const float bon = wave_sum(r * kp * p.in[11][l * 512 + ch]);
        const float y = v * s;
        const float mean = wave_sum(y) * (1.f / 64.f);
        const float d = y - mean;
        const float var = wave_sum(d * d) * (1.f / 64.f);
        const float o = (d * rsqrtf(var + 64e-5f) * p.in[12][l * 512 + ch] + p.in[13][l * 512 + ch] + bon * v) * g;
        yrw[t0 * 512 + ch] = f2bf(o);
      }
    } else {
      const int h = hh - 8;
      float part = 0.f;
      if (tid < 64) part = pf[1792 + h * 64 + tid] * pf[1792 + 256 + h * 64 + tid];
      if (tid < 64) { part = wave_sum(part); if (lane == 0) smf[0] = part * 0.125f; }
      __syncthreads();
      const float s = smf[0];
      float y = 0.f;
      if (tid < 128) y = s * pf[1792 + 512 + h * 128 + tid];
      float q = wave_sum(y * y);
      if (tid < 128 && lane == 0) smf[1 + (tid >> 6)] = q;
      __syncthreads();
      if (tid < 128) {
        const float ms = (smf[1] + smf[2]) * (1.f / 128.f);
        const float g = pf[1792 + 1024 + h * 128 + tid];
        yret[t0 * 512 + h * 128 + tid] = f2bf(y * rsqrtf(ms + 1e-6f) * siluf_(g));
      }
    }
  }
}

namespace pg8 {
#define PG8_LAS __attribute__((address_space(3)))
typedef unsigned short bf16_t;
typedef short bf16x8 __attribute__((ext_vector_type(8)));
typedef float f32x4 __attribute__((ext_vector_type(4)));
typedef unsigned u32x4 __attribute__((ext_vector_type(4)));
constexpr int BM = 256, BK = 64, HALF = 128, HTB = HALF * BK * 2  , STAGE_BYTES = 8 * HTB, NXCD = 8, WGM = 8;

__host__ __device__ __forceinline__ int lds_byte(int r, int c) { const int st = (r >> 4) * 2 + (c >> 5), rr = r & 15, cc = c & 31, ob = rr * 64 + cc * 2; return st * 1024 + (ob ^ (((ob >> 9) & 1) << 5)); }
__host__ __device__ __forceinline__ void stage_rc(int b, int& R, int& C) { const int st = b / 1024, sb = b % 1024, swz = sb ^ (((sb >> 9) & 1) << 5); R = (st >> 1) * 16 + swz / 64; C = (st & 1) * 32 + (swz % 64) / 2; }
__host__ __device__ __forceinline__ int perm32(int rho) { const int n = rho >> 4, i = rho & 15; return 8 * (i >> 2) + 4 * n + (i & 3); }

struct Unit { int pm, pn, arow, slot; };
struct Gemm { const bf16_t* A; const bf16_t* Bt; int M, N, K; };

struct StaticOrder {
    int nM, nN, nwg, G, c;
    __host__ __device__ void init(int M, int N, int G_, int c_) { nM = M / BM; nN = N / BM; nwg = nM * nN; G = G_; c = c_; }
    __host__ __device__ bool next(int i, Unit& u) const {
        const long L = (long)i * G + c; if (L >= nwg) return false;
        int wgid = (int)L; { const int q = nwg / NXCD, r = nwg % NXCD, xcd = wgid % NXCD, off = wgid / NXCD; wgid = (xcd < r ? xcd * (q + 1) : r * (q + 1) + (xcd - r) * q) + off; }
        const int nig = WGM * nN, gid = wgid / nig, fm = gid * WGM, gsz = (nM - fm) < WGM ? (nM - fm) : WGM;
        u.pm = fm + ((wgid % nig) % gsz); u.pn = (wgid % nig) / gsz; u.arow = u.pm * BM; u.slot = i & 1; return true;
    }
    __device__ __forceinline__ void a_ready(const Unit&) const {}
    __device__ __forceinline__ void done(const Unit&) const {}
};

__device__ __forceinline__ unsigned cvt_pk_bf16(float lo, float hi) { unsigned r; asm volatile("v_cvt_pk_bf16_f32 %0, %1, %2" : "=v"(r) : "v"(lo), "v"(hi)); return r; }

template <class Epi, class Sched, bool STAMP = false>
__device__ __forceinline__ void gemm_phase(PG8_LAS unsigned char* lds, const Gemm g, const Sched& S, const Epi& E, unsigned long long* stamps) {
    const int tid = my_tid(), wid = __builtin_amdgcn_readfirstlane(tid >> 6), lane = tid & 63, wr = wid >> 2, wc = wid & 3, fr = lane & 15, fq = lane >> 4;
    const int K = g.K, nt = K / BK;
    int ts_lo = 0, ts_hi = 0, nts = 0; const unsigned long long rt_entry = STAMP ? (unsigned long long)wall_clock64() : 0ull;
#define PG8_STAMP() do { if (STAMP && wid == 0 && nts < 64) { const unsigned long long _c = (unsigned long long)clock64(); \
        ts_lo = (lane == nts) ? (int)(unsigned)_c : ts_lo; ts_hi = (lane == nts) ? (int)(unsigned)(_c >> 32) : ts_hi; ++nts; } } while (0)
    PG8_STAMP();
    unsigned voffA[2], voffB[2];
#pragma unroll
    for (int i = 0; i < 2; ++i) { int R, C; stage_rc(tid * 16 + i * 8192, R, C); const int Rb = Epi::PERM ? ((R & ~31) + perm32(R & 31)) : R;
        voffA[i] = (unsigned)(R * K + C) * 2u; voffB[i] = (unsigned)(Rb * K + C) * 2u; }
    const size_t kstep = (size_t)(BK * 2);
    const size_t hstep = (size_t)HALF * K * 2;
    const size_t tstep = 2 * hstep;
    const unsigned ldsw = (unsigned)wid * 1024u;
    const int aoff = lds_byte(wr * 64 + fr, fq * 8), boff = lds_byte(wc * 32 + fr, fq * 8);
#define PG8_SA(b, h) (((b) * 2 + (h)) * HTB)
#define PG8_SB(b, h) ((4 + (b) * 2 + (h)) * HTB)
#define PG8_STAGE(bufoff, gbase, voff) do { _Pragma("unroll") for (int _i = 0; _i < 2; ++_i) \
        __builtin_amdgcn_global_load_lds((const unsigned*)((const char*)(gbase) + (voff)[_i]), (PG8_LAS unsigned*)(lds + (bufoff) + ldsw + _i * 8192), 16, 0, 0); } while (0)
#define PG8_LDA(dst, b, h) do { _Pragma("unroll") for (int m = 0; m < 4; ++m) _Pragma("unroll") for (int k = 0; k < 2; ++k) dst[m][k] = *(const PG8_LAS bf16x8*)(lds + PG8_SA(b, h) + aoff + m * 2048 + k * 1024); } while (0)
#define PG8_LDB(dst, b, h) do { _Pragma("unroll") for (int n = 0; n < 2; ++n) _Pragma("unroll") for (int k = 0; k < 2; ++k) dst[n][k] = *(const PG8_LAS bf16x8*)(lds + PG8_SB(b, h) + boff + n * 2048 + k * 1024); } while (0)
#define PG8_MMA(ai, bj, At, Bt) do { __builtin_amdgcn_s_setprio(1); _Pragma("unroll") for (int m = 0; m < 4; ++m) _Pragma("unroll") for (int n = 0; n < 2; ++n) _Pragma("unroll") for (int k = 0; k < 2; ++k) \
        acc[ai][bj][m][n] = __builtin_amdgcn_mfma_f32_16x16x32_bf16(Bt[n][k], At[m][k], acc[ai][bj][m][n], 0, 0, 0); __builtin_amdgcn_s_setprio(0); } while (0)
#define PG8_WAIT_V(n) asm volatile("s_waitcnt vmcnt(" #n ")" ::: "memory")
#define PG8_WAIT_L(n) asm volatile("s_waitcnt lgkmcnt(" #n ")" ::: "memory")
#define PG8_BAR __builtin_amdgcn_s_barrier()
#define PG8_SCHED __builtin_amdgcn_sched_barrier(0)
    Unit cur, nxt; int ui = 0;
    if (!S.next(0, cur)) return;
    f32x4 acc[2][2][4][2];
#pragma unroll
    for (int a = 0; a < 2; ++a)
#pragma unroll
        for (int b = 0; b < 2; ++b)
#pragma unroll
            for (int m = 0; m < 4; ++m)
#pragma unroll
                for (int n = 0; n < 2; ++n) acc[a][b][m][n] = (f32x4){0.f, 0.f, 0.f, 0.f};
    bf16x8 At[4][2], B0[2][2], B1[2][2];
    const char* cA = (const char*)g.A + (long)cur.arow * (long)(K * 2); const char* cB = (const char*)g.Bt + (size_t)cur.pn * tstep;
    S.a_ready(cur);
    PG8_STAGE(PG8_SB(0, 0), cB, voffB); PG8_STAGE(PG8_SA(0, 0), cA, voffA); PG8_STAGE(PG8_SB(0, 1), cB + hstep, voffB); PG8_STAGE(PG8_SA(0, 1), cA + hstep, voffA);
    if (wr == 1) PG8_BAR;
    PG8_WAIT_V(4); PG8_BAR;
    PG8_STAGE(PG8_SB(1, 0), cB + kstep, voffB); PG8_STAGE(PG8_SA(1, 0), cA + kstep, voffA); PG8_STAGE(PG8_SB(1, 1), cB + hstep + kstep, voffB);
    PG8_WAIT_V(6); PG8_BAR;
    PG8_STAMP();
    for (;;) {
        const bool has_next = S.next(ui + 1, nxt);
        const char* nA = has_next ? (const char*)g.A + (long)nxt.arow * (long)(K * 2) : cA; const char* nB = has_next ? (const char*)g.Bt + (size_t)nxt.pn * tstep : cB;
        for (int t = 0; t < nt; t += 2) {
            const bool last = (t == nt - 2);
            const char* a1 = cA + (size_t)(t + 1) * kstep;
            const char* a2 = last ? nA : cA + (size_t)(t + 2) * kstep; const char* b2 = last ? nB : cB + (size_t)(t + 2) * kstep;
            const char* a3 = a2 + kstep; const char* b3 = b2 + kstep;
            if (last && has_next) S.a_ready(nxt);
            PG8_LDB(B0, 0, 0); PG8_SCHED; PG8_LDA(At, 0, 0); PG8_STAGE(PG8_SA(1, 1), a1 + hstep, voffA);
            PG8_WAIT_L(8); PG8_BAR; PG8_WAIT_L(0); PG8_MMA(0, 0, At, B0); PG8_BAR; PG8_SCHED;
            PG8_LDB(B1, 0, 1); PG8_STAGE(PG8_SB(0, 0), b2, voffB);
            PG8_BAR; PG8_WAIT_L(0); PG8_MMA(0, 1, At, B1); PG8_BAR;
            PG8_LDA(At, 0, 1); PG8_STAGE(PG8_SA(0, 0), a2, voffA);
            PG8_BAR; PG8_WAIT_L(0); PG8_MMA(1, 0, At, B0); PG8_BAR; PG8_SCHED;
            PG8_STAGE(PG8_SB(0, 1), b2 + hstep, voffB);
            PG8_WAIT_V(6); PG8_BAR; PG8_MMA(1, 1, At, B1); PG8_BAR;
            PG8_LDB(B0, 1, 0); PG8_SCHED; PG8_LDA(At, 1, 0); PG8_STAGE(PG8_SA(0, 1), a2 + hstep, voffA);
            PG8_WAIT_L(8); PG8_BAR; PG8_WAIT_L(0); PG8_MMA(0, 0, At, B0); PG8_BAR; PG8_SCHED;
            PG8_LDB(B1, 1, 1); PG8_STAGE(PG8_SB(1, 0), b3, voffB);
            PG8_BAR; PG8_WAIT_L(0); PG8_MMA(0, 1, At, B1); PG8_BAR;
            PG8_LDA(At, 1, 1); PG8_STAGE(PG8_SA(1, 0), a3, voffA);
            PG8_BAR; PG8_WAIT_L(0); PG8_MMA(1, 0, At, B0); PG8_BAR; PG8_SCHED;
            PG8_STAGE(PG8_SB(1, 1), b3 + hstep, voffB);
            PG8_WAIT_V(6); PG8_BAR; PG8_MMA(1, 1, At, B1); PG8_BAR;
        }
        PG8_STAMP();
        if constexpr (!Epi::AFTER_DRAIN) { E(acc, cur, wr, wc, fr, fq); S.done(cur); }
        PG8_STAMP();
        if (!has_next) break;
#pragma unroll
        for (int a = 0; a < 2; ++a)
#pragma unroll
            for (int b = 0; b < 2; ++b)
#pragma unroll
                for (int m = 0; m < 4; ++m)
#pragma unroll
                    for (int n = 0; n < 2; ++n) acc[a][b][m][n] = (f32x4){0.f, 0.f, 0.f, 0.f};
        cur = nxt; cA = nA; cB = nB; ++ui;
    }
    PG8_WAIT_V(0);
    if (wr == 0) PG8_BAR;
    PG8_BAR;
    if constexpr (Epi::AFTER_DRAIN) { E.fused(acc, cur, wr, wc, fr, fq, lds, wid, lane); S.done(cur); }
    PG8_STAMP();
    if (STAMP && wid == 0) { stamps[lane] = lane < nts ? (((unsigned long long)(unsigned)ts_hi << 32) | (unsigned)ts_lo) : 0ull;
        if (lane == 62) stamps[62] = rt_entry; if (lane == 63) stamps[63] = (unsigned long long)wall_clock64(); }
#undef PG8_STAMP
#undef PG8_SA
#undef PG8_SB
#undef PG8_STAGE
#undef PG8_LDA
#undef PG8_LDB
#undef PG8_MMA
#undef PG8_WAIT_V
#undef PG8_WAIT_L
#undef PG8_BAR
#undef PG8_SCHED
}
}

struct EpiInproj {
  static constexpr bool PERM = true, AFTER_DRAIN = false;
  u16* O; int ldc; const float* ssq;
  __device__ __forceinline__ void operator()(const pg8::f32x4 (&acc)[2][2][4][2], const pg8::Unit& u, int wr, int wc, int fr, int fq) const {
    const int row0 = u.pm * 256 + wr * 64 + fr, col0 = u.pn * 256 + wc * 32 + 8 * fq;
#pragma unroll
    for (int ai = 0; ai < 2; ++ai)
#pragma unroll
      for (int m = 0; m < 4; ++m) {
        const int row = row0 + ai * 128 + m * 16;
        const float rs = ssq ? rsqrtf(ssq[row] * (1.0f / DM) + 1e-6f) : 1.0f;
        u16* rowp = O + (size_t)row * ldc + col0;
#pragma unroll
        for (int bj = 0; bj < 2; ++bj) {
          const pg8::f32x4 v0 = acc[ai][bj][m][0] * rs, v1 = acc[ai][bj][m][1] * rs;
          u32x4 w;
          w.x = pack2(v0[0], v0[1]); w.y = pack2(v0[2], v0[3]); w.z = pack2(v1[0], v1[1]); w.w = pack2(v1[2], v1[3]);
          *(u32x4*)(rowp + bj * 128) = w;
        }
      }
  }
};
struct EpiRes {
  static constexpr bool PERM = false, AFTER_DRAIN = false;
  const float* xin; float* xout; u16* xbo; float* ssq;
  __device__ __forceinline__ void operator()(const pg8::f32x4 (&acc)[2][2][4][2], const pg8::Unit& u, int wr, int wc, int fr, int fq) const {
    const int row0 = u.pm * 256 + wr * 64 + fr, col0 = u.pn * 256 + wc * 32 + 4 * fq;
#pragma unroll
    for (int ai = 0; ai < 2; ++ai)
#pragma unroll
      for (int m = 0; m < 4; ++m) {
        const int row = row0 + ai * 128 + m * 16;
        float sq = 0.f;
#pragma unroll
        for (int bj = 0; bj < 2; ++bj)
#pragma unroll
          for (int n = 0; n < 2; ++n) {
            const size_t o = (size_t)row * DM + col0 + bj * 128 + n * 16;
            const pg8::f32x4 y = *(const pg8::f32x4*)(xin + o) + acc[ai][bj][m][n];
            *(pg8::f32x4*)(xout + o) = y;
            if (xbo) {
              *(uint2*)(xbo + o) = make_uint2(pack2(y[0], y[1]), pack2(y[2], y[3]));
              sq += y[0] * y[0] + y[1] * y[1] + y[2] * y[2] + y[3] * y[3];
            }
          }
        if (xbo) {
          sq += __shfl_xor(sq, 16);
          sq += __shfl_xor(sq, 32);
          if (fq == 0) atomicAdd(ssq + row, sq);
        }
        __builtin_amdgcn_sched_barrier(0);
      }
  }
};
struct TriOrder : pg8::StaticOrder {
  int a_rows_per_g;
  __device__ bool next(int i, pg8::Unit& u) const {
    const int g = i % 3;
    if (!pg8::StaticOrder::next(i / 3, u)) return false;
    u.arow = g * a_rows_per_g + u.pm * 256;
    u.pn += 4 * g;
    u.slot = i & 1;
    return true;
  }
};
struct EpiP {
  static constexpr bool PERM = true, AFTER_DRAIN = false;
  u16* O;
  __device__ __forceinline__ void operator()(const pg8::f32x4 (&acc)[2][2][4][2], const pg8::Unit& u, int wr, int wc, int fr, int fq) const {
    const int g = u.pn >> 2, ct = u.pn & 3;
    const int row0 = u.pm * 256 + wr * 64 + fr, col0 = ct * 256 + wc * 32 + 8 * fq;
    u16* base = O + (size_t)g * NTOK * DM;
#pragma unroll
    for (int ai = 0; ai < 2; ++ai)
#pragma unroll
      for (int m = 0; m < 4; ++m) {
        u16* rowp = base + (size_t)(row0 + ai * 128 + m * 16) * DM + col0;
#pragma unroll
        for (int bj = 0; bj < 2; ++bj) {
          const pg8::f32x4 v0 = acc[ai][bj][m][0], v1 = acc[ai][bj][m][1];
          u32x4 w;
          w.x = pack2(v0[0], v0[1]); w.y = pack2(v0[2], v0[3]); w.z = pack2(v1[0], v1[1]); w.w = pack2(v1[2], v1[3]);
          *(u32x4*)(rowp + bj * 128) = w;
        }
      }
  }
};
struct EpiGate {
  static constexpr bool PERM = true, AFTER_DRAIN = false;
  u16* Mo; const u16* Pall; const float* ssq;
  __device__ __forceinline__ void operator()(const pg8::f32x4 (&acc)[2][2][4][2], const pg8::Unit& u, int wr, int wc, int fr, int fq) const {
    const int g = u.pn >> 2, first = (g == 0);
    const u16* P = Pall + (size_t)g * NTOK * DM;
    const int row0 = u.pm * 256 + wr * 64 + fr, col0 = (u.pn & 3) * 256 + wc * 32 + 8 * fq;
#pragma unroll
    for (int ai = 0; ai < 2; ++ai)
#pragma unroll
      for (int m = 0; m < 4; ++m) {
        const int row = row0 + ai * 128 + m * 16;
        const float rs = rsqrtf(ssq[row] * (1.0f / DM) + 1e-6f);
#pragma unroll
        for (int bj = 0; bj < 2; ++bj) {
          const size_t o = (size_t)row * DM + col0 + bj * 128;
          float pv[8], mv[8];
          unpack8(*(const uint4*)(P + o), pv);
          if (!first) unpack8(*(const uint4*)(Mo + o), mv);
          else {
#pragma unroll
            for (int j = 0; j < 8; ++j) mv[j] = 0.f;
          }
#pragma unroll
          for (int j = 0; j < 4; ++j) {
            mv[j] += sigmoidf_(acc[ai][bj][m][0][j] * rs) * pv[j];
            mv[4 + j] += sigmoidf_(acc[ai][bj][m][1][j] * rs) * pv[4 + j];
          }
          *(uint4*)(Mo + o) = pack8(mv);
        }
        __builtin_amdgcn_sched_barrier(0);
      }
  }
};
struct FfnOrder : pg8::StaticOrder {
  __device__ bool next(int i, pg8::Unit& u) const {
    if (!pg8::StaticOrder::next(i, u)) return false;
    const int b = u.pm / 33, mi = u.pm % 33;
    u.arow = b * SEQ + mi * 254 - 2;
    return true;
  }
};
struct EpiFfn {
  static constexpr bool PERM = true, AFTER_DRAIN = false;
  const Params* pp; int l; int bid;
  __device__ __forceinline__ void operator()(const pg8::f32x4 (&acc)[2][2][4][2], const pg8::Unit& u, int wr, int wc, int fr, int fq) const {
    const int b = u.pm / 33, mi = u.pm % 33;
    const int tokbase = b * SEQ + mi * 254 - 2, tbeg = b * SEQ, tend = (b + 1) * SEQ;
    asm volatile("" : "+v"(fr), "+v"(fq));
    u16* act = (u16*)(pp->ws + OFF_BIG + B_ACT);
    const float* ssq = (const float*)(pp->ws + OFF_RSTD) + (size_t)(2 * l + 1) * NTOK;
    const float* cw = pp->in[22] + (size_t)l * 3 * 2 * DFF;
    const float* cb = pp->in[23] + (size_t)l * 2 * DFF;
    u16* S = (u16*)(pp->ws + OFF_BIG + 192 * MiB) + (size_t)bid * 131072 + (size_t)u.slot * 65536;
#pragma unroll
    for (int ai = 0; ai < 2; ++ai)
#pragma unroll
      for (int m = 0; m < 4; ++m) {
        const int r = ai * 128 + wr * 64 + m * 16 + fr;
        int tk = tokbase + r; tk = tk < 0 ? 0 : (tk > NTOK - 1 ? NTOK - 1 : tk);
        const float rs = rsqrtf(ssq[tk] * (1.0f / DM) + 1e-6f);
#pragma unroll
        for (int bj = 0; bj < 2; ++bj) {
          const pg8::f32x4 v0 = acc[ai][bj][m][0] * rs, v1 = acc[ai][bj][m][1] * rs;
          u32x4 w;
          w.x = pack2(v0[0], v0[1]); w.y = pack2(v0[2], v0[3]); w.z = pack2(v1[0], v1[1]); w.w = pack2(v1[2], v1[3]);
          *(u32x4*)(S + r * 256 + bj * 128 + wc * 32 + 8 * fq) = w;
        }
      }
    asm volatile("s_waitcnt vmcnt(0)" ::: "memory");
    __builtin_amdgcn_s_barrier();
    __builtin_amdgcn_s_barrier();
    asm volatile("" ::: "memory");
    const int tid = my_tid(), cc = tid & 31, rg = tid >> 5;
    const int gcol = u.pn * 128 + cc * 4, vcol = DFF + gcol;
    float wg[3][4], wv[3][4], bg[4], bv[4];
#pragma unroll
    for (int q = 0; q < 3; ++q) {
      const float4 a0 = *(const float4*)(cw + q * 2 * DFF + gcol);
      const float4 c0 = *(const float4*)(cw + q * 2 * DFF + vcol);
      wg[q][0] = a0.x; wg[q][1] = a0.y; wg[q][2] = a0.z; wg[q][3] = a0.w;
      wv[q][0] = c0.x; wv[q][1] = c0.y; wv[q][2] = c0.z; wv[q][3] = c0.w;
    }
    {
      const float4 a0 = *(const float4*)(cb + gcol);
      const float4 c0 = *(const float4*)(cb + vcol);
      bg[0] = a0.x; bg[1] = a0.y; bg[2] = a0.z; bg[3] = a0.w;
      bv[0] = c0.x; bv[1] = c0.y; bv[2] = c0.z; bv[3] = c0.w;
    }
    uint2 rgt[18], rvl[18];
#pragma unroll
    for (int q = 0; q < 18; ++q) {
      int r = rg * 16 + q - 2; r = r < 0 ? 0 : r;
      rgt[q] = *(const uint2*)(S + r * 256 + cc * 4);
      rvl[q] = *(const uint2*)(S + r * 256 + 128 + cc * 4);
    }
    float g2[4], g1[4], v2[4], v1[4];
#define UNP4(src_, dst_) { dst_[0] = __uint_as_float(src_.x << 16); dst_[1] = __uint_as_float(src_.x & 0xffff0000u); dst_[2] = __uint_as_float(src_.y << 16); dst_[3] = __uint_as_float(src_.y & 0xffff0000u); }
    {
      const bool z0 = (tokbase + rg * 16 - 2) < tbeg, z1 = (tokbase + rg * 16 - 1) < tbeg;
      UNP4(rgt[0], g2); UNP4(rvl[0], v2); UNP4(rgt[1], g1); UNP4(rvl[1], v1);
#pragma unroll
      for (int j = 0; j < 4; ++j) { if (z0) { g2[j] = 0.f; v2[j] = 0.f; } if (z1) { g1[j] = 0.f; v1[j] = 0.f; } }
    }
#pragma unroll
    for (int q = 2; q < 18; ++q) {
      const int r = rg * 16 + q - 2;
      const int tk = tokbase + r;
      float g0[4], v0[4], o[4];
      UNP4(rgt[q], g0); UNP4(rvl[q], v0);
      if (tk < tbeg) {
#pragma unroll
        for (int j = 0; j < 4; ++j) { g0[j] = 0.f; v0[j] = 0.f; }
      }
#pragma unroll
      for (int j = 0; j < 4; ++j) {
        const float cg = bg[j] + wg[0][j] * g2[j] + wg[1][j] * g1[j] + wg[2][j] * g0[j];
        const float cv = bv[j] + wv[0][j] * v2[j] + wv[1][j] * v1[j] + wv[2][j] * v0[j];
        o[j] = siluf_(cg) * cv;
        g2[j] = g1[j]; g1[j] = g0[j]; v2[j] = v1[j]; v1[j] = v0[j];
      }
      if (r >= 2 && tk < tend) *(uint2*)(act + (size_t)tk * DFF + u.pn * 128 + cc * 4) = make_uint2(pack2(o[0], o[1]), pack2(o[2], o[3]));
    }
#undef UNP4
  }
};
template <class Epi>
DEV void pg8_gemm(unsigned char* smraw, const u16* A, const u16* Bt, int M, int N, int K, const Epi& E, int bid, int nb) {
  pg8::Gemm g{A, Bt, M, N, K};
  pg8::StaticOrder S;
  S.init(M, N, nb, bid);
  pg8::gemm_phase<Epi, pg8::StaticOrder, false>((PG8_LAS unsigned char*)smraw, g, S, E, nullptr);
}

#define PPL 15
#define NPHASE (2 + 2 * PPL)
template <int ph>
DEV void run_phase(const Params& p, unsigned char* smraw, int bid, int nb) {
  u16* smem = (u16*)smraw;
  float* smf = (float*)smraw;
  float* xo = p.out;
  u16* xb = (u16*)(p.ws + OFF_XB);
  float* ssq_all = (float*)(p.ws + OFF_RSTD);
  if (ph == 0) { phase_prep(p, smf, bid, nb); phase_norm(p.in[0], xb, ssq_all, bid, nb); return; }
  if (ph == NPHASE - 1) { phase_final(xo, p.in[25], bid, nb); return; }
  const int l = (ph - 1) / PPL, s = (ph - 1) % PPL;
  const float* xcur = (l == 0) ? p.in[0] : xo;
  unsigned char* W = p.ws + OFF_W + (size_t)l * LW_BYTES;
  float* ssq1 = ssq_all + (size_t)(2 * l) * NTOK;
  float* ssq2 = ssq_all + (size_t)(2 * l + 1) * NTOK;
  switch (s) {
    case 0: break;
    case 1: { EpiInproj E{(u16*)(p.ws + OFF_BIG + B_PRW), 1792, ssq1}; pg8_gemm(smraw, xb, (const u16*)(W + W_IN), NTOK, 1792, DM, E, bid, nb); } break;
    case 2: phase_rwprep(p, l, smem, bid, nb); break;
    case 3: phase_scan<1>(p, l, smf, bid, nb); break;
    case 4: phase_scanprop(p, smf, bid, nb); first_tok_proj(p, l, xcur, smf, nb - 1 - bid, nb); break;
    case 5: phase_scan<3>(p, l, smf, bid, nb); break;
    case 6: { EpiInproj E{(u16*)(p.ws + OFF_BIG + B_PRS), 2560, ssq1}; pg8_gemm(smraw, xb, (const u16*)(W + W_IN) + (size_t)1792 * DM, NTOK, 2560, DM, E, bid, nb); } break;
    case 7:
      for (int u = bid; u < 1024; u += nb) ret_kv_unit(p, u, smem);
      for (int u = bid; u < 256; u += nb) sgu_unit(p, l, u, smem);
      break;
    case 8: phase_retprefix(p, bid, nb); break;
    case 9:
      for (int u = bid; u < 1024; u += nb) ret_out_unit(p, u, smem);
      first_tok_fix(p, l, smf, nb - 1 - bid, nb);
      break;
    case 10: {
      TriOrder S; S.init(NTOK, DM, nb, bid); S.a_rows_per_g = NTOK;
      EpiP E{(u16*)(p.ws + OFF_BIG + B_P)};
      pg8::Gemm g{(const u16*)(p.ws + OFF_BIG + B_YRW), (const u16*)(W + W_BR), NTOK, DM, 512};
      pg8::gemm_phase<EpiP, TriOrder, false>((PG8_LAS unsigned char*)smraw, g, S, E, nullptr);
    } break;
    case 11: {
      TriOrder S; S.init(NTOK, DM, nb, bid); S.a_rows_per_g = 0;
      EpiGate E{(u16*)(p.ws + OFF_BIG + B_M), (const u16*)(p.ws + OFF_BIG + B_P), ssq1};
      pg8::Gemm g{xb, (const u16*)(W + W_IN) + (size_t)4352 * DM, NTOK, DM, DM};
      pg8::gemm_phase<EpiGate, TriOrder, false>((PG8_LAS unsigned char*)smraw, g, S, E, nullptr);
    } break;
    case 12: { EpiRes E{xcur, xo, xb, ssq2}; pg8_gemm(smraw, (const u16*)(p.ws + OFF_BIG + B_M), (const u16*)(W + W_OUT), NTOK, DM, DM, E, bid, nb); } break;
    case 13: {
      FfnOrder S;
      S.init(132 * 256, 2 * DFF, nb, bid);
      EpiFfn E{&p, l, bid};
      pg8::Gemm g{xb, (const u16*)(W + W_UP), 132 * 256, 2 * DFF, DM};
      pg8::gemm_phase<EpiFfn, FfnOrder, false>((PG8_LAS unsigned char*)smraw, g, S, E, nullptr);
    } break;
    case 14: {
      EpiRes E{xo, xo, (l == 0) ? xb : nullptr, (l == 0) ? ssq_all + (size_t)2 * NTOK : nullptr};
      pg8_gemm(smraw, (const u16*)(p.ws + OFF_BIG + B_ACT), (const u16*)(W + W_DN), NTOK, DM, DFF, E, bid, nb);
    } break;
  }
}
DEV constexpr bool phase_empty(int ph) {
  return ph >= 1 && ph < NPHASE - 1 && ((ph - 1) % PPL == 0);
}

#define XB_TMO      128
#define XB_XCNT(j)  (256  + 64 * (j))
#define XB_XSUB(j)  (1280 + 64 * (j))
#define XB_XGEN(j)  (2304 + 64 * (j))
#define XB_TOP      3328
#define XB_TOPGEN   3392
#define XCD_BAR_WORDS 3456
#define XB_SPIN_CAP (1u << 18)
#define LAS __attribute__((address_space(3)))

__device__ __forceinline__ unsigned xb_ld(unsigned* p)              { return __hip_atomic_load(p, __ATOMIC_RELAXED, __HIP_MEMORY_SCOPE_AGENT); }
__device__ __forceinline__ unsigned xb_add(unsigned* p, unsigned v) { return __hip_atomic_fetch_add(p, v, __ATOMIC_RELAXED, __HIP_MEMORY_SCOPE_AGENT); }
__device__ __forceinline__ unsigned xb_xcc_id() { return (unsigned)__builtin_amdgcn_s_getreg((3 << 11) | 20) & 0xFu; }
#define XB_SPIN(cond, bar) do { unsigned _sp = 0; while (cond) { __builtin_amdgcn_s_sleep(1); \
    if ((++_sp & 255u) == 0u) { if (xb_ld(&(bar)[XB_TMO])) break; if (_sp > XB_SPIN_CAP) { atomicAdd(&(bar)[XB_TMO], 1u); break; } } } } while (0)

struct XcdBarrier {
    unsigned* bar; unsigned x;
    volatile LAS unsigned* st;
};

__device__ __forceinline__ XcdBarrier xcd_barrier_post(unsigned* bar, volatile LAS unsigned* st) {
    XcdBarrier b; b.bar = bar; b.x = xb_xcc_id(); b.st = st;
    if (my_tid() == 0) (void)xb_add(&bar[XB_XCNT(b.x)], 1u);
    return b;
}
__device__ __forceinline__ void xcd_barrier_complete(unsigned* bar, unsigned x, unsigned& nloc, unsigned& nx) {
    const unsigned G = gridDim.x * gridDim.y * gridDim.z;
    unsigned sum, cnt, mine, sp = 0u;
    for (;;) {
        sum = 0u; cnt = 0u; mine = 0u;
#pragma unroll
        for (unsigned j = 0; j < 16; ++j) { const unsigned c = xb_ld(&bar[XB_XCNT(j)]); sum += c; cnt += (c > 0u) ? 1u : 0u; mine = (j == x) ? c : mine; }
        if (sum == G) break;
        __builtin_amdgcn_s_sleep(1);
        if ((++sp & 255u) == 0u) { if (xb_ld(&bar[XB_TMO])) break; if (sp > XB_SPIN_CAP) { atomicAdd(&bar[XB_TMO], 1u); break; } }
    }
    nloc = mine > 0u ? mine : 1u; nx = cnt > 0u ? cnt : 1u;
}

__device__ __forceinline__ void xcd_barrier(const XcdBarrier& b) {
    asm volatile("s_waitcnt vmcnt(0)" ::: "memory");
    __syncthreads();
    if (my_tid() == 0) {
        unsigned* bar = b.bar;
        __builtin_amdgcn_s_waitcnt(0);
        unsigned nloc = b.st[0], nx = b.st[1];
        if (nloc == 0u) { xcd_barrier_complete(bar, b.x, nloc, nx); b.st[0] = nloc; b.st[1] = nx; }
        const unsigned old = xb_add(&bar[XB_XSUB(b.x)], 1u);
        const unsigned gen = old / nloc;
        if (old + 1u == (gen + 1u) * nloc) {
            __builtin_amdgcn_fence(__ATOMIC_RELEASE, "agent");
            asm volatile("s_waitcnt vmcnt(0)" ::: "memory");
            const unsigned og = xb_add(&bar[XB_TOP], 1u);
            const unsigned tg = og / nx;
            if (og + 1u == (tg + 1u) * nx) xb_add(&bar[XB_TOPGEN], 1u);
            else XB_SPIN(xb_ld(&bar[XB_TOPGEN]) == tg, bar);
            __builtin_amdgcn_fence(__ATOMIC_ACQUIRE, "agent");
            xb_add(&bar[XB_XGEN(b.x)], 1u);
            asm volatile("s_waitcnt vmcnt(0)" ::: "memory");
        } else {
            XB_SPIN(xb_ld(&bar[XB_XGEN(b.x)]) == gen, bar);
            __builtin_amdgcn_fence(__ATOMIC_ACQUIRE, "agent");
            asm volatile("s_waitcnt vmcnt(0)" ::: "memory");
        }
    }
    __syncthreads();
}


DEV void gsync(unsigned* ctr, unsigned& target) {
  asm volatile("s_waitcnt vmcnt(0)" ::: "memory");
  __syncthreads();
  if (my_tid() == 0) {
    target += gridDim.x;
    __builtin_amdgcn_fence(__ATOMIC_RELEASE, "agent");
    asm volatile("s_waitcnt vmcnt(0)" ::: "memory");
    __hip_atomic_fetch_add(ctr, 1u, __ATOMIC_RELAXED, __HIP_MEMORY_SCOPE_AGENT);
    while (__hip_atomic_load(ctr, __ATOMIC_RELAXED, __HIP_MEMORY_SCOPE_AGENT) < target) __builtin_amdgcn_s_sleep(2);
    __builtin_amdgcn_fence(__ATOMIC_ACQUIRE, "agent");
    asm volatile("s_waitcnt vmcnt(0)" ::: "memory");
  }
  __syncthreads();
}

#if COOP
template <int PH>
DEV void run_seq(const Params& p, unsigned char* smraw, cg::grid_group& grid, const XcdBarrier& xb) {
  if constexpr (phase_empty(PH)) {
    run_seq<PH + 1>(p, smraw, grid, xb);
  } else {
    int bid_ = blockIdx.x;
    asm volatile("" : "+s"(bid_));
    run_phase<PH>(p, smraw, bid_, gridDim.x);
    if constexpr (PH + 1 < NPHASE) {
      if constexpr (PH == 0) grid.sync();
      else xcd_barrier(xb);
      run_seq<PH + 1>(p, smraw, grid, xb);
    }
  }
}
__global__ void __launch_bounds__(NTHR) mega(Params p) {
  __shared__ __align__(16) unsigned char smraw[147456];
  cg::grid_group grid = cg::this_grid();
  __shared__ uint4 xb_words;
  if (my_tid() == 0) xb_words = make_uint4(0u, 0u, 0u, 0u);
  __syncthreads();
  XcdBarrier xb = xcd_barrier_post((unsigned*)p.ws, (volatile LAS unsigned*)&xb_words);
  run_seq<0>(p, smraw, grid, xb);
}
#else
template <int PH>
__global__ void __launch_bounds__(NTHR) phk(Params p) {
  __shared__ __align__(16) unsigned char smraw[147456];
  run_phase<PH>(p, smraw, blockIdx.x, gridDim.x);
}
template <int PH>
static void launch_seq(const Params& p, hipStream_t stream) {
  phk<PH><<<256, NTHR, 0, stream>>>(p);
  if constexpr (PH + 1 < NPHASE) launch_seq<PH + 1>(p, stream);
}
#endif

extern "C" void kernel_launch(void* const* d_in, const int* in_sizes, int n_in, void* d_out, int out_size, void* d_ws,
                              size_t ws_size, hipStream_t stream) {
  Params p{};
  for (int i = 0; i < 26; ++i) p.in[i] = (const float*)d_in[i];
  p.out = (float*)d_out;
  p.ws = (unsigned char*)d_ws;
  if (ws_size < WS_NEED) { fprintf(stderr, "workspace too small: %zu < %llu\n", ws_size, (unsigned long long)WS_NEED); return; }
#if COOP
  static int grid_blocks = 0;
  if (!grid_blocks) {
    int dev = 0, cus = 0, per_cu = 0;
    hipGetDevice(&dev);
    hipDeviceGetAttribute(&cus, hipDeviceAttributeMultiprocessorCount, dev);
    hipOccupancyMaxActiveBlocksPerMultiprocessor(&per_cu, mega, NTHR, 0);
    if (per_cu > 1) per_cu = 1;
    grid_blocks = cus * per_cu;
  }
  hipMemsetAsync(d_ws, 0, 16384, stream);
  void* args[] = {&p};
  hipError_t e = hipLaunchCooperativeKernel((void*)mega, dim3(grid_blocks), dim3(NTHR), args, 0, stream);
  if (e != hipSuccess) fprintf(stderr, "cooperative launch failed: %s (grid %d)\n", hipGetErrorString(e), grid_blocks);
#else
  launch_seq<0>(p, stream);
#endif
}
```

```cpp
#include <hip/hip_runtime.h>
#include <hip/hip_cooperative_groups.h>
#include <cstdio>
#include <cstdint>
namespace cg = cooperative_groups;

#ifndef COOP
#define COOP 1
#endif

#define DEV __device__ __forceinline__
typedef unsigned short u16;
typedef short bf16x8 __attribute__((ext_vector_type(8)));
typedef float f32x16 __attribute__((ext_vector_type(16)));

#define NTHR 512
#define NTOK 32768
#define SEQ 8192
#define DM 1024
#define INC 7424
#define DFF 2816
#define MiB (1048576ull)

#define OFF_ROPE (64ull * 1024)
#define OFF_RSTD (OFF_ROPE + 2 * MiB)
#define OFF_PF (OFF_RSTD + 640ull * 1024)
#define OFF_W (3 * MiB)
#define LW_BYTES (37 * MiB)
#define W_IN 0ull
#define W_BR 15204352ull
#define W_OUT 18350080ull
#define W_UP 20447232ull
#define W_DN 31981568ull
#define W_RWUP 37748736ull
#define W_RAUP 37814272ull
#define W_RGUP 37879808ull
#define W_SGW 38010880ull
#define OFF_XB (77 * MiB)
#define OFF_BIG (141 * MiB)
#define B_PRW 0ull
#define B_YRW 0ull
#define B_YRET (32 * MiB)
#define B_YSG (64 * MiB)
#define B_OPS (112 * MiB)
#define B_PRS (112 * MiB)
#define B_KV (272 * MiB)
#define B_M 0ull
#define B_P (128 * MiB)
#define B_PL (304 * MiB)
#define B_SINIT (320 * MiB)
#define B_ACT 0ull
#define WS_NEED (OFF_BIG + 328 * MiB)

struct Params {
  const float* in[26];
  float* out;
  unsigned char* ws;
};

DEV int my_tid() {
  int t = __builtin_amdgcn_workitem_id_x();
  asm volatile("" : "+v"(t));
  return t;
}
DEV u16 f2bf(float f) {
  unsigned u = __float_as_uint(f);
  u += 0x7fffu + ((u >> 16) & 1u);
  return (u16)(u >> 16);
}
DEV float bf2f(u16 h) { return __uint_as_float(((unsigned)h) << 16); }
DEV unsigned pack2(float a, float b) { return (unsigned)f2bf(a) | ((unsigned)f2bf(b) << 16); }
DEV void unpack8(uint4 v, float* f) {
  f[0] = __uint_as_float(v.x << 16); f[1] = __uint_as_float(v.x & 0xffff0000u);
  f[2] = __uint_as_float(v.y << 16); f[3] = __uint_as_float(v.y & 0xffff0000u);
  f[4] = __uint_as_float(v.z << 16); f[5] = __uint_as_float(v.z & 0xffff0000u);
  f[6] = __uint_as_float(v.w << 16); f[7] = __uint_as_float(v.w & 0xffff0000u);
}
DEV uint4 pack8(const float* f) {
  return make_uint4(pack2(f[0], f[1]), pack2(f[2], f[3]), pack2(f[4], f[5]), pack2(f[6], f[7]));
}
template <int CTRL>
DEV float dppmov(float x) {
  return __builtin_bit_cast(float, __builtin_amdgcn_update_dpp(0, __builtin_bit_cast(int, x), CTRL, 0xF, 0xF, true));
}
DEV float red4(float x) { x += dppmov<0xB1>(x); x += dppmov<0x4E>(x); return x; }
DEV float red8(float x) { x = red4(x); x += dppmov<0x141>(x); return x; }
DEV float wave_sum(float x) {
  x = red8(x);
  x += dppmov<0x140>(x);
  const int xi = __builtin_bit_cast(int, x);
  return __builtin_bit_cast(float, __builtin_amdgcn_readlane(xi, 0)) + __builtin_bit_cast(float, __builtin_amdgcn_readlane(xi, 16)) +
         __builtin_bit_cast(float, __builtin_amdgcn_readlane(xi, 32)) + __builtin_bit_cast(float, __builtin_amdgcn_readlane(xi, 48));
}
DEV float sigmoidf_(float x) { return 1.f / (1.f + __expf(-x)); }
DEV float siluf_(float x) { return x / (1.f + __expf(-x)); }
DEV float geluf_(float x) { return 0.5f * x * (1.f + erff(x * 0.70710678118654752f)); }

DEV float rstd_of(const float* ssq, int row) { return rsqrtf(ssq[row] * (1.0f / DM) + 1e-6f); }
DEV int vbid(int bid, int nb) { return ((nb & 7) == 0) ? (bid & 7) * (nb >> 3) + (bid >> 3) : bid; }
DEV void tile_map(int t, int MTL, int NTL, int& m, int& n) {
  int per = 8 * NTL;
  int g = t / per;
  int r = t - g * per;
  int gm = MTL - g * 8; gm = gm > 8 ? 8 : gm;
  m = g * 8 + r % gm;
  n = r / gm;
}

typedef unsigned u32x4 __attribute__((ext_vector_type(4)));
template <int NA>
struct GStage { u32x4 a0, a1, a2, a3, b0, b1; };
DEV u32x4 g_ld_a(const u16* A, long lda, int g, int azero_below, int arow_max, int ko) {
  const bool z = g < azero_below;
  g = g < 0 ? 0 : g;
  g = g > arow_max ? arow_max : g;
  u32x4 v = *(const u32x4*)(A + (long)g * lda + ko);
  const u32x4 zero = {0u, 0u, 0u, 0u};
  return z ? zero : v;
}
template <int NA>
DEV void g_load(GStage<NA>& S, const u16* A, long lda, int arow, int azero_below, int arow_max,
                const u16* bp0, const u16* bp1, int ko) {
  S.a0 = g_ld_a(A, lda, arow, azero_below, arow_max, ko);
  S.a1 = g_ld_a(A, lda, arow + 64, azero_below, arow_max, ko);
  if constexpr (NA == 4) {
    S.a2 = g_ld_a(A, lda, arow + 128, azero_below, arow_max, ko);
    S.a3 = g_ld_a(A, lda, arow + 192, azero_below, arow_max, ko);
  }
  S.b0 = *(const u32x4*)(bp0 + ko);
  S.b1 = *(const u32x4*)(bp1 + ko);
}
template <int NA>
DEV void g_store(const GStage<NA>& S, u16* An, u16* Bn, int st_off) {
  *(u32x4*)(An + st_off) = S.a0;
  *(u32x4*)(An + st_off + 64 * 72) = S.a1;
  if constexpr (NA == 4) {
    *(u32x4*)(An + st_off + 128 * 72) = S.a2;
    *(u32x4*)(An + st_off + 192 * 72) = S.a3;
  }
  *(u32x4*)(Bn + st_off) = S.b0;
  *(u32x4*)(Bn + st_off + 64 * 72) = S.b1;
}
template <int MT>
DEV void g_compute(f32x16 (&acc)[MT][2], const u16* Ab, const u16* Bb) {
#pragma unroll
  for (int ks = 0; ks < 4; ++ks) {
    bf16x8 a[MT], b[2];
#pragma unroll
    for (int i = 0; i < MT; ++i) a[i] = *(const bf16x8*)(Ab + i * 32 * 72 + ks * 16);
#pragma unroll
    for (int j = 0; j < 2; ++j) b[j] = *(const bf16x8*)(Bb + j * 32 * 72 + ks * 16);
#pragma unroll
    for (int i = 0; i < MT; ++i)
#pragma unroll
      for (int j = 0; j < 2; ++j) acc[i][j] = __builtin_amdgcn_mfma_f32_32x32x16_bf16(a[i], b[j], acc[i][j], 0, 0, 0);
  }
}
template <int MT>
DEV void gemm_tile(f32x16 (&acc)[MT][2], const u16* A, long lda, int arow0, int azero_below, int arow_max,
                   const u16* B, long ldb, int K, u16* smem) {
  constexpr int TM = 128 * MT;
  constexpr int ASZ = TM * 72, BSZ = 128 * 72;
  constexpr int NA = TM / 64;
  const int tid = my_tid(), lane = tid & 63, wave = tid >> 6, wm = wave >> 1, wn = wave & 1;
  const int crow = tid >> 3, ckc = tid & 7;
  GStage<NA> s0, s1;
  const u16* Ak = A + ckc * 8;
  const int arow = arow0 + crow;
  const u16* bp0 = B + (long)crow * ldb + ckc * 8;
  const u16* bp1 = B + (long)(crow + 64) * ldb + ckc * 8;
  const int nk = K >> 6;
  const int arow_l = (wm * 32 * MT + (lane & 31)) * 72 + (lane >> 5) * 8;
  const int brow_l = (wn * 64 + (lane & 31)) * 72 + (lane >> 5) * 8;
  const int st_off = crow * 72 + ckc * 8;
  g_load<NA>(s0, Ak, lda, arow, azero_below, arow_max, bp0, bp1, 0);
  g_store<NA>(s0, smem, smem + ASZ, st_off);
  g_load<NA>(s1, Ak, lda, arow, azero_below, arow_max, bp0, bp1, 64);
  __syncthreads();
  for (int kt = 0; kt < nk; kt += 2) {
    if (kt + 2 < nk) g_load<NA>(s0, Ak, lda, arow, azero_below, arow_max, bp0, bp1, (kt + 2) * 64);
    g_compute<MT>(acc, smem + arow_l, smem + ASZ + brow_l);
    g_store<NA>(s1, smem + (ASZ + BSZ), smem + (ASZ + BSZ) + ASZ, st_off);
    __syncthreads();
    if (kt + 3 < nk) g_load<NA>(s1, Ak, lda, arow, azero_below, arow_max, bp0, bp1, (kt + 3) * 64);
    g_compute<MT>(acc, smem + (ASZ + BSZ) + arow_l, smem + (ASZ + BSZ) + ASZ + brow_l);
    if (kt + 2 < nk) g_store<NA>(s0, smem, smem + ASZ, st_off);
    __syncthreads();
  }
}
struct GStageB { u32x4 a0, a1, a2, a3, b0, b1, b2, b3; };
DEV const u16* g_rowptr(const u16* A, long lda, int g, int arow_max) {
  g = g < 0 ? 0 : g;
  g = g > arow_max ? arow_max : g;
  return A + (long)g * lda;
}
DEV void gb_load(GStageB& S, const u16* A, long lda, int arow, int arow_max, const u16* Bk, long ldb, int ko) {
  S.a0 = *(const u32x4*)(g_rowptr(A, lda, arow, arow_max) + ko);
  S.a1 = *(const u32x4*)(g_rowptr(A, lda, arow + 64, arow_max) + ko);
  S.a2 = *(const u32x4*)(g_rowptr(A, lda, arow + 128, arow_max) + ko);
  S.a3 = *(const u32x4*)(g_rowptr(A, lda, arow + 192, arow_max) + ko);
  S.b0 = *(const u32x4*)(Bk + ko);
  S.b1 = *(const u32x4*)(Bk + 64 * ldb + ko);
  S.b2 = *(const u32x4*)(Bk + 128 * ldb + ko);
  S.b3 = *(const u32x4*)(Bk + 192 * ldb + ko);
}
DEV void gb_store(const GStageB& S, u16* An, u16* Bn, int st_off, int arow, int azero_below) {
  const u32x4 zero = {0u, 0u, 0u, 0u};
  *(u32x4*)(An + st_off) = (arow < azero_below) ? zero : S.a0;
  *(u32x4*)(An + st_off + 64 * 72) = (arow + 64 < azero_below) ? zero : S.a1;
  *(u32x4*)(An + st_off + 128 * 72) = (arow + 128 < azero_below) ? zero : S.a2;
  *(u32x4*)(An + st_off + 192 * 72) = (arow + 192 < azero_below) ? zero : S.a3;
  *(u32x4*)(Bn + st_off) = S.b0;
  *(u32x4*)(Bn + st_off + 64 * 72) = S.b1;
  *(u32x4*)(Bn + st_off + 128 * 72) = S.b2;
  *(u32x4*)(Bn + st_off + 192 * 72) = S.b3;
}
DEV void gb_compute(f32x16 (&acc)[2][4], const u16* Ab, const u16* Bb) {
#pragma unroll
  for (int ks = 0; ks < 4; ++ks) {
    bf16x8 a[2], b[4];
#pragma unroll
    for (int i = 0; i < 2; ++i) a[i] = *(const bf16x8*)(Ab + i * 32 * 72 + ks * 16);
#pragma unroll
    for (int j = 0; j < 4; ++j) b[j] = *(const bf16x8*)(Bb + j * 32 * 72 + ks * 16);
#pragma unroll
    for (int i = 0; i < 2; ++i)
#pragma unroll
      for (int j = 0; j < 4; ++j) acc[i][j] = __builtin_amdgcn_mfma_f32_32x32x16_bf16(a[i], b[j], acc[i][j], 0, 0, 0);
  }
}
DEV void gemm_big(f32x16 (&acc)[2][4], const u16* A, long lda, int arow0, int azero_below, int arow_max,
                  const u16* B, long ldb, int K, u16* smem) {
  constexpr int ASZ = 256 * 72, BSZ = 256 * 72;
  const int tid = my_tid(), lane = tid & 63, wave = tid >> 6, wm = wave >> 1, wn = wave & 1;
  const int crow = tid >> 3, ckc = tid & 7;
  const u16* Ak = A + ckc * 8;
  const int arow = arow0 + crow;
  const u16* Bk = B + (long)crow * ldb + ckc * 8;
  const int nk = K >> 6;
  const int arow_l = (wm * 64 + (lane & 31)) * 72 + (lane >> 5) * 8;
  const int brow_l = (wn * 128 + (lane & 31)) * 72 + (lane >> 5) * 8;
  const int st_off = crow * 72 + ckc * 8;
  GStageB s;
  gb_load(s, Ak, lda, arow, arow_max, Bk, ldb, 0);
  gb_store(s, smem, smem + ASZ, st_off, arow, azero_below);
  __syncthreads();
  for (int kt = 0; kt < nk; ++kt) {
    const bool more = kt + 1 < nk;
    if (more) gb_load(s, Ak, lda, arow, arow_max, Bk, ldb, (kt + 1) * 64);
    __builtin_amdgcn_sched_barrier(0);
    const u16* cb = smem + (kt & 1) * (ASZ + BSZ);
    gb_compute(acc, cb + arow_l, cb + ASZ + brow_l);
    __builtin_amdgcn_sched_barrier(0);
    if (more) {
      u16* nb_ = smem + ((kt + 1) & 1) * (ASZ + BSZ);
      gb_store(s, nb_, nb_ + ASZ, st_off, arow, azero_below);
    }
    __syncthreads();
  }
}
#define BIG_ROW(i, e) (wm * 64 + (i) * 32 + ((e) & 3) + 8 * ((e) >> 2) + 4 * (lane >> 5))
#define BIG_COL(j) (wn * 128 + (j) * 32 + (lane & 31))
#define ZERO_BIG(acc)                                   \
  _Pragma("unroll") for (int i_ = 0; i_ < 2; ++i_)      \
  _Pragma("unroll") for (int j_ = 0; j_ < 4; ++j_)      \
  _Pragma("unroll") for (int e_ = 0; e_ < 16; ++e_) acc[i_][j_][e_] = 0.f;

#define ACC_ROW(MT_, i, e) (wm * 32 * (MT_) + (i) * 32 + ((e) & 3) + 8 * ((e) >> 2) + 4 * (lane >> 5))
#define ACC_COL(j) (wn * 64 + (j) * 32 + (lane & 31))

DEV void tconv(const float* src, int K, int N, u16* dst, const float* scale, int mode, float* t, int bid, int nb) {
  const int tid = my_tid();
  const int KT = K >> 6, NT = N >> 6;
  for (int tt = bid; tt < KT * NT; tt += nb) {
    const int kt = tt % KT, nt = tt / KT;
    const int k0 = kt * 64, n0 = nt * 64;
    int sn0 = n0;
    if (mode == 1) { int j = n0 >> 8, c = n0 & 255; sn0 = (c < 128) ? (j * 128 + c) : (DFF + j * 128 + c - 128); }
    {
      const int kk = tid >> 6, n = tid & 63;
#pragma unroll
      for (int i = 0; i < 8; ++i) {
        int k = kk + 8 * i;
        float v = src[(long)(k0 + k) * N + sn0 + n];
        if (scale) v *= scale[k0 + k];
        t[k * 65 + n] = v;
      }
    }
    __syncthreads();
    {
      const int n = tid >> 3, k8 = tid & 7;
      float f[8];
#pragma unroll
      for (int j = 0; j < 8; ++j) f[j] = t[(k8 * 8 + j) * 65 + n];
      *(uint4*)(dst + (long)(n0 + n) * K + k0 + k8 * 8) = pack8(f);
    }
    __syncthreads();
  }
}

DEV void phase_prep(const Params& p, float* smf, int bid, int nb) {
  for (int l = 0; l < 2; ++l) {
    unsigned char* W = p.ws + OFF_W + (size_t)l * LW_BYTES;
    tconv(p.in[2] + (size_t)l * DM * INC, DM, INC, (u16*)(W + W_IN), p.in[1] + l * DM, 0, smf, bid, nb);
    for (int g = 0; g < 3; ++g)
      tconv(p.in[18] + (size_t)(l * 3 + g) * 512 * DM, 512, DM, (u16*)(W + W_BR) + (size_t)g * DM * 512, nullptr, 0, smf, bid, nb);
    tconv(p.in[19] + (size_t)l * DM * DM, DM, DM, (u16*)(W + W_OUT), nullptr, 0, smf, bid, nb);
    tconv(p.in[21] + (size_t)l * DM * 2 * DFF, DM, 2 * DFF, (u16*)(W + W_UP), p.in[20] + l * DM, 1, smf, bid, nb);
    tconv(p.in[24] + (size_t)l * DFF * DM, DFF, DM, (u16*)(W + W_DN), nullptr, 0, smf, bid, nb);
    tconv(p.in[5] + (size_t)l * 64 * 512, 64, 512, (u16*)(W + W_RWUP), nullptr, 0, smf, bid, nb);
    tconv(p.in[7] + (size_t)l * 64 * 512, 64, 512, (u16*)(W + W_RAUP), nullptr, 0, smf, bid, nb);
    tconv(p.in[8] + (size_t)l * 128 * 512, 128, 512, (u16*)(W + W_RGUP), nullptr, 0, smf, bid, nb);
    const float* sw = p.in[16] + (size_t)l * 4 * 128 * 128;
    u16* sd = (u16*)(W + W_SGW);
    for (int idx = bid * NTHR + my_tid(); idx < 4 * 128 * 128; idx += nb * NTHR) {
      int i = (idx >> 7) & 127, j = idx & 127;
      sd[idx] = f2bf(j <= i ? sw[idx] : 0.f);
    }
  }
  {
    float* sq = (float*)(p.ws + OFF_RSTD) + NTOK;
    for (int idx = bid * NTHR + my_tid(); idx < 3 * NTOK; idx += nb * NTHR) sq[idx] = 0.f;
  }
  float* rc = (float*)(p.ws + OFF_ROPE);
  float* rs = rc + SEQ * 32;
  for (int idx = bid * NTHR + my_tid(); idx < SEQ * 32; idx += nb * NTHR) {
    int pos = idx >> 5, d = idx & 31;
    float lin = (d == 31) ? 1.0f : (float)d * (1.0f / 31.0f);
    float invf = 1.0f / powf(10000.0f, lin);
    float ang = (float)pos * invf;
    double rev = (double)ang * 0.15915494309189533577;
    float fr = (float)(rev - floor(rev));
    rc[idx] = __builtin_amdgcn_cosf(fr);
    rs[idx] = __builtin_amdgcn_sinf(fr);
  }
}

DEV void phase_norm(const float* x, u16* xb, float* rstd, int bid, int nb) {
  const int lane = my_tid() & 63, wave = my_tid() >> 6;
  for (int row = bid * 8 + wave; row < NTOK; row += nb * 8) {
    const float4* xr = (const float4*)(x + (size_t)row * DM);
    float4 v[4];
    float ss = 0.f;
#pragma unroll
    for (int i = 0; i < 4; ++i) {
      v[i] = xr[lane + 64 * i];
      ss += v[i].x * v[i].x + v[i].y * v[i].y + v[i].z * v[i].z + v[i].w * v[i].w;
    }
    ss = wave_sum(ss);
    if (lane == 0) rstd[row] = ss;
    uint2* o = (uint2*)(xb + (size_t)row * DM);
#pragma unroll
    for (int i = 0; i < 4; ++i) o[lane + 64 * i] = make_uint2(pack2(v[i].x, v[i].y), pack2(v[i].z, v[i].w));
  }
}
DEV void phase_final(float* x, const float* g, int bid, int nb) {
  const int lane = my_tid() & 63, wave = my_tid() >> 6;
  for (int row = bid * 8 + wave; row < NTOK; row += nb * 8) {
    float4* xr = (float4*)(x + (size_t)row * DM);
    const float4* gr = (const float4*)g;
    float4 v[4];
    float ss = 0.f;
#pragma unroll
    for (int i = 0; i < 4; ++i) {
      v[i] = xr[lane + 64 * i];
      ss += v[i].x * v[i].x + v[i].y * v[i].y + v[i].z * v[i].z + v[i].w * v[i].w;
    }
    ss = wave_sum(ss);
    float r = rsqrtf(ss * (1.0f / DM) + 1e-6f);
#pragma unroll
    for (int i = 0; i < 4; ++i) {
      float4 gg = gr[lane + 64 * i];
      xr[lane + 64 * i] = make_float4(v[i].x * r * gg.x, v[i].y * r * gg.y, v[i].z * r * gg.z, v[i].w * r * gg.w);
    }
  }
}

DEV void phase_inproj(const u16* xb, const float* rstd, const u16* wt, int N, u16* out, u16* smem, int bid, int nb) {
  const int tid = my_tid(), lane = tid & 63, wave = tid >> 6, wm = wave >> 1, wn = wave & 1;
  const int MTL = NTOK / 256, NTL = N / 256;
  for (int t = vbid(bid, nb); t < MTL * NTL; t += nb) {
    int m, n;
    tile_map(t, MTL, NTL, m, n);
    f32x16 acc[2][4];
    ZERO_BIG(acc);
    gemm_big(acc, xb, DM, m * 256, -(1 << 30), NTOK - 1, wt + (size_t)n * 256 * DM, DM, DM, smem);
#pragma unroll
    for (int i = 0; i < 2; ++i)
#pragma unroll
      for (int e = 0; e < 16; ++e) {
        const int r = BIG_ROW(i, e);
        const float rs = rstd_of(rstd, m * 256 + r);
#pragma unroll
        for (int j = 0; j < 4; ++j) smem[r * 264 + BIG_COL(j)] = f2bf(acc[i][j][e] * rs);
      }
    __syncthreads();
#pragma unroll 4
    for (int k = 0; k < 16; ++k) {
      const int c = tid + NTHR * k;
      const int r = c >> 5, cc = c & 31;
      *(uint4*)(out + (size_t)(m * 256 + r) * N + n * 256 + cc * 8) = *(const uint4*)(smem + r * 264 + cc * 8);
    }
    __syncthreads();
  }
}

#define OPS_STRIDE ((size_t)NTOK * 512)
template <int WHICH>
DEV void rwprep_gemm(const u16* T, u16* OS, const u16* wsrc, const float* w0, const float* a0, u16* ops, int t0, int nbk) {
  const int tid = my_tid(), lane = tid & 63, wave = tid >> 6, wm = wave >> 1, wn = wave & 1;
  constexpr int kd = (WHICH == 2) ? 128 : 64;
  constexpr int aoff = (WHICH == 0) ? 0 : (WHICH == 1 ? 64 : 128);
  constexpr int arr = (WHICH == 0) ? 4 : (WHICH == 1 ? 3 : 5);
  const int arow = (wm * 32 + (lane & 31)) * 264 + (lane >> 5) * 8;
  const int bn = nbk * 128 + wn * 64 + (lane & 31);
  bf16x8 bfr[kd / 16][2];
#pragma unroll
  for (int ks = 0; ks < kd / 16; ++ks)
#pragma unroll
    for (int j = 0; j < 2; ++j) bfr[ks][j] = *(const bf16x8*)(wsrc + (size_t)(bn + j * 32) * kd + ks * 16 + (lane >> 5) * 8);
  f32x16 ac[2];
#pragma unroll
  for (int j = 0; j < 2; ++j)
#pragma unroll
    for (int e = 0; e < 16; ++e) ac[j][e] = 0.f;
#pragma unroll
  for (int ks = 0; ks < kd / 16; ++ks) {
    const bf16x8 a1 = *(const bf16x8*)(T + arow + aoff + ks * 16);
#pragma unroll
    for (int j = 0; j < 2; ++j) ac[j] = __builtin_amdgcn_mfma_f32_32x32x16_bf16(a1, bfr[ks][j], ac[j], 0, 0, 0);
  }
#pragma unroll
  for (int j = 0; j < 2; ++j) {
    const int cl = ACC_COL(j);
    const int ch = nbk * 128 + cl;
    const float w0c = w0[ch], a0c = a0[ch];
#pragma unroll
    for (int e = 0; e < 16; ++e) {
      float val;
      if (WHICH == 0) {
        const float z = -(w0c + ac[j][e]);
        const float sp = fmaxf(z, 0.f) + log1pf(__expf(-fabsf(z)));
        val = __expf(-sp - 0.5f);
      } else if (WHICH == 1) {
        val = sigmoidf_(a0c + ac[j][e]);
      } else {
        val = ac[j][e];
      }
      OS[ACC_ROW(1, 0, e) * 136 + cl] = f2bf(val);
    }
  }
  __syncthreads();
#pragma unroll
  for (int k = 0; k < 4; ++k) {
    const int c = tid + NTHR * k;
    const int r = c >> 4, cc = c & 15;
    *(uint4*)(ops + (size_t)arr * OPS_STRIDE + (size_t)(t0 + r) * 512 + nbk * 128 + cc * 8) = *(const uint4*)(OS + r * 136 + cc * 8);
  }
  __syncthreads();
}

DEV void phase_rwprep(const Params& p, int l, u16* smem, int bid, int nb) {
  const int tid = my_tid(), lane = tid & 63, wave = tid >> 6, wm = wave >> 1, wn = wave & 1;
  const u16* prw = (const u16*)(p.ws + OFF_BIG + B_PRW);
  u16* ops = (u16*)(p.ws + OFF_BIG + B_OPS);
  unsigned char* W = p.ws + OFF_W + (size_t)l * LW_BYTES;
  const u16* wup = (const u16*)(W + W_RWUP);
  const u16* aup = (const u16*)(W + W_RAUP);
  const u16* gup = (const u16*)(W + W_RGUP);
  const float* mu = p.in[3] + l * 1792;
  const float* w0 = p.in[4] + l * 512;
  const float* a0 = p.in[6] + l * 512;
  u16* T = smem;
  for (int tile = bid; tile < NTOK / 128; tile += nb) {
    const int t0 = tile * 128;
    for (int c0 = tid; c0 < 128 * 224; c0 += NTHR * 8) {
      u32x4 cu[8], pv[8];
#pragma unroll
      for (int q = 0; q < 8; ++q) {
        const int c = c0 + NTHR * q;
        const int tok = c / 224, ch = (c % 224) * 8;
        const int t = t0 + tok;
        cu[q] = *(const u32x4*)(prw + (size_t)t * 1792 + ch);
        const int tp = ((t & (SEQ - 1)) != 0) ? t - 1 : t;
        pv[q] = *(const u32x4*)(prw + (size_t)tp * 1792 + ch);
      }
#pragma unroll
      for (int q = 0; q < 8; ++q) {
        const int c = c0 + NTHR * q;
        const int tok = c / 224, ch = (c % 224) * 8;
        const int t = t0 + tok;
        float cur[8], prv[8], o[8];
        unpack8(make_uint4(cu[q].x, cu[q].y, cu[q].z, cu[q].w), cur);
        unpack8(make_uint4(pv[q].x, pv[q].y, pv[q].z, pv[q].w), prv);
        if ((t & (SEQ - 1)) == 0) {
#pragma unroll
          for (int j = 0; j < 8; ++j) prv[j] = 0.f;
        }
        float4 m0 = *(const float4*)(mu + ch), m1 = *(const float4*)(mu + ch + 4);
        float mm[8] = {m0.x, m0.y, m0.z, m0.w, m1.x, m1.y, m1.z, m1.w};
#pragma unroll
        for (int j = 0; j < 8; ++j) o[j] = cur[j] + mm[j] * (prv[j] - cur[j]);
        if (ch < 1536) {
          int arr = ch >> 9;
          *(uint4*)(ops + arr * OPS_STRIDE + (size_t)t * 512 + (ch & 511)) = pack8(o);
        } else {
          int cc = ch - 1536;
          if (cc < 64) {
#pragma unroll
            for (int j = 0; j < 8; ++j) o[j] = tanhf(o[j]);
          } else if (cc >= 128) {
#pragma unroll
            for (int j = 0; j < 8; ++j) o[j] = sigmoidf_(o[j]);
          }
          *(uint4*)(T + tok * 264 + cc) = pack8(o);
        }
      }
    }
    __syncthreads();
    u16* OS = smem + 128 * 264;
    for (int nbk = 0; nbk < 4; ++nbk) {
      rwprep_gemm<0>(T, OS, wup, w0, a0, ops, t0, nbk);
      rwprep_gemm<1>(T, OS, aup, w0, a0, ops, t0, nbk);
      rwprep_gemm<2>(T, OS, gup, w0, a0, ops, t0, nbk);
    }
    __syncthreads();
  }
}

#define TS 32
struct ScanStage {
  float* W; float* KK; float* BB; float* KP; float* RR; float* VV; float* YY;
};
template <int PASS>
DEV void phase_scan(const Params& p, int l, float* smf, int bid, int nb) {
  const int tid = my_tid();
  const int half = tid >> 8, tu = tid & 255;
  const u16* ops = (const u16*)(p.ws + OFF_BIG + B_OPS);
  float* PL = (float*)(p.ws + OFF_BIG + B_PL);
  const float* SIN = (const float*)(p.ws + OFF_BIG + B_SINIT);
  u16* yrw = (u16*)(p.ws + OFF_BIG + B_YRW);
  const float* k_k = p.in[9] + l * 512;
  const float* k_a = p.in[10] + l * 512;
  const float* r_k = p.in[11] + l * 512;
  const float* lng = p.in[12] + l * 512;
  const float* lnb = p.in[13] + l * 512;
  float* base = smf + half * (7 * TS * 64);
  float* sW = base; float* sKK = base + TS * 64; float* sB = base + 2 * TS * 64; float* sKP = base + 3 * TS * 64;
  float* sR = base + 4 * TS * 64; float* sV = base + 5 * TS * 64; float* sY = base + 6 * TS * 64;
  const int ss = tu >> 3, c8 = tu & 7;
  const int ks = tu & 7, rp = tu >> 3;
  for (int u2 = bid; u2 < 256; u2 += nb) {
    const int u = u2 * 2 + half;
    const int bh = u >> 4, c = u & 15;
    const int b = bh >> 3, h = bh & 7;
    const int tok0 = b * SEQ + c * 512;
    const int chb = h * 64 + c8 * 8;
    float S0[8], S1[8], Q0[8], Q1[8];
    if (PASS == 1) {
#pragma unroll
      for (int j = 0; j < 8; ++j) {
        S0[j] = 0.f; S1[j] = 0.f;
        Q0[j] = (ks * 8 + j == 2 * rp) ? 1.f : 0.f;
        Q1[j] = (ks * 8 + j == 2 * rp + 1) ? 1.f : 0.f;
      }
    } else {
      const float* si = SIN + (size_t)u * 4096;
      float4 x0 = *(const float4*)(si + (2 * rp) * 64 + ks * 8), x1 = *(const float4*)(si + (2 * rp) * 64 + ks * 8 + 4);
      float4 y0 = *(const float4*)(si + (2 * rp + 1) * 64 + ks * 8), y1 = *(const float4*)(si + (2 * rp + 1) * 64 + ks * 8 + 4);
      S0[0] = x0.x; S0[1] = x0.y; S0[2] = x0.z; S0[3] = x0.w; S0[4] = x1.x; S0[5] = x1.y; S0[6] = x1.z; S0[7] = x1.w;
      S1[0] = y0.x; S1[1] = y0.y; S1[2] = y0.z; S1[3] = y0.w; S1[4] = y1.x; S1[5] = y1.y; S1[6] = y1.z; S1[7] = y1.w;
#pragma unroll
      for (int j = 0; j < 8; ++j) { Q0[j] = 0.f; Q1[j] = 0.f; }
    }
    float kkc[8], kac[8], rkc[8];
    {
      float4 q0 = *(const float4*)(k_k + chb), q1 = *(const float4*)(k_k + chb + 4);
      kkc[0] = q0.x; kkc[1] = q0.y; kkc[2] = q0.z; kkc[3] = q0.w; kkc[4] = q1.x; kkc[5] = q1.y; kkc[6] = q1.z; kkc[7] = q1.w;
      q0 = *(const float4*)(k_a + chb); q1 = *(const float4*)(k_a + chb + 4);
      kac[0] = q0.x; kac[1] = q0.y; kac[2] = q0.z; kac[3] = q0.w; kac[4] = q1.x; kac[5] = q1.y; kac[6] = q1.z; kac[7] = q1.w;
      q0 = *(const float4*)(r_k + chb); q1 = *(const float4*)(r_k + chb + 4);
      rkc[0] = q0.x; rkc[1] = q0.y; rkc[2] = q0.z; rkc[3] = q0.w; rkc[4] = q1.x; rkc[5] = q1.y; rkc[6] = q1.z; rkc[7] = q1.w;
    }
    uint4 pr_r, pr_k, pr_v, pr_a, pr_e, pr_g = make_uint4(0, 0, 0, 0);
    {
      const size_t o0 = (size_t)(tok0 + ss) * 512 + chb;
      pr_r = *(const uint4*)(ops + 0 * OPS_STRIDE + o0);
      pr_k = *(const uint4*)(ops + 1 * OPS_STRIDE + o0);
      pr_v = *(const uint4*)(ops + 2 * OPS_STRIDE + o0);
      pr_a = *(const uint4*)(ops + 3 * OPS_STRIDE + o0);
      pr_e = *(const uint4*)(ops + 4 * OPS_STRIDE + o0);
      if (PASS == 3) pr_g = *(const uint4*)(ops + 5 * OPS_STRIDE + o0);
    }
    for (int sc = 0; sc < 512 / TS; ++sc) {
      const size_t o = (size_t)(tok0 + sc * TS + ss) * 512 + chb;
      float fr[8], fk[8], fv[8], fa[8], fe[8];
      unpack8(pr_r, fr);
      unpack8(pr_k, fk);
      unpack8(pr_v, fv);
      unpack8(pr_a, fa);
      unpack8(pr_e, fe);
      const uint4 graw = pr_g;
      if (sc + 1 < 512 / TS) {
        const size_t o1 = o + (size_t)TS * 512;
        pr_r = *(const uint4*)(ops + 0 * OPS_STRIDE + o1);
        pr_k = *(const uint4*)(ops + 1 * OPS_STRIDE + o1);
        pr_v = *(const uint4*)(ops + 2 * OPS_STRIDE + o1);
        pr_a = *(const uint4*)(ops + 3 * OPS_STRIDE + o1);
        pr_e = *(const uint4*)(ops + 4 * OPS_STRIDE + o1);
        if (PASS == 3) pr_g = *(const uint4*)(ops + 5 * OPS_STRIDE + o1);
      }
      float kk[8], kp[8], ssq = 0.f, bon = 0.f;
#pragma unroll
      for (int j = 0; j < 8; ++j) {
        kk[j] = fk[j] * kkc[j];
        ssq += kk[j] * kk[j];
        kp[j] = fk[j] * (1.f + (fa[j] - 1.f) * kac[j]);
        bon += fr[j] * kp[j] * rkc[j];
      }
      ssq = red8(ssq);
      bon = red8(bon);
      const float inv = 1.f / fmaxf(sqrtf(ssq), 1e-12f);
      float fw[8], fb[8];
#pragma unroll
      for (int j = 0; j < 8; ++j) {
        kk[j] *= inv;
        fb[j] = fa[j] * kk[j];
        fw[j] = __expf(-fe[j]);
      }
      {
        const int so = ss * 64 + c8 * 8;
        *(float4*)(sW + so) = make_float4(fw[0], fw[1], fw[2], fw[3]); *(float4*)(sW + so + 4) = make_float4(fw[4], fw[5], fw[6], fw[7]);
        *(float4*)(sKK + so) = make_float4(kk[0], kk[1], kk[2], kk[3]); *(float4*)(sKK + so + 4) = make_float4(kk[4], kk[5], kk[6], kk[7]);
        *(float4*)(sB + so) = make_float4(fb[0], fb[1], fb[2], fb[3]); *(float4*)(sB + so + 4) = make_float4(fb[4], fb[5], fb[6], fb[7]);
        *(float4*)(sKP + so) = make_float4(kp[0], kp[1], kp[2], kp[3]); *(float4*)(sKP + so + 4) = make_float4(kp[4], kp[5], kp[6], kp[7]);
        *(float4*)(sV + so) = make_float4(fv[0], fv[1], fv[2], fv[3]); *(float4*)(sV + so + 4) = make_float4(fv[4], fv[5], fv[6], fv[7]);
        if (PASS == 3) {
          *(float4*)(sR + so) = make_float4(fr[0], fr[1], fr[2], fr[3]); *(float4*)(sR + so + 4) = make_float4(fr[4], fr[5], fr[6], fr[7]);
        }
      }
      __syncthreads();
      typedef float f2 __attribute__((ext_vector_type(2)));
      f2 SP[8], QP[8];
#pragma unroll
      for (int j = 0; j < 8; ++j) { SP[j] = (f2){S0[j], S1[j]}; QP[j] = (f2){Q0[j], Q1[j]}; }
#pragma unroll 2
      for (int s = 0; s < TS; ++s) {
        const int so = s * 64 + ks * 8;
        float4 t0 = *(const float4*)(sW + so), t1 = *(const float4*)(sW + so + 4);
        const float w[8] = {t0.x, t0.y, t0.z, t0.w, t1.x, t1.y, t1.z, t1.w};
        t0 = *(const float4*)(sKK + so); t1 = *(const float4*)(sKK + so + 4);
        const float kq[8] = {t0.x, t0.y, t0.z, t0.w, t1.x, t1.y, t1.z, t1.w};
        t0 = *(const float4*)(sB + so); t1 = *(const float4*)(sB + so + 4);
        const float bq[8] = {t0.x, t0.y, t0.z, t0.w, t1.x, t1.y, t1.z, t1.w};
        t0 = *(const float4*)(sKP + so); t1 = *(const float4*)(sKP + so + 4);
        const float kpq[8] = {t0.x, t0.y, t0.z, t0.w, t1.x, t1.y, t1.z, t1.w};
        const float2 vraw = *(const float2*)(sV + s * 64 + 2 * rp);
        const f2 vv = (f2){vraw.x, vraw.y};
        f2 sa = SP[0] * kq[0];
#pragma unroll
        for (int j = 1; j < 8; ++j) sa = SP[j] * kq[j] + sa;
        sa = (f2){red8(sa.x), red8(sa.y)};
#pragma unroll
        for (int j = 0; j < 8; ++j) SP[j] = SP[j] * w[j] + (vv * kpq[j] - sa * bq[j]);
        if (PASS == 1) {
          f2 pa = QP[0] * kq[0];
#pragma unroll
          for (int j = 1; j < 8; ++j) pa = QP[j] * kq[j] + pa;
          pa = (f2){red8(pa.x), red8(pa.y)};
#pragma unroll
          for (int j = 0; j < 8; ++j) QP[j] = QP[j] * w[j] - pa * bq[j];
        } else {
          t0 = *(const float4*)(sR + so); t1 = *(const float4*)(sR + so + 4);
          const float rq[8] = {t0.x, t0.y, t0.z, t0.w, t1.x, t1.y, t1.z, t1.w};
          f2 y = SP[0] * rq[0];
#pragma unroll
          for (int j = 1; j < 8; ++j) y = SP[j] * rq[j] + y;
          const float y0 = red8(y.x), y1 = red8(y.y);
          if (ks == 0) *(float2*)(sY + s * 64 + 2 * rp) = make_float2(y0, y1);
        }
      }
#pragma unroll
      for (int j = 0; j < 8; ++j) { S0[j] = SP[j].x; S1[j] = SP[j].y; Q0[j] = QP[j].x; Q1[j] = QP[j].y; }
      __syncthreads();
      if (PASS == 3) {
        const int so = ss * 64 + c8 * 8;
        float4 y0 = *(const float4*)(sY + so), y1 = *(const float4*)(sY + so + 4);
        float y[8] = {y0.x, y0.y, y0.z, y0.w, y1.x, y1.y, y1.z, y1.w};
        float sm = 0.f;
#pragma unroll
        for (int j = 0; j < 8; ++j) sm += y[j];
        const float mean = red8(sm) * (1.f / 64.f);
        float sv = 0.f;
#pragma unroll
        for (int j = 0; j < 8; ++j) { y[j] -= mean; sv += y[j] * y[j]; }
        const float var = red8(sv) * (1.f / 64.f);
        const float rs = rsqrtf(var + 64e-5f);
        float g[8], outv[8];
        unpack8(graw, g);
        float4 l0 = *(const float4*)(lng + chb), l1 = *(const float4*)(lng + chb + 4);
        float4 b0 = *(const float4*)(lnb + chb), b1 = *(const float4*)(lnb + chb + 4);
        float lg[8] = {l0.x, l0.y, l0.z, l0.w, l1.x, l1.y, l1.z, l1.w};
        float lb[8] = {b0.x, b0.y, b0.z, b0.w, b1.x, b1.y, b1.z, b1.w};
#pragma unroll
        for (int j = 0; j < 8; ++j) outv[j] = (y[j] * rs * lg[j] + lb[j] + bon * fv[j]) * g[j];
        if (!(c == 0 && sc == 0 && ss == 0)) *(uint4*)(yrw + o) = pack8(outv);
      }
    }
    if (PASS == 1) {
      float* pl = PL + (size_t)u * 8192;
      float* Pm = pl;
      float* Lm = pl + 4096;
      *(float4*)(Pm + (2 * rp) * 64 + ks * 8) = make_float4(Q0[0], Q0[1], Q0[2], Q0[3]);
      *(float4*)(Pm + (2 * rp) * 64 + ks * 8 + 4) = make_float4(Q0[4], Q0[5], Q0[6], Q0[7]);
      *(float4*)(Pm + (2 * rp + 1) * 64 + ks * 8) = make_float4(Q1[0], Q1[1], Q1[2], Q1[3]);
      *(float4*)(Pm + (2 * rp + 1) * 64 + ks * 8 + 4) = make_float4(Q1[4], Q1[5], Q1[6], Q1[7]);
      *(float4*)(Lm + (2 * rp) * 64 + ks * 8) = make_float4(S0[0], S0[1], S0[2], S0[3]);
      *(float4*)(Lm + (2 * rp) * 64 + ks * 8 + 4) = make_float4(S0[4], S0[5], S0[6], S0[7]);
      *(float4*)(Lm + (2 * rp + 1) * 64 + ks * 8) = make_float4(S1[0], S1[1], S1[2], S1[3]);
      *(float4*)(Lm + (2 * rp + 1) * 64 + ks * 8 + 4) = make_float4(S1[4], S1[5], S1[6], S1[7]);
    }
  }
}

DEV void phase_scanprop(const Params& p, float* smf, int bid, int nb) {
  const int tid = my_tid();
  const float* PL = (const float*)(p.ws + OFF_BIG + B_PL);
  float* SIN = (float*)(p.ws + OFF_BIG + B_SINIT);
  float* sS = smf;
  float* sP = smf + 4096;
  const int i = tid >> 3, k8 = tid & 7;
  for (int bh = bid; bh < 32; bh += nb) {
    float cur[8];
#pragma unroll
    for (int j = 0; j < 8; ++j) cur[j] = 0.f;
    const float* pl0 = PL + (size_t)(bh * 16) * 8192;
    float4 np0 = *(const float4*)(pl0 + tid * 8), np1 = *(const float4*)(pl0 + tid * 8 + 4);
    float4 nl0 = *(const float4*)(pl0 + 4096 + i * 64 + k8 * 8), nl1 = *(const float4*)(pl0 + 4096 + i * 64 + k8 * 8 + 4);
    for (int c = 0; c < 16; ++c) {
      const int u = bh * 16 + c;
      float* so = SIN + (size_t)u * 4096 + i * 64 + k8 * 8;
      *(float4*)so = make_float4(cur[0], cur[1], cur[2], cur[3]);
      *(float4*)(so + 4) = make_float4(cur[4], cur[5], cur[6], cur[7]);
      if (c == 15) break;
      *(float4*)(sS + i * 64 + k8 * 8) = make_float4(cur[0], cur[1], cur[2], cur[3]);
      *(float4*)(sS + i * 64 + k8 * 8 + 4) = make_float4(cur[4], cur[5], cur[6], cur[7]);
      *(float4*)(sP + tid * 8) = np0;
      *(float4*)(sP + tid * 8 + 4) = np1;
      float nw[8] = {nl0.x, nl0.y, nl0.z, nl0.w, nl1.x, nl1.y, nl1.z, nl1.w};
      __syncthreads();
      if (c + 1 < 15) {
        const float* pl = PL + (size_t)(u + 1) * 8192;
        np0 = *(const float4*)(pl + tid * 8); np1 = *(const float4*)(pl + tid * 8 + 4);
        nl0 = *(const float4*)(pl + 4096 + i * 64 + k8 * 8); nl1 = *(const float4*)(pl + 4096 + i * 64 + k8 * 8 + 4);
      }
#pragma unroll 8
      for (int j = 0; j < 64; ++j) {
        const float sij = sS[i * 64 + j];
        float4 p0 = *(const float4*)(sP + j * 64 + k8 * 8), p1 = *(const float4*)(sP + j * 64 + k8 * 8 + 4);
        nw[0] += sij * p0.x; nw[1] += sij * p0.y; nw[2] += sij * p0.z; nw[3] += sij * p0.w;
        nw[4] += sij * p1.x; nw[5] += sij * p1.y; nw[6] += sij * p1.z; nw[7] += sij * p1.w;
      }
#pragma unroll
      for (int j = 0; j < 8; ++j) cur[j] = nw[j];
      __syncthreads();
    }
  }
}

DEV float ret_log2gamma(int h) { return log2f(1.0f - exp2f(-5.0f - (float)h)); }

DEV void stage_rot(const u16* src, size_t ld, const float* rc, const float* rs, int pos0, u16* dst, float sc, float l2g, int rowmode) {
  const int tid = my_tid();
  const int row = tid >> 2, d0 = (tid & 3) * 8;
  float lo[8], hi[8], olo[8], ohi[8];
  unpack8(*(const uint4*)(src + (size_t)row * ld + d0), lo);
  unpack8(*(const uint4*)(src + (size_t)row * ld + d0 + 32), hi);
  const float* cp = rc + (size_t)(pos0 + row) * 32 + d0;
  const float* sp = rs + (size_t)(pos0 + row) * 32 + d0;
  float4 c0 = *(const float4*)cp, c1 = *(const float4*)(cp + 4);
  float4 s0 = *(const float4*)sp, s1 = *(const float4*)(sp + 4);
  float cc[8] = {c0.x, c0.y, c0.z, c0.w, c1.x, c1.y, c1.z, c1.w};
  float sn[8] = {s0.x, s0.y, s0.z, s0.w, s1.x, s1.y, s1.z, s1.w};
  float rsc = sc;
  if (rowmode == 1) rsc *= exp2f((float)(row + 1) * l2g);
  if (rowmode == 2) rsc *= exp2f((float)(127 - row) * l2g);
#pragma unroll
  for (int j = 0; j < 8; ++j) {
    olo[j] = (lo[j] * cc[j] - hi[j] * sn[j]) * rsc;
    ohi[j] = (hi[j] * cc[j] + lo[j] * sn[j]) * rsc;
  }
  *(uint4*)(dst + row * 72 + d0) = pack8(olo);
  *(uint4*)(dst + row * 72 + d0 + 32) = pack8(ohi);
}
DEV void stage_rot_T(const u16* src, size_t ld, const float* rc, const float* rs, int pos0, u16* dst, float sc, float l2g) {
  const int tid = my_tid();
  const int row = tid >> 2, d0 = (tid & 3) * 8;
  float lo[8], hi[8];
  unpack8(*(const uint4*)(src + (size_t)row * ld + d0), lo);
  unpack8(*(const uint4*)(src + (size_t)row * ld + d0 + 32), hi);
  const float* cp = rc + (size_t)(pos0 + row) * 32 + d0;
  const float* sp = rs + (size_t)(pos0 + row) * 32 + d0;
  float4 c0 = *(const float4*)cp, c1 = *(const float4*)(cp + 4);
  float4 s0 = *(const float4*)sp, s1 = *(const float4*)(sp + 4);
  float cc[8] = {c0.x, c0.y, c0.z, c0.w, c1.x, c1.y, c1.z, c1.w};
  float sn[8] = {s0.x, s0.y, s0.z, s0.w, s1.x, s1.y, s1.z, s1.w};
  const float rsc = sc * exp2f((float)(127 - row) * l2g);
#pragma unroll
  for (int j = 0; j < 8; ++j) {
    dst[(d0 + j) * 136 + row] = f2bf((lo[j] * cc[j] - hi[j] * sn[j]) * rsc);
    dst[(d0 + j + 32) * 136 + row] = f2bf((hi[j] * cc[j] + lo[j] * sn[j]) * rsc);
  }
}
DEV void stage_vT(const u16* src, size_t ld, u16* dst) {
  const int tid = my_tid();
  const int row = tid >> 2, d0 = (tid & 3) * 32;
#pragma unroll
  for (int c = 0; c < 4; ++c) {
    uint4 v = *(const uint4*)(src + (size_t)row * ld + d0 + c * 8);
    unsigned w[4] = {v.x, v.y, v.z, v.w};
#pragma unroll
    for (int j = 0; j < 4; ++j) {
      dst[(d0 + c * 8 + 2 * j) * 136 + row] = (u16)(w[j] & 0xffffu);
      dst[(d0 + c * 8 + 2 * j + 1) * 136 + row] = (u16)(w[j] >> 16);
    }
  }
}

DEV void ret_kv_unit(const Params& p, int u, u16* smem) {
  const int tid = my_tid(), lane = tid & 63, wave = tid >> 6;
  const u16* prs = (const u16*)(p.ws + OFF_BIG + B_PRS);
  float* KV = (float*)(p.ws + OFF_BIG + B_KV);
  const float* rc = (const float*)(p.ws + OFF_ROPE);
  const float* rs = rc + SEQ * 32;
  const int n = u & 63, h = (u >> 6) & 3, b = u >> 8;
  const size_t t0 = (size_t)b * SEQ + n * 128;
  const float l2g = ret_log2gamma(h);
  u16* KT = smem;
  u16* VT = smem + 64 * 136;
  stage_rot_T(prs + t0 * 2560 + 256 + h * 64, 2560, rc, rs, n * 128, KT, 0.125f, l2g);
  stage_vT(prs + t0 * 2560 + 512 + h * 128, 2560, VT);
  __syncthreads();
  const int mi = wave >> 1, nj = wave & 1;
  f32x16 acc;
#pragma unroll
  for (int e = 0; e < 16; ++e) acc[e] = 0.f;
#pragma unroll
  for (int ks = 0; ks < 8; ++ks) {
    bf16x8 a = *(const bf16x8*)(VT + (mi * 32 + (lane & 31)) * 136 + ks * 16 + (lane >> 5) * 8);
    bf16x8 bb = *(const bf16x8*)(KT + (nj * 32 + (lane & 31)) * 136 + ks * 16 + (lane >> 5) * 8);
    acc = __builtin_amdgcn_mfma_f32_32x32x16_bf16(a, bb, acc, 0, 0, 0);
  }
  float* kv = KV + (size_t)u * 8192;
#pragma unroll
  for (int e = 0; e < 16; ++e) {
    int dv = mi * 32 + (e & 3) + 8 * (e >> 2) + 4 * (lane >> 5);
    int dk = nj * 32 + (lane & 31);
    kv[dv * 64 + dk] = acc[e];
  }
  __syncthreads();
}

DEV void sgu_unit(const Params& p, int l, int u, u16* smem) {
  const int tid = my_tid(), lane = tid & 63, wave = tid >> 6, wm = wave >> 1, wn = wave & 1;
  const u16* prs = (const u16*)(p.ws + OFF_BIG + B_PRS);
  u16* ysg = (u16*)(p.ws + OFF_BIG + B_YSG);
  const u16* sgw = (const u16*)(p.ws + OFF_W + (size_t)l * LW_BYTES + W_SGW);
  const float* lng = p.in[14] + l * 512;
  const float* lnb = p.in[15] + l * 512;
  const float* sgb = p.in[17] + l * 512;
  const size_t t0 = (size_t)u * 128;
  u16* VT = smem;
  u16* WT = smem + 128 * 136;
  float* st = (float*)(smem + 2 * 128 * 136);
  float* OS = st + 256;
  const int tok = tid >> 2, q = tid & 3;
  const u16* vrow = prs + (t0 + tok) * 2560 + 1536 + 512;
  {
    float s = 0.f, s2 = 0.f;
#pragma unroll 4
    for (int c = 0; c < 16; ++c) {
      float f[8];
      unpack8(*(const uint4*)(vrow + q * 128 + c * 8), f);
#pragma unroll
      for (int j = 0; j < 8; ++j) { float gl = geluf_(f[j]); s += gl; s2 += gl * gl; }
    }
    s = red4(s); s2 = red4(s2);
    const float mean = s * (1.f / 512.f);
    const float var = fmaxf(s2 * (1.f / 512.f) - mean * mean, 0.f);
    if (q == 0) { st[tok] = mean; st[128 + tok] = rsqrtf(var + 1e-6f); }
  }
  __syncthreads();
  const float mean = st[tok], rstd = st[128 + tok];
  for (int g = 0; g < 4; ++g) {
#pragma unroll
    for (int c = 0; c < 4; ++c) {
      const int d = q * 32 + c * 8;
      float f[8];
      unpack8(*(const uint4*)(vrow + g * 128 + d), f);
      float4 g0 = *(const float4*)(lng + g * 128 + d), g1 = *(const float4*)(lng + g * 128 + d + 4);
      float4 b0 = *(const float4*)(lnb + g * 128 + d), b1 = *(const float4*)(lnb + g * 128 + d + 4);
      float gg[8] = {g0.x, g0.y, g0.z, g0.w, g1.x, g1.y, g1.z, g1.w};
      float bb[8] = {b0.x, b0.y, b0.z, b0.w, b1.x, b1.y, b1.z, b1.w};
#pragma unroll
      for (int j = 0; j < 8; ++j) VT[(d + j) * 136 + tok] = f2bf((geluf_(f[j]) - mean) * rstd * gg[j] + bb[j]);
      *(uint4*)(WT + tok * 136 + d) = *(const uint4*)(sgw + (size_t)g * 16384 + tok * 128 + d);
    }
    __syncthreads();
    f32x16 acc[2];
#pragma unroll
    for (int j = 0; j < 2; ++j)
#pragma unroll
      for (int e = 0; e < 16; ++e) acc[j][e] = 0.f;
#pragma unroll
    for (int ks = 0; ks < 8; ++ks) {
      bf16x8 a = *(const bf16x8*)(WT + (wm * 32 + (lane & 31)) * 136 + ks * 16 + (lane >> 5) * 8);
#pragma unroll
      for (int j = 0; j < 2; ++j) {
        bf16x8 bb = *(const bf16x8*)(VT + (wn * 64 + j * 32 + (lane & 31)) * 136 + ks * 16 + (lane >> 5) * 8);
        acc[j] = __builtin_amdgcn_mfma_f32_32x32x16_bf16(a, bb, acc[j], 0, 0, 0);
      }
    }
#pragma unroll
    for (int e = 0; e < 16; ++e) {
      const int i = ACC_ROW(1, 0, e);
      const float bias = sgb[g * 128 + i];
#pragma unroll
      for (int j = 0; j < 2; ++j) OS[i * 132 + ACC_COL(j)] = acc[j][e] + bias;
    }
    __syncthreads();
#pragma unroll
    for (int k = 0; k < 4; ++k) {
      const int c = tid + NTHR * k;
      const int i = c >> 4, d = (c & 15) * 8;
      float uu[8], o[8];
      unpack8(*(const uint4*)(prs + (t0 + i) * 2560 + 1536 + g * 128 + d), uu);
      const float4 m0 = *(const float4*)(OS + i * 132 + d), m1 = *(const float4*)(OS + i * 132 + d + 4);
      const float mm[8] = {m0.x, m0.y, m0.z, m0.w, m1.x, m1.y, m1.z, m1.w};
#pragma unroll
      for (int q = 0; q < 8; ++q) o[q] = geluf_(uu[q]) * mm[q];
      *(uint4*)(ysg + (t0 + i) * 512 + g * 128 + d) = pack8(o);
    }
    __syncthreads();
  }
}

DEV void phase_retprefix(const Params& p, int bid, int nb) {
  float* KV = (float*)(p.ws + OFF_BIG + B_KV);
  for (int gid = bid * NTHR + my_tid(); gid < 16 * 8192; gid += nb * NTHR) {
    const int bh = gid >> 13, e = gid & 8191;
    const int h = bh & 3;
    const float cd = exp2f(128.f * ret_log2gamma(h));
    float R = 0.f;
    float* ptr = KV + (size_t)bh * 64 * 8192 + e;
    for (int n = 0; n < 64; ++n) {
      float kv = ptr[(size_t)n * 8192];
      ptr[(size_t)n * 8192] = R;
      R = R * cd + kv;
    }
  }
}

DEV void ret_out_unit(const Params& p, int u, u16* smem) {
  const int tid = my_tid(), lane = tid & 63, wave = tid >> 6, wm = wave >> 1, wn = wave & 1;
  const u16* prs = (const u16*)(p.ws + OFF_BIG + B_PRS);
  const float* KV = (const float*)(p.ws + OFF_BIG + B_KV);
  u16* yret = (u16*)(p.ws + OFF_BIG + B_YRET);
  const float* rc = (const float*)(p.ws + OFF_ROPE);
  const float* rs = rc + SEQ * 32;
  const int n = u & 63, h = (u >> 6) & 3, b = u >> 8;
  const size_t t0 = (size_t)b * SEQ + n * 128;
  const float l2g = ret_log2gamma(h);
  u16* Q = smem;
  u16* Kr = Q + 128 * 72;
  u16* VT = Kr + 128 * 72;
  u16* Qd = VT + 128 * 136;
  u16* RT = Qd + 128 * 72;
  u16* SP = RT + 128 * 72;
  float* OT = (float*)smem;
  stage_rot(prs + t0 * 2560 + h * 64, 2560, rc, rs, n * 128, Q, 1.0f, l2g, 0);
  stage_rot(prs + t0 * 2560 + h * 64, 2560, rc, rs, n * 128, Qd, 1.0f, l2g, 1);
  stage_rot(prs + t0 * 2560 + 256 + h * 64, 2560, rc, rs, n * 128, Kr, 0.125f, l2g, 0);
  stage_vT(prs + t0 * 2560 + 512 + h * 128, 2560, VT);
  {
    const int dv = tid >> 2, q = tid & 3;
    const float* src = KV + (size_t)u * 8192 + dv * 64 + q * 16;
    float4 a0 = *(const float4*)src, a1 = *(const float4*)(src + 4), a2 = *(const float4*)(src + 8), a3 = *(const float4*)(src + 12);
    float f0[8] = {a0.x, a0.y, a0.z, a0.w, a1.x, a1.y, a1.z, a1.w};
    float f1[8] = {a2.x, a2.y, a2.z, a2.w, a3.x, a3.y, a3.z, a3.w};
    *(uint4*)(RT + dv * 72 + q * 16) = pack8(f0);
    *(uint4*)(RT + dv * 72 + q * 16 + 8) = pack8(f1);
  }
  __syncthreads();
  f32x16 acc[2];
#pragma unroll
  for (int j = 0; j < 2; ++j)
#pragma unroll
    for (int e = 0; e < 16; ++e) acc[j][e] = 0.f;
#pragma unroll
  for (int ks = 0; ks < 4; ++ks) {
    bf16x8 a = *(const bf16x8*)(Q + (wm * 32 + (lane & 31)) * 72 + ks * 16 + (lane >> 5) * 8);
#pragma unroll
    for (int j = 0; j < 2; ++j) {
      bf16x8 bb = *(const bf16x8*)(Kr + (wn * 64 + j * 32 + (lane & 31)) * 72 + ks * 16 + (lane >> 5) * 8);
      acc[j] = __builtin_amdgcn_mfma_f32_32x32x16_bf16(a, bb, acc[j], 0, 0, 0);
    }
  }
#pragma unroll
  for (int j = 0; j < 2; ++j)
#pragma unroll
    for (int e = 0; e < 16; ++e) {
      const int i = ACC_ROW(1, 0, e), jj = ACC_COL(j);
      const float dcy = (i >= jj) ? exp2f((float)(i - jj) * l2g) : 0.f;
      SP[i * 136 + jj] = f2bf(acc[j][e] * dcy);
    }
  __syncthreads();
#pragma unroll
  for (int j = 0; j < 2; ++j)
#pragma unroll
    for (int e = 0; e < 16; ++e) acc[j][e] = 0.f;
#pragma unroll
  for (int ks = 0; ks < 8; ++ks) {
    bf16x8 a = *(const bf16x8*)(SP + (wm * 32 + (lane & 31)) * 136 + ks * 16 + (lane >> 5) * 8);
#pragma unroll
    for (int j = 0; j < 2; ++j) {
      bf16x8 bb = *(const bf16x8*)(VT + (wn * 64 + j * 32 + (lane & 31)) * 136 + ks * 16 + (lane >> 5) * 8);
      acc[j] = __builtin_amdgcn_mfma_f32_32x32x16_bf16(a, bb, acc[j], 0, 0, 0);
    }
  }
#pragma unroll
  for (int ks = 0; ks < 4; ++ks) {
    bf16x8 a = *(const bf16x8*)(Qd + (wm * 32 + (lane & 31)) * 72 + ks * 16 + (lane >> 5) * 8);
#pragma unroll
    for (int j = 0; j < 2; ++j) {
      bf16x8 bb = *(const bf16x8*)(RT + (wn * 64 + j * 32 + (lane & 31)) * 72 + ks * 16 + (lane >> 5) * 8);
      acc[j] = __builtin_amdgcn_mfma_f32_32x32x16_bf16(a, bb, acc[j], 0, 0, 0);
    }
  }
  __syncthreads();
#pragma unroll
  for (int j = 0; j < 2; ++j)
#pragma unroll
    for (int e = 0; e < 16; ++e) OT[ACC_ROW(1, 0, e) * 132 + ACC_COL(j)] = acc[j][e];
  __syncthreads();
  {
    const int row = tid >> 2, q = tid & 3;
    float o[32];
    float ssq = 0.f;
#pragma unroll
    for (int c = 0; c < 8; ++c) {
      float4 v = *(const float4*)(OT + row * 132 + q * 32 + c * 4);
      o[c * 4] = v.x; o[c * 4 + 1] = v.y; o[c * 4 + 2] = v.z; o[c * 4 + 3] = v.w;
      ssq += v.x * v.x + v.y * v.y + v.z * v.z + v.w * v.w;
    }
    ssq = red4(ssq);
    const float r = rsqrtf(ssq * (1.f / 128.f) + 1e-6f);
    const u16* gp = prs + (t0 + row) * 2560 + 1024 + h * 128 + q * 32;
    u16* op = yret + (t0 + row) * 512 + h * 128 + q * 32;
#pragma unroll
    for (int c = 0; c < 4; ++c) {
      float g[8], ov[8];
      unpack8(*(const uint4*)(gp + c * 8), g);
#pragma unroll
      for (int j = 0; j < 8; ++j) ov[j] = o[c * 8 + j] * r * siluf_(g[j]);
      if (!(n == 0 && row == 0)) *(uint4*)(op + c * 8) = pack8(ov);
    }
  }
  __syncthreads();
}

DEV void phase_merge(const Params& p, int l, const float* rstd, u16* smem, int bid, int nb) {
  const int tid = my_tid(), lane = tid & 63, wave = tid >> 6, wm = wave >> 1, wn = wave & 1;
  const u16* xb = (const u16*)(p.ws + OFF_XB);
  unsigned char* W = p.ws + OFF_W + (size_t)l * LW_BYTES;
  const u16* win = (const u16*)(W + W_IN);
  const u16* wbr = (const u16*)(W + W_BR);
  u16* M = (u16*)(p.ws + OFF_BIG + B_M);
  const int MTL = NTOK / 128, NTL = DM / 128;
  for (int t = vbid(bid, nb); t < MTL * NTL; t += nb) {
    int m, n;
    tile_map(t, MTL, NTL, m, n);
    f32x16 ms[1][2];
#pragma unroll
    for (int j = 0; j < 2; ++j)
#pragma unroll
      for (int e = 0; e < 16; ++e) ms[0][j][e] = 0.f;
    for (int g = 0; g < 3; ++g) {
      const u16* yg = (const u16*)(p.ws + OFF_BIG + (g == 0 ? B_YRW : (g == 1 ? B_YRET : B_YSG)));
      f32x16 ab[1][2], ag[1][2];
#pragma unroll
      for (int j = 0; j < 2; ++j)
#pragma unroll
        for (int e = 0; e < 16; ++e) { ab[0][j][e] = 0.f; ag[0][j][e] = 0.f; }
      gemm_tile<1>(ab, yg, 512, m * 128, -(1 << 30), NTOK - 1, wbr + ((size_t)g * DM + n * 128) * 512, 512, 512, smem);
      gemm_tile<1>(ag, xb, DM, m * 128, -(1 << 30), NTOK - 1, win + ((size_t)(4352 + g * DM + n * 128)) * DM, DM, DM, smem);
#pragma unroll
      for (int e = 0; e < 16; ++e) {
        const float rs = rstd_of(rstd, m * 128 + ACC_ROW(1, 0, e));
#pragma unroll
        for (int j = 0; j < 2; ++j) ms[0][j][e] += sigmoidf_(ag[0][j][e] * rs) * ab[0][j][e];
        if ((e & 3) == 3) __builtin_amdgcn_sched_barrier(0);
      }
    }
#pragma unroll
    for (int e = 0; e < 16; ++e) {
      const size_t row = m * 128 + ACC_ROW(1, 0, e);
#pragma unroll
      for (int j = 0; j < 2; ++j) M[row * DM + n * 128 + ACC_COL(j)] = f2bf(ms[0][j][e]);
    }
  }
}

DEV void phase_resgemm(const u16* A, int K, const u16* wt, const float* xin, float* xout, u16* xbo, float* ssq, u16* smem, int bid, int nb) {
  const int tid = my_tid(), lane = tid & 63, wave = tid >> 6, wm = wave >> 1, wn = wave & 1;
  const int MTL = NTOK / 256, NTL = DM / 256;
  for (int t = vbid(bid, nb); t < MTL * NTL; t += nb) {
    int m, n;
    tile_map(t, MTL, NTL, m, n);
    f32x16 acc[2][4];
    ZERO_BIG(acc);
    gemm_big(acc, A, K, m * 256, -(1 << 30), NTOK - 1, wt + (size_t)n * 256 * K, K, K, smem);
    float* F = (float*)smem;
#pragma unroll
    for (int i = 0; i < 2; ++i) {
#pragma unroll
      for (int e = 0; e < 16; ++e) {
        const int lr = wm * 32 + (e & 3) + 8 * (e >> 2) + 4 * (lane >> 5);
#pragma unroll
        for (int j = 0; j < 4; ++j) F[lr * 260 + BIG_COL(j)] = acc[i][j][e];
      }
      __syncthreads();
#pragma unroll 4
      for (int k = 0; k < 16; ++k) {
        const int c = tid + NTHR * k;
        const int lr = c >> 6, cc = c & 63;
        const size_t row = (size_t)m * 256 + (lr >> 5) * 64 + i * 32 + (lr & 31);
        const size_t o = row * DM + n * 256 + cc * 4;
        const float4 v = *(const float4*)(F + lr * 260 + cc * 4);
        const float4 x = *(const float4*)(xin + o);
        const float4 y = make_float4(x.x + v.x, x.y + v.y, x.z + v.z, x.w + v.w);
        *(float4*)(xout + o) = y;
        if (xbo) {
          *(uint2*)(xbo + o) = make_uint2(pack2(y.x, y.y), pack2(y.z, y.w));
          const float sq = wave_sum(y.x * y.x + y.y * y.y + y.z * y.z + y.w * y.w);
          if (lane == 0) atomicAdd(ssq + row, sq);
        }
      }
      __syncthreads();
    }
  }
}

DEV void phase_ffnup(const Params& p, int l, const float* rstd, u16* smem, int bid, int nb) {
  const int tid = my_tid(), lane = tid & 63, wave = tid >> 6, wm = wave >> 1, wn = wave & 1;
  const u16* xb = (const u16*)(p.ws + OFF_XB);
  const u16* wup = (const u16*)(p.ws + OFF_W + (size_t)l * LW_BYTES + W_UP);
  u16* act = (u16*)(p.ws + OFF_BIG + B_ACT);
  const float* cw = p.in[22] + (size_t)l * 3 * 2 * DFF;
  const float* cb = p.in[23] + (size_t)l * 2 * DFF;
  u16* U = smem;
  const int MPB = 33;
  const int MTL = 4 * MPB, NTL = DFF / 128;
  for (int t = vbid(bid, nb); t < MTL * NTL; t += nb) {
    int m, n;
    tile_map(t, MTL, NTL, m, n);
    const int b = m / MPB, mi = m % MPB;
    const int tokbase = b * SEQ + mi * 254 - 2;
    f32x16 acc[2][4];
    ZERO_BIG(acc);
    gemm_big(acc, xb, DM, tokbase, b * SEQ, NTOK - 1, wup + (size_t)n * 256 * DM, DM, DM, smem);
#pragma unroll
    for (int i = 0; i < 2; ++i)
#pragma unroll
      for (int e = 0; e < 16; ++e) {
        const int r = BIG_ROW(i, e);
        int tk = tokbase + r; tk = tk < 0 ? 0 : (tk > NTOK - 1 ? NTOK - 1 : tk);
        const float rs = rstd_of(rstd, tk);
#pragma unroll
        for (int j = 0; j < 4; ++j) U[r * 264 + BIG_COL(j)] = f2bf(acc[i][j][e] * rs);
      }
    __syncthreads();
    {
      const int c = (tid & 63) * 2, rg = tid >> 6;
      const int gcol = n * 128 + c, vcol = DFF + n * 128 + c;
      float wg0[2], wg1[2], wg2[2], bg[2], wv0[2], wv1[2], wv2[2], bv[2];
#pragma unroll
      for (int q = 0; q < 2; ++q) {
        wg0[q] = cw[gcol + q]; wg1[q] = cw[2 * DFF + gcol + q]; wg2[q] = cw[4 * DFF + gcol + q]; bg[q] = cb[gcol + q];
        wv0[q] = cw[vcol + q]; wv1[q] = cw[2 * DFF + vcol + q]; wv2[q] = cw[4 * DFF + vcol + q]; bv[q] = cb[vcol + q];
      }
      const int r0 = 2 + rg * 32;
      const int rend = (r0 + 32 > 256) ? 256 : r0 + 32;
      unsigned t;
      float g2[2], g1[2], v2[2], v1[2];
      t = *(const unsigned*)(U + (r0 - 2) * 264 + c); g2[0] = __uint_as_float(t << 16); g2[1] = __uint_as_float(t & 0xffff0000u);
      t = *(const unsigned*)(U + (r0 - 1) * 264 + c); g1[0] = __uint_as_float(t << 16); g1[1] = __uint_as_float(t & 0xffff0000u);
      t = *(const unsigned*)(U + (r0 - 2) * 264 + 128 + c); v2[0] = __uint_as_float(t << 16); v2[1] = __uint_as_float(t & 0xffff0000u);
      t = *(const unsigned*)(U + (r0 - 1) * 264 + 128 + c); v1[0] = __uint_as_float(t << 16); v1[1] = __uint_as_float(t & 0xffff0000u);
      const int tend = (b + 1) * SEQ;
      for (int r = r0; r < rend; ++r) {
        const unsigned ug = *(const unsigned*)(U + r * 264 + c), uv = *(const unsigned*)(U + r * 264 + 128 + c);
        const float g0[2] = {__uint_as_float(ug << 16), __uint_as_float(ug & 0xffff0000u)};
        const float v0[2] = {__uint_as_float(uv << 16), __uint_as_float(uv & 0xffff0000u)};
        float o[2];
#pragma unroll
        for (int q = 0; q < 2; ++q) {
          const float cg = bg[q] + wg0[q] * g2[q] + wg1[q] * g1[q] + wg2[q] * g0[q];
          const float cv = bv[q] + wv0[q] * v2[q] + wv1[q] * v1[q] + wv2[q] * v0[q];
          o[q] = siluf_(cg) * cv;
          g2[q] = g1[q]; g1[q] = g0[q]; v2[q] = v1[q]; v1[q] = v0[q];
        }
        const int tk = tokbase + r;
        if (tk < tend) *(unsigned*)(act + (size_t)tk * DFF + n * 128 + c) = pack2(o[0], o[1]);
      }
    }
    __syncthreads();
  }
}

#define PF_COLS 3328
DEV void first_tok_proj(const Params& p, int l, const float* xcur, float* smf, int bid, int nb) {
  float* PF = (float*)(p.ws + OFF_PF);
  const float* w = p.in[2] + (size_t)l * DM * INC;
  const float* g1 = p.in[1] + l * DM;
  const int tid = my_tid(), lane = tid & 63, wave = tid >> 6;
  for (int task = bid; task < 4 * 52; task += nb) {
    const int b = task / 52, c = (task % 52) * 64 + lane;
    const float* xr = xcur + (size_t)b * SEQ * DM;
    float acc = 0.f, ss = 0.f;
    const int k0 = wave * 128;
#pragma unroll 16
    for (int k = k0; k < k0 + 128; ++k) {
      const float xv = xr[k];
      ss += xv * xv;
      acc += xv * g1[k] * w[(size_t)k * INC + c];
    }
    smf[wave * 64 + lane] = acc;
    smf[512 + wave * 64 + lane] = ss;
    __syncthreads();
    if (wave == 0) {
      float ta = 0.f, ts = 0.f;
#pragma unroll
      for (int q = 0; q < 8; ++q) { ta += smf[q * 64 + lane]; ts += smf[512 + q * 64 + lane]; }
      PF[b * PF_COLS + c] = ta * rsqrtf(ts * (1.0f / DM) + 1e-6f);
    }
    __syncthreads();
  }
}
DEV void first_tok_fix(const Params& p, int l, float* smf, int bid, int nb) {
  const int tid = my_tid(), lane = tid & 63;
  const float* PF = (const float*)(p.ws + OFF_PF);
  u16* yrw = (u16*)(p.ws + OFF_BIG + B_YRW);
  u16* yret = (u16*)(p.ws + OFF_BIG + B_YRET);
  const float* mu = p.in[3] + l * 1792;
  for (int task = bid; task < 48; task += nb) {
    const int b = task / 12, hh = task % 12;
    const float* pf = PF + b * PF_COLS;
    const size_t t0 = (size_t)b * SEQ;
    __syncthreads();
    if (hh < 8) {
      const int h = hh;
      if (tid < 64) smf[tid] = pf[1600 + tid] * (1.f - mu[1600 + tid]);
      if (tid < 128) smf[64 + tid] = sigmoidf_(pf[1664 + tid] * (1.f - mu[1664 + tid]));
      __syncthreads();
      if (tid < 64) {
        const int ch = h * 64 + tid;
        const float r = pf[ch] * (1.f - mu[ch]);
        const float k = pf[512 + ch] * (1.f - mu[512 + ch]);
        const float v = pf[1024 + ch] * (1.f - mu[1024 + ch]);
        const float* aup = p.in[7] + (size_t)l * 64 * 512;
        const float* gup = p.in[8] + (size_t)l * 128 * 512;
        float al = p.in[6][l * 512 + ch], g = 0.f;
        for (int j = 0; j < 64; ++j) al += smf[j] * aup[j * 512 + ch];
        for (int j = 0; j < 128; ++j) g += smf[64 + j] * gup[j * 512 + ch];
        const float a = sigmoidf_(al);
        const float kp = k * (1.f + (a - 1.f) * p.in[10][l * 512 + ch]);
        const float s = wave_sum(kp * r);
        const float bon = wave_sum(r * kp * p.in[11][l * 512 + ch]);
        const float y = v * s;
        const float mean = wave_sum(y) * (1.f / 64.f);
        const float d = y - mean;
        const float var = wave_sum(d * d) * (1.f / 64.f);
        const float o = (d * rsqrtf(var + 64e-5f) * p.in[12][l * 512 + ch] + p.in[13][l * 512 + ch] + bon * v) * g;
        yrw[t0 * 512 + ch] = f2bf(o);
      }
    } else {
      const int h = hh - 8;
      float part = 0.f;
      if (tid < 64) part = pf[1792 + h * 64 + tid] * pf[1792 + 256 + h * 64 + tid];
      if (tid < 64) { part = wave_sum(part); if (lane == 0) smf[0] = part * 0.125f; }
      __syncthreads();
      const float s = smf[0];
      float y = 0.f;
      if (tid < 128) y = s * pf[1792 + 512 + h * 128 + tid];
      float q = wave_sum(y * y);
      if (tid < 128 && lane == 0) smf[1 + (tid >> 6)] = q;
      __syncthreads();
      if (tid < 128) {
        const float ms = (smf[1] + smf[2]) * (1.f / 128.f);
        const float g = pf[1792 + 1024 + h * 128 + tid];
        yret[t0 * 512 + h * 128 + tid] = f2bf(y * rsqrtf(ms + 1e-6f) * siluf_(g));
      }
    }
  }
}

namespace pg8 {
#define PG8_LAS __attribute__((address_space(3)))
typedef unsigned short bf16_t;
typedef short bf16x8 __attribute__((ext_vector_type(8)));
typedef float f32x4 __attribute__((ext_vector_type(4)));
typedef unsigned u32x4 __attribute__((ext_vector_type(4)));
constexpr int BM = 256, BK = 64, HALF = 128, HTB = HALF * BK * 2  , STAGE_BYTES = 8 * HTB, NXCD = 8, WGM = 8;

__host__ __device__ __forceinline__ int lds_byte(int r, int c) { const int st = (r >> 4) * 2 + (c >> 5), rr = r & 15, cc = c & 31, ob = rr * 64 + cc * 2; return st * 1024 + (ob ^ (((ob >> 9) & 1) << 5)); }
__host__ __device__ __forceinline__ void stage_rc(int b, int& R, int& C) { const int st = b / 1024, sb = b % 1024, swz = sb ^ (((sb >> 9) & 1) << 5); R = (st >> 1) * 16 + swz / 64; C = (st & 1) * 32 + (swz % 64) / 2; }
__host__ __device__ __forceinline__ int perm32(int rho) { const int n = rho >> 4, i = rho & 15; return 8 * (i >> 2) + 4 * n + (i & 3); }

struct Unit { int pm, pn, arow, slot; };
struct Gemm { const bf16_t* A; const bf16_t* Bt; int M, N, K; };

struct StaticOrder {
    int nM, nN, nwg, G, c;
    __host__ __device__ void init(int M, int N, int G_, int c_) { nM = M / BM; nN = N / BM; nwg = nM * nN; G = G_; c = c_; }
    __host__ __device__ bool next(int i, Unit& u) const {
        const long L = (long)i * G + c; if (L >= nwg) return false;
        int wgid = (int)L; { const int q = nwg / NXCD, r = nwg % NXCD, xcd = wgid % NXCD, off = wgid / NXCD; wgid = (xcd < r ? xcd * (q + 1) : r * (q + 1) + (xcd - r) * q) + off; }
        const int nig = WGM * nN, gid = wgid / nig, fm = gid * WGM, gsz = (nM - fm) < WGM ? (nM - fm) : WGM;
        u.pm = fm + ((wgid % nig) % gsz); u.pn = (wgid % nig) / gsz; u.arow = u.pm * BM; u.slot = i & 1; return true;
    }
    __device__ __forceinline__ void a_ready(const Unit&) const {}
    __device__ __forceinline__ void done(const Unit&) const {}
};

__device__ __forceinline__ unsigned cvt_pk_bf16(float lo, float hi) { unsigned r; asm volatile("v_cvt_pk_bf16_f32 %0, %1, %2" : "=v"(r) : "v"(lo), "v"(hi)); return r; }

template <class Epi, class Sched, bool STAMP = false>
__device__ __forceinline__ void gemm_phase(PG8_LAS unsigned char* lds, const Gemm g, const Sched& S, const Epi& E, unsigned long long* stamps) {
    const int tid = my_tid(), wid = __builtin_amdgcn_readfirstlane(tid >> 6), lane = tid & 63, wr = wid >> 2, wc = wid & 3, fr = lane & 15, fq = lane >> 4;
    const int K = g.K, nt = K / BK;
    int ts_lo = 0, ts_hi = 0, nts = 0; const unsigned long long rt_entry = STAMP ? (unsigned long long)wall_clock64() : 0ull;
#define PG8_STAMP() do { if (STAMP && wid == 0 && nts < 64) { const unsigned long long _c = (unsigned long long)clock64(); \
        ts_lo = (lane == nts) ? (int)(unsigned)_c : ts_lo; ts_hi = (lane == nts) ? (int)(unsigned)(_c >> 32) : ts_hi; ++nts; } } while (0)
    PG8_STAMP();
    unsigned voffA[2], voffB[2];
#pragma unroll
    for (int i = 0; i < 2; ++i) { int R, C; stage_rc(tid * 16 + i * 8192, R, C); const int Rb = Epi::PERM ? ((R & ~31) + perm32(R & 31)) : R;
        voffA[i] = (unsigned)(R * K + C) * 2u; voffB[i] = (unsigned)(Rb * K + C) * 2u; }
    const size_t kstep = (size_t)(BK * 2);
    const size_t hstep = (size_t)HALF * K * 2;
    const size_t tstep = 2 * hstep;
    const unsigned ldsw = (unsigned)wid * 1024u;
    const int aoff = lds_byte(wr * 64 + fr, fq * 8), boff = lds_byte(wc * 32 + fr, fq * 8);
#define PG8_SA(b, h) (((b) * 2 + (h)) * HTB)
#define PG8_SB(b, h) ((4 + (b) * 2 + (h)) * HTB)
#define PG8_STAGE(bufoff, gbase, voff) do { _Pragma("unroll") for (int _i = 0; _i < 2; ++_i) \
        __builtin_amdgcn_global_load_lds((const unsigned*)((const char*)(gbase) + (voff)[_i]), (PG8_LAS unsigned*)(lds + (bufoff) + ldsw + _i * 8192), 16, 0, 0); } while (0)
#define PG8_LDA(dst, b, h) do { _Pragma("unroll") for (int m = 0; m < 4; ++m) _Pragma("unroll") for (int k = 0; k < 2; ++k) dst[m][k] = *(const PG8_LAS bf16x8*)(lds + PG8_SA(b, h) + aoff + m * 2048 + k * 1024); } while (0)
#define PG8_LDB(dst, b, h) do { _Pragma("unroll") for (int n = 0; n < 2; ++n) _Pragma("unroll") for (int k = 0; k < 2; ++k) dst[n][k] = *(const PG8_LAS bf16x8*)(lds + PG8_SB(b, h) + boff + n * 2048 + k * 1024); } while (0)
#define PG8_MMA(ai, bj, At, Bt) do { __builtin_amdgcn_s_setprio(1); _Pragma("unroll") for (int m = 0; m < 4; ++m) _Pragma("unroll") for (int n = 0; n < 2; ++n) _Pragma("unroll") for (int k = 0; k < 2; ++k) \
        acc[ai][bj][m][n] = __builtin_amdgcn_mfma_f32_16x16x32_bf16(Bt[n][k], At[m][k], acc[ai][bj][m][n], 0, 0, 0); __builtin_amdgcn_s_setprio(0); } while (0)
#define PG8_WAIT_V(n) asm volatile("s_waitcnt vmcnt(" #n ")" ::: "memory")
#define PG8_WAIT_L(n) asm volatile("s_waitcnt lgkmcnt(" #n ")" ::: "memory")
#define PG8_BAR __builtin_amdgcn_s_barrier()
#define PG8_SCHED __builtin_amdgcn_sched_barrier(0)
    Unit cur, nxt; int ui = 0;
    if (!S.next(0, cur)) return;
    f32x4 acc[2][2][4][2];
#pragma unroll
    for (int a = 0; a < 2; ++a)
#pragma unroll
        for (int b = 0; b < 2; ++b)
#pragma unroll
            for (int m = 0; m < 4; ++m)
#pragma unroll
                for (int n = 0; n < 2; ++n) acc[a][b][m][n] = (f32x4){0.f, 0.f, 0.f, 0.f};
    bf16x8 At[4][2], B0[2][2], B1[2][2];
    const char* cA = (const char*)g.A + (long)cur.arow * (long)(K * 2); const char* cB = (const char*)g.Bt + (size_t)cur.pn * tstep;
    S.a_ready(cur);
    PG8_STAGE(PG8_SB(0, 0), cB, voffB); PG8_STAGE(PG8_SA(0, 0), cA, voffA); PG8_STAGE(PG8_SB(0, 1), cB + hstep, voffB); PG8_STAGE(PG8_SA(0, 1), cA + hstep, voffA);
    if (wr == 1) PG8_BAR;
    PG8_WAIT_V(4); PG8_BAR;
    PG8_STAGE(PG8_SB(1, 0), cB + kstep, voffB); PG8_STAGE(PG8_SA(1, 0), cA + kstep, voffA); PG8_STAGE(PG8_SB(1, 1), cB + hstep + kstep, voffB);
    PG8_WAIT_V(6); PG8_BAR;
    PG8_STAMP();
    for (;;) {
        const bool has_next = S.next(ui + 1, nxt);
        const char* nA = has_next ? (const char*)g.A + (long)nxt.arow * (long)(K * 2) : cA; const char* nB = has_next ? (const char*)g.Bt + (size_t)nxt.pn * tstep : cB;
        for (int t = 0; t < nt; t += 2) {
            const bool last = (t == nt - 2);
            const char* a1 = cA + (size_t)(t + 1) * kstep;
            const char* a2 = last ? nA : cA + (size_t)(t + 2) * kstep; const char* b2 = last ? nB : cB + (size_t)(t + 2) * kstep;
            const char* a3 = a2 + kstep; const char* b3 = b2 + kstep;
            if (last && has_next) S.a_ready(nxt);
            PG8_LDB(B0, 0, 0); PG8_SCHED; PG8_LDA(At, 0, 0); PG8_STAGE(PG8_SA(1, 1), a1 + hstep, voffA);
            PG8_WAIT_L(8); PG8_BAR; PG8_WAIT_L(0); PG8_MMA(0, 0, At, B0); PG8_BAR; PG8_SCHED;
            PG8_LDB(B1, 0, 1); PG8_STAGE(PG8_SB(0, 0), b2, voffB);
            PG8_BAR; PG8_WAIT_L(0); PG8_MMA(0, 1, At, B1); PG8_BAR;
            PG8_LDA(At, 0, 1); PG8_STAGE(PG8_SA(0, 0), a2, voffA);
            PG8_BAR; PG8_WAIT_L(0); PG8_MMA(1, 0, At, B0); PG8_BAR; PG8_SCHED;
            PG8_STAGE(PG8_SB(0, 1), b2 + hstep, voffB);
            PG8_WAIT_V(6); PG8_BAR; PG8_MMA(1, 1, At, B1); PG8_BAR;
            PG8_LDB(B0, 1, 0); PG8_SCHED; PG8_LDA(At, 1, 0); PG8_STAGE(PG8_SA(0, 1), a2 + hstep, voffA);
            PG8_WAIT_L(8); PG8_BAR; PG8_WAIT_L(0); PG8_MMA(0, 0, At, B0); PG8_BAR; PG8_SCHED;
            PG8_LDB(B1, 1, 1); PG8_STAGE(PG8_SB(1, 0), b3, voffB);
            PG8_BAR; PG8_WAIT_L(0); PG8_MMA(0, 1, At, B1); PG8_BAR;
            PG8_LDA(At, 1, 1); PG8_STAGE(PG8_SA(1, 0), a3, voffA);
            PG8_BAR; PG8_WAIT_L(0); PG8_MMA(1, 0, At, B0); PG8_BAR; PG8_SCHED;
            PG8_STAGE(PG8_SB(1, 1), b3 + hstep, voffB);
            PG8_WAIT_V(6); PG8_BAR; PG8_MMA(1, 1, At, B1); PG8_BAR;
        }
        PG8_STAMP();
        if constexpr (!Epi::AFTER_DRAIN) { E(acc, cur, wr, wc, fr, fq); S.done(cur); }
        PG8_STAMP();
        if (!has_next) break;
#pragma unroll
        for (int a = 0; a < 2; ++a)
#pragma unroll
            for (int b = 0; b < 2; ++b)
#pragma unroll
                for (int m = 0; m < 4; ++m)
#pragma unroll
                    for (int n = 0; n < 2; ++n) acc[a][b][m][n] = (f32x4){0.f, 0.f, 0.f, 0.f};
        cur = nxt; cA = nA; cB = nB; ++ui;
    }
    PG8_WAIT_V(0);
    if (wr == 0) PG8_BAR;
    PG8_BAR;
    if constexpr (Epi::AFTER_DRAIN) { E.fused(acc, cur, wr, wc, fr, fq, lds, wid, lane); S.done(cur); }
    PG8_STAMP();
    if (STAMP && wid == 0) { stamps[lane] = lane < nts ? (((unsigned long long)(unsigned)ts_hi << 32) | (unsigned)ts_lo) : 0ull;
        if (lane == 62) stamps[62] = rt_entry; if (lane == 63) stamps[63] = (unsigned long long)wall_clock64(); }
#undef PG8_STAMP
#undef PG8_SA
#undef PG8_SB
#undef PG8_STAGE
#undef PG8_LDA
#undef PG8_LDB
#undef PG8_MMA
#undef PG8_WAIT_V
#undef PG8_WAIT_L
#undef PG8_BAR
#undef PG8_SCHED
}
}

struct EpiInproj {
  static constexpr bool PERM = true, AFTER_DRAIN = false;
  u16* O; int ldc; const float* ssq;
  __device__ __forceinline__ void operator()(const pg8::f32x4 (&acc)[2][2][4][2], const pg8::Unit& u, int wr, int wc, int fr, int fq) const {
    const int row0 = u.pm * 256 + wr * 64 + fr, col0 = u.pn * 256 + wc * 32 + 8 * fq;
#pragma unroll
    for (int ai = 0; ai < 2; ++ai)
#pragma unroll
      for (int m = 0; m < 4; ++m) {
        const int row = row0 + ai * 128 + m * 16;
        const float rs = ssq ? rsqrtf(ssq[row] * (1.0f / DM) + 1e-6f) : 1.0f;
        u16* rowp = O + (size_t)row * ldc + col0;
#pragma unroll
        for (int bj = 0; bj < 2; ++bj) {
          const pg8::f32x4 v0 = acc[ai][bj][m][0] * rs, v1 = acc[ai][bj][m][1] * rs;
          u32x4 w;
          w.x = pack2(v0[0], v0[1]); w.y = pack2(v0[2], v0[3]); w.z = pack2(v1[0], v1[1]); w.w = pack2(v1[2], v1[3]);
          *(u32x4*)(rowp + bj * 128) = w;
        }
      }
  }
};
struct EpiRes {
  static constexpr bool PERM = false, AFTER_DRAIN = false;
  const float* xin; float* xout; u16* xbo; float* ssq;
  __device__ __forceinline__ void operator()(const pg8::f32x4 (&acc)[2][2][4][2], const pg8::Unit& u, int wr, int wc, int fr, int fq) const {
    const int row0 = u.pm * 256 + wr * 64 + fr, col0 = u.pn * 256 + wc * 32 + 4 * fq;
#pragma unroll
    for (int ai = 0; ai < 2; ++ai)
#pragma unroll
      for (int m = 0; m < 4; ++m) {
        const int row = row0 + ai * 128 + m * 16;
        float sq = 0.f;
#pragma unroll
        for (int bj = 0; bj < 2; ++bj)
#pragma unroll
          for (int n = 0; n < 2; ++n) {
            const size_t o = (size_t)row * DM + col0 + bj * 128 + n * 16;
            const pg8::f32x4 y = *(const pg8::f32x4*)(xin + o) + acc[ai][bj][m][n];
            *(pg8::f32x4*)(xout + o) = y;
            if (xbo) {
              *(uint2*)(xbo + o) = make_uint2(pack2(y[0], y[1]), pack2(y[2], y[3]));
              sq += y[0] * y[0] + y[1] * y[1] + y[2] * y[2] + y[3] * y[3];
            }
          }
        if (xbo) {
          sq += __shfl_xor(sq, 16);
          sq += __shfl_xor(sq, 32);
          if (fq == 0) atomicAdd(ssq + row, sq);
        }
        __builtin_amdgcn_sched_barrier(0);
      }
  }
};
struct TriOrder : pg8::StaticOrder {
  int a_rows_per_g;
  __device__ bool next(int i, pg8::Unit& u) const {
    const int g = i % 3;
    if (!pg8::StaticOrder::next(i / 3, u)) return false;
    u.arow = g * a_rows_per_g + u.pm * 256;
    u.pn += 4 * g;
    u.slot = i & 1;
    return true;
  }
};
struct EpiP {
  static constexpr bool PERM = true, AFTER_DRAIN = false;
  u16* O;
  __device__ __forceinline__ void operator()(const pg8::f32x4 (&acc)[2][2][4][2], const pg8::Unit& u, int wr, int wc, int fr, int fq) const {
    const int g = u.pn >> 2, ct = u.pn & 3;
    const int row0 = u.pm * 256 + wr * 64 + fr, col0 = ct * 256 + wc * 32 + 8 * fq;
    u16* base = O + (size_t)g * NTOK * DM;
#pragma unroll
    for (int ai = 0; ai < 2; ++ai)
#pragma unroll
      for (int m = 0; m < 4; ++m) {
        u16* rowp = base + (size_t)(row0 + ai * 128 + m * 16) * DM + col0;
#pragma unroll
        for (int bj = 0; bj < 2; ++bj) {
          const pg8::f32x4 v0 = acc[ai][bj][m][0], v1 = acc[ai][bj][m][1];
          u32x4 w;
          w.x = pack2(v0[0], v0[1]); w.y = pack2(v0[2], v0[3]); w.z = pack2(v1[0], v1[1]); w.w = pack2(v1[2], v1[3]);
          *(u32x4*)(rowp + bj * 128) = w;
        }
      }
  }
};
struct EpiGate {
  static constexpr bool PERM = true, AFTER_DRAIN = false;
  u16* Mo; const u16* Pall; const float* ssq;
  __device__ __forceinline__ void operator()(const pg8::f32x4 (&acc)[2][2][4][2], const pg8::Unit& u, int wr, int wc, int fr, int fq) const {
    const int g = u.pn >> 2, first = (g == 0);
    const u16* P = Pall + (size_t)g * NTOK * DM;
    const int row0 = u.pm * 256 + wr * 64 + fr, col0 = (u.pn & 3) * 256 + wc * 32 + 8 * fq;
#pragma unroll
    for (int ai = 0; ai < 2; ++ai)
#pragma unroll
      for (int m = 0; m < 4; ++m) {
        const int row = row0 + ai * 128 + m * 16;
        const float rs = rsqrtf(ssq[row] * (1.0f / DM) + 1e-6f);
#pragma unroll
        for (int bj = 0; bj < 2; ++bj) {
          const size_t o = (size_t)row * DM + col0 + bj * 128;
          float pv[8], mv[8];
          unpack8(*(const uint4*)(P + o), pv);
          if (!first) unpack8(*(const uint4*)(Mo + o), mv);
          else {
#pragma unroll
            for (int j = 0; j < 8; ++j) mv[j] = 0.f;
          }
#pragma unroll
          for (int j = 0; j < 4; ++j) {
            mv[j] += sigmoidf_(acc[ai][bj][m][0][j] * rs) * pv[j];
            mv[4 + j] += sigmoidf_(acc[ai][bj][m][1][j] * rs) * pv[4 + j];
          }
          *(uint4*)(Mo + o) = pack8(mv);
        }
        __builtin_amdgcn_sched_barrier(0);
      }
  }
};
struct FfnOrder : pg8::StaticOrder {
  __device__ bool next(int i, pg8::Unit& u) const {
    if (!pg8::StaticOrder::next(i, u)) return false;
    const int b = u.pm / 33, mi = u.pm % 33;
    u.arow = b * SEQ + mi * 254 - 2;
    return true;
  }
};
struct EpiFfn {
  static constexpr bool PERM = true, AFTER_DRAIN = false;
  const Params* pp; int l; int bid;
  __device__ __forceinline__ void operator()(const pg8::f32x4 (&acc)[2][2][4][2], const pg8::Unit& u, int wr, int wc, int fr, int fq) const {
    const int b = u.pm / 33, mi = u.pm % 33;
    const int tokbase = b * SEQ + mi * 254 - 2, tbeg = b * SEQ, tend = (b + 1) * SEQ;
    asm volatile("" : "+v"(fr), "+v"(fq));
    u16* act = (u16*)(pp->ws + OFF_BIG + B_ACT);
    const float* ssq = (const float*)(pp->ws + OFF_RSTD) + (size_t)(2 * l + 1) * NTOK;
    const float* cw = pp->in[22] + (size_t)l * 3 * 2 * DFF;
    const float* cb = pp->in[23] + (size_t)l * 2 * DFF;
    u16* S = (u16*)(pp->ws + OFF_BIG + 192 * MiB) + (size_t)bid * 131072 + (size_t)u.slot * 65536;
#pragma unroll
    for (int ai = 0; ai < 2; ++ai)
#pragma unroll
      for (int m = 0; m < 4; ++m) {
        const int r = ai * 128 + wr * 64 + m * 16 + fr;
        int tk = tokbase + r; tk = tk < 0 ? 0 : (tk > NTOK - 1 ? NTOK - 1 : tk);
        const float rs = rsqrtf(ssq[tk] * (1.0f / DM) + 1e-6f);
#pragma unroll
        for (int bj = 0; bj < 2; ++bj) {
          const pg8::f32x4 v0 = acc[ai][bj][m][0] * rs, v1 = acc[ai][bj][m][1] * rs;
          u32x4 w;
          w.x = pack2(v0[0], v0[1]); w.y = pack2(v0[2], v0[3]); w.z = pack2(v1[0], v1[1]); w.w = pack2(v1[2], v1[3]);
          *(u32x4*)(S + r * 256 + bj * 128 + wc * 32 + 8 * fq) = w;
        }
      }
    asm volatile("s_waitcnt vmcnt(0)" ::: "memory");
    __builtin_amdgcn_s_barrier();
    __builtin_amdgcn_s_barrier();
    asm volatile("" ::: "memory");
    const int tid = my_tid(), cc = tid & 31, rg = tid >> 5;
    const int gcol = u.pn * 128 + cc * 4, vcol = DFF + gcol;
    float wg[3][4], wv[3][4], bg[4], bv[4];
#pragma unroll
    for (int q = 0; q < 3; ++q) {
      const float4 a0 = *(const float4*)(cw + q * 2 * DFF + gcol);
      const float4 c0 = *(const float4*)(cw + q * 2 * DFF + vcol);
      wg[q][0] = a0.x; wg[q][1] = a0.y; wg[q][2] = a0.z; wg[q][3] = a0.w;
      wv[q][0] = c0.x; wv[q][1] = c0.y; wv[q][2] = c0.z; wv[q][3] = c0.w;
    }
    {
      const float4 a0 = *(const float4*)(cb + gcol);
      const float4 c0 = *(const float4*)(cb + vcol);
      bg[0] = a0.x; bg[1] = a0.y; bg[2] = a0.z; bg[3] = a0.w;
      bv[0] = c0.x; bv[1] = c0.y; bv[2] = c0.z; bv[3] = c0.w;
    }
    uint2 rgt[18], rvl[18];
#pragma unroll
    for (int q = 0; q < 18; ++q) {
      int r = rg * 16 + q - 2; r = r < 0 ? 0 : r;
      rgt[q] = *(const uint2*)(S + r * 256 + cc * 4);
      rvl[q] = *(const uint2*)(S + r * 256 + 128 + cc * 4);
    }
    float g2[4], g1[4], v2[4], v1[4];
#define UNP4(src_, dst_) { dst_[0] = __uint_as_float(src_.x << 16); dst_[1] = __uint_as_float(src_.x & 0xffff0000u); dst_[2] = __uint_as_float(src_.y << 16); dst_[3] = __uint_as_float(src_.y & 0xffff0000u); }
    {
      const bool z0 = (tokbase + rg * 16 - 2) < tbeg, z1 = (tokbase + rg * 16 - 1) < tbeg;
      UNP4(rgt[0], g2); UNP4(rvl[0], v2); UNP4(rgt[1], g1); UNP4(rvl[1], v1);
#pragma unroll
      for (int j = 0; j < 4; ++j) { if (z0) { g2[j] = 0.f; v2[j] = 0.f; } if (z1) { g1[j] = 0.f; v1[j] = 0.f; } }
    }
#pragma unroll
    for (int q = 2; q < 18; ++q) {
      const int r = rg * 16 + q - 2;
      const int tk = tokbase + r;
      float g0[4], v0[4], o[4];
      UNP4(rgt[q], g0); UNP4(rvl[q], v0);
      if (tk < tbeg) {
#pragma unroll
        for (int j = 0; j < 4; ++j) { g0[j] = 0.f; v0[j] = 0.f; }
      }
#pragma unroll
      for (int j = 0; j < 4; ++j) {
        const float cg = bg[j] + wg[0][j] * g2[j] + wg[1][j] * g1[j] + wg[2][j] * g0[j];
        const float cv = bv[j] + wv[0][j] * v2[j] + wv[1][j] * v1[j] + wv[2][j] * v0[j];
        o[j] = siluf_(cg) * cv;
        g2[j] = g1[j]; g1[j] = g0[j]; v2[j] = v1[j]; v1[j] = v0[j];
      }
      if (r >= 2 && tk < tend) *(uint2*)(act + (size_t)tk * DFF + u.pn * 128 + cc * 4) = make_uint2(pack2(o[0], o[1]), pack2(o[2], o[3]));
    }
#undef UNP4
  }
};
template <class Epi>
DEV void pg8_gemm(unsigned char* smraw, const u16* A, const u16* Bt, int M, int N, int K, const Epi& E, int bid, int nb) {
  pg8::Gemm g{A, Bt, M, N, K};
  pg8::StaticOrder S;
  S.init(M, N, nb, bid);
  pg8::gemm_phase<Epi, pg8::StaticOrder, false>((PG8_LAS unsigned char*)smraw, g, S, E, nullptr);
}

#define PPL 15
#define NPHASE (2 + 2 * PPL)
template <int ph>
DEV void run_phase(const Params& p, unsigned char* smraw, int bid, int nb) {
  u16* smem = (u16*)smraw;
  float* smf = (float*)smraw;
  float* xo = p.out;
  u16* xb = (u16*)(p.ws + OFF_XB);
  float* ssq_all = (float*)(p.ws + OFF_RSTD);
  if (ph == 0) { phase_prep(p, smf, bid, nb); phase_norm(p.in[0], xb, ssq_all, bid, nb); return; }
  if (ph == NPHASE - 1) { phase_final(xo, p.in[25], bid, nb); return; }
  const int l = (ph - 1) / PPL, s = (ph - 1) % PPL;
  const float* xcur = (l == 0) ? p.in[0] : xo;
  unsigned char* W = p.ws + OFF_W + (size_t)l * LW_BYTES;
  float* ssq1 = ssq_all + (size_t)(2 * l) * NTOK;
  float* ssq2 = ssq_all + (size_t)(2 * l + 1) * NTOK;
  switch (s) {
    case 0: break;
    case 1: { EpiInproj E{(u16*)(p.ws + OFF_BIG + B_PRW), 1792, ssq1}; pg8_gemm(smraw, xb, (const u16*)(W + W_IN), NTOK, 1792, DM, E, bid, nb); } break;
    case 2: phase_rwprep(p, l, smem, bid, nb); break;
    case 3: phase_scan<1>(p, l, smf, bid, nb); break;
    case 4: phase_scanprop(p, smf, bid, nb); first_tok_proj(p, l, xcur, smf, nb - 1 - bid, nb); break;
    case 5: phase_scan<3>(p, l, smf, bid, nb); break;
    case 6: { EpiInproj E{(u16*)(p.ws + OFF_BIG + B_PRS), 2560, ssq1}; pg8_gemm(smraw, xb, (const u16*)(W + W_IN) + (size_t)1792 * DM, NTOK, 2560, DM, E, bid, nb); } break;
    case 7:
      for (int u = bid; u < 1024; u += nb) ret_kv_unit(p, u, smem);
      for (int u = bid; u < 256; u += nb) sgu_unit(p, l, u, smem);
      break;
    case 8: phase_retprefix(p, bid, nb); break;
    case 9:
      for (int u = bid; u < 1024; u += nb) ret_out_unit(p, u, smem);
      first_tok_fix(p, l, smf, nb - 1 - bid, nb);
      break;
    case 10: {
      TriOrder S; S.init(NTOK, DM, nb, bid); S.a_rows_per_g = NTOK;
      EpiP E{(u16*)(p.ws + OFF_BIG + B_P)};
      pg8::Gemm g{(const u16*)(p.ws + OFF_BIG + B_YRW), (const u16*)(W + W_BR), NTOK, DM, 512};
      pg8::gemm_phase<EpiP, TriOrder, false>((PG8_LAS unsigned char*)smraw, g, S, E, nullptr);
    } break;
    case 11: {
      TriOrder S; S.init(NTOK, DM, nb, bid); S.a_rows_per_g = 0;
      EpiGate E{(u16*)(p.ws + OFF_BIG + B_M), (const u16*)(p.ws + OFF_BIG + B_P), ssq1};
      pg8::Gemm g{xb, (const u16*)(W + W_IN) + (size_t)4352 * DM, NTOK, DM, DM};
      pg8::gemm_phase<EpiGate, TriOrder, false>((PG8_LAS unsigned char*)smraw, g, S, E, nullptr);
    } break;
    case 12: { EpiRes E{xcur, xo, xb, ssq2}; pg8_gemm(smraw, (const u16*)(p.ws + OFF_BIG + B_M), (const u16*)(W + W_OUT), NTOK, DM, DM, E, bid, nb); } break;
    case 13: {
      FfnOrder S;
      S.init(132 * 256, 2 * DFF, nb, bid);
      EpiFfn E{&p, l, bid};
      pg8::Gemm g{xb, (const u16*)(W + W_UP), 132 * 256, 2 * DFF, DM};
      pg8::gemm_phase<EpiFfn, FfnOrder, false>((PG8_LAS unsigned char*)smraw, g, S, E, nullptr);
    } break;
    case 14: {
      EpiRes E{xo, xo, (l == 0) ? xb : nullptr, (l == 0) ? ssq_all + (size_t)2 * NTOK : nullptr};
      pg8_gemm(smraw, (const u16*)(p.ws + OFF_BIG + B_ACT), (const u16*)(W + W_DN), NTOK, DM, DFF, E, bid, nb);
    } break;
  }
}
DEV constexpr bool phase_empty(int ph) {
  return ph >= 1 && ph < NPHASE - 1 && ((ph - 1) % PPL == 0);
}

#define XB_TMO      128
#define XB_XCNT(j)  (256  + 64 * (j))
#define XB_XSUB(j)  (1280 + 64 * (j))
#define XB_XGEN(j)  (2304 + 64 * (j))
#define XB_TOP      3328
#define XB_TOPGEN   3392
#define XCD_BAR_WORDS 3456
#define XB_SPIN_CAP (1u << 18)
#define LAS __attribute__((address_space(3)))

__device__ __forceinline__ unsigned xb_ld(unsigned* p)              { return __hip_atomic_load(p, __ATOMIC_RELAXED, __HIP_MEMORY_SCOPE_AGENT); }
__device__ __forceinline__ unsigned xb_add(unsigned* p, unsigned v) { return __hip_atomic_fetch_add(p, v, __ATOMIC_RELAXED, __HIP_MEMORY_SCOPE_AGENT); }
__device__ __forceinline__ unsigned xb_xcc_id() { return (unsigned)__builtin_amdgcn_s_getreg((3 << 11) | 20) & 0xFu; }
#define XB_SPIN(cond, bar) do { unsigned _sp = 0; while (cond) { __builtin_amdgcn_s_sleep(1); \
    if ((++_sp & 255u) == 0u) { if (xb_ld(&(bar)[XB_TMO])) break; if (_sp > XB_SPIN_CAP) { atomicAdd(&(bar)[XB_TMO], 1u); break; } } } } while (0)

struct XcdBarrier {
    unsigned* bar; unsigned x;
    volatile LAS unsigned* st;
};

__device__ __forceinline__ XcdBarrier xcd_barrier_post(unsigned* bar, volatile LAS unsigned* st) {
    XcdBarrier b; b.bar = bar; b.x = xb_xcc_id(); b.st = st;
    if (my_tid() == 0) (void)xb_add(&bar[XB_XCNT(b.x)], 1u);
    return b;
}
__device__ __forceinline__ void xcd_barrier_complete(unsigned* bar, unsigned x, unsigned& nloc, unsigned& nx) {
    const unsigned G = gridDim.x * gridDim.y * gridDim.z;
    unsigned sum, cnt, mine, sp = 0u;
    for (;;) {
        sum = 0u; cnt = 0u; mine = 0u;
#pragma unroll
        for (unsigned j = 0; j < 16; ++j) { const unsigned c = xb_ld(&bar[XB_XCNT(j)]); sum += c; cnt += (c > 0u) ? 1u : 0u; mine = (j == x) ? c : mine; }
        if (sum == G) break;
        __builtin_amdgcn_s_sleep(1);
        if ((++sp & 255u) == 0u) { if (xb_ld(&bar[XB_TMO])) break; if (sp > XB_SPIN_CAP) { atomicAdd(&bar[XB_TMO], 1u); break; } }
    }
    nloc = mine > 0u ? mine : 1u; nx = cnt > 0u ? cnt : 1u;
}

__device__ __forceinline__ void xcd_barrier(const XcdBarrier& b) {
    asm volatile("s_waitcnt vmcnt(0)" ::: "memory");
    __syncthreads();
    if (my_tid() == 0) {
        unsigned* bar = b.bar;
        __builtin_amdgcn_s_waitcnt(0);
        unsigned nloc = b.st[0], nx = b.st[1];
        if (nloc == 0u) { xcd_barrier_complete(bar, b.x, nloc, nx); b.st[0] = nloc; b.st[1] = nx; }
        const unsigned old = xb_add(&bar[XB_XSUB(b.x)], 1u);
        const unsigned gen = old / nloc;
        if (old + 1u == (gen + 1u) * nloc) {
            __builtin_amdgcn_fence(__ATOMIC_RELEASE, "agent");
            asm volatile("s_waitcnt vmcnt(0)" ::: "memory");
            const unsigned og = xb_add(&bar[XB_TOP], 1u);
            const unsigned tg = og / nx;
            if (og + 1u == (tg + 1u) * nx) xb_add(&bar[XB_TOPGEN], 1u);
            else XB_SPIN(xb_ld(&bar[XB_TOPGEN]) == tg, bar);
            __builtin_amdgcn_fence(__ATOMIC_ACQUIRE, "agent");
            xb_add(&bar[XB_XGEN(b.x)], 1u);
            asm volatile("s_waitcnt vmcnt(0)" ::: "memory");
        } else {
            XB_SPIN(xb_ld(&bar[XB_XGEN(b.x)]) == gen, bar);
            __builtin_amdgcn_fence(__ATOMIC_ACQUIRE, "agent");
            asm volatile("s_waitcnt vmcnt(0)" ::: "memory");
        }
    }
    __syncthreads();
}


DEV void gsync(unsigned* ctr, unsigned& target) {
  asm volatile("s_waitcnt vmcnt(0)" ::: "memory");
  __syncthreads();
  if (my_tid() == 0) {
    target += gridDim.x;
    __builtin_amdgcn_fence(__ATOMIC_RELEASE, "agent");
    asm volatile("s_waitcnt vmcnt(0)" ::: "memory");
    __hip_atomic_fetch_add(ctr, 1u, __ATOMIC_RELAXED, __HIP_MEMORY_SCOPE_AGENT);
    while (__hip_atomic_load(ctr, __ATOMIC_RELAXED, __HIP_MEMORY_SCOPE_AGENT) < target) __builtin_amdgcn_s_sleep(2);
    __builtin_amdgcn_fence(__ATOMIC_ACQUIRE, "agent");
    asm volatile("s_waitcnt vmcnt(0)" ::: "memory");
  }
  __syncthreads();
}

#if COOP
template <int PH>
DEV void run_seq(const Params& p, unsigned char* smraw, cg::grid_group& grid, const XcdBarrier& xb) {
  if constexpr (phase_empty(PH)) {
    run_seq<PH + 1>(p, smraw, grid, xb);
  } else {
    int bid_ = blockIdx.x;
    asm volatile("" : "+s"(bid_));
    run_phase<PH>(p, smraw, bid_, gridDim.x);
    if constexpr (PH + 1 < NPHASE) {
      if constexpr (PH == 0) grid.sync();
      else xcd_barrier(xb);
      run_seq<PH + 1>(p, smraw, grid, xb);
    }
  }
}
__global__ void __launch_bounds__(NTHR) mega(Params p) {
  __shared__ __align__(16) unsigned char smraw[147456];
  cg::grid_group grid = cg::this_grid();
  __shared__ uint4 xb_words;
  if (my_tid() == 0) xb_words = make_uint4(0u, 0u, 0u, 0u);
  __syncthreads();
  XcdBarrier xb = xcd_barrier_post((unsigned*)p.ws, (volatile LAS unsigned*)&xb_words);
  run_seq<0>(p, smraw, grid, xb);
}
#else
template <int PH>
__global__ void __launch_bounds__(NTHR) phk(Params p) {
  __shared__ __align__(16) unsigned char smraw[147456];
  run_phase<PH>(p, smraw, blockIdx.x, gridDim.x);
}
template <int PH>
static void launch_seq(const Params& p, hipStream_t stream) {
  phk<PH><<<256, NTHR, 0, stream>>>(p);
  if constexpr (PH + 1 < NPHASE) launch_seq<PH + 1>(p, stream);
}
#endif

extern "C" void kernel_launch(void* const* d_in, const int* in_sizes, int n_in, void* d_out, int out_size, void* d_ws,
                              size_t ws_size, hipStream_t stream) {
  Params p{};
  for (int i = 0; i < 26; ++i) p.in[i] = (const float*)d_in[i];
  p.out = (float*)d_out;
  p.ws = (unsigned char*)d_ws;
  if (ws_size < WS_NEED) { fprintf(stderr, "workspace too small: %zu < %llu\n", ws_size, (unsigned long long)WS_NEED); return; }
#if COOP
  static int grid_blocks = 0;
  if (!grid_blocks) {
    int dev = 0, cus = 0, per_cu = 0;
    hipGetDevice(&dev);
    hipDeviceGetAttribute(&cus, hipDeviceAttributeMultiprocessorCount, dev);
    hipOccupancyMaxActiveBlocksPerMultiprocessor(&per_cu, mega, NTHR, 0);
    if (per_cu > 1) per_cu = 1;
    grid_blocks = cus * per_cu;
  }
  hipMemsetAsync(d_ws, 0, 16384, stream);
  void* args[] = {&p};
  hipError_t e = hipLaunchCooperativeKernel((void*)mega, dim3(grid_blocks), dim3(NTHR), args, 0, stream);
  if (e != hipSuccess) fprintf(stderr, "cooperative launch failed: %s (grid %d)\n", hipGetErrorString(e), grid_blocks);
#else
  launch_seq<0>(p, stream);
#endif
}
```

```cpp
#include <hip/hip_runtime.h>
#include <hip/hip_cooperative_groups.h>
#include <cstdio>
#include <cstdint>
namespace cg = cooperative_groups;

#ifndef COOP
#define COOP 1
#endif

#define DEV __device__ __forceinline__
typedef unsigned short u16;
typedef short bf16x8 __attribute__((ext_vector_type(8)));
typedef float f32x16 __attribute__((ext_vector_type(16)));

#define NTHR 512
#define NTOK 32768
#define SEQ 8192
#define DM 1024
#define INC 7424
#define DFF 2816
#define MiB (1048576ull)

#define OFF_ROPE (64ull * 1024)
#define OFF_RSTD (OFF_ROPE + 2 * MiB)
#define OFF_PF (OFF_RSTD + 640ull * 1024)
#define OFF_W (3 * MiB)
#define LW_BYTES (37 * MiB)
#define W_IN 0ull
#define W_BR 15204352ull
#define W_OUT 18350080ull
#define W_UP 20447232ull
#define W_DN 31981568ull
#define W_RWUP 37748736ull
#define W_RAUP 37814272ull
#define W_RGUP 37879808ull
#define W_SGW 38010880ull
#define OFF_XB (77 * MiB)
#define OFF_BIG (141 * MiB)
#define B_PRW 0ull
#define B_YRW 0ull
#define B_YRET (32 * MiB)
#define B_YSG (64 * MiB)
#define B_OPS (112 * MiB)
#define B_PRS (112 * MiB)
#define B_KV (272 * MiB)
#define B_M 0ull
#define B_P (128 * MiB)
#define B_PL (304 * MiB)
#define B_SINIT (320 * MiB)
#define B_ACT 0ull
#define WS_NEED (OFF_BIG + 328 * MiB)

struct Params {
  const float* in[26];
  float* out;
  unsigned char* ws;
};

DEV int my_tid() {
  int t = __builtin_amdgcn_workitem_id_x();
  asm volatile("" : "+v"(t));
  return t;
}
DEV u16 f2bf(float f) {
  unsigned u = __float_as_uint(f);
  u += 0x7fffu + ((u >> 16) & 1u);
  return (u16)(u >> 16);
}
DEV float bf2f(u16 h) { return __uint_as_float(((unsigned)h) << 16); }
DEV unsigned pack2(float a, float b) { return (unsigned)f2bf(a) | ((unsigned)f2bf(b) << 16); }
DEV void unpack8(uint4 v, float* f) {
  f[0] = __uint_as_float(v.x << 16); f[1] = __uint_as_float(v.x & 0xffff0000u);
  f[2] = __uint_as_float(v.y << 16); f[3] = __uint_as_float(v.y & 0xffff0000u);
  f[4] = __uint_as_float(v.z << 16); f[5] = __uint_as_float(v.z & 0xffff0000u);
  f[6] = __uint_as_float(v.w << 16); f[7] = __uint_as_float(v.w & 0xffff0000u);
}
DEV uint4 pack8(const float* f) {
  return make_uint4(pack2(f[0], f[1]), pack2(f[2], f[3]), pack2(f[4], f[5]), pack2(f[6], f[7]));
}
template <int CTRL>
DEV float dppmov(float x) {
  return __builtin_bit_cast(float, __builtin_amdgcn_update_dpp(0, __builtin_bit_cast(int, x), CTRL, 0xF, 0xF, true));
}
DEV float red4(float x) { x += dppmov<0xB1>(x); x += dppmov<0x4E>(x); return x; }
DEV float red8(float x) { x = red4(x); x += dppmov<0x141>(x); return x; }
DEV float wave_sum(float x) {
  x = red8(x);
  x += dppmov<0x140>(x);
  const int xi = __builtin_bit_cast(int, x);
  return __builtin_bit_cast(float, __builtin_amdgcn_readlane(xi, 0)) + __builtin_bit_cast(float, __builtin_amdgcn_readlane(xi, 16)) +
         __builtin_bit_cast(float, __builtin_amdgcn_readlane(xi, 32)) + __builtin_bit_cast(float, __builtin_amdgcn_readlane(xi, 48));
}
DEV float sigmoidf_(float x) { return 1.f / (1.f + __expf(-x)); }
DEV float siluf_(float x) { return x / (1.f + __expf(-x)); }
DEV float geluf_(float x) { return 0.5f * x * (1.f + erff(x * 0.70710678118654752f)); }

DEV float rstd_of(const float* ssq, int row) { return rsqrtf(ssq[row] * (1.0f / DM) + 1e-6f); }
DEV int vbid(int bid, int nb) { return ((nb & 7) == 0) ? (bid & 7) * (nb >> 3) + (bid >> 3) : bid; }
DEV void tile_map(int t, int MTL, int NTL, int& m, int& n) {
  int per = 8 * NTL;
  int g = t / per;
  int r = t - g * per;
  int gm = MTL - g * 8; gm = gm > 8 ? 8 : gm;
  m = g * 8 + r % gm;
  n = r / gm;
}

typedef unsigned u32x4 __attribute__((ext_vector_type(4)));
template <int NA>
struct GStage { u32x4 a0, a1, a2, a3, b0, b1; };
DEV u32x4 g_ld_a(const u16* A, long lda, int g, int azero_below, int arow_max, int ko) {
  const bool z = g < azero_below;
  g = g < 0 ? 0 : g;
  g = g > arow_max ? arow_max : g;
  u32x4 v = *(const u32x4*)(A + (long)g * lda + ko);
  const u32x4 zero = {0u, 0u, 0u, 0u};
  return z ? zero : v;
}
template <int NA>
DEV void g_load(GStage<NA>& S, const u16* A, long lda, int arow, int azero_below, int arow_max,
                const u16* bp0, const u16* bp1, int ko) {
  S.a0 = g_ld_a(A, lda, arow, azero_below, arow_max, ko);
  S.a1 = g_ld_a(A, lda, arow + 64, azero_below, arow_max, ko);
  if constexpr (NA == 4) {
    S.a2 = g_ld_a(A, lda, arow + 128, azero_below, arow_max, ko);
    S.a3 = g_ld_a(A, lda, arow + 192, azero_below, arow_max, ko);
  }
  S.b0 = *(const u32x4*)(bp0 + ko);
  S.b1 = *(const u32x4*)(bp1 + ko);
}
template <int NA>
DEV void g_store(const GStage<NA>& S, u16* An, u16* Bn, int st_off) {
  *(u32x4*)(An + st_off) = S.a0;
  *(u32x4*)(An + st_off + 64 * 72) = S.a1;
  if constexpr (NA == 4) {
    *(u32x4*)(An + st_off + 128 * 72) = S.a2;
    *(u32x4*)(An + st_off + 192 * 72) = S.a3;
  }
  *(u32x4*)(Bn + st_off) = S.b0;
  *(u32x4*)(Bn + st_off + 64 * 72) = S.b1;
}
template <int MT>
DEV void g_compute(f32x16 (&acc)[MT][2], const u16* Ab, const u16* Bb) {
#pragma unroll
  for (int ks = 0; ks < 4; ++ks) {
    bf16x8 a[MT], b[2];
#pragma unroll
    for (int i = 0; i < MT; ++i) a[i] = *(const bf16x8*)(Ab + i * 32 * 72 + ks * 16);
#pragma unroll
    for (int j = 0; j < 2; ++j) b[j] = *(const bf16x8*)(Bb + j * 32 * 72 + ks * 16);
#pragma unroll
    for (int i = 0; i < MT; ++i)
#pragma unroll
      for (int j = 0; j < 2; ++j) acc[i][j] = __builtin_amdgcn_mfma_f32_32x32x16_bf16(a[i], b[j], acc[i][j], 0, 0, 0);
  }
}
template <int MT>
DEV void gemm_tile(f32x16 (&acc)[MT][2], const u16* A, long lda, int arow0, int azero_below, int arow_max,
                   const u16* B, long ldb, int K, u16* smem) {
  constexpr int TM = 128 * MT;
  constexpr int ASZ = TM * 72, BSZ = 128 * 72;
  constexpr int NA = TM / 64;
  const int tid = my_tid(), lane = tid & 63, wave = tid >> 6, wm = wave >> 1, wn = wave & 1;
  const int crow = tid >> 3, ckc = tid & 7;
  GStage<NA> s0, s1;
  const u16* Ak = A + ckc * 8;
  const int arow = arow0 + crow;
  const u16* bp0 = B + (long)crow * ldb + ckc * 8;
  const u16* bp1 = B + (long)(crow + 64) * ldb + ckc * 8;
  const int nk = K >> 6;
  const int arow_l = (wm * 32 * MT + (lane & 31)) * 72 + (lane >> 5) * 8;
  const int brow_l = (wn * 64 + (lane & 31)) * 72 + (lane >> 5) * 8;
  const int st_off = crow * 72 + ckc * 8;
  g_load<NA>(s0, Ak, lda, arow, azero_below, arow_max, bp0, bp1, 0);
  g_store<NA>(s0, smem, smem + ASZ, st_off);
  g_load<NA>(s1, Ak, lda, arow, azero_below, arow_max, bp0, bp1, 64);
  __syncthreads();
  for (int kt = 0; kt < nk; kt += 2) {
    if (kt + 2 < nk) g_load<NA>(s0, Ak, lda, arow, azero_below, arow_max, bp0, bp1, (kt + 2) * 64);
    g_compute<MT>(acc, smem + arow_l, smem + ASZ + brow_l);
    g_store<NA>(s1, smem + (ASZ + BSZ), smem + (ASZ + BSZ) + ASZ, st_off);
    __syncthreads();
    if (kt + 3 < nk) g_load<NA>(s1, Ak, lda, arow, azero_below, arow_max, bp0, bp1, (kt + 3) * 64);
    g_compute<MT>(acc, smem + (ASZ + BSZ) + arow_l, smem + (ASZ + BSZ) + ASZ + brow_l);
    if (kt + 2 < nk) g_store<NA>(s0, smem, smem + ASZ, st_off);
    __syncthreads();
  }
}
struct GStageB { u32x4 a0, a1, a2, a3, b0, b1, b2, b3; };
DEV const u16* g_rowptr(const u16* A, long lda, int g, int arow_max) {
  g = g < 0 ? 0 : g;
  g = g > arow_max ? arow_max : g;
  return A + (long)g * lda;
}
DEV void gb_load(GStageB& S, const u16* A, long lda, int arow, int arow_max, const u16* Bk, long ldb, int ko) {
  S.a0 = *(const u32x4*)(g_rowptr(A, lda, arow, arow_max) + ko);
  S.a1 = *(const u32x4*)(g_rowptr(A, lda, arow + 64, arow_max) + ko);
  S.a2 = *(const u32x4*)(g_rowptr(A, lda, arow + 128, arow_max) + ko);
  S.a3 = *(const u32x4*)(g_rowptr(A, lda, arow + 192, arow_max) + ko);
  S.b0 = *(const u32x4*)(Bk + ko);
  S.b1 = *(const u32x4*)(Bk + 64 * ldb + ko);
  S.b2 = *(const u32x4*)(Bk + 128 * ldb + ko);
  S.b3 = *(const u32x4*)(Bk + 192 * ldb + ko);
}
DEV void gb_store(const GStageB& S, u16* An, u16* Bn, int st_off, int arow, int azero_below) {
  const u32x4 zero = {0u, 0u, 0u, 0u};
  *(u32x4*)(An + st_off) = (arow < azero_below) ? zero : S.a0;
  *(u32x4*)(An + st_off + 64 * 72) = (arow + 64 < azero_below) ? zero : S.a1;
  *(u32x4*)(An + st_off + 128 * 72) = (arow + 128 < azero_below) ? zero : S.a2;
  *(u32x4*)(An + st_off + 192 * 72) = (arow + 192 < azero_below) ? zero : S.a3;
  *(u32x4*)(Bn + st_off) = S.b0;
  *(u32x4*)(Bn + st_off + 64 * 72) = S.b1;
  *(u32x4*)(Bn + st_off + 128 * 72) = S.b2;
  *(u32x4*)(Bn + st_off + 192 * 72) = S.b3;
}
DEV void gb_compute(f32x16 (&acc)[2][4], const u16* Ab, const u16* Bb) {
#pragma unroll
  for (int ks = 0; ks < 4; ++ks) {
    bf16x8 a[2], b[4];
#pragma unroll
    for (int i = 0; i < 2; ++i) a[i] = *(const bf16x8*)(Ab + i * 32 * 72 + ks * 16);
#pragma unroll
    for (int j = 0; j < 4; ++j) b[j] = *(const bf16x8*)(Bb + j * 32 * 72 + ks * 16);
#pragma unroll
    for (int i = 0; i < 2; ++i)
#pragma unroll
      for (int j = 0; j < 4; ++j) acc[i][j] = __builtin_amdgcn_mfma_f32_32x32x16_bf16(a[i], b[j], acc[i][j], 0, 0, 0);
  }
}
DEV void gemm_big(f32x16 (&acc)[2][4], const u16* A, long lda, int arow0, int azero_below, int arow_max,
                  const u16* B, long ldb, int K, u16* smem) {
  constexpr int ASZ = 256 * 72, BSZ = 256 * 72;
  const int tid = my_tid(), lane = tid & 63, wave = tid >> 6, wm = wave >> 1, wn = wave & 1;
  const int crow = tid >> 3, ckc = tid & 7;
  const u16* Ak = A + ckc * 8;
  const int arow = arow0 + crow;
  const u16* Bk = B + (long)crow * ldb + ckc * 8;
  const int nk = K >> 6;
  const int arow_l = (wm * 64 + (lane & 31)) * 72 + (lane >> 5) * 8;
  const int brow_l = (wn * 128 + (lane & 31)) * 72 + (lane >> 5) * 8;
  const int st_off = crow * 72 + ckc * 8;
  GStageB s;
  gb_load(s, Ak, lda, arow, arow_max, Bk, ldb, 0);
  gb_store(s, smem, smem + ASZ, st_off, arow, azero_below);
  __syncthreads();
  for (int kt = 0; kt < nk; ++kt) {
    const bool more = kt + 1 < nk;
    if (more) gb_load(s, Ak, lda, arow, arow_max, Bk, ldb, (kt + 1) * 64);
    __builtin_amdgcn_sched_barrier(0);
    const u16* cb = smem + (kt & 1) * (ASZ + BSZ);
    gb_compute(acc, cb + arow_l, cb + ASZ + brow_l);
    __builtin_amdgcn_sched_barrier(0);
    if (more) {
      u16* nb_ = smem + ((kt + 1) & 1) * (ASZ + BSZ);
      gb_store(s, nb_, nb_ + ASZ, st_off, arow, azero_below);
    }
    __syncthreads();
  }
}
#define BIG_ROW(i, e) (wm * 64 + (i) * 32 + ((e) & 3) + 8 * ((e) >> 2) + 4 * (lane >> 5))
#define BIG_COL(j) (wn * 128 + (j) * 32 + (lane & 31))
#define ZERO_BIG(acc)                                   \
  _Pragma("unroll") for (int i_ = 0; i_ < 2; ++i_)      \
  _Pragma("unroll") for (int j_ = 0; j_ < 4; ++j_)      \
  _Pragma("unroll") for (int e_ = 0; e_ < 16; ++e_) acc[i_][j_][e_] = 0.f;

#define ACC_ROW(MT_, i, e) (wm * 32 * (MT_) + (i) * 32 + ((e) & 3) + 8 * ((e) >> 2) + 4 * (lane >> 5))
#define ACC_COL(j) (wn * 64 + (j) * 32 + (lane & 31))

DEV void tconv_coords(int tt, int KT, int mode, int& k0, int& n0, int& sn0) {
  const int kt = tt % KT, nt = tt / KT;
  k0 = kt * 64; n0 = nt * 64; sn0 = n0;
  if (mode == 1) { int j = n0 >> 8, c = n0 & 255; sn0 = (c < 128) ? (j * 128 + c) : (DFF + j * 128 + c - 128); }
}
DEV void tconv(const float* src, int K, int N, u16* dst, const float* scale, int mode, float* t, int bid, int nb) {
  const int tid = my_tid();
  const int KT = K >> 6, NT = N >> 6, ntiles = KT * NT;
  float* t1 = t + 64 * 65;
  for (int tt = bid; tt < ntiles; tt += 2 * nb) {
    const int tt2 = tt + nb;
    const bool has2 = tt2 < ntiles;
    int k0a, n0a, sna, k0b = 0, n0b = 0, snb = 0;
    tconv_coords(tt, KT, mode, k0a, n0a, sna);
    if (has2) tconv_coords(tt2, KT, mode, k0b, n0b, snb);
    {
      const int kk = tid >> 6, n = tid & 63;
      float va[8], vb[8];
#pragma unroll
      for (int i = 0; i < 8; ++i) {
        const int k = kk + 8 * i;
        va[i] = src[(long)(k0a + k) * N + sna + n];
        vb[i] = has2 ? src[(long)(k0b + k) * N + snb + n] : 0.f;
      }
#pragma unroll
      for (int i = 0; i < 8; ++i) {
        const int k = kk + 8 * i;
        float a = va[i], b = vb[i];
        if (scale) { a *= scale[k0a + k]; if (has2) b *= scale[k0b + k]; }
        t[k * 65 + n] = a;
        t1[k * 65 + n] = b;
      }
    }
    __syncthreads();
    {
      const int n = tid >> 3, k8 = tid & 7;
      float f[8];
#pragma unroll
      for (int j = 0; j < 8; ++j) f[j] = t[(k8 * 8 + j) * 65 + n];
      *(uint4*)(dst + (long)(n0a + n) * K + k0a + k8 * 8) = pack8(f);
      if (has2) {
#pragma unroll
        for (int j = 0; j < 8; ++j) f[j] = t1[(k8 * 8 + j) * 65 + n];
        *(uint4*)(dst + (long)(n0b + n) * K + k0b + k8 * 8) = pack8(f);
      }
    }
    __syncthreads();
  }
}

DEV void phase_prep(const Params& p, float* smf, int bid, int nb) {
  for (int l = 0; l < 2; ++l) {
    unsigned char* W = p.ws + OFF_W + (size_t)l * LW_BYTES;
    tconv(p.in[2] + (size_t)l * DM * INC, DM, INC, (u16*)(W + W_IN), p.in[1] + l * DM, 0, smf, bid, nb);
    for (int g = 0; g < 3; ++g)
      tconv(p.in[18] + (size_t)(l * 3 + g) * 512 * DM, 512, DM, (u16*)(W + W_BR) + (size_t)g * DM * 512, nullptr, 0, smf, bid, nb);
    tconv(p.in[19] + (size_t)l * DM * DM, DM, DM, (u16*)(W + W_OUT), nullptr, 0, smf, bid, nb);
    tconv(p.in[21] + (size_t)l * DM * 2 * DFF, DM, 2 * DFF, (u16*)(W + W_UP), p.in[20] + l * DM, 1, smf, bid, nb);
    tconv(p.in[24] + (size_t)l * DFF * DM, DFF, DM, (u16*)(W + W_DN), nullptr, 0, smf, bid, nb);
    tconv(p.in[5] + (size_t)l * 64 * 512, 64, 512, (u16*)(W + W_RWUP), nullptr, 0, smf, bid, nb);
    tconv(p.in[7] + (size_t)l * 64 * 512, 64, 512, (u16*)(W + W_RAUP), nullptr, 0, smf, bid, nb);
    tconv(p.in[8] + (size_t)l * 128 * 512, 128, 512, (u16*)(W + W_RGUP), nullptr, 0, smf, bid, nb);
    const float* sw = p.in[16] + (size_t)l * 4 * 128 * 128;
    u16* sd = (u16*)(W + W_SGW);
    for (int idx = bid * NTHR + my_tid(); idx < 4 * 128 * 128; idx += nb * NTHR) {
      int i = (idx >> 7) & 127, j = idx & 127;
      sd[idx] = f2bf(j <= i ? sw[idx] : 0.f);
    }
  }
  {
    float* sq = (float*)(p.ws + OFF_RSTD) + NTOK;
    for (int idx = bid * NTHR + my_tid(); idx < 3 * NTOK; idx += nb * NTHR) sq[idx] = 0.f;
  }
  float* rc = (float*)(p.ws + OFF_ROPE);
  float* rs = rc + SEQ * 32;
  for (int idx = bid * NTHR + my_tid(); idx < SEQ * 32; idx += nb * NTHR) {
    int pos = idx >> 5, d = idx & 31;
    float lin = (d == 31) ? 1.0f : (float)d * (1.0f / 31.0f);
    float invf = 1.0f / powf(10000.0f, lin);
    float ang = (float)pos * invf;
    double rev = (double)ang * 0.15915494309189533577;
    float fr = (float)(rev - floor(rev));
    rc[idx] = __builtin_amdgcn_cosf(fr);
    rs[idx] = __builtin_amdgcn_sinf(fr);
  }
}

DEV void phase_norm(const float* x, u16* xb, float* rstd, int bid, int nb) {
  const int lane = my_tid() & 63, wave = my_tid() >> 6;
  for (int row = bid * 8 + wave; row < NTOK; row += nb * 8) {
    const float4* xr = (const float4*)(x + (size_t)row * DM);
    float4 v[4];
    float ss = 0.f;
#pragma unroll
    for (int i = 0; i < 4; ++i) {
      v[i] = xr[lane + 64 * i];
      ss += v[i].x * v[i].x + v[i].y * v[i].y + v[i].z * v[i].z + v[i].w * v[i].w;
    }
    ss = wave_sum(ss);
    if (lane == 0) rstd[row] = ss;
    uint2* o = (uint2*)(xb + (size_t)row * DM);
#pragma unroll
    for (int i = 0; i < 4; ++i) o[lane + 64 * i] = make_uint2(pack2(v[i].x, v[i].y), pack2(v[i].z, v[i].w));
  }
}
DEV void phase_final(float* x, const float* g, int bid, int nb) {
  const int lane = my_tid() & 63, wave = my_tid() >> 6;
  for (int row = bid * 8 + wave; row < NTOK; row += nb * 8) {
    float4* xr = (float4*)(x + (size_t)row * DM);
    const float4* gr = (const float4*)g;
    float4 v[4];
    float ss = 0.f;
#pragma unroll
    for (int i = 0; i < 4; ++i) {
      v[i] = xr[lane + 64 * i];
      ss += v[i].x * v[i].x + v[i].y * v[i].y + v[i].z * v[i].z + v[i].w * v[i].w;
    }
    ss = wave_sum(ss);
    float r = rsqrtf(ss * (1.0f / DM) + 1e-6f);
#pragma unroll
    for (int i = 0; i < 4; ++i) {
      float4 gg = gr[lane + 64 * i];
      xr[lane + 64 * i] = make_float4(v[i].x * r * gg.x, v[i].y * r * gg.y, v[i].z * r * gg.z, v[i].w * r * gg.w);
    }
  }
}

DEV void phase_inproj(const u16* xb, const float* rstd, const u16* wt, int N, u16* out, u16* smem, int bid, int nb) {
  const int tid = my_tid(), lane = tid & 63, wave = tid >> 6, wm = wave >> 1, wn = wave & 1;
  const int MTL = NTOK / 256, NTL = N / 256;
  for (int t = vbid(bid, nb); t < MTL * NTL; t += nb) {
    int m, n;
    tile_map(t, MTL, NTL, m, n);
    f32x16 acc[2][4];
    ZERO_BIG(acc);
    gemm_big(acc, xb, DM, m * 256, -(1 << 30), NTOK - 1, wt + (size_t)n * 256 * DM, DM, DM, smem);
#pragma unroll
    for (int i = 0; i < 2; ++i)
#pragma unroll
      for (int e = 0; e < 16; ++e) {
        const int r = BIG_ROW(i, e);
        const float rs = rstd_of(rstd, m * 256 + r);
#pragma unroll
        for (int j = 0; j < 4; ++j) smem[r * 264 + BIG_COL(j)] = f2bf(acc[i][j][e] * rs);
      }
    __syncthreads();
#pragma unroll 4
    for (int k = 0; k < 16; ++k) {
      const int c = tid + NTHR * k;
      const int r = c >> 5, cc = c & 31;
      *(uint4*)(out + (size_t)(m * 256 + r) * N + n * 256 + cc * 8) = *(const uint4*)(smem + r * 264 + cc * 8);
    }
    __syncthreads();
  }
}

#define OPS_STRIDE ((size_t)NTOK * 512)
template <int WHICH>
DEV void rwprep_gemm(const u16* T, u16* OS, const u16* wsrc, const float* w0, const float* a0, u16* ops, int t0, int nbk) {
  const int tid = my_tid(), lane = tid & 63, wave = tid >> 6, wm = wave >> 1, wn = wave & 1;
  constexpr int kd = (WHICH == 2) ? 128 : 64;
  constexpr int aoff = (WHICH == 0) ? 0 : (WHICH == 1 ? 64 : 128);
  constexpr int arr = (WHICH == 0) ? 4 : (WHICH == 1 ? 3 : 5);
  const int arow = (wm * 32 + (lane & 31)) * 264 + (lane >> 5) * 8;
  const int bn = nbk * 128 + wn * 64 + (lane & 31);
  bf16x8 bfr[kd / 16][2];
#pragma unroll
  for (int ks = 0; ks < kd / 16; ++ks)
#pragma unroll
    for (int j = 0; j < 2; ++j) bfr[ks][j] = *(const bf16x8*)(wsrc + (size_t)(bn + j * 32) * kd + ks * 16 + (lane >> 5) * 8);
  f32x16 ac[2];
#pragma unroll
  for (int j = 0; j < 2; ++j)
#pragma unroll
    for (int e = 0; e < 16; ++e) ac[j][e] = 0.f;
#pragma unroll
  for (int ks = 0; ks < kd / 16; ++ks) {
    const bf16x8 a1 = *(const bf16x8*)(T + arow + aoff + ks * 16);
#pragma unroll
    for (int j = 0; j < 2; ++j) ac[j] = __builtin_amdgcn_mfma_f32_32x32x16_bf16(a1, bfr[ks][j], ac[j], 0, 0, 0);
  }
#pragma unroll
  for (int j = 0; j < 2; ++j) {
    const int cl = ACC_COL(j);
    const int ch = nbk * 128 + cl;
    const float w0c = w0[ch], a0c = a0[ch];
#pragma unroll
    for (int e = 0; e < 16; ++e) {
      float val;
      if (WHICH == 0) {
        const float z = -(w0c + ac[j][e]);
        const float sp = fmaxf(z, 0.f) + log1pf(__expf(-fabsf(z)));
        val = __expf(-sp - 0.5f);
      } else if (WHICH == 1) {
        val = sigmoidf_(a0c + ac[j][e]);
      } else {
        val = ac[j][e];
      }
      OS[ACC_ROW(1, 0, e) * 136 + cl] = f2bf(val);
    }
  }
  __syncthreads();
#pragma unroll
  for (int k = 0; k < 4; ++k) {
    const int c = tid + NTHR * k;
    const int r = c >> 4, cc = c & 15;
    *(uint4*)(ops + (size_t)arr * OPS_STRIDE + (size_t)(t0 + r) * 512 + nbk * 128 + cc * 8) = *(const uint4*)(OS + r * 136 + cc * 8);
  }
  __syncthreads();
}

DEV void phase_rwprep(const Params& p, int l, u16* smem, int bid, int nb) {
  const int tid = my_tid(), lane = tid & 63, wave = tid >> 6, wm = wave >> 1, wn = wave & 1;
  const u16* prw = (const u16*)(p.ws + OFF_BIG + B_PRW);
  u16* ops = (u16*)(p.ws + OFF_BIG + B_OPS);
  unsigned char* W = p.ws + OFF_W + (size_t)l * LW_BYTES;
  const u16* wup = (const u16*)(W + W_RWUP);
  const u16* aup = (const u16*)(W + W_RAUP);
  const u16* gup = (const u16*)(W + W_RGUP);
  const float* mu = p.in[3] + l * 1792;
  const float* w0 = p.in[4] + l * 512;
  const float* a0 = p.in[6] + l * 512;
  u16* T = smem;
  for (int tile = bid; tile < NTOK / 128; tile += nb) {
    const int t0 = tile * 128;
    for (int c0 = tid; c0 < 128 * 224; c0 += NTHR * 8) {
      u32x4 cu[8], pv[8];
#pragma unroll
      for (int q = 0; q < 8; ++q) {
        const int c = c0 + NTHR * q;
        const int tok = c / 224, ch = (c % 224) * 8;
        const int t = t0 + tok;
        cu[q] = *(const u32x4*)(prw + (size_t)t * 1792 + ch);
        const int tp = ((t & (SEQ - 1)) != 0) ? t - 1 : t;
        pv[q] = *(const u32x4*)(prw + (size_t)tp * 1792 + ch);
      }
#pragma unroll
      for (int q = 0; q < 8; ++q) {
        const int c = c0 + NTHR * q;
        const int tok = c / 224, ch = (c % 224) * 8;
        const int t = t0 + tok;
        float cur[8], prv[8], o[8];
        unpack8(make_uint4(cu[q].x, cu[q].y, cu[q].z, cu[q].w), cur);
        unpack8(make_uint4(pv[q].x, pv[q].y, pv[q].z, pv[q].w), prv);
        if ((t & (SEQ - 1)) == 0) {
#pragma unroll
          for (int j = 0; j < 8; ++j) prv[j] = 0.f;
        }
        float4 m0 = *(const float4*)(mu + ch), m1 = *(const float4*)(mu + ch + 4);
        float mm[8] = {m0.x, m0.y, m0.z, m0.w, m1.x, m1.y, m1.z, m1.w};
#pragma unroll
        for (int j = 0; j < 8; ++j) o[j] = cur[j] + mm[j] * (prv[j] - cur[j]);
        if (ch < 1536) {
          int arr = ch >> 9;
          *(uint4*)(ops + arr * OPS_STRIDE + (size_t)t * 512 + (ch & 511)) = pack8(o);
        } else {
          int cc = ch - 1536;
          if (cc < 64) {
#pragma unroll
            for (int j = 0; j < 8; ++j) o[j] = tanhf(o[j]);
          } else if (cc >= 128) {
#pragma unroll
            for (int j = 0; j < 8; ++j) o[j] = sigmoidf_(o[j]);
          }
          *(uint4*)(T + tok * 264 + cc) = pack8(o);
        }
      }
    }
    __syncthreads();
    u16* OS = smem + 128 * 264;
    for (int nbk = 0; nbk < 4; ++nbk) {
      rwprep_gemm<0>(T, OS, wup, w0, a0, ops, t0, nbk);
      rwprep_gemm<1>(T, OS, aup, w0, a0, ops, t0, nbk);
      rwprep_gemm<2>(T, OS, gup, w0, a0, ops, t0, nbk);
    }
    __syncthreads();
  }
}

#define TS 32
struct ScanStage {
  float* W; float* KK; float* BB; float* KP; float* RR; float* VV; float* YY;
};
template <int PASS>
DEV void phase_scan(const Params& p, int l, float* smf, int bid, int nb) {
  const int tid = my_tid();
  const int half = tid >> 8, tu = tid & 255;
  const u16* ops = (const u16*)(p.ws + OFF_BIG + B_OPS);
  float* PL = (float*)(p.ws + OFF_BIG + B_PL);
  const float* SIN = (const float*)(p.ws + OFF_BIG + B_SINIT);
  u16* yrw = (u16*)(p.ws + OFF_BIG + B_YRW);
  const float* k_k = p.in[9] + l * 512;
  const float* k_a = p.in[10] + l * 512;
  const float* r_k = p.in[11] + l * 512;
  const float* lng = p.in[12] + l * 512;
  const float* lnb = p.in[13] + l * 512;
  float* base = smf + half * (7 * TS * 64);
  float* sW = base; float* sKK = base + TS * 64; float* sB = base + 2 * TS * 64; float* sKP = base + 3 * TS * 64;
  float* sR = base + 4 * TS * 64; float* sV = base + 5 * TS * 64; float* sY = base + 6 * TS * 64;
  const int ss = tu >> 3, c8 = tu & 7;
  const int ks = tu & 7, rp = tu >> 3;
  for (int u2 = bid; u2 < 256; u2 += nb) {
    const int u = u2 * 2 + half;
    const int bh = u >> 4, c = u & 15;
    const int b = bh >> 3, h = bh & 7;
    const int tok0 = b * SEQ + c * 512;
    const int chb = h * 64 + c8 * 8;
    float S0[8], S1[8], Q0[8], Q1[8];
    if (PASS == 1) {
#pragma unroll
      for (int j = 0; j < 8; ++j) {
        S0[j] = 0.f; S1[j] = 0.f;
        Q0[j] = (ks * 8 + j == 2 * rp) ? 1.f : 0.f;
        Q1[j] = (ks * 8 + j == 2 * rp + 1) ? 1.f : 0.f;
      }
    } else {
      const float* si = SIN + (size_t)u * 4096;
      float4 x0 = *(const float4*)(si + (2 * rp) * 64 + ks * 8), x1 = *(const float4*)(si + (2 * rp) * 64 + ks * 8 + 4);
      float4 y0 = *(const float4*)(si + (2 * rp + 1) * 64 + ks * 8), y1 = *(const float4*)(si + (2 * rp + 1) * 64 + ks * 8 + 4);
      S0[0] = x0.x; S0[1] = x0.y; S0[2] = x0.z; S0[3] = x0.w; S0[4] = x1.x; S0[5] = x1.y; S0[6] = x1.z; S0[7] = x1.w;
      S1[0] = y0.x; S1[1] = y0.y; S1[2] = y0.z; S1[3] = y0.w; S1[4] = y1.x; S1[5] = y1.y; S1[6] = y1.z; S1[7] = y1.w;
#pragma unroll
      for (int j = 0; j < 8; ++j) { Q0[j] = 0.f; Q1[j] = 0.f; }
    }
    float kkc[8], kac[8], rkc[8];
    {
      float4 q0 = *(const float4*)(k_k + chb), q1 = *(const float4*)(k_k + chb + 4);
      kkc[0] = q0.x; kkc[1] = q0.y; kkc[2] = q0.z; kkc[3] = q0.w; kkc[4] = q1.x; kkc[5] = q1.y; kkc[6] = q1.z; kkc[7] = q1.w;
      q0 = *(const float4*)(k_a + chb); q1 = *(const float4*)(k_a + chb + 4);
      kac[0] = q0.x; kac[1] = q0.y; kac[2] = q0.z; kac[3] = q0.w; kac[4] = q1.x; kac[5] = q1.y; kac[6] = q1.z; kac[7] = q1.w;
      q0 = *(const float4*)(r_k + chb); q1 = *(const float4*)(r_k + chb + 4);
      rkc[0] = q0.x; rkc[1] = q0.y; rkc[2] = q0.z; rkc[3] = q0.w; rkc[4] = q1.x; rkc[5] = q1.y; rkc[6] = q1.z; rkc[7] = q1.w;
    }
    uint4 pr_r, pr_k, pr_v, pr_a, pr_e, pr_g = make_uint4(0, 0, 0, 0);
    {
      const size_t o0 = (size_t)(tok0 + ss) * 512 + chb;
      pr_r = *(const uint4*)(ops + 0 * OPS_STRIDE + o0);
      pr_k = *(const uint4*)(ops + 1 * OPS_STRIDE + o0);
      pr_v = *(const uint4*)(ops + 2 * OPS_STRIDE + o0);
      pr_a = *(const uint4*)(ops + 3 * OPS_STRIDE + o0);
      pr_e = *(const uint4*)(ops + 4 * OPS_STRIDE + o0);
      if (PASS == 3) pr_g = *(const uint4*)(ops + 5 * OPS_STRIDE + o0);
    }
    for (int sc = 0; sc < 512 / TS; ++sc) {
      const size_t o = (size_t)(tok0 + sc * TS + ss) * 512 + chb;
      float fr[8], fk[8], fv[8], fa[8], fe[8];
      unpack8(pr_r, fr);
      unpack8(pr_k, fk);
      unpack8(pr_v, fv);
      unpack8(pr_a, fa);
      unpack8(pr_e, fe);
      const uint4 graw = pr_g;
      if (sc + 1 < 512 / TS) {
        const size_t o1 = o + (size_t)TS * 512;
        pr_r = *(const uint4*)(ops + 0 * OPS_STRIDE + o1);
        pr_k = *(const uint4*)(ops + 1 * OPS_STRIDE + o1);
        pr_v = *(const uint4*)(ops + 2 * OPS_STRIDE + o1);
        pr_a = *(const uint4*)(ops + 3 * OPS_STRIDE + o1);
        pr_e = *(const uint4*)(ops + 4 * OPS_STRIDE + o1);
        if (PASS == 3) pr_g = *(const uint4*)(ops + 5 * OPS_STRIDE + o1);
      }
      float kk[8], kp[8], ssq = 0.f, bon = 0.f;
#pragma unroll
      for (int j = 0; j < 8; ++j) {
        kk[j] = fk[j] * kkc[j];
        ssq += kk[j] * kk[j];
        kp[j] = fk[j] * (1.f + (fa[j] - 1.f) * kac[j]);
        bon += fr[j] * kp[j] * rkc[j];
      }
      ssq = red8(ssq);
      bon = red8(bon);
      const float inv = 1.f / fmaxf(sqrtf(ssq), 1e-12f);
      float fw[8], fb[8];
#pragma unroll
      for (int j = 0; j < 8; ++j) {
        kk[j] *= inv;
        fb[j] = fa[j] * kk[j];
        fw[j] = __expf(-fe[j]);
      }
      {
        const int so = ss * 64 + c8 * 8;
        *(float4*)(sW + so) = make_float4(fw[0], fw[1], fw[2], fw[3]); *(float4*)(sW + so + 4) = make_float4(fw[4], fw[5], fw[6], fw[7]);
        *(float4*)(sKK + so) = make_float4(kk[0], kk[1], kk[2], kk[3]); *(float4*)(sKK + so + 4) = make_float4(kk[4], kk[5], kk[6], kk[7]);
        *(float4*)(sB + so) = make_float4(fb[0], fb[1], fb[2], fb[3]); *(float4*)(sB + so + 4) = make_float4(fb[4], fb[5], fb[6], fb[7]);
        *(float4*)(sKP + so) = make_float4(kp[0], kp[1], kp[2], kp[3]); *(float4*)(sKP + so + 4) = make_float4(kp[4], kp[5], kp[6], kp[7]);
        *(float4*)(sV + so) = make_float4(fv[0], fv[1], fv[2], fv[3]); *(float4*)(sV + so + 4) = make_float4(fv[4], fv[5], fv[6], fv[7]);
        if (PASS == 3) {
          *(float4*)(sR + so) = make_float4(fr[0], fr[1], fr[2], fr[3]); *(float4*)(sR + so + 4) = make_float4(fr[4], fr[5], fr[6], fr[7]);
        }
      }
      __syncthreads();
      typedef float f2 __attribute__((ext_vector_type(2)));
      f2 SP[8], QP[8];
#pragma unroll
      for (int j = 0; j < 8; ++j) { SP[j] = (f2){S0[j], S1[j]}; QP[j] = (f2){Q0[j], Q1[j]}; }
#pragma unroll 2
      for (int s = 0; s < TS; ++s) {
        const int so = s * 64 + ks * 8;
        float4 t0 = *(const float4*)(sW + so), t1 = *(const float4*)(sW + so + 4);
        const float w[8] = {t0.x, t0.y, t0.z, t0.w, t1.x, t1.y, t1.z, t1.w};
        t0 = *(const float4*)(sKK + so); t1 = *(const float4*)(sKK + so + 4);
        const float kq[8] = {t0.x, t0.y, t0.z, t0.w, t1.x, t1.y, t1.z, t1.w};
        t0 = *(const float4*)(sB + so); t1 = *(const float4*)(sB + so + 4);
        const float bq[8] = {t0.x, t0.y, t0.z, t0.w, t1.x, t1.y, t1.z, t1.w};
        t0 = *(const float4*)(sKP + so); t1 = *(const float4*)(sKP + so + 4);
        const float kpq[8] = {t0.x, t0.y, t0.z, t0.w, t1.x, t1.y, t1.z, t1.w};
        const float2 vraw = *(const float2*)(sV + s * 64 + 2 * rp);
        const f2 vv = (f2){vraw.x, vraw.y};
        f2 sa = SP[0] * kq[0];
#pragma unroll
        for (int j = 1; j < 8; ++j) sa = SP[j] * kq[j] + sa;
        sa = (f2){red8(sa.x), red8(sa.y)};
#pragma unroll
        for (int j = 0; j < 8; ++j) SP[j] = SP[j] * w[j] + (vv * kpq[j] - sa * bq[j]);
        if (PASS == 1) {
          f2 pa = QP[0] * kq[0];
#pragma unroll
          for (int j = 1; j < 8; ++j) pa = QP[j] * kq[j] + pa;
          pa = (f2){red8(pa.x), red8(pa.y)};
#pragma unroll
          for (int j = 0; j < 8; ++j) QP[j] = QP[j] * w[j] - pa * bq[j];
        } else {
          t0 = *(const float4*)(sR + so); t1 = *(const float4*)(sR + so + 4);
          const float rq[8] = {t0.x, t0.y, t0.z, t0.w, t1.x, t1.y, t1.z, t1.w};
          f2 y = SP[0] * rq[0];
#pragma unroll
          for (int j = 1; j < 8; ++j) y = SP[j] * rq[j] + y;
          const float y0 = red8(y.x), y1 = red8(y.y);
          if (ks == 0) *(float2*)(sY + s * 64 + 2 * rp) = make_float2(y0, y1);
        }
      }
#pragma unroll
      for (int j = 0; j < 8; ++j) { S0[j] = SP[j].x; S1[j] = SP[j].y; Q0[j] = QP[j].x; Q1[j] = QP[j].y; }
      __syncthreads();
      if (PASS == 3) {
        const int so = ss * 64 + c8 * 8;
        float4 y0 = *(const float4*)(sY + so), y1 = *(const float4*)(sY + so + 4);
        float y[8] = {y0.x, y0.y, y0.z, y0.w, y1.x, y1.y, y1.z, y1.w};
        float sm = 0.f;
#pragma unroll
        for (int j = 0; j < 8; ++j) sm += y[j];
        const float mean = red8(sm) * (1.f / 64.f);
        float sv = 0.f;
#pragma unroll
        for (int j = 0; j < 8; ++j) { y[j] -= mean; sv += y[j] * y[j]; }
        const float var = red8(sv) * (1.f / 64.f);
        const float rs = rsqrtf(var + 64e-5f);
        float g[8], outv[8];
        unpack8(graw, g);
        float4 l0 = *(const float4*)(lng + chb), l1 = *(const float4*)(lng + chb + 4);
        float4 b0 = *(const float4*)(lnb + chb), b1 = *(const float4*)(lnb + chb + 4);
        float lg[8] = {l0.x, l0.y, l0.z, l0.w, l1.x, l1.y, l1.z, l1.w};
        float lb[8] = {b0.x, b0.y, b0.z, b0.w, b1.x, b1.y, b1.z, b1.w};
#pragma unroll
        for (int j = 0; j < 8; ++j) outv[j] = (y[j] * rs * lg[j] + lb[j] + bon * fv[j]) * g[j];
        if (!(c == 0 && sc == 0 && ss == 0)) *(uint4*)(yrw + o) = pack8(outv);
      }
    }
    if (PASS == 1) {
      float* pl = PL + (size_t)u * 8192;
      float* Pm = pl;
      float* Lm = pl + 4096;
      *(float4*)(Pm + (2 * rp) * 64 + ks * 8) = make_float4(Q0[0], Q0[1], Q0[2], Q0[3]);
      *(float4*)(Pm + (2 * rp) * 64 + ks * 8 + 4) = make_float4(Q0[4], Q0[5], Q0[6], Q0[7]);
      *(float4*)(Pm + (2 * rp + 1) * 64 + ks * 8) = make_float4(Q1[0], Q1[1], Q1[2], Q1[3]);
      *(float4*)(Pm + (2 * rp + 1) * 64 + ks * 8 + 4) = make_float4(Q1[4], Q1[5], Q1[6], Q1[7]);
      *(float4*)(Lm + (2 * rp) * 64 + ks * 8) = make_float4(S0[0], S0[1], S0[2], S0[3]);
      *(float4*)(Lm + (2 * rp) * 64 + ks * 8 + 4) = make_float4(S0[4], S0[5], S0[6], S0[7]);
      *(float4*)(Lm + (2 * rp + 1) * 64 + ks * 8) = make_float4(S1[0], S1[1], S1[2], S1[3]);
      *(float4*)(Lm + (2 * rp + 1) * 64 + ks * 8 + 4) = make_float4(S1[4], S1[5], S1[6], S1[7]);
    }
  }
}

DEV void phase_scanprop(const Params& p, float* smf, int bid, int nb) {
  const int tid = my_tid();
  const float* PL = (const float*)(p.ws + OFF_BIG + B_PL);
  float* SIN = (float*)(p.ws + OFF_BIG + B_SINIT);
  float* sS = smf;
  float* sP = smf + 4096;
  const int i = tid >> 3, k8 = tid & 7;
  for (int bh = bid; bh < 32; bh += nb) {
    float cur[8];
#pragma unroll
    for (int j = 0; j < 8; ++j) cur[j] = 0.f;
    const float* pl0 = PL + (size_t)(bh * 16) * 8192;
    float4 np0 = *(const float4*)(pl0 + tid * 8), np1 = *(const float4*)(pl0 + tid * 8 + 4);
    float4 nl0 = *(const float4*)(pl0 + 4096 + i * 64 + k8 * 8), nl1 = *(const float4*)(pl0 + 4096 + i * 64 + k8 * 8 + 4);
    for (int c = 0; c < 16; ++c) {
      const int u = bh * 16 + c;
      float* so = SIN + (size_t)u * 4096 + i * 64 + k8 * 8;
      *(float4*)so = make_float4(cur[0], cur[1], cur[2], cur[3]);
      *(float4*)(so + 4) = make_float4(cur[4], cur[5], cur[6], cur[7]);
      if (c == 15) break;
      *(float4*)(sS + i * 64 + k8 * 8) = make_float4(cur[0], cur[1], cur[2], cur[3]);
      *(float4*)(sS + i * 64 + k8 * 8 + 4) = make_float4(cur[4], cur[5], cur[6], cur[7]);
      *(float4*)(sP + tid * 8) = np0;
      *(float4*)(sP + tid * 8 + 4) = np1;
      float nw[8] = {nl0.x, nl0.y, nl0.z, nl0.w, nl1.x, nl1.y, nl1.z, nl1.w};
      __syncthreads();
      if (c + 1 < 15) {
        const float* pl = PL + (size_t)(u + 1) * 8192;
        np0 = *(const float4*)(pl + tid * 8); np1 = *(const float4*)(pl + tid * 8 + 4);
        nl0 = *(const float4*)(pl + 4096 + i * 64 + k8 * 8); nl1 = *(const float4*)(pl + 4096 + i * 64 + k8 * 8 + 4);
      }
#pragma unroll 8
      for (int j = 0; j < 64; ++j) {
        const float sij = sS[i * 64 + j];
        float4 p0 = *(const float4*)(sP + j * 64 + k8 * 8), p1 = *(const float4*)(sP + j * 64 + k8 * 8 + 4);
        nw[0] += sij * p0.x; nw[1] += sij * p0.y; nw[2] += sij * p0.z; nw[3] += sij * p0.w;
        nw[4] += sij * p1.x; nw[5] += sij * p1.y; nw[6] += sij * p1.z; nw[7] += sij * p1.w;
      }
#pragma unroll
      for (int j = 0; j < 8; ++j) cur[j] = nw[j];
      __syncthreads();
    }
  }
}

DEV float ret_log2gamma(int h) { return log2f(1.0f - exp2f(-5.0f - (float)h)); }

DEV void stage_rot(const u16* src, size_t ld, const float* rc, const float* rs, int pos0, u16* dst, float sc, float l2g, int rowmode) {
  const int tid = my_tid();
  const int row = tid >> 2, d0 = (tid & 3) * 8;
  float lo[8], hi[8], olo[8], ohi[8];
  unpack8(*(const uint4*)(src + (size_t)row * ld + d0), lo);
  unpack8(*(const uint4*)(src + (size_t)row * ld + d0 + 32), hi);
  const float* cp = rc + (size_t)(pos0 + row) * 32 + d0;
  const float* sp = rs + (size_t)(pos0 + row) * 32 + d0;
  float4 c0 = *(const float4*)cp, c1 = *(const float4*)(cp + 4);
  float4 s0 = *(const float4*)sp, s1 = *(const float4*)(sp + 4);
  float cc[8] = {c0.x, c0.y, c0.z, c0.w, c1.x, c1.y, c1.z, c1.w};
  float sn[8] = {s0.x, s0.y, s0.z, s0.w, s1.x, s1.y, s1.z, s1.w};
  float rsc = sc;
  if (rowmode == 1) rsc *= exp2f((float)(row + 1) * l2g);
  if (rowmode == 2) rsc *= exp2f((float)(127 - row) * l2g);
#pragma unroll
  for (int j = 0; j < 8; ++j) {
    olo[j] = (lo[j] * cc[j] - hi[j] * sn[j]) * rsc;
    ohi[j] = (hi[j] * cc[j] + lo[j] * sn[j]) * rsc;
  }
  *(uint4*)(dst + row * 72 + d0) = pack8(olo);
  *(uint4*)(dst + row * 72 + d0 + 32) = pack8(ohi);
}
DEV void stage_rot_T(const u16* src, size_t ld, const float* rc, const float* rs, int pos0, u16* dst, float sc, float l2g) {
  const int tid = my_tid();
  const int row = tid >> 2, d0 = (tid & 3) * 8;
  float lo[8], hi[8];
  unpack8(*(const uint4*)(src + (size_t)row * ld + d0), lo);
  unpack8(*(const uint4*)(src + (size_t)row * ld + d0 + 32), hi);
  const float* cp = rc + (size_t)(pos0 + row) * 32 + d0;
  const float* sp = rs + (size_t)(pos0 + row) * 32 + d0;
  float4 c0 = *(const float4*)cp, c1 = *(const float4*)(cp + 4);
  float4 s0 = *(const float4*)sp, s1 = *(const float4*)(sp + 4);
  float cc[8] = {c0.x, c0.y, c0.z, c0.w, c1.x, c1.y, c1.z, c1.w};
  float sn[8] = {s0.x, s0.y, s0.z, s0.w, s1.x, s1.y, s1.z, s1.w};
  const float rsc = sc * exp2f((float)(127 - row) * l2g);
#pragma unroll
  for (int j = 0; j < 8; ++j) {
    dst[(d0 + j) * 136 + row] = f2bf((lo[j] * cc[j] - hi[j] * sn[j]) * rsc);
    dst[(d0 + j + 32) * 136 + row] = f2bf((hi[j] * cc[j] + lo[j] * sn[j]) * rsc);
  }
}
DEV void stage_vT(const u16* src, size_t ld, u16* dst) {
  const int tid = my_tid();
  const int row = tid >> 2, d0 = (tid & 3) * 32;
#pragma unroll
  for (int c = 0; c < 4; ++c) {
    uint4 v = *(const uint4*)(src + (size_t)row * ld + d0 + c * 8);
    unsigned w[4] = {v.x, v.y, v.z, v.w};
#pragma unroll
    for (int j = 0; j < 4; ++j) {
      dst[(d0 + c * 8 + 2 * j) * 136 + row] = (u16)(w[j] & 0xffffu);
      dst[(d0 + c * 8 + 2 * j + 1) * 136 + row] = (u16)(w[j] >> 16);
    }
  }
}

DEV void ret_kv_unit(const Params& p, int u, u16* smem) {
  const int tid = my_tid(), lane = tid & 63, wave = tid >> 6;
  const u16* prs = (const u16*)(p.ws + OFF_BIG + B_PRS);
  float* KV = (float*)(p.ws + OFF_BIG + B_KV);
  const float* rc = (const float*)(p.ws + OFF_ROPE);
  const float* rs = rc + SEQ * 32;
  const int n = u & 63, h = (u >> 6) & 3, b = u >> 8;
  const size_t t0 = (size_t)b * SEQ + n * 128;
  const float l2g = ret_log2gamma(h);
  u16* KT = smem;
  u16* VT = smem + 64 * 136;
  stage_rot_T(prs + t0 * 2560 + 256 + h * 64, 2560, rc, rs, n * 128, KT, 0.125f, l2g);
  stage_vT(prs + t0 * 2560 + 512 + h * 128, 2560, VT);
  __syncthreads();
  const int mi = wave >> 1, nj = wave & 1;
  f32x16 acc;
#pragma unroll
  for (int e = 0; e < 16; ++e) acc[e] = 0.f;
#pragma unroll
  for (int ks = 0; ks < 8; ++ks) {
    bf16x8 a = *(const bf16x8*)(VT + (mi * 32 + (lane & 31)) * 136 + ks * 16 + (lane >> 5) * 8);
    bf16x8 bb = *(const bf16x8*)(KT + (nj * 32 + (lane & 31)) * 136 + ks * 16 + (lane >> 5) * 8);
    acc = __builtin_amdgcn_mfma_f32_32x32x16_bf16(a, bb, acc, 0, 0, 0);
  }
  float* kv = KV + (size_t)u * 8192;
#pragma unroll
  for (int e = 0; e < 16; ++e) {
    int dv = mi * 32 + (e & 3) + 8 * (e >> 2) + 4 * (lane >> 5);
    int dk = nj * 32 + (lane & 31);
    kv[dv * 64 + dk] = acc[e];
  }
  __syncthreads();
}

DEV void sgu_unit(const Params& p, int l, int u, u16* smem) {
  const int tid = my_tid(), lane = tid & 63, wave = tid >> 6, wm = wave >> 1, wn = wave & 1;
  const u16* prs = (const u16*)(p.ws + OFF_BIG + B_PRS);
  u16* ysg = (u16*)(p.ws + OFF_BIG + B_YSG);
  const u16* sgw = (const u16*)(p.ws + OFF_W + (size_t)l * LW_BYTES + W_SGW);
  const float* lng = p.in[14] + l * 512;
  const float* lnb = p.in[15] + l * 512;
  const float* sgb = p.in[17] + l * 512;
  const size_t t0 = (size_t)u * 128;
  u16* VT = smem;
  u16* WT = smem + 128 * 136;
  float* st = (float*)(smem + 2 * 128 * 136);
  float* OS = st + 256;
  const int tok = tid >> 2, q = tid & 3;
  const u16* vrow = prs + (t0 + tok) * 2560 + 1536 + 512;
  {
    float s = 0.f, s2 = 0.f;
#pragma unroll 4
    for (int c = 0; c < 16; ++c) {
      float f[8];
      unpack8(*(const uint4*)(vrow + q * 128 + c * 8), f);
#pragma unroll
      for (int j = 0; j < 8; ++j) { float gl = geluf_(f[j]); s += gl; s2 += gl * gl; }
    }
    s = red4(s); s2 = red4(s2);
    const float mean = s * (1.f / 512.f);
    const float var = fmaxf(s2 * (1.f / 512.f) - mean * mean, 0.f);
    if (q == 0) { st[tok] = mean; st[128 + tok] = rsqrtf(var + 1e-6f); }
  }
  __syncthreads();
  const float mean = st[tok], rstd = st[128 + tok];
  for (int g = 0; g < 4; ++g) {
#pragma unroll
    for (int c = 0; c < 4; ++c) {
      const int d = q * 32 + c * 8;
      float f[8];
      unpack8(*(const uint4*)(vrow + g * 128 + d), f);
      float4 g0 = *(const float4*)(lng + g * 128 + d), g1 = *(const float4*)(lng + g * 128 + d + 4);
      float4 b0 = *(const float4*)(lnb + g * 128 + d), b1 = *(const float4*)(lnb + g * 128 + d + 4);
      float gg[8] = {g0.x, g0.y, g0.z, g0.w, g1.x, g1.y, g1.z, g1.w};
      float bb[8] = {b0.x, b0.y, b0.z, b0.w, b1.x, b1.y, b1.z, b1.w};
#pragma unroll
      for (int j = 0; j < 8; ++j) VT[(d + j) * 136 + tok] = f2bf((geluf_(f[j]) - mean) * rstd * gg[j] + bb[j]);
      *(uint4*)(WT + tok * 136 + d) = *(const uint4*)(sgw + (size_t)g * 16384 + tok * 128 + d);
    }
    __syncthreads();
    f32x16 acc[2];
#pragma unroll
    for (int j = 0; j < 2; ++j)
#pragma unroll
      for (int e = 0; e < 16; ++e) acc[j][e] = 0.f;
#pragma unroll
    for (int ks = 0; ks < 8; ++ks) {
      bf16x8 a = *(const bf16x8*)(WT + (wm * 32 + (lane & 31)) * 136 + ks * 16 + (lane >> 5) * 8);
#pragma unroll
      for (int j = 0; j < 2; ++j) {
        bf16x8 bb = *(const bf16x8*)(VT + (wn * 64 + j * 32 + (lane & 31)) * 136 + ks * 16 + (lane >> 5) * 8);
        acc[j] = __builtin_amdgcn_mfma_f32_32x32x16_bf16(a, bb, acc[j], 0, 0, 0);
      }
    }
#pragma unroll
    for (int e = 0; e < 16; ++e) {
      const int i = ACC_ROW(1, 0, e);
      const float bias = sgb[g * 128 + i];
#pragma unroll
      for (int j = 0; j < 2; ++j) OS[i * 132 + ACC_COL(j)] = acc[j][e] + bias;
    }
    __syncthreads();
#pragma unroll
    for (int k = 0; k < 4; ++k) {
      const int c = tid + NTHR * k;
      const int i = c >> 4, d = (c & 15) * 8;
      float uu[8], o[8];
      unpack8(*(const uint4*)(prs + (t0 + i) * 2560 + 1536 + g * 128 + d), uu);
      const float4 m0 = *(const float4*)(OS + i * 132 + d), m1 = *(const float4*)(OS + i * 132 + d + 4);
      const float mm[8] = {m0.x, m0.y, m0.z, m0.w, m1.x, m1.y, m1.z, m1.w};
#pragma unroll
      for (int q = 0; q < 8; ++q) o[q] = geluf_(uu[q]) * mm[q];
      *(uint4*)(ysg + (t0 + i) * 512 + g * 128 + d) = pack8(o);
    }
    __syncthreads();
  }
}

DEV void phase_retprefix(const Params& p, int bid, int nb) {
  float* KV = (float*)(p.ws + OFF_BIG + B_KV);
  for (int gid = bid * NTHR + my_tid(); gid < 16 * 8192; gid += nb * NTHR) {
    const int bh = gid >> 13, e = gid & 8191;
    const int h = bh & 3;
    const float cd = exp2f(128.f * ret_log2gamma(h));
    float R = 0.f;
    float* ptr = KV + (size_t)bh * 64 * 8192 + e;
    for (int n = 0; n < 64; ++n) {
      float kv = ptr[(size_t)n * 8192];
      ptr[(size_t)n * 8192] = R;
      R = R * cd + kv;
    }
  }
}

DEV void ret_out_unit(const Params& p, int u, u16* smem) {
  const int tid = my_tid(), lane = tid & 63, wave = tid >> 6, wm = wave >> 1, wn = wave & 1;
  const u16* prs = (const u16*)(p.ws + OFF_BIG + B_PRS);
  const float* KV = (const float*)(p.ws + OFF_BIG + B_KV);
  u16* yret = (u16*)(p.ws + OFF_BIG + B_YRET);
  const float* rc = (const float*)(p.ws + OFF_ROPE);
  const float* rs = rc + SEQ * 32;
  const int n = u & 63, h = (u >> 6) & 3, b = u >> 8;
  const size_t t0 = (size_t)b * SEQ + n * 128;
  const float l2g = ret_log2gamma(h);
  u16* Q = smem;
  u16* Kr = Q + 128 * 72;
  u16* VT = Kr + 128 * 72;
  u16* Qd = VT + 128 * 136;
  u16* RT = Qd + 128 * 72;
  u16* SP = RT + 128 * 72;
  float* OT = (float*)smem;
  stage_rot(prs + t0 * 2560 + h * 64, 2560, rc, rs, n * 128, Q, 1.0f, l2g, 0);
  stage_rot(prs + t0 * 2560 + h * 64, 2560, rc, rs, n * 128, Qd, 1.0f, l2g, 1);
  stage_rot(prs + t0 * 2560 + 256 + h * 64, 2560, rc, rs, n * 128, Kr, 0.125f, l2g, 0);
  stage_vT(prs + t0 * 2560 + 512 + h * 128, 2560, VT);
  {
    const int dv = tid >> 2, q = tid & 3;
    const float* src = KV + (size_t)u * 8192 + dv * 64 + q * 16;
    float4 a0 = *(const float4*)src, a1 = *(const float4*)(src + 4), a2 = *(const float4*)(src + 8), a3 = *(const float4*)(src + 12);
    float f0[8] = {a0.x, a0.y, a0.z, a0.w, a1.x, a1.y, a1.z, a1.w};
    float f1[8] = {a2.x, a2.y, a2.z, a2.w, a3.x, a3.y, a3.z, a3.w};
    *(uint4*)(RT + dv * 72 + q * 16) = pack8(f0);
    *(uint4*)(RT + dv * 72 + q * 16 + 8) = pack8(f1);
  }
  __syncthreads();
  f32x16 acc[2];
#pragma unroll
  for (int j = 0; j < 2; ++j)
#pragma unroll
    for (int e = 0; e < 16; ++e) acc[j][e] = 0.f;
#pragma unroll
  for (int ks = 0; ks < 4; ++ks) {
    bf16x8 a = *(const bf16x8*)(Q + (wm * 32 + (lane & 31)) * 72 + ks * 16 + (lane >> 5) * 8);
#pragma unroll
    for (int j = 0; j < 2; ++j) {
      bf16x8 bb = *(const bf16x8*)(Kr + (wn * 64 + j * 32 + (lane & 31)) * 72 + ks * 16 + (lane >> 5) * 8);
      acc[j] = __builtin_amdgcn_mfma_f32_32x32x16_bf16(a, bb, acc[j], 0, 0, 0);
    }
  }
#pragma unroll
  for (int j = 0; j < 2; ++j)
#pragma unroll
    for (int e = 0; e < 16; ++e) {
      const int i = ACC_ROW(1, 0, e), jj = ACC_COL(j);
      const float dcy = (i >= jj) ? exp2f((float)(i - jj) * l2g) : 0.f;
      SP[i * 136 + jj] = f2bf(acc[j][e] * dcy);
    }
  __syncthreads();
#pragma unroll
  for (int j = 0; j < 2; ++j)
#pragma unroll
    for (int e = 0; e < 16; ++e) acc[j][e] = 0.f;
#pragma unroll
  for (int ks = 0; ks < 8; ++ks) {
    bf16x8 a = *(const bf16x8*)(SP + (wm * 32 + (lane & 31)) * 136 + ks * 16 + (lane >> 5) * 8);
#pragma unroll
    for (int j = 0; j < 2; ++j) {
      bf16x8 bb = *(const bf16x8*)(VT + (wn * 64 + j * 32 + (lane & 31)) * 136 + ks * 16 + (lane >> 5) * 8);
      acc[j] = __builtin_amdgcn_mfma_f32_32x32x16_bf16(a, bb, acc[j], 0, 0, 0);
    }
  }
#pragma unroll
  for (int ks = 0; ks < 4; ++ks) {
    bf16x8 a = *(const bf16x8*)(Qd + (wm * 32 + (lane & 31)) * 72 + ks * 16 + (lane >> 5) * 8);
#pragma unroll
    for (int j = 0; j < 2; ++j) {
      bf16x8 bb = *(const bf16x8*)(RT + (wn * 64 + j * 32 + (lane & 31)) * 72 + ks * 16 + (lane >> 5) * 8);
      acc[j] = __builtin_amdgcn_mfma_f32_32x32x16_bf16(a, bb, acc[j], 0, 0, 0);
    }
  }
  __syncthreads();
#pragma unroll
  for (int j = 0; j < 2; ++j)
#pragma unroll
    for (int e = 0; e < 16; ++e) OT[ACC_ROW(1, 0, e) * 132 + ACC_COL(j)] = acc[j][e];
  __syncthreads();
  {
    const int row = tid >> 2, q = tid & 3;
    float o[32];
    float ssq = 0.f;
#pragma unroll
    for (int c = 0; c < 8; ++c) {
      float4 v = *(const float4*)(OT + row * 132 + q * 32 + c * 4);
      o[c * 4] = v.x; o[c * 4 + 1] = v.y; o[c * 4 + 2] = v.z; o[c * 4 + 3] = v.w;
      ssq += v.x * v.x + v.y * v.y + v.z * v.z + v.w * v.w;
    }
    ssq = red4(ssq);
    const float r = rsqrtf(ssq * (1.f / 128.f) + 1e-6f);
    const u16* gp = prs + (t0 + row) * 2560 + 1024 + h * 128 + q * 32;
    u16* op = yret + (t0 + row) * 512 + h * 128 + q * 32;
#pragma unroll
    for (int c = 0; c < 4; ++c) {
      float g[8], ov[8];
      unpack8(*(const uint4*)(gp + c * 8), g);
#pragma unroll
      for (int j = 0; j < 8; ++j) ov[j] = o[c * 8 + j] * r * siluf_(g[j]);
      if (!(n == 0 && row == 0)) *(uint4*)(op + c * 8) = pack8(ov);
    }
  }
  __syncthreads();
}

DEV void phase_merge(const Params& p, int l, const float* rstd, u16* smem, int bid, int nb) {
  const int tid = my_tid(), lane = tid & 63, wave = tid >> 6, wm = wave >> 1, wn = wave & 1;
  const u16* xb = (const u16*)(p.ws + OFF_XB);
  unsigned char* W = p.ws + OFF_W + (size_t)l * LW_BYTES;
  const u16* win = (const u16*)(W + W_IN);
  const u16* wbr = (const u16*)(W + W_BR);
  u16* M = (u16*)(p.ws + OFF_BIG + B_M);
  const int MTL = NTOK / 128, NTL = DM / 128;
  for (int t = vbid(bid, nb); t < MTL * NTL; t += nb) {
    int m, n;
    tile_map(t, MTL, NTL, m, n);
    f32x16 ms[1][2];
#pragma unroll
    for (int j = 0; j < 2; ++j)
#pragma unroll
      for (int e = 0; e < 16; ++e) ms[0][j][e] = 0.f;
    for (int g = 0; g < 3; ++g) {
      const u16* yg = (const u16*)(p.ws + OFF_BIG + (g == 0 ? B_YRW : (g == 1 ? B_YRET : B_YSG)));
      f32x16 ab[1][2], ag[1][2];
#pragma unroll
      for (int j = 0; j < 2; ++j)
#pragma unroll
        for (int e = 0; e < 16; ++e) { ab[0][j][e] = 0.f; ag[0][j][e] = 0.f; }
      gemm_tile<1>(ab, yg, 512, m * 128, -(1 << 30), NTOK - 1, wbr + ((size_t)g * DM + n * 128) * 512, 512, 512, smem);
      gemm_tile<1>(ag, xb, DM, m * 128, -(1 << 30), NTOK - 1, win + ((size_t)(4352 + g * DM + n * 128)) * DM, DM, DM, smem);
#pragma unroll
      for (int e = 0; e < 16; ++e) {
        const float rs = rstd_of(rstd, m * 128 + ACC_ROW(1, 0, e));
#pragma unroll
        for (int j = 0; j < 2; ++j) ms[0][j][e] += sigmoidf_(ag[0][j][e] * rs) * ab[0][j][e];
        if ((e & 3) == 3) __builtin_amdgcn_sched_barrier(0);
      }
    }
#pragma unroll
    for (int e = 0; e < 16; ++e) {
      const size_t row = m * 128 + ACC_ROW(1, 0, e);
#pragma unroll
      for (int j = 0; j < 2; ++j) M[row * DM + n * 128 + ACC_COL(j)] = f2bf(ms[0][j][e]);
    }
  }
}

DEV void phase_resgemm(const u16* A, int K, const u16* wt, const float* xin, float* xout, u16* xbo, float* ssq, u16* smem, int bid, int nb) {
  const int tid = my_tid(), lane = tid & 63, wave = tid >> 6, wm = wave >> 1, wn = wave & 1;
  const int MTL = NTOK / 256, NTL = DM / 256;
  for (int t = vbid(bid, nb); t < MTL * NTL; t += nb) {
    int m, n;
    tile_map(t, MTL, NTL, m, n);
    f32x16 acc[2][4];
    ZERO_BIG(acc);
    gemm_big(acc, A, K, m * 256, -(1 << 30), NTOK - 1, wt + (size_t)n * 256 * K, K, K, smem);
    float* F = (float*)smem;
#pragma unroll
    for (int i = 0; i < 2; ++i) {
#pragma unroll
      for (int e = 0; e < 16; ++e) {
        const int lr = wm * 32 + (e & 3) + 8 * (e >> 2) + 4 * (lane >> 5);
#pragma unroll
        for (int j = 0; j < 4; ++j) F[lr * 260 + BIG_COL(j)] = acc[i][j][e];
      }
      __syncthreads();
#pragma unroll 4
      for (int k = 0; k < 16; ++k) {
        const int c = tid + NTHR * k;
        const int lr = c >> 6, cc = c & 63;
        const size_t row = (size_t)m * 256 + (lr >> 5) * 64 + i * 32 + (lr & 31);
        const size_t o = row * DM + n * 256 + cc * 4;
        const float4 v = *(const float4*)(F + lr * 260 + cc * 4);
        const float4 x = *(const float4*)(xin + o);
        const float4 y = make_float4(x.x + v.x, x.y + v.y, x.z + v.z, x.w + v.w);
        *(float4*)(xout + o) = y;
        if (xbo) {
          *(uint2*)(xbo + o) = make_uint2(pack2(y.x, y.y), pack2(y.z, y.w));
          const float sq = wave_sum(y.x * y.x + y.y * y.y + y.z * y.z + y.w * y.w);
          if (lane == 0) atomicAdd(ssq + row, sq);
        }
      }
      __syncthreads();
    }
  }
}

DEV void phase_ffnup(const Params& p, int l, const float* rstd, u16* smem, int bid, int nb) {
  const int tid = my_tid(), lane = tid & 63, wave = tid >> 6, wm = wave >> 1, wn = wave & 1;
  const u16* xb = (const u16*)(p.ws + OFF_XB);
  const u16* wup = (const u16*)(p.ws + OFF_W + (size_t)l * LW_BYTES + W_UP);
  u16* act = (u16*)(p.ws + OFF_BIG + B_ACT);
  const float* cw = p.in[22] + (size_t)l * 3 * 2 * DFF;
  const float* cb = p.in[23] + (size_t)l * 2 * DFF;
  u16* U = smem;
  const int MPB = 33;
  const int MTL = 4 * MPB, NTL = DFF / 128;
  for (int t = vbid(bid, nb); t < MTL * NTL; t += nb) {
    int m, n;
    tile_map(t, MTL, NTL, m, n);
    const int b = m / MPB, mi = m % MPB;
    const int tokbase = b * SEQ + mi * 254 - 2;
    f32x16 acc[2][4];
    ZERO_BIG(acc);
    gemm_big(acc, xb, DM, tokbase, b * SEQ, NTOK - 1, wup + (size_t)n * 256 * DM, DM, DM, smem);
#pragma unroll
    for (int i = 0; i < 2; ++i)
#pragma unroll
      for (int e = 0; e < 16; ++e) {
        const int r = BIG_ROW(i, e);
        int tk = tokbase + r; tk = tk < 0 ? 0 : (tk > NTOK - 1 ? NTOK - 1 : tk);
        const float rs = rstd_of(rstd, tk);
#pragma unroll
        for (int j = 0; j < 4; ++j) U[r * 264 + BIG_COL(j)] = f2bf(acc[i][j][e] * rs);
      }
    __syncthreads();
    {
      const int c = (tid & 63) * 2, rg = tid >> 6;
      const int gcol = n * 128 + c, vcol = DFF + n * 128 + c;
      float wg0[2], wg1[2], wg2[2], bg[2], wv0[2], wv1[2], wv2[2], bv[2];
#pragma unroll
      for (int q = 0; q < 2; ++q) {
        wg0[q] = cw[gcol + q]; wg1[q] = cw[2 * DFF + gcol + q]; wg2[q] = cw[4 * DFF + gcol + q]; bg[q] = cb[gcol + q];
        wv0[q] = cw[vcol + q]; wv1[q] = cw[2 * DFF + vcol + q]; wv2[q] = cw[4 * DFF + vcol + q]; bv[q] = cb[vcol + q];
      }
      const int r0 = 2 + rg * 32;
      const int rend = (r0 + 32 > 256) ? 256 : r0 + 32;
      unsigned t;
      float g2[2], g1[2], v2[2], v1[2];
      t = *(const unsigned*)(U + (r0 - 2) * 264 + c); g2[0] = __uint_as_float(t << 16); g2[1] = __uint_as_float(t & 0xffff0000u);
      t = *(const unsigned*)(U + (r0 - 1) * 264 + c); g1[0] = __uint_as_float(t << 16); g1[1] = __uint_as_float(t & 0xffff0000u);
      t = *(const unsigned*)(U + (r0 - 2) * 264 + 128 + c); v2[0] = __uint_as_float(t << 16); v2[1] = __uint_as_float(t & 0xffff0000u);
      t = *(const unsigned*)(U + (r0 - 1) * 264 + 128 + c); v1[0] = __uint_as_float(t << 16); v1[1] = __uint_as_float(t & 0xffff0000u);
      const int tend = (b + 1) * SEQ;
      for (int r = r0; r < rend; ++r) {
        const unsigned ug = *(const unsigned*)(U + r * 264 + c), uv = *(const unsigned*)(U + r * 264 + 128 + c);
        const float g0[2] = {__uint_as_float(ug << 16), __uint_as_float(ug & 0xffff0000u)};
        const float v0[2] = {__uint_as_float(uv << 16), __uint_as_float(uv & 0xffff0000u)};
        float o[2];
#pragma unroll
        for (int q = 0; q < 2; ++q) {
          const float cg = bg[q] + wg0[q] * g2[q] + wg1[q] * g1[q] + wg2[q] * g0[q];
          const float cv = bv[q] + wv0[q] * v2[q] + wv1[q] * v1[q] + wv2[q] * v0[q];
          o[q] = siluf_(cg) * cv;
          g2[q] = g1[q]; g1[q] = g0[q]; v2[q] = v1[q]; v1[q] = v0[q];
        }
        const int tk = tokbase + r;
        if (tk < tend) *(unsigned*)(act + (size_t)tk * DFF + n * 128 + c) = pack2(o[0], o[1]);
      }
    }
    __syncthreads();
  }
}

#define PF_COLS 3328
DEV void first_tok_proj(const Params& p, int l, const float* xcur, float* smf, int bid, int nb) {
  float* PF = (float*)(p.ws + OFF_PF);
  const float* w = p.in[2] + (size_t)l * DM * INC;
  const float* g1 = p.in[1] + l * DM;
  const int tid = my_tid(), lane = tid & 63, wave = tid >> 6;
  for (int task = bid; task < 4 * 52; task += nb) {
    const int b = task / 52, c = (task % 52) * 64 + lane;
    const float* xr = xcur + (size_t)b * SEQ * DM;
    float acc = 0.f, ss = 0.f;
    const int k0 = wave * 128;
#pragma unroll 16
    for (int k = k0; k < k0 + 128; ++k) {
      const float xv = xr[k];
      ss += xv * xv;
      acc += xv * g1[k] * w[(size_t)k * INC + c];
    }
    smf[wave * 64 + lane] = acc;
    smf[512 + wave * 64 + lane] = ss;
    __syncthreads();
    if (wave == 0) {
      float ta = 0.f, ts = 0.f;
#pragma unroll
      for (int q = 0; q < 8; ++q) { ta += smf[q * 64 + lane]; ts += smf[512 + q * 64 + lane]; }
      PF[b * PF_COLS + c] = ta * rsqrtf(ts * (1.0f / DM) + 1e-6f);
    }
    __syncthreads();
  }
}
DEV void first_tok_fix(const Params& p, int l, float* smf, int bid, int nb) {
  const int tid = my_tid(), lane = tid & 63;
  const float* PF = (const float*)(p.ws + OFF_PF);
  u16* yrw = (u16*)(p.ws + OFF_BIG + B_YRW);
  u16* yret = (u16*)(p.ws + OFF_BIG + B_YRET);
  const float* mu = p.in[3] + l * 1792;
  for (int task = bid; task < 48; task += nb) {
    const int b = task / 12, hh = task % 12;
    const float* pf = PF + b * PF_COLS;
    const size_t t0 = (size_t)b * SEQ;
    __syncthreads();
    if (hh < 8) {
      const int h = hh;
      if (tid < 64) smf[tid] = pf[1600 + tid] * (1.f - mu[1600 + tid]);
      if (tid < 128) smf[64 + tid] = sigmoidf_(pf[1664 + tid] * (1.f - mu[1664 + tid]));
      __syncthreads();
      if (tid < 64) {
        const int ch = h * 64 + tid;
        const float r = pf[ch] * (1.f - mu[ch]);
        const float k = pf[512 + ch] * (1.f - mu[512 + ch]);
        const float v = pf[1024 + ch] * (1.f - mu[1024 + ch]);
        const float* aup = p.in[7] + (size_t)l * 64 * 512;
        const float* gup = p.in[8] + (size_t)l * 128 * 512;
        float al = p.in[6][l * 512 + ch], g = 0.f;
        for (int j = 0; j < 64; ++j) al += smf[j] * aup[j * 512 + ch];
        for (int j = 0; j < 128; ++j) g += smf[64 + j] * gup[j * 512 + ch];
        const float a = sigmoidf_(al);
        const float kp = k * (1.f + (a - 1.f) * p.in[10][l * 512 + ch]);
        const float s = wave_sum(kp * r);
        const float bon = wave_sum(r * kp * p.in[11][l * 512 + ch]);
        const float y = v * s;
        const float mean = wave_sum(y) * (1.f / 64.f);
        const float d = y - mean;
        const float var = wave_sum(d * d) * (1.f / 64.f);
        const float o = (d * rsqrtf(var + 64e-5f) * p.in[12][l * 512 + ch] + p.in[13][l * 512 + ch] + bon * v) * g;
        yrw[t0 * 512 + ch] = f2bf(o);
      }
    } else {
      const int h = hh - 8;
      float part = 0.f;
      if (tid < 64) part = pf[1792 + h * 64 + tid] * pf[1792 + 256 + h * 64 + tid];
      if (tid < 64) { part = wave_sum(part); if (lane == 0) smf[0] = part * 0.125f; }
      __syncthreads();
      const float s = smf[0];
      float y = 0.f;
      if (tid < 128) y = s * pf[1792 + 512 + h * 128 + tid];
      float q = wave_sum(y * y);
      if (tid < 128 && lane == 0) smf[1 + (tid >> 6)] = q;
      __syncthreads();
      if (tid < 128) {
        const float ms = (smf[1] + smf[2]) * (1.f / 128.f);
        const float g = pf[1792 + 1024 + h * 128 + tid];
        yret[t0 * 512 + h * 128 + tid] = f2bf(y * rsqrtf(ms + 1e-6f) * siluf_(g));
      }
    }
  }
}

namespace pg8 {
#define PG8_LAS __attribute__((address_space(3)))
typedef unsigned short bf16_t;
typedef short bf16x8 __attribute__((ext_vector_type(8)));
typedef float f32x4 __attribute__((ext_vector_type(4)));
typedef unsigned u32x4 __attribute__((ext_vector_type(4)));
constexpr int BM = 256, BK = 64, HALF = 128, HTB = HALF * BK * 2  , STAGE_BYTES = 8 * HTB, NXCD = 8, WGM = 8;

__host__ __device__ __forceinline__ int lds_byte(int r, int c) { const int st = (r >> 4) * 2 + (c >> 5), rr = r & 15, cc = c & 31, ob = rr * 64 + cc * 2; return st * 1024 + (ob ^ (((ob >> 9) & 1) << 5)); }
__host__ __device__ __forceinline__ void stage_rc(int b, int& R, int& C) { const int st = b / 1024, sb = b % 1024, swz = sb ^ (((sb >> 9) & 1) << 5); R = (st >> 1) * 16 + swz / 64; C = (st & 1) * 32 + (swz % 64) / 2; }
__host__ __device__ __forceinline__ int perm32(int rho) { const int n = rho >> 4, i = rho & 15; return 8 * (i >> 2) + 4 * n + (i & 3); }

struct Unit { int pm, pn, arow, slot; };
struct Gemm { const bf16_t* A; const bf16_t* Bt; int M, N, K; };

struct StaticOrder {
    int nM, nN, nwg, G, c;
    __host__ __device__ void init(int M, int N, int G_, int c_) { nM = M / BM; nN = N / BM; nwg = nM * nN; G = G_; c = c_; }
    __host__ __device__ bool next(int i, Unit& u) const {
        const long L = (long)i * G + c; if (L >= nwg) return false;
        int wgid = (int)L; { const int q = nwg / NXCD, r = nwg % NXCD, xcd = wgid % NXCD, off = wgid / NXCD; wgid = (xcd < r ? xcd * (q + 1) : r * (q + 1) + (xcd - r) * q) + off; }
        const int nig = WGM * nN, gid = wgid / nig, fm = gid * WGM, gsz = (nM - fm) < WGM ? (nM - fm) : WGM;
        u.pm = fm + ((wgid % nig) % gsz); u.pn = (wgid % nig) / gsz; u.arow = u.pm * BM; u.slot = i & 1; return true;
    }
    __device__ __forceinline__ void a_ready(const Unit&) const {}
    __device__ __forceinline__ void done(const Unit&) const {}
};

__device__ __forceinline__ unsigned cvt_pk_bf16(float lo, float hi) { unsigned r; asm volatile("v_cvt_pk_bf16_f32 %0, %1, %2" : "=v"(r) : "v"(lo), "v"(hi)); return r; }

template <class Epi, class Sched, bool STAMP = false>
__device__ __forceinline__ void gemm_phase(PG8_LAS unsigned char* lds, const Gemm g, const Sched& S, const Epi& E, unsigned long long* stamps) {
    const int tid = my_tid(), wid = __builtin_amdgcn_readfirstlane(tid >> 6), lane = tid & 63, wr = wid >> 2, wc = wid & 3, fr = lane & 15, fq = lane >> 4;
    const int K = g.K, nt = K / BK;
    int ts_lo = 0, ts_hi = 0, nts = 0; const unsigned long long rt_entry = STAMP ? (unsigned long long)wall_clock64() : 0ull;
#define PG8_STAMP() do { if (STAMP && wid == 0 && nts < 64) { const unsigned long long _c = (unsigned long long)clock64(); \
        ts_lo = (lane == nts) ? (int)(unsigned)_c : ts_lo; ts_hi = (lane == nts) ? (int)(unsigned)(_c >> 32) : ts_hi; ++nts; } } while (0)
    PG8_STAMP();
    unsigned voffA[2], voffB[2];
#pragma unroll
    for (int i = 0; i < 2; ++i) { int R, C; stage_rc(tid * 16 + i * 8192, R, C); const int Rb = Epi::PERM ? ((R & ~31) + perm32(R & 31)) : R;
        voffA[i] = (unsigned)(R * K + C) * 2u; voffB[i] = (unsigned)(Rb * K + C) * 2u; }
    const size_t kstep = (size_t)(BK * 2);
    const size_t hstep = (size_t)HALF * K * 2;
    const size_t tstep = 2 * hstep;
    const unsigned ldsw = (unsigned)wid * 1024u;
    const int aoff = lds_byte(wr * 64 + fr, fq * 8), boff = lds_byte(wc * 32 + fr, fq * 8);
#define PG8_SA(b, h) (((b) * 2 + (h)) * HTB)
#define PG8_SB(b, h) ((4 + (b) * 2 + (h)) * HTB)
#define PG8_STAGE(bufoff, gbase, voff) do { _Pragma("unroll") for (int _i = 0; _i < 2; ++_i) \
        __builtin_amdgcn_global_load_lds((const unsigned*)((const char*)(gbase) + (voff)[_i]), (PG8_LAS unsigned*)(lds + (bufoff) + ldsw + _i * 8192), 16, 0, 0); } while (0)
#define PG8_LDA(dst, b, h) do { _Pragma("unroll") for (int m = 0; m < 4; ++m) _Pragma("unroll") for (int k = 0; k < 2; ++k) dst[m][k] = *(const PG8_LAS bf16x8*)(lds + PG8_SA(b, h) + aoff + m * 2048 + k * 1024); } while (0)
#define PG8_LDB(dst, b, h) do { _Pragma("unroll") for (int n = 0; n < 2; ++n) _Pragma("unroll") for (int k = 0; k < 2; ++k) dst[n][k] = *(const PG8_LAS bf16x8*)(lds + PG8_SB(b, h) + boff + n * 2048 + k * 1024); } while (0)
#define PG8_MMA(ai, bj, At, Bt) do { __builtin_amdgcn_s_setprio(1); _Pragma("unroll") for (int m = 0; m < 4; ++m) _Pragma("unroll") for (int n = 0; n < 2; ++n) _Pragma("unroll") for (int k = 0; k < 2; ++k) \
        acc[ai][bj][m][n] = __builtin_amdgcn_mfma_f32_16x16x32_bf16(Bt[n][k], At[m][k], acc[ai][bj][m][n], 0, 0, 0); __builtin_amdgcn_s_setprio(0); } while (0)
#define PG8_WAIT_V(n) asm volatile("s_waitcnt vmcnt(" #n ")" ::: "memory")
#define PG8_WAIT_L(n) asm volatile("s_waitcnt lgkmcnt(" #n ")" ::: "memory")
#define PG8_BAR __builtin_amdgcn_s_barrier()
#define PG8_SCHED __builtin_amdgcn_sched_barrier(0)
    Unit cur, nxt; int ui = 0;
    if (!S.next(0, cur)) return;
    f32x4 acc[2][2][4][2];
#pragma unroll
    for (int a = 0; a < 2; ++a)
#pragma unroll
        for (int b = 0; b < 2; ++b)
#pragma unroll
            for (int m = 0; m < 4; ++m)
#pragma unroll
                for (int n = 0; n < 2; ++n) acc[a][b][m][n] = (f32x4){0.f, 0.f, 0.f, 0.f};
    bf16x8 At[4][2], B0[2][2], B1[2][2];
    const char* cA = (const char*)g.A + (long)cur.arow * (long)(K * 2); const char* cB = (const char*)g.Bt + (size_t)cur.pn * tstep;
    S.a_ready(cur);
    PG8_STAGE(PG8_SB(0, 0), cB, voffB); PG8_STAGE(PG8_SA(0, 0), cA, voffA); PG8_STAGE(PG8_SB(0, 1), cB + hstep, voffB); PG8_STAGE(PG8_SA(0, 1), cA + hstep, voffA);
    if (wr == 1) PG8_BAR;
    PG8_WAIT_V(4); PG8_BAR;
    PG8_STAGE(PG8_SB(1, 0), cB + kstep, voffB); PG8_STAGE(PG8_SA(1, 0), cA + kstep, voffA); PG8_STAGE(PG8_SB(1, 1), cB + hstep + kstep, voffB);
    PG8_WAIT_V(6); PG8_BAR;
    PG8_STAMP();
    for (;;) {
        const bool has_next = S.next(ui + 1, nxt);
        const char* nA = has_next ? (const char*)g.A + (long)nxt.arow * (long)(K * 2) : cA; const char* nB = has_next ? (const char*)g.Bt + (size_t)nxt.pn * tstep : cB;
        for (int t = 0; t < nt; t += 2) {
            const bool last = (t == nt - 2);
            const char* a1 = cA + (size_t)(t + 1) * kstep;
            const char* a2 = last ? nA : cA + (size_t)(t + 2) * kstep; const char* b2 = last ? nB : cB + (size_t)(t + 2) * kstep;
            const char* a3 = a2 + kstep; const char* b3 = b2 + kstep;
            if (last && has_next) S.a_ready(nxt);
            PG8_LDB(B0, 0, 0); PG8_SCHED; PG8_LDA(At, 0, 0); PG8_STAGE(PG8_SA(1, 1), a1 + hstep, voffA);
            PG8_WAIT_L(8); PG8_BAR; PG8_WAIT_L(0); PG8_MMA(0, 0, At, B0); PG8_BAR; PG8_SCHED;
            PG8_LDB(B1, 0, 1); PG8_STAGE(PG8_SB(0, 0), b2, voffB);
            PG8_BAR; PG8_WAIT_L(0); PG8_MMA(0, 1, At, B1); PG8_BAR;
            PG8_LDA(At, 0, 1); PG8_STAGE(PG8_SA(0, 0), a2, voffA);
            PG8_BAR; PG8_WAIT_L(0); PG8_MMA(1, 0, At, B0); PG8_BAR; PG8_SCHED;
            PG8_STAGE(PG8_SB(0, 1), b2 + hstep, voffB);
            PG8_WAIT_V(6); PG8_BAR; PG8_MMA(1, 1, At, B1); PG8_BAR;
            PG8_LDB(B0, 1, 0); PG8_SCHED; PG8_LDA(At, 1, 0); PG8_STAGE(PG8_SA(0, 1), a2 + hstep, voffA);
            PG8_WAIT_L(8); PG8_BAR; PG8_WAIT_L(0); PG8_MMA(0, 0, At, B0); PG8_BAR; PG8_SCHED;
            PG8_LDB(B1, 1, 1); PG8_STAGE(PG8_SB(1, 0), b3, voffB);
            PG8_BAR; PG8_WAIT_L(0); PG8_MMA(0, 1, At, B1); PG8_BAR;
            PG8_LDA(At, 1, 1); PG8_STAGE(PG8_SA(1, 0), a3, voffA);
            PG8_BAR; PG8_WAIT_L(0); PG8_MMA(1, 0, At, B0); PG8_BAR; PG8_SCHED;
            PG8_STAGE(PG8_SB(1, 1), b3 + hstep, voffB);
            PG8_WAIT_V(6); PG8_BAR; PG8_MMA(1, 1, At, B1); PG8_BAR;
        }
        PG8_STAMP();
        if constexpr (!Epi::AFTER_DRAIN) { E(acc, cur, wr, wc, fr, fq); S.done(cur); }
        PG8_STAMP();
        if (!has_next) break;
#pragma unroll
        for (int a = 0; a < 2; ++a)
#pragma unroll
            for (int b = 0; b < 2; ++b)
#pragma unroll
                for (int m = 0; m < 4; ++m)
#pragma unroll
                    for (int n = 0; n < 2; ++n) acc[a][b][m][n] = (f32x4){0.f, 0.f, 0.f, 0.f};
        cur = nxt; cA = nA; cB = nB; ++ui;
    }
    PG8_WAIT_V(0);
    if (wr == 0) PG8_BAR;
    PG8_BAR;
    if constexpr (Epi::AFTER_DRAIN) { E.fused(acc, cur, wr, wc, fr, fq, lds, wid, lane); S.done(cur); }
    PG8_STAMP();
    if (STAMP && wid == 0) { stamps[lane] = lane < nts ? (((unsigned long long)(unsigned)ts_hi << 32) | (unsigned)ts_lo) : 0ull;
        if (lane == 62) stamps[62] = rt_entry; if (lane == 63) stamps[63] = (unsigned long long)wall_clock64(); }
#undef PG8_STAMP
#undef PG8_SA
#undef PG8_SB
#undef PG8_STAGE
#undef PG8_LDA
#undef PG8_LDB
#undef PG8_MMA
#undef PG8_WAIT_V
#undef PG8_WAIT_L
#undef PG8_BAR
#undef PG8_SCHED
}
}

struct EpiInproj {
  static constexpr bool PERM = true, AFTER_DRAIN = false;
  u16* O; int ldc; const float* ssq;
  __device__ __forceinline__ void operator()(const pg8::f32x4 (&acc)[2][2][4][2], const pg8::Unit& u, int wr, int wc, int fr, int fq) const {
    const int row0 = u.pm * 256 + wr * 64 + fr, col0 = u.pn * 256 + wc * 32 + 8 * fq;
#pragma unroll
    for (int ai = 0; ai < 2; ++ai)
#pragma unroll
      for (int m = 0; m < 4; ++m) {
        const int row = row0 + ai * 128 + m * 16;
        const float rs = ssq ? rsqrtf(ssq[row] * (1.0f / DM) + 1e-6f) : 1.0f;
        u16* rowp = O + (size_t)row * ldc + col0;
#pragma unroll
        for (int bj = 0; bj < 2; ++bj) {
          const pg8::f32x4 v0 = acc[ai][bj][m][0] * rs, v1 = acc[ai][bj][m][1] * rs;
          u32x4 w;
          w.x = pack2(v0[0], v0[1]); w.y = pack2(v0[2], v0[3]); w.z = pack2(v1[0], v1[1]); w.w = pack2(v1[2], v1[3]);
          *(u32x4*)(rowp + bj * 128) = w;
        }
      }
  }
};
struct EpiRes {
  static constexpr bool PERM = false, AFTER_DRAIN = false;
  const float* xin; float* xout; u16* xbo; float* ssq;
  __device__ __forceinline__ void operator()(const pg8::f32x4 (&acc)[2][2][4][2], const pg8::Unit& u, int wr, int wc, int fr, int fq) const {
    const int row0 = u.pm * 256 + wr * 64 + fr, col0 = u.pn * 256 + wc * 32 + 4 * fq;
#pragma unroll
    for (int ai = 0; ai < 2; ++ai)
#pragma unroll
      for (int m = 0; m < 4; ++m) {
        const int row = row0 + ai * 128 + m * 16;
        float sq = 0.f;
#pragma unroll
        for (int bj = 0; bj < 2; ++bj)
#pragma unroll
          for (int n = 0; n < 2; ++n) {
            const size_t o = (size_t)row * DM + col0 + bj * 128 + n * 16;
            const pg8::f32x4 y = *(const pg8::f32x4*)(xin + o) + acc[ai][bj][m][n];
            *(pg8::f32x4*)(xout + o) = y;
            if (xbo) {
              *(uint2*)(xbo + o) = make_uint2(pack2(y[0], y[1]), pack2(y[2], y[3]));
              sq += y[0] * y[0] + y[1] * y[1] + y[2] * y[2] + y[3] * y[3];
            }
          }
        if (xbo) {
          sq += __shfl_xor(sq, 16);
          sq += __shfl_xor(sq, 32);
          if (fq == 0) atomicAdd(ssq + row, sq);
        }
        __builtin_amdgcn_sched_barrier(0);
      }
  }
};
struct TriOrder : pg8::StaticOrder {
  int a_rows_per_g;
  __device__ bool next(int i, pg8::Unit& u) const {
    const int g = i % 3;
    if (!pg8::StaticOrder::next(i / 3, u)) return false;
    u.arow = g * a_rows_per_g + u.pm * 256;
    u.pn += 4 * g;
    u.slot = i & 1;
    return true;
  }
};
struct EpiP {
  static constexpr bool PERM = true, AFTER_DRAIN = false;
  u16* O;
  __device__ __forceinline__ void operator()(const pg8::f32x4 (&acc)[2][2][4][2], const pg8::Unit& u, int wr, int wc, int fr, int fq) const {
    const int g = u.pn >> 2, ct = u.pn & 3;
    const int row0 = u.pm * 256 + wr * 64 + fr, col0 = ct * 256 + wc * 32 + 8 * fq;
    u16* base = O + (size_t)g * NTOK * DM;
#pragma unroll
    for (int ai = 0; ai < 2; ++ai)
#pragma unroll
      for (int m = 0; m < 4; ++m) {
        u16* rowp = base + (size_t)(row0 + ai * 128 + m * 16) * DM + col0;
#pragma unroll
        for (int bj = 0; bj < 2; ++bj) {
          const pg8::f32x4 v0 = acc[ai][bj][m][0], v1 = acc[ai][bj][m][1];
          u32x4 w;
          w.x = pack2(v0[0], v0[1]); w.y = pack2(v0[2], v0[3]); w.z = pack2(v1[0], v1[1]); w.w = pack2(v1[2], v1[3]);
          *(u32x4*)(rowp + bj * 128) = w;
        }
      }
  }
};
struct EpiGate {
  static constexpr bool PERM = true, AFTER_DRAIN = false;
  u16* Mo; const u16* Pall; const float* ssq;
  __device__ __forceinline__ void operator()(const pg8::f32x4 (&acc)[2][2][4][2], const pg8::Unit& u, int wr, int wc, int fr, int fq) const {
    const int g = u.pn >> 2, first = (g == 0);
    const u16* P = Pall + (size_t)g * NTOK * DM;
    const int row0 = u.pm * 256 + wr * 64 + fr, col0 = (u.pn & 3) * 256 + wc * 32 + 8 * fq;
#pragma unroll
    for (int ai = 0; ai < 2; ++ai)
#pragma unroll
      for (int m = 0; m < 4; ++m) {
        const int row = row0 + ai * 128 + m * 16;
        const float rs = rsqrtf(ssq[row] * (1.0f / DM) + 1e-6f);
#pragma unroll
        for (int bj = 0; bj < 2; ++bj) {
          const size_t o = (size_t)row * DM + col0 + bj * 128;
          float pv[8], mv[8];
          unpack8(*(const uint4*)(P + o), pv);
          if (!first) unpack8(*(const uint4*)(Mo + o), mv);
          else {
#pragma unroll
            for (int j = 0; j < 8; ++j) mv[j] = 0.f;
          }
#pragma unroll
          for (int j = 0; j < 4; ++j) {
            mv[j] += sigmoidf_(acc[ai][bj][m][0][j] * rs) * pv[j];
            mv[4 + j] += sigmoidf_(acc[ai][bj][m][1][j] * rs) * pv[4 + j];
          }
          *(uint4*)(Mo + o) = pack8(mv);
        }
        __builtin_amdgcn_sched_barrier(0);
      }
  }
};
struct FfnOrder : pg8::StaticOrder {
  __device__ bool next(int i, pg8::Unit& u) const {
    if (!pg8::StaticOrder::next(i, u)) return false;
    const int b = u.pm / 33, mi = u.pm % 33;
    u.arow = b * SEQ + mi * 254 - 2;
    return true;
  }
};
struct EpiFfn {
  static constexpr bool PERM = true, AFTER_DRAIN = false;
  const Params* pp; int l; int bid;
  __device__ __forceinline__ void operator()(const pg8::f32x4 (&acc)[2][2][4][2], const pg8::Unit& u, int wr, int wc, int fr, int fq) const {
    const int b = u.pm / 33, mi = u.pm % 33;
    const int tokbase = b * SEQ + mi * 254 - 2, tbeg = b * SEQ, tend = (b + 1) * SEQ;
    asm volatile("" : "+v"(fr), "+v"(fq));
    u16* act = (u16*)(pp->ws + OFF_BIG + B_ACT);
    const float* ssq = (const float*)(pp->ws + OFF_RSTD) + (size_t)(2 * l + 1) * NTOK;
    const float* cw = pp->in[22] + (size_t)l * 3 * 2 * DFF;
    const float* cb = pp->in[23] + (size_t)l * 2 * DFF;
    u16* S = (u16*)(pp->ws + OFF_BIG + 192 * MiB) + (size_t)bid * 131072 + (size_t)u.slot * 65536;
#pragma unroll
    for (int ai = 0; ai < 2; ++ai)
#pragma unroll
      for (int m = 0; m < 4; ++m) {
        const int r = ai * 128 + wr * 64 + m * 16 + fr;
        int tk = tokbase + r; tk = tk < 0 ? 0 : (tk > NTOK - 1 ? NTOK - 1 : tk);
        const float rs = rsqrtf(ssq[tk] * (1.0f / DM) + 1e-6f);
#pragma unroll
        for (int bj = 0; bj < 2; ++bj) {
          const pg8::f32x4 v0 = acc[ai][bj][m][0] * rs, v1 = acc[ai][bj][m][1] * rs;
          u32x4 w;
          w.x = pack2(v0[0], v0[1]); w.y = pack2(v0[2], v0[3]); w.z = pack2(v1[0], v1[1]); w.w = pack2(v1[2], v1[3]);
          *(u32x4*)(S + r * 256 + bj * 128 + wc * 32 + 8 * fq) = w;
        }
      }
    asm volatile("s_waitcnt vmcnt(0)" ::: "memory");
    __builtin_amdgcn_s_barrier();
    __builtin_amdgcn_s_barrier();
    asm volatile("" ::: "memory");
    const int tid = my_tid(), cc = tid & 31, rg = tid >> 5;
    const int gcol = u.pn * 128 + cc * 4, vcol = DFF + gcol;
    float wg[3][4], wv[3][4], bg[4], bv[4];
#pragma unroll
    for (int q = 0; q < 3; ++q) {
      const float4 a0 = *(const float4*)(cw + q * 2 * DFF + gcol);
      const float4 c0 = *(const float4*)(cw + q * 2 * DFF + vcol);
      wg[q][0] = a0.x; wg[q][1] = a0.y; wg[q][2] = a0.z; wg[q][3] = a0.w;
      wv[q][0] = c0.x; wv[q][1] = c0.y; wv[q][2] = c0.z; wv[q][3] = c0.w;
    }
    {
      const float4 a0 = *(const float4*)(cb + gcol);
      const float4 c0 = *(const float4*)(cb + vcol);
      bg[0] = a0.x; bg[1] = a0.y; bg[2] = a0.z; bg[3] = a0.w;
      bv[0] = c0.x; bv[1] = c0.y; bv[2] = c0.z; bv[3] = c0.w;
    }
    uint2 rgt[18], rvl[18];
#pragma unroll
    for (int q = 0; q < 18; ++q) {
      int r = rg * 16 + q - 2; r = r < 0 ? 0 : r;
      rgt[q] = *(const uint2*)(S + r * 256 + cc * 4);
      rvl[q] = *(const uint2*)(S + r * 256 + 128 + cc * 4);
    }
    float g2[4], g1[4], v2[4], v1[4];
#define UNP4(src_, dst_) { dst_[0] = __uint_as_float(src_.x << 16); dst_[1] = __uint_as_float(src_.x & 0xffff0000u); dst_[2] = __uint_as_float(src_.y << 16); dst_[3] = __uint_as_float(src_.y & 0xffff0000u); }
    {
      const bool z0 = (tokbase + rg * 16 - 2) < tbeg, z1 = (tokbase + rg * 16 - 1) < tbeg;
      UNP4(rgt[0], g2); UNP4(rvl[0], v2); UNP4(rgt[1], g1); UNP4(rvl[1], v1);
#pragma unroll
      for (int j = 0; j < 4; ++j) { if (z0) { g2[j] = 0.f; v2[j] = 0.f; } if (z1) { g1[j] = 0.f; v1[j] = 0.f; } }
    }
#pragma unroll
    for (int q = 2; q < 18; ++q) {
      const int r = rg * 16 + q - 2;
      const int tk = tokbase + r;
      float g0[4], v0[4], o[4];
      UNP4(rgt[q], g0); UNP4(rvl[q], v0);
      if (tk < tbeg) {
#pragma unroll
        for (int j = 0; j < 4; ++j) { g0[j] = 0.f; v0[j] = 0.f; }
      }
#pragma unroll
      for (int j = 0; j < 4; ++j) {
        const float cg = bg[j] + wg[0][j] * g2[j] + wg[1][j] * g1[j] + wg[2][j] * g0[j];
        const float cv = bv[j] + wv[0][j] * v2[j] + wv[1][j] * v1[j] + wv[2][j] * v0[j];
        o[j] = siluf_(cg) * cv;
        g2[j] = g1[j]; g1[j] = g0[j]; v2[j] = v1[j]; v1[j] = v0[j];
      }
      if (r >= 2 && tk < tend) *(uint2*)(act + (size_t)tk * DFF + u.pn * 128 + cc * 4) = make_uint2(pack2(o[0], o[1]), pack2(o[2], o[3]));
    }
#undef UNP4
  }
};
template <class Epi>
DEV void pg8_gemm(unsigned char* smraw, const u16* A, const u16* Bt, int M, int N, int K, const Epi& E, int bid, int nb) {
  pg8::Gemm g{A, Bt, M, N, K};
  pg8::StaticOrder S;
  S.init(M, N, nb, bid);
  pg8::gemm_phase<Epi, pg8::StaticOrder, false>((PG8_LAS unsigned char*)smraw, g, S, E, nullptr);
}

#define PPL 15
#define NPHASE (2 + 2 * PPL)
template <int ph>
DEV void run_phase(const Params& p, unsigned char* smraw, int bid, int nb) {
  u16* smem = (u16*)smraw;
  float* smf = (float*)smraw;
  float* xo = p.out;
  u16* xb = (u16*)(p.ws + OFF_XB);
  float* ssq_all = (float*)(p.ws + OFF_RSTD);
  if (ph == 0) { phase_prep(p, smf, bid, nb); phase_norm(p.in[0], xb, ssq_all, bid, nb); return; }
  if (ph == NPHASE - 1) { phase_final(xo, p.in[25], bid, nb); return; }
  const int l = (ph - 1) / PPL, s = (ph - 1) % PPL;
  const float* xcur = (l == 0) ? p.in[0] : xo;
  unsigned char* W = p.ws + OFF_W + (size_t)l * LW_BYTES;
  float* ssq1 = ssq_all + (size_t)(2 * l) * NTOK;
  float* ssq2 = ssq_all + (size_t)(2 * l + 1) * NTOK;
  switch (s) {
    case 0: break;
    case 1: { EpiInproj E{(u16*)(p.ws + OFF_BIG + B_PRW), 1792, ssq1}; pg8_gemm(smraw, xb, (const u16*)(W + W_IN), NTOK, 1792, DM, E, bid, nb); } break;
    case 2: phase_rwprep(p, l, smem, bid, nb); break;
    case 3: phase_scan<1>(p, l, smf, bid, nb); break;
    case 4: phase_scanprop(p, smf, bid, nb); first_tok_proj(p, l, xcur, smf, nb - 1 - bid, nb); break;
    case 5: phase_scan<3>(p, l, smf, bid, nb); break;
    case 6: { EpiInproj E{(u16*)(p.ws + OFF_BIG + B_PRS), 2560, ssq1}; pg8_gemm(smraw, xb, (const u16*)(W + W_IN) + (size_t)1792 * DM, NTOK, 2560, DM, E, bid, nb); } break;
    case 7:
      for (int u = bid; u < 1024; u += nb) ret_kv_unit(p, u, smem);
      for (int u = bid; u < 256; u += nb) sgu_unit(p, l, u, smem);
      break;
    case 8: phase_retprefix(p, bid, nb); break;
    case 9:
      for (int u = bid; u < 1024; u += nb) ret_out_unit(p, u, smem);
      first_tok_fix(p, l, smf, nb - 1 - bid, nb);
      break;
    case 10: {
      TriOrder S; S.init(NTOK, DM, nb, bid); S.a_rows_per_g = NTOK;
      EpiP E{(u16*)(p.ws + OFF_BIG + B_P)};
      pg8::Gemm g{(const u16*)(p.ws + OFF_BIG + B_YRW), (const u16*)(W + W_BR), NTOK, DM, 512};
      pg8::gemm_phase<EpiP, TriOrder, false>((PG8_LAS unsigned char*)smraw, g, S, E, nullptr);
    } break;
    case 11: {
      TriOrder S; S.init(NTOK, DM, nb, bid); S.a_rows_per_g = 0;
      EpiGate E{(u16*)(p.ws + OFF_BIG + B_M), (const u16*)(p.ws + OFF_BIG + B_P), ssq1};
      pg8::Gemm g{xb, (const u16*)(W + W_IN) + (size_t)4352 * DM, NTOK, DM, DM};
      pg8::gemm_phase<EpiGate, TriOrder, false>((PG8_LAS unsigned char*)smraw, g, S, E, nullptr);
    } break;
    case 12: { EpiRes E{xcur, xo, xb, ssq2}; pg8_gemm(smraw, (const u16*)(p.ws + OFF_BIG + B_M), (const u16*)(W + W_OUT), NTOK, DM, DM, E, bid, nb); } break;
    case 13: {
      FfnOrder S;
      S.init(132 * 256, 2 * DFF, nb, bid);
      EpiFfn E{&p, l, bid};
      pg8::Gemm g{xb, (const u16*)(W + W_UP), 132 * 256, 2 * DFF, DM};
      pg8::gemm_phase<EpiFfn, FfnOrder, false>((PG8_LAS unsigned char*)smraw, g, S, E, nullptr);
    } break;
    case 14: {
      EpiRes E{xo, xo, (l == 0) ? xb : nullptr, (l == 0) ? ssq_all + (size_t)2 * NTOK : nullptr};
      pg8_gemm(smraw, (const u16*)(p.ws + OFF_BIG + B_ACT), (const u16*)(W + W_DN), NTOK, DM, DFF, E, bid, nb);
    } break;
  }
}
DEV constexpr bool phase_empty(int ph) {
  return ph >= 1 && ph < NPHASE - 1 && ((ph - 1) % PPL == 0);
}

#define XB_TMO      128
#define XB_XCNT(j)  (256  + 64 * (j))
#define XB_XSUB(j)  (1280 + 64 * (j))
#define XB_XGEN(j)  (2304 + 64 * (j))
#define XB_TOP      3328
#define XB_TOPGEN   3392
#define XCD_BAR_WORDS 3456
#define XB_SPIN_CAP (1u << 18)
#define LAS __attribute__((address_space(3)))

__device__ __forceinline__ unsigned xb_ld(unsigned* p)              { return __hip_atomic_load(p, __ATOMIC_RELAXED, __HIP_MEMORY_SCOPE_AGENT); }
__device__ __forceinline__ unsigned xb_add(unsigned* p, unsigned v) { return __hip_atomic_fetch_add(p, v, __ATOMIC_RELAXED, __HIP_MEMORY_SCOPE_AGENT); }
__device__ __forceinline__ unsigned xb_xcc_id() { return (unsigned)__builtin_amdgcn_s_getreg((3 << 11) | 20) & 0xFu; }
#define XB_SPIN(cond, bar) do { unsigned _sp = 0; while (cond) { __builtin_amdgcn_s_sleep(1); \
    if ((++_sp & 255u) == 0u) { if (xb_ld(&(bar)[XB_TMO])) break; if (_sp > XB_SPIN_CAP) { atomicAdd(&(bar)[XB_TMO], 1u); break; } } } } while (0)

struct XcdBarrier {
    unsigned* bar; unsigned x;
    volatile LAS unsigned* st;
};

__device__ __forceinline__ XcdBarrier xcd_barrier_post(unsigned* bar, volatile LAS unsigned* st) {
    XcdBarrier b; b.bar = bar; b.x = xb_xcc_id(); b.st = st;
    if (my_tid() == 0) (void)xb_add(&bar[XB_XCNT(b.x)], 1u);
    return b;
}
__device__ __forceinline__ void xcd_barrier_complete(unsigned* bar, unsigned x, unsigned& nloc, unsigned& nx) {
    const unsigned G = gridDim.x * gridDim.y * gridDim.z;
    unsigned sum, cnt, mine, sp = 0u;
    for (;;) {
        sum = 0u; cnt = 0u; mine = 0u;
#pragma unroll
        for (unsigned j = 0; j < 16; ++j) { const unsigned c = xb_ld(&bar[XB_XCNT(j)]); sum += c; cnt += (c > 0u) ? 1u : 0u; mine = (j == x) ? c : mine; }
        if (sum == G) break;
        __builtin_amdgcn_s_sleep(1);
        if ((++sp & 255u) == 0u) { if (xb_ld(&bar[XB_TMO])) break; if (sp > XB_SPIN_CAP) { atomicAdd(&bar[XB_TMO], 1u); break; } }
    }
    nloc = mine > 0u ? mine : 1u; nx = cnt > 0u ? cnt : 1u;
}

__device__ __forceinline__ void xcd_barrier(const XcdBarrier& b) {
    asm volatile("s_waitcnt vmcnt(0)" ::: "memory");
    __syncthreads();
    if (my_tid() == 0) {
        unsigned* bar = b.bar;
        __builtin_amdgcn_s_waitcnt(0);
        unsigned nloc = b.st[0], nx = b.st[1];
        if (nloc == 0u) { xcd_barrier_complete(bar, b.x, nloc, nx); b.st[0] = nloc; b.st[1] = nx; }
        const unsigned old = xb_add(&bar[XB_XSUB(b.x)], 1u);
        const unsigned gen = old / nloc;
        if (old + 1u == (gen + 1u) * nloc) {
            __builtin_amdgcn_fence(__ATOMIC_RELEASE, "agent");
            asm volatile("s_waitcnt vmcnt(0)" ::: "memory");
            const unsigned og = xb_add(&bar[XB_TOP], 1u);
            const unsigned tg = og / nx;
            if (og + 1u == (tg + 1u) * nx) xb_add(&bar[XB_TOPGEN], 1u);
            else XB_SPIN(xb_ld(&bar[XB_TOPGEN]) == tg, bar);
            __builtin_amdgcn_fence(__ATOMIC_ACQUIRE, "agent");
            xb_add(&bar[XB_XGEN(b.x)], 1u);
            asm volatile("s_waitcnt vmcnt(0)" ::: "memory");
        } else {
            XB_SPIN(xb_ld(&bar[XB_XGEN(b.x)]) == gen, bar);
            __builtin_amdgcn_fence(__ATOMIC_ACQUIRE, "agent");
            asm volatile("s_waitcnt vmcnt(0)" ::: "memory");
        }
    }
    __syncthreads();
}


DEV void gsync(unsigned* ctr, unsigned& target) {
  asm volatile("s_waitcnt vmcnt(0)" ::: "memory");
  __syncthreads();
  if (my_tid() == 0) {
    target += gridDim.x;
    __builtin_amdgcn_fence(__ATOMIC_RELEASE, "agent");
    asm volatile("s_waitcnt vmcnt(0)" ::: "memory");
    __hip_atomic_fetch_add(ctr, 1u, __ATOMIC_RELAXED, __HIP_MEMORY_SCOPE_AGENT);
    while (__hip_atomic_load(ctr, __ATOMIC_RELAXED, __HIP_MEMORY_SCOPE_AGENT) < target) __builtin_amdgcn_s_sleep(2);
    __builtin_amdgcn_fence(__ATOMIC_ACQUIRE, "agent");
    asm volatile("s_waitcnt vmcnt(0)" ::: "memory");
  }
  __syncthreads();
}

#if COOP
template <int PH>
DEV void run_seq(const Params& p, unsigned char* smraw, cg::grid_group& grid, const XcdBarrier& xb) {
  if constexpr (phase_empty(PH)) {
    run_seq<PH + 1>(p, smraw, grid, xb);
  } else {
    int bid_ = blockIdx.x;
    asm volatile("" : "+s"(bid_));
    run_phase<PH>(p, smraw, bid_, gridDim.x);
    if constexpr (PH + 1 < NPHASE) {
      if constexpr (PH == 0) grid.sync();
      else xcd_barrier(xb);
      run_seq<PH + 1>(p, smraw, grid, xb);
    }
  }
}
__global__ void __launch_bounds__(NTHR) mega(Params p) {
  __shared__ __align__(16) unsigned char smraw[147456];
  cg::grid_group grid = cg::this_grid();
  __shared__ uint4 xb_words;
  if (my_tid() == 0) xb_words = make_uint4(0u, 0u, 0u, 0u);
  __syncthreads();
  XcdBarrier xb = xcd_barrier_post((unsigned*)p.ws, (volatile LAS unsigned*)&xb_words);
  run_seq<0>(p, smraw, grid, xb);
}
#else
template <int PH>
__global__ void __launch_bounds__(NTHR) phk(Params p) {
  __shared__ __align__(16) unsigned char smraw[147456];
  run_phase<PH>(p, smraw, blockIdx.x, gridDim.x);
}
template <int PH>
static void launch_seq(const Params& p, hipStream_t stream) {
  phk<PH><<<256, NTHR, 0, stream>>>(p);
  if constexpr (PH + 1 < NPHASE) launch_seq<PH + 1>(p, stream);
}
#endif

extern "C" void kernel_launch(void* const* d_in, const int* in_sizes, int n_in, void* d_out, int out_size, void* d_ws,
                              size_t ws_size, hipStream_t stream) {
  Params p{};
  for (int i = 0; i < 26; ++i) p.in[i] = (const float*)d_in[i];
  p.out = (float*)d_out;
  p.ws = (unsigned char*)d_ws;
  if (ws_size < WS_NEED) { fprintf(stderr, "workspace too small: %zu < %llu\n", ws_size, (unsigned long long)WS_NEED); return; }
#if COOP
  static int grid_blocks = 0;
  if (!grid_blocks) {
    int dev = 0, cus = 0, per_cu = 0;
    hipGetDevice(&dev);
    hipDeviceGetAttribute(&cus, hipDeviceAttributeMultiprocessorCount, dev);
    hipOccupancyMaxActiveBlocksPerMultiprocessor(&per_cu, mega, NTHR, 0);
    if (per_cu > 1) per_cu = 1;
    grid_blocks = cus * per_cu;
  }
  hipMemsetAsync(d_ws, 0, 16384, stream);
  void* args[] = {&p};
  hipError_t e = hipLaunchCooperativeKernel((void*)mega, dim3(grid_blocks), dim3(NTHR), args, 0, stream);
  if (e != hipSuccess) fprintf(stderr, "cooperative launch failed: %s (grid %d)\n", hipGetErrorString(e), grid_blocks);
#else
  launch_seq<0>(p, stream);
#endif
}
```
